# Optimizing an MI355X kernel written in HIP

```python
import jax, jax.numpy as jnp
from jax import lax
import numpy as np

D_MODEL = 1024
BATCH = 4
SEQ = 8192
DEPTH = 2

GRID_W = 64
CTX_LEN = 256
N_Q_HEADS = 8
N_KV_HEADS = 2
GQA_GROUP = N_Q_HEADS // N_KV_HEADS
HEAD_DIM = 64
WINDOW = 128
ATT_BLOCK = 128
ROPE_BASE = 10000.0
Q_DIM = N_Q_HEADS * HEAD_DIM
KV_DIM = N_KV_HEADS * HEAD_DIM
SG_GROUPS = 8
SG_HEAD = 64
SG_WIDTH = SG_GROUPS * SG_HEAD
SG_CHUNK = 128
EVEN_IN = Q_DIM + 2 * KV_DIM + 2 * SG_WIDTH
EVEN_MIX = Q_DIM + SG_WIDTH
CONV_WIDTH = D_MODEL
CONV_K = 3
N_GROUPS = 4
EXPERTS_PER_GROUP = 8
N_EXPERTS = N_GROUPS * EXPERTS_PER_GROUP
TOP_K_IN_GROUP = 2
EXPERT_HIDDEN = D_MODEL // 2
MOE_BLOCK = 128
N_EVEN = (DEPTH + 1) // 2
N_ODD = DEPTH // 2
EPS = 1e-6
NEG_INF = -1e30

kernel_name = 'hybrid_diffusion_swa_sgmlp_shortconv_hmoe'


def rms_norm(x, g):
    xf = x.astype(jnp.float32)
    y = xf * lax.rsqrt(jnp.mean(xf * xf, axis=-1, keepdims=True) + EPS)
    return (y * g.astype(jnp.float32)).astype(x.dtype)


def layer_norm(x, g):
    xf = x.astype(jnp.float32)
    mu = jnp.mean(xf, axis=-1, keepdims=True)
    xc = xf - mu
    y = xc * lax.rsqrt(jnp.mean(xc * xc, axis=-1, keepdims=True) + EPS)
    return (y * g.astype(jnp.float32)).astype(x.dtype)


def modulate(h, shift, scale):
    return h * (1 + scale) + shift


def axial_rope_tables(rows, dtype):
    quarter = HEAD_DIM // 4
    row_ids = jnp.repeat(jnp.arange(rows, dtype=jnp.float32), GRID_W)
    col_ids = jnp.tile(jnp.arange(GRID_W, dtype=jnp.float32), rows)
    inv = ROPE_BASE ** (-jnp.arange(quarter, dtype=jnp.float32) / quarter)
    ang_r = row_ids[:, None] * inv
    ang_c = col_ids[:, None] * inv
    return (jnp.cos(ang_r)[:, None, :].astype(dtype), jnp.sin(ang_r)[:, None, :].astype(dtype),
            jnp.cos(ang_c)[:, None, :].astype(dtype), jnp.sin(ang_c)[:, None, :].astype(dtype))


def apply_axial_rope(t, rope):
    cos_r, sin_r, cos_c, sin_c = rope
    half = HEAD_DIM // 2
    quarter = HEAD_DIM // 4

    def rot(u, cos, sin):
        u1, u2 = u[..., :quarter], u[..., quarter:]
        return jnp.concatenate([u1 * cos - u2 * sin, u2 * cos + u1 * sin], axis=-1)

    return jnp.concatenate([rot(t[..., :half], cos_r, sin_r), rot(t[..., half:], cos_c, sin_c)], axis=-1)


def windowed_attention(q, k, v, kc, vc, sink):
    b, s = q.shape[:2]
    nb = s // ATT_BLOCK
    scale = HEAD_DIM ** -0.5
    f32 = jnp.float32
    qb = q.reshape(b, nb, ATT_BLOCK, N_KV_HEADS, GQA_GROUP, HEAD_DIM)

    def band(t):
        tp = jnp.pad(t, ((0, 0), (ATT_BLOCK, ATT_BLOCK), (0, 0), (0, 0)))
        tp = tp.reshape(b, nb + 2, ATT_BLOCK, N_KV_HEADS, HEAD_DIM)
        return jnp.concatenate([tp[:, :-2], tp[:, 1:-1], tp[:, 2:]], axis=2)

    kb, vb = band(k), band(v)
    s_loc = jnp.einsum('bnqhgd,bnkhd->bnhgqk', qb, kb, preferred_element_type=f32) * scale
    s_ctx = jnp.einsum('bnqhgd,bchd->bnhgqc', qb, kc, preferred_element_type=f32) * scale
    qi = jnp.arange(ATT_BLOCK)[:, None]
    kj = jnp.arange(3 * ATT_BLOCK)[None, :]
    in_win = jnp.abs(kj - qi - ATT_BLOCK) <= WINDOW
    kpos = (jnp.arange(nb)[:, None] - 1) * ATT_BLOCK + jnp.arange(3 * ATT_BLOCK)[None, :]
    mask = in_win[None] & ((kpos >= 0) & (kpos < s))[:, None, :]
    s_loc = jnp.where(mask[None, :, None, None], s_loc, NEG_INF)
    sink_l = jnp.broadcast_to(sink.astype(f32).reshape(1, 1, N_KV_HEADS, GQA_GROUP, 1, 1), s_ctx.shape[:-1] + (1,))
    p = jax.nn.softmax(jnp.concatenate([sink_l, s_ctx, s_loc], axis=-1), axis=-1)
    n_ctx = kc.shape[1]
    p_ctx = p[..., 1:1 + n_ctx].astype(vc.dtype)
    p_loc = p[..., 1 + n_ctx:].astype(vb.dtype)
    o = (jnp.einsum('bnhgqc,bchd->bnqhgd', p_ctx, vc)
         + jnp.einsum('bnhgqk,bnkhd->bnqhgd', p_loc, vb))
    return o.reshape(b, s, Q_DIM)


def context_attention(qc, kc, vc, sink):
    b, n = qc.shape[:2]
    f32 = jnp.float32
    qh = qc.reshape(b, n, N_KV_HEADS, GQA_GROUP, HEAD_DIM)
    sc = jnp.einsum('bqhgd,bkhd->bhgqk', qh, kc, preferred_element_type=f32) * (HEAD_DIM ** -0.5)
    sink_c = jnp.broadcast_to(sink.astype(f32).reshape(1, N_KV_HEADS, GQA_GROUP, 1, 1), sc.shape[:-1] + (1,))
    p = jax.nn.softmax(jnp.concatenate([sink_c, sc], axis=-1), axis=-1)
    o = jnp.einsum('bhgqk,bkhd->bqhgd', p[..., 1:].astype(vc.dtype), vc)
    return o.reshape(b, n, Q_DIM)


def spatial_gating(u, z, g_sgu, w_sp, b_sp):
    b, n = u.shape[:2]
    u = jax.nn.gelu(u, approximate=False)
    z = layer_norm(jax.nn.gelu(z, approximate=False), g_sgu)
    zc = z.reshape(b, n // SG_CHUNK, SG_CHUNK, SG_GROUPS, SG_HEAD)
    sgate = jnp.einsum('hij,bnjhc->bnihc', w_sp, zc) + b_sp.T[:, :, None]
    return (u.reshape(zc.shape) * sgate).reshape(b, n, SG_WIDTH)


def even_mixer(h, hc, w_in, sink, g_sgu, w_sp, b_sp, w_out, rope, need_ctx):
    b, s, _ = h.shape
    n_ctx = hc.shape[1]
    q, k, v, u, z = jnp.split(h @ w_in, [Q_DIM, Q_DIM + KV_DIM, Q_DIM + 2 * KV_DIM, Q_DIM + 2 * KV_DIM + SG_WIDTH], axis=-1)
    q = apply_axial_rope(q.reshape(b, s, N_Q_HEADS, HEAD_DIM), rope)
    k = apply_axial_rope(k.reshape(b, s, N_KV_HEADS, HEAD_DIM), rope)
    v = v.reshape(b, s, N_KV_HEADS, HEAD_DIM)
    kc, vc = jnp.split(hc @ w_in[:, Q_DIM:Q_DIM + 2 * KV_DIM], 2, axis=-1)
    kc = kc.reshape(b, n_ctx, N_KV_HEADS, HEAD_DIM)
    vc = vc.reshape(b, n_ctx, N_KV_HEADS, HEAD_DIM)
    att = windowed_attention(q, k, v, kc, vc, sink)
    sg = spatial_gating(u, z, g_sgu, w_sp, b_sp)
    out_lat = jnp.concatenate([att, sg], axis=-1) @ w_out
    if not need_ctx:
        return out_lat, None
    qc = hc @ w_in[:, :Q_DIM]
    uc, zc = jnp.split(hc @ w_in[:, Q_DIM + 2 * KV_DIM:], 2, axis=-1)
    att_c = context_attention(qc, kc, vc, sink)
    sg_c = spatial_gating(uc, zc, g_sgu, w_sp, b_sp)
    return out_lat, jnp.concatenate([att_c, sg_c], axis=-1) @ w_out


def short_conv_mixer(h, w_in, conv_w, w_out):
    bg, cg, xt = jnp.split(h @ w_in, 3, axis=-1)
    y = cg * xt
    yp = jnp.pad(y, ((0, 0), (1, 1), (0, 0)))
    conv = yp[:, :-2] * conv_w[0] + yp[:, 1:-1] * conv_w[1] + yp[:, 2:] * conv_w[2]
    return (bg * conv) @ w_out


def moe_ffn(h, w_rg, b_rg, w_re, b_re, w_gate, w_up, w_down):
    n, d = h.shape
    f32 = jnp.float32
    g_logits = jnp.einsum('nd,dg->ng', h, w_rg, preferred_element_type=f32) + b_rg.astype(f32)
    g_idx = jnp.argmax(g_logits, axis=-1).astype(jnp.int32)
    g_w = jnp.take_along_axis(jax.nn.softmax(g_logits, axis=-1), g_idx[:, None], axis=-1)
    e_logits = (jnp.einsum('nd,de->ne', h, w_re, preferred_element_type=f32) + b_re.astype(f32))
    e_logits = e_logits.reshape(n, N_GROUPS, EXPERTS_PER_GROUP)
    e_sel = jnp.take_along_axis(e_logits, g_idx[:, None, None], axis=1)[:, 0]
    top_v, top_i = lax.top_k(e_sel, TOP_K_IN_GROUP)
    gate = g_w * jax.nn.softmax(top_v, axis=-1)
    expert = g_idx[:, None] * EXPERTS_PER_GROUP + top_i.astype(jnp.int32)
    n_assign = n * TOP_K_IN_GROUP
    flat_e = expert.reshape(-1)
    flat_tok = jnp.repeat(jnp.arange(n, dtype=jnp.int32), TOP_K_IN_GROUP)
    flat_w = gate.reshape(-1).astype(h.dtype)
    order = jnp.argsort(flat_e)
    sorted_e = flat_e[order]
    counts = jnp.bincount(flat_e, length=N_EXPERTS)
    padded = (counts + MOE_BLOCK - 1) // MOE_BLOCK * MOE_BLOCK
    pad_end = jnp.cumsum(padded)
    pad_start = pad_end - padded
    raw_start = jnp.cumsum(counts) - counts
    dest = pad_start[sorted_e] + jnp.arange(n_assign, dtype=pad_start.dtype) - raw_start[sorted_e]
    n_blocks = -(-n_assign // MOE_BLOCK) + N_EXPERTS
    n_rows = n_blocks * MOE_BLOCK
    row_tok = jnp.zeros((n_rows,), jnp.int32).at[dest].set(flat_tok[order])
    row_w = jnp.zeros((n_rows,), h.dtype).at[dest].set(flat_w[order])
    block_e = jnp.clip(jnp.searchsorted(pad_end, jnp.arange(n_blocks, dtype=pad_end.dtype) * MOE_BLOCK, side='right'), 0, N_EXPERTS - 1)
    xb = h[row_tok].reshape(n_blocks, MOE_BLOCK, d)

    def expert_block(args):
        xblk, e = args
        hid = jax.nn.silu(xblk @ w_gate[e]) * (xblk @ w_up[e])
        return hid @ w_down[e]

    yb = lax.map(expert_block, (xb, block_e)).reshape(n_rows, d)
    return jnp.zeros_like(h).at[row_tok].add(yb * row_w[:, None])


def setup_inputs(seed: int = 0) -> dict:
    key = jax.random.key(seed)
    ks = jax.random.split(key, 25)
    D = D_MODEL

    def nrm(k, shape, s):
        return jax.random.normal(k, shape, jnp.float32) * s

    return {
        'x': nrm(ks[0], (BATCH, SEQ, D), 1.0),
        'c': nrm(ks[1], (BATCH, D), 1.0),
        'ctx': nrm(ks[2], (BATCH, CTX_LEN, D), 1.0),
        'c_ctx': nrm(ks[3], (D,), 1.0),
        'w_ada': nrm(ks[4], (DEPTH, D, 6 * D), 0.5 * D ** -0.5),
        'b_ada': nrm(ks[5], (DEPTH, 6 * D), 0.02),
        'g_norm1': 1.0 + nrm(ks[6], (DEPTH, D), 0.1),
        'g_norm2': 1.0 + nrm(ks[7], (DEPTH, D), 0.1),
        'g_final': 1.0 + nrm(ks[8], (D,), 0.1),
        'w_in_even': nrm(ks[9], (N_EVEN, D, EVEN_IN), D ** -0.5),
        'attn_sink': nrm(ks[10], (N_EVEN, N_Q_HEADS), 1.0),
        'g_sgu': 1.0 + nrm(ks[11], (N_EVEN, SG_WIDTH), 0.1),
        'w_spatial': nrm(ks[12], (N_EVEN, SG_GROUPS, SG_CHUNK, SG_CHUNK), SG_CHUNK ** -0.5),
        'b_spatial': 1.0 + nrm(ks[13], (N_EVEN, SG_GROUPS, SG_CHUNK), 0.1),
        'w_out_even': nrm(ks[14], (N_EVEN, EVEN_MIX, D), EVEN_MIX ** -0.5),
        'w_in_odd': nrm(ks[15], (N_ODD, D, 3 * CONV_WIDTH), D ** -0.5),
        'conv_w': nrm(ks[16], (N_ODD, CONV_K, CONV_WIDTH), CONV_K ** -0.5),
        'w_out_odd': nrm(ks[17], (N_ODD, CONV_WIDTH, D), CONV_WIDTH ** -0.5),
        'w_router_group': nrm(ks[18], (DEPTH, D, N_GROUPS), D ** -0.5),
        'b_router_group': nrm(ks[19], (DEPTH, N_GROUPS), 0.01),
        'w_router_expert': nrm(ks[20], (DEPTH, D, N_EXPERTS), D ** -0.5),
        'b_router_expert': nrm(ks[21], (DEPTH, N_EXPERTS), 0.01),
        'w_gate': nrm(ks[22], (DEPTH, N_EXPERTS, D, EXPERT_HIDDEN), D ** -0.5),
        'w_up': nrm(ks[23], (DEPTH, N_EXPERTS, D, EXPERT_HIDDEN), D ** -0.5),
        'w_down': nrm(ks[24], (DEPTH, N_EXPERTS, EXPERT_HIDDEN, D), EXPERT_HIDDEN ** -0.5),
    }


def reference(x, c, ctx, c_ctx, w_ada, b_ada, g_norm1, g_norm2, g_final, w_in_even, attn_sink, g_sgu,
              w_spatial, b_spatial, w_out_even, w_in_odd, conv_w, w_out_odd, w_router_group,
              b_router_group, w_router_expert, b_router_expert, w_gate, w_up, w_down):
    b, s, d = x.shape
    rows = s // GRID_W
    rope = axial_rope_tables(rows, x.dtype)
    silu_c = jax.nn.silu(c)
    silu_cc = jax.nn.silu(c_ctx)
    lat, cx = x, ctx
    for l in range(DEPTH):
        need_ctx = any(j % 2 == 0 for j in range(l + 1, DEPTH))
        m = jnp.split(silu_c @ w_ada[l] + b_ada[l], 6, axis=-1)
        sh1, sc1, g1, sh2, sc2, g2 = [t[:, None, :] for t in m]
        h = modulate(rms_norm(lat, g_norm1[l]), sh1, sc1)
        mix_c = None
        if l % 2 == 0 or need_ctx:
            csh1, csc1, cg1, csh2, csc2, cg2 = jnp.split(silu_cc @ w_ada[l] + b_ada[l], 6, axis=-1)
            hc = modulate(rms_norm(cx, g_norm1[l]), csh1, csc1)
        i = l // 2
        if l % 2 == 0:
            mix, mix_c = even_mixer(h, hc, w_in_even[i], attn_sink[i], g_sgu[i], w_spatial[i],
                                    b_spatial[i], w_out_even[i], rope, need_ctx)
        else:
            mix = short_conv_mixer(h, w_in_odd[i], conv_w[i], w_out_odd[i])
            if need_ctx:
                mix_c = short_conv_mixer(hc, w_in_odd[i], conv_w[i], w_out_odd[i])
        lat = lat + g1 * mix
        h2 = modulate(rms_norm(lat, g_norm2[l]), sh2, sc2)
        lat = lat + g2 * moe_ffn(h2.reshape(-1, d), w_router_group[l], b_router_group[l], w_router_expert[l],
                                 b_router_expert[l], w_gate[l], w_up[l], w_down[l]).reshape(b, s, d)
        if need_ctx:
            cx = cx + cg1 * mix_c
            hc2 = modulate(rms_norm(cx, g_norm2[l]), csh2, csc2)
            cx = cx + cg2 * moe_ffn(hc2.reshape(-1, d), w_router_group[l], b_router_group[l], w_router_expert[l],
                                    b_router_expert[l], w_gate[l], w_up[l], w_down[l]).reshape(cx.shape)
    return rms_norm(lat, g_final)
```

```cpp
#include <hip/hip_runtime.h>
#include <cstdio>
#include <cstdint>
namespace pg8 {
#define PG8_LAS __attribute__((address_space(3)))
typedef unsigned short bf16_t;
typedef short bf16x8 __attribute__((ext_vector_type(8)));
typedef float f32x4 __attribute__((ext_vector_type(4)));
typedef unsigned u32x4 __attribute__((ext_vector_type(4)));
constexpr int BM = 256, BK = 64, HALF = 128, HTB = HALF * BK * 2  , STAGE_BYTES = 8 * HTB, NXCD = 8, WGM = 8;

__host__ __device__ __forceinline__ int lds_byte(int r, int c) { const int st = (r >> 4) * 2 + (c >> 5), rr = r & 15, cc = c & 31, ob = rr * 64 + cc * 2; return st * 1024 + (ob ^ (((ob >> 9) & 1) << 5)); }
__host__ __device__ __forceinline__ void stage_rc(int b, int& R, int& C) { const int st = b / 1024, sb = b % 1024, swz = sb ^ (((sb >> 9) & 1) << 5); R = (st >> 1) * 16 + swz / 64; C = (st & 1) * 32 + (swz % 64) / 2; }
__host__ __device__ __forceinline__ int perm32(int rho) { const int n = rho >> 4, i = rho & 15; return 8 * (i >> 2) + 4 * n + (i & 3); }

struct Unit { int pm, pn; };
struct Gemm { const bf16_t* A; const bf16_t* Bt; int M, N, K; };

struct StaticOrder {
    int nM, nN, nwg, G, c;
    __host__ __device__ void init(int M, int N, int G_, int c_) { nM = M / BM; nN = N / BM; nwg = nM * nN; G = G_; c = c_; }
    __host__ __device__ bool next(int i, Unit& u) const {
        const long L = (long)i * G + c; if (L >= nwg) return false;
        int wgid = (int)L; { const int q = nwg / NXCD, r = nwg % NXCD, xcd = wgid % NXCD, off = wgid / NXCD; wgid = (xcd < r ? xcd * (q + 1) : r * (q + 1) + (xcd - r) * q) + off; }
        const int nig = WGM * nN, gid = wgid / nig, fm = gid * WGM, gsz = (nM - fm) < WGM ? (nM - fm) : WGM;
        u.pm = fm + ((wgid % nig) % gsz); u.pn = (wgid % nig) / gsz; return true;
    }
    __device__ __forceinline__ void a_ready(const Unit&) const {}
    __device__ __forceinline__ void done(const Unit&) const {}
};

__device__ __forceinline__ unsigned cvt_pk_bf16(float lo, float hi) { unsigned r; asm volatile("v_cvt_pk_bf16_f32 %0, %1, %2" : "=v"(r) : "v"(lo), "v"(hi)); return r; }
typedef float f32x2 __attribute__((ext_vector_type(2)));
__device__ __forceinline__ f32x2 gelu_pk(f32x2 v) {
    const f32x2 av = __builtin_elementwise_abs(v), d = av * 0.2316418882f + 1.0f;
    f32x2 t; t.x = __builtin_amdgcn_rcpf(d.x); t.y = __builtin_amdgcn_rcpf(d.y);
    f32x2 q = t * 0.5307027145f + (-0.7265760135f); q = q * t + 0.7107068705f; q = q * t + (-0.142248368f); q = q * t + 0.127414796f; q = q * t;
    const f32x2 s = (v * v) * (-0.72134752044f);
    f32x2 e; e.x = __builtin_amdgcn_exp2f(s.x); e.y = __builtin_amdgcn_exp2f(s.y);
    const f32x2 m = v * (q * e), r = v - m;
    f32x2 o; o.x = v.x < 0.f ? m.x : r.x; o.y = v.y < 0.f ? m.y : r.y; return o;
}

typedef unsigned u32x2 __attribute__((ext_vector_type(2)));
__device__ __forceinline__ int perm16(int x) { return (x & 3) | ((x & 4) << 1) | ((x & 8) >> 1); }
__device__ __forceinline__ bf16_t bf1(float v) { return (bf16_t)(cvt_pk_bf16(v, 0.f) & 0xffffu); }
__device__ __forceinline__ u32x2 pk4(f32x4 v) { u32x2 w; w.x = cvt_pk_bf16(v[0], v[1]); w.y = cvt_pk_bf16(v[2], v[3]); return w; }
__device__ __forceinline__ f32x4 gelu4(f32x4 v) { const f32x2 a = gelu_pk((f32x2){v[0], v[1]}), b = gelu_pk((f32x2){v[2], v[3]}); return (f32x4){a.x, a.y, b.x, b.y}; }
__device__ __forceinline__ float silu1(float g) { return g * __builtin_amdgcn_rcpf(1.0f + __builtin_amdgcn_exp2f(-1.4426950408889634f * g)); }

struct EpiInE {
    static constexpr bool PERM = false, AFTER_DRAIN = false;
    bf16_t* QK; bf16_t* VT; bf16_t* KC; bf16_t* VCT; const float* rc; const float* rs; float qscale;
    __device__ __forceinline__ void operator()(const f32x4 (&acc)[2][2][4][2], const Unit& u, int wr, int wc, int fr, int fq) const {
        const int row0 = u.pm * BM + wr * 64 + fr;
        if (u.pm >= 128) {
#pragma unroll
            for (int ai = 0; ai < 2; ++ai)
#pragma unroll
                for (int m = 0; m < 4; ++m) {
                    const int row = row0 + ai * HALF + m * 16 - 32768, b = row >> 8, j = row & 255, jp = (j & ~15) | perm16(j & 15);
#pragma unroll
                    for (int n = 0; n < 2; ++n) {
                        *(u32x2*)(KC + (size_t)row * 128 + wc * 32 + n * 16 + 4 * fq) = pk4(acc[ai][0][m][n]);
#pragma unroll
                        for (int i = 0; i < 4; ++i) { const int cv = wc * 32 + n * 16 + 4 * fq + i; VCT[((size_t)(b * 2 + (cv >> 6)) * 64 + (cv & 63)) * 256 + jp] = bf1(acc[ai][1][m][n][i]); }
                    }
                }
            return;
        }
        if (u.pn <= 2) {
            const float sc = (u.pn < 2) ? qscale : 1.0f;
#pragma unroll
            for (int ai = 0; ai < 2; ++ai)
#pragma unroll
                for (int m = 0; m < 4; ++m) {
                    const int row = row0 + ai * HALF + m * 16, pos = row & 8191, pidx = (wc & 1) ? (pos & 63) : (pos >> 6);
                    const f32x4 c4 = *(const f32x4*)(rc + pidx * 16 + 4 * fq) * sc, s4 = *(const f32x4*)(rs + pidx * 16 + 4 * fq) * sc;
                    bf16_t* rowp = QK + (size_t)row * 1792 + u.pn * BM + wc * 32 + 4 * fq;
#pragma unroll
                    for (int bj = 0; bj < 2; ++bj) {
                        if (u.pn == 2 && bj == 1) break;
                        const f32x4 v0 = acc[ai][bj][m][0], v1 = acc[ai][bj][m][1];
                        *(u32x2*)(rowp + bj * HALF) = pk4(v0 * c4 - v1 * s4);
                        *(u32x2*)(rowp + bj * HALF + 16) = pk4(v1 * c4 + v0 * s4);
                    }
                    if (u.pn == 2) {
                        const int b = row >> 13, pp = (pos & ~15) | perm16(pos & 15);
#pragma unroll
                        for (int n = 0; n < 2; ++n)
#pragma unroll
                            for (int i = 0; i < 4; ++i) { const int cv = wc * 32 + n * 16 + 4 * fq + i; VT[((size_t)(b * 2 + (cv >> 6)) * 64 + (cv & 63)) * 8192 + pp] = bf1(acc[ai][1][m][n][i]); }
                    }
                }
            return;
        }
#pragma unroll
        for (int ai = 0; ai < 2; ++ai)
#pragma unroll
            for (int m = 0; m < 4; ++m) {
                bf16_t* rowp = QK + (size_t)(row0 + ai * HALF + m * 16) * 1792 + u.pn * BM + wc * 32 + 4 * fq;
#pragma unroll
                for (int bj = 0; bj < 2; ++bj)
#pragma unroll
                    for (int n = 0; n < 2; ++n) *(u32x2*)(rowp + bj * HALF + n * 16) = pk4(gelu4(acc[ai][bj][m][n]));
            }
    }
};
struct EpiRes {
    static constexpr bool PERM = false, AFTER_DRAIN = false;
    const float* base; float* out; const float* gate;
    __device__ __forceinline__ void operator()(const f32x4 (&acc)[2][2][4][2], const Unit& u, int wr, int wc, int fr, int fq) const {
        const int row0 = u.pm * BM + wr * 64 + fr, col0 = u.pn * BM + wc * 32 + 4 * fq, b = u.pm >> 5;
        f32x4 gv[2][2];
#pragma unroll
        for (int bj = 0; bj < 2; ++bj)
#pragma unroll
            for (int n = 0; n < 2; ++n) gv[bj][n] = *(const f32x4*)(gate + (size_t)b * 6144 + col0 + bj * HALF + n * 16);
#pragma unroll
        for (int ai = 0; ai < 2; ++ai)
#pragma unroll
            for (int m = 0; m < 4; ++m) { const size_t off = (size_t)(row0 + ai * HALF + m * 16) * 1024 + col0;
#pragma unroll
                for (int bj = 0; bj < 2; ++bj)
#pragma unroll
                    for (int n = 0; n < 2; ++n) { const f32x4 bs = *(const f32x4*)(base + off + bj * HALF + n * 16); *(f32x4*)(out + off + bj * HALF + n * 16) = bs + gv[bj][n] * acc[ai][bj][m][n]; }
                asm volatile("" ::: "memory"); }
    }
};
struct EpiSwiGLU {
    static constexpr bool PERM = true, AFTER_DRAIN = false;
    bf16_t* HID;
    __device__ __forceinline__ void operator()(const f32x4 (&acc)[2][2][4][2], const Unit& u, int wr, int wc, int fr, int fq) const {
        const int row0 = u.pm * BM + wr * 64 + fr, col0 = (u.pn & 3) * HALF + wc * 32 + 8 * fq;
#pragma unroll
        for (int ai = 0; ai < 2; ++ai)
#pragma unroll
            for (int m = 0; m < 4; ++m) {
                const f32x4 g0 = acc[ai][0][m][0], g1 = acc[ai][0][m][1], u0 = acc[ai][1][m][0], u1 = acc[ai][1][m][1];
                u32x4 w;
                w.x = cvt_pk_bf16(silu1(g0[0]) * u0[0], silu1(g0[1]) * u0[1]); w.y = cvt_pk_bf16(silu1(g0[2]) * u0[2], silu1(g0[3]) * u0[3]);
                w.z = cvt_pk_bf16(silu1(g1[0]) * u1[0], silu1(g1[1]) * u1[1]); w.w = cvt_pk_bf16(silu1(g1[2]) * u1[2], silu1(g1[3]) * u1[3]);
                *(u32x4*)(HID + (size_t)(row0 + ai * HALF + m * 16) * 512 + col0) = w;
            }
    }
};
struct EpiDown {
    static constexpr bool PERM = true, AFTER_DRAIN = false;
    bf16_t* Y;
    __device__ __forceinline__ void operator()(const f32x4 (&acc)[2][2][4][2], const Unit& u, int wr, int wc, int fr, int fq) const {
        const int row0 = u.pm * BM + wr * 64 + fr, col0 = (u.pn & 3) * BM + wc * 32 + 8 * fq;
#pragma unroll
        for (int ai = 0; ai < 2; ++ai)
#pragma unroll
            for (int m = 0; m < 4; ++m) { bf16_t* rowp = Y + (size_t)(row0 + ai * HALF + m * 16) * 1024 + col0;
#pragma unroll
                for (int bj = 0; bj < 2; ++bj) { const f32x4 v0 = acc[ai][bj][m][0], v1 = acc[ai][bj][m][1];
                    u32x4 w; w.x = cvt_pk_bf16(v0[0], v0[1]); w.y = cvt_pk_bf16(v0[2], v0[3]); w.z = cvt_pk_bf16(v1[0], v1[1]); w.w = cvt_pk_bf16(v1[2], v1[3]);
                    *(u32x4*)(rowp + bj * HALF) = w; } }
    }
};
struct EpiInO {
    static constexpr bool PERM = true, AFTER_DRAIN = false;
    bf16_t* BG; bf16_t* Y;
    __device__ __forceinline__ void operator()(const f32x4 (&acc)[2][2][4][2], const Unit& u, int wr, int wc, int fr, int fq) const {
        const int row0 = u.pm * BM + wr * 64 + fr;
        if (u.pn < 8) {
            const int col0 = u.pn * HALF + wc * 32 + 8 * fq;
#pragma unroll
            for (int ai = 0; ai < 2; ++ai)
#pragma unroll
                for (int m = 0; m < 4; ++m) { const f32x4 v0 = acc[ai][0][m][0] * acc[ai][1][m][0], v1 = acc[ai][0][m][1] * acc[ai][1][m][1];
                    u32x4 w; w.x = cvt_pk_bf16(v0[0], v0[1]); w.y = cvt_pk_bf16(v0[2], v0[3]); w.z = cvt_pk_bf16(v1[0], v1[1]); w.w = cvt_pk_bf16(v1[2], v1[3]);
                    *(u32x4*)(Y + (size_t)(row0 + ai * HALF + m * 16) * 1024 + col0) = w; }
        } else {
            const int col0 = (u.pn - 8) * BM + wc * 32 + 8 * fq;
#pragma unroll
            for (int ai = 0; ai < 2; ++ai)
#pragma unroll
                for (int m = 0; m < 4; ++m) { bf16_t* rowp = BG + (size_t)(row0 + ai * HALF + m * 16) * 1024 + col0;
#pragma unroll
                    for (int bj = 0; bj < 2; ++bj) { const f32x4 v0 = acc[ai][bj][m][0], v1 = acc[ai][bj][m][1];
                        u32x4 w; w.x = cvt_pk_bf16(v0[0], v0[1]); w.y = cvt_pk_bf16(v0[2], v0[3]); w.z = cvt_pk_bf16(v1[0], v1[1]); w.w = cvt_pk_bf16(v1[2], v1[3]);
                        *(u32x4*)(rowp + bj * HALF) = w; } }
        }
    }
};
struct InEOrder {
    StaticOrder so; int G, c;
    __device__ __forceinline__ bool next(int i, Unit& u) const {
        const long L = (long)i * G + c;
        if (L < 896) return so.next(i, u);
        if (L < 900) { u.pm = 128 + (int)(L - 896); u.pn = 2; return true; }
        return false;
    }
    __device__ __forceinline__ void a_ready(const Unit&) const {}
    __device__ __forceinline__ void done(const Unit&) const {}
};
struct MoeOrder {
    const PG8_LAS int* tile_e; int nunits, G, c;
    __device__ __forceinline__ bool next(int i, Unit& u) const {
        const long L = (long)i * G + c; if (L >= nunits) return false;
        const int t = (int)(L >> 2); u.pm = t; u.pn = tile_e[t] * 4 + (int)(L & 3); return true;
    }
    __device__ __forceinline__ void a_ready(const Unit&) const {}
    __device__ __forceinline__ void done(const Unit&) const {}
};
template <class Epi, class Sched, bool ALIGN_EPI = false, bool SP2 = false>
__device__ __forceinline__ void gemm_phase(PG8_LAS unsigned char* lds, const Gemm g, const Sched& S, const Epi& E) {
    const int tid = threadIdx.x, wid = __builtin_amdgcn_readfirstlane(tid >> 6), lane = tid & 63, wr = wid >> 2, wc = wid & 3, fr = lane & 15, fq = lane >> 4;
    const int K = g.K, nt = K / BK;
    unsigned voffA[2], voffB[2];
#pragma unroll
    for (int i = 0; i < 2; ++i) { int R, C; stage_rc(tid * 16 + i * 8192, R, C); const int Rb = Epi::PERM ? ((R & ~31) + perm32(R & 31)) : R;
        voffA[i] = (unsigned)(R * K + C) * 2u; voffB[i] = (unsigned)(Rb * K + C) * 2u; }
    const size_t kstep = (size_t)(BK * 2);
    const size_t hstep = (size_t)HALF * K * 2;
    const size_t tstep = 2 * hstep;
    const unsigned ldsw = (unsigned)wid * 1024u;
    const int aoff = lds_byte(wr * 64 + fr, fq * 8), boff = lds_byte(wc * 32 + fr, fq * 8);
#define PG8_SA(b, h) (((b) * 2 + (h)) * HTB)
#define PG8_SB(b, h) ((4 + (b) * 2 + (h)) * HTB)
#define PG8_STAGE(bufoff, gbase, voff) do { _Pragma("unroll") for (int _i = 0; _i < 2; ++_i) \
        __builtin_amdgcn_global_load_lds((const unsigned*)((const char*)(gbase) + (voff)[_i]), (PG8_LAS unsigned*)(lds + (bufoff) + ldsw + _i * 8192), 16, 0, 0); } while (0)
#define PG8_LDA(dst, b, h) do { _Pragma("unroll") for (int m = 0; m < 4; ++m) _Pragma("unroll") for (int k = 0; k < 2; ++k) dst[m][k] = *(const PG8_LAS bf16x8*)(lds + PG8_SA(b, h) + aoff + m * 2048 + k * 1024); } while (0)
#define PG8_LDB(dst, b, h) do { _Pragma("unroll") for (int n = 0; n < 2; ++n) _Pragma("unroll") for (int k = 0; k < 2; ++k) dst[n][k] = *(const PG8_LAS bf16x8*)(lds + PG8_SB(b, h) + boff + n * 2048 + k * 1024); } while (0)
#define PG8_MMA(ai, bj, At, Bt) do { __builtin_amdgcn_s_setprio(1); _Pragma("unroll") for (int m = 0; m < 4; ++m) _Pragma("unroll") for (int n = 0; n < 2; ++n) _Pragma("unroll") for (int k = 0; k < 2; ++k) \
        acc[ai][bj][m][n] = __builtin_amdgcn_mfma_f32_16x16x32_bf16(Bt[n][k], At[m][k], acc[ai][bj][m][n], 0, 0, 0); __builtin_amdgcn_s_setprio(0); } while (0)
#define PG8_WAIT_V(n) asm volatile("s_waitcnt vmcnt(" #n ")" ::: "memory")
#define PG8_WAIT_L(n) asm volatile("s_waitcnt lgkmcnt(" #n ")" ::: "memory")
#define PG8_BAR __builtin_amdgcn_s_barrier()
#define PG8_SCHED __builtin_amdgcn_sched_barrier(0)
    Unit cur, nxt; int ui = 0;
    if (!S.next(0, cur)) return;
    f32x4 acc[2][2][4][2];
#pragma unroll
    for (int a = 0; a < 2; ++a)
#pragma unroll
        for (int b = 0; b < 2; ++b)
#pragma unroll
            for (int m = 0; m < 4; ++m)
#pragma unroll
                for (int n = 0; n < 2; ++n) acc[a][b][m][n] = (f32x4){0.f, 0.f, 0.f, 0.f};
    bf16x8 At[4][2], B0[2][2], B1[2][2];
    const char* cA = (const char*)g.A + (size_t)cur.pm * tstep; const char* cB = (const char*)g.Bt + (size_t)cur.pn * tstep;
    S.a_ready(cur);
    if constexpr (SP2) {
        PG8_STAGE(PG8_SB(0, 0), cB, voffB); PG8_STAGE(PG8_SB(0, 1), cB + hstep, voffB); PG8_STAGE(PG8_SA(0, 0), cA, voffA); PG8_STAGE(PG8_SA(0, 1), cA + hstep, voffA);
        if (wr == 1) PG8_BAR;
        PG8_WAIT_V(2); PG8_BAR;
        PG8_STAGE(PG8_SB(1, 0), cB + kstep, voffB); PG8_STAGE(PG8_SA(1, 0), cA + kstep, voffA); PG8_STAGE(PG8_SB(1, 1), cB + hstep + kstep, voffB);
        PG8_WAIT_V(6); PG8_BAR;
    } else {
        PG8_STAGE(PG8_SB(0, 0), cB, voffB); PG8_STAGE(PG8_SA(0, 0), cA, voffA); PG8_STAGE(PG8_SB(0, 1), cB + hstep, voffB); PG8_STAGE(PG8_SA(0, 1), cA + hstep, voffA);
        if (wr == 1) PG8_BAR;
        PG8_WAIT_V(4); PG8_BAR;
        PG8_STAGE(PG8_SB(1, 0), cB + kstep, voffB); PG8_STAGE(PG8_SA(1, 0), cA + kstep, voffA); PG8_STAGE(PG8_SB(1, 1), cB + hstep + kstep, voffB);
        PG8_WAIT_V(6); PG8_BAR;
    }
    for (;;) {
        const bool has_next = S.next(ui + 1, nxt);
        const char* nA = has_next ? (const char*)g.A + (size_t)nxt.pm * tstep : cA; const char* nB = has_next ? (const char*)g.Bt + (size_t)nxt.pn * tstep : cB;
        for (int t = 0; t < nt; t += 2) {
            const bool last = (t == nt - 2);
            const char* a1 = cA + (size_t)(t + 1) * kstep;
            const char* a2 = last ? nA : cA + (size_t)(t + 2) * kstep; const char* b2 = last ? nB : cB + (size_t)(t + 2) * kstep;
            const char* a3 = a2 + kstep; const char* b3 = b2 + kstep;
            if (last && has_next) S.a_ready(nxt);
            if constexpr (SP2) {
            PG8_LDB(B0, 0, 0); PG8_LDB(B1, 0, 1); PG8_SCHED; PG8_LDA(At, 0, 0); PG8_STAGE(PG8_SA(1, 1), a1 + hstep, voffA);
            PG8_WAIT_V(8); PG8_WAIT_L(0); PG8_BAR; PG8_MMA(0, 0, At, B0); PG8_MMA(0, 1, At, B1); PG8_BAR; PG8_SCHED;
            PG8_LDA(At, 0, 1); PG8_STAGE(PG8_SB(0, 0), b2, voffB); PG8_STAGE(PG8_SB(0, 1), b2 + hstep, voffB); PG8_STAGE(PG8_SA(0, 0), a2, voffA);
            PG8_WAIT_V(8); PG8_WAIT_L(0); PG8_BAR; PG8_MMA(1, 0, At, B0); PG8_MMA(1, 1, At, B1); PG8_BAR; PG8_SCHED;
            PG8_LDB(B0, 1, 0); PG8_LDB(B1, 1, 1); PG8_SCHED; PG8_LDA(At, 1, 0); PG8_STAGE(PG8_SA(0, 1), a2 + hstep, voffA);
            PG8_WAIT_V(8); PG8_WAIT_L(0); PG8_BAR; PG8_MMA(0, 0, At, B0); PG8_MMA(0, 1, At, B1); PG8_BAR; PG8_SCHED;
            PG8_LDA(At, 1, 1); PG8_STAGE(PG8_SB(1, 0), b3, voffB); PG8_STAGE(PG8_SB(1, 1), b3 + hstep, voffB); PG8_STAGE(PG8_SA(1, 0), a3, voffA);
            PG8_WAIT_V(8); PG8_WAIT_L(0); PG8_BAR; PG8_MMA(1, 0, At, B0); PG8_MMA(1, 1, At, B1); PG8_BAR; PG8_SCHED;
            } else {
            PG8_LDB(B0, 0, 0); PG8_SCHED; PG8_LDA(At, 0, 0); PG8_STAGE(PG8_SA(1, 1), a1 + hstep, voffA);
            PG8_WAIT_L(8); PG8_BAR; PG8_WAIT_L(0); PG8_MMA(0, 0, At, B0); PG8_BAR; PG8_SCHED;
            PG8_LDB(B1, 0, 1); PG8_STAGE(PG8_SB(0, 0), b2, voffB);
            PG8_BAR; PG8_WAIT_L(0); PG8_MMA(0, 1, At, B1); PG8_BAR;
            PG8_LDA(At, 0, 1); PG8_STAGE(PG8_SA(0, 0), a2, voffA);
            PG8_BAR; PG8_WAIT_L(0); PG8_MMA(1, 0, At, B0); PG8_BAR; PG8_SCHED;
            PG8_STAGE(PG8_SB(0, 1), b2 + hstep, voffB);
            PG8_WAIT_V(6); PG8_BAR; PG8_MMA(1, 1, At, B1); PG8_BAR;
            PG8_LDB(B0, 1, 0); PG8_SCHED; PG8_LDA(At, 1, 0); PG8_STAGE(PG8_SA(0, 1), a2 + hstep, voffA);
            PG8_WAIT_L(8); PG8_BAR; PG8_WAIT_L(0); PG8_MMA(0, 0, At, B0); PG8_BAR; PG8_SCHED;
            PG8_LDB(B1, 1, 1); PG8_STAGE(PG8_SB(1, 0), b3, voffB);
            PG8_BAR; PG8_WAIT_L(0); PG8_MMA(0, 1, At, B1); PG8_BAR;
            PG8_LDA(At, 1, 1); PG8_STAGE(PG8_SA(1, 0), a3, voffA);
            PG8_BAR; PG8_WAIT_L(0); PG8_MMA(1, 0, At, B0); PG8_BAR; PG8_SCHED;
            PG8_STAGE(PG8_SB(1, 1), b3 + hstep, voffB);
            PG8_WAIT_V(6); PG8_BAR; PG8_MMA(1, 1, At, B1); PG8_BAR;
            }
        }
        if constexpr (ALIGN_EPI) { if (wr == 0) PG8_BAR; }
        if constexpr (!Epi::AFTER_DRAIN) { E(acc, cur, wr, wc, fr, fq); S.done(cur); }
        if (!has_next) break;
#pragma unroll
        for (int a = 0; a < 2; ++a)
#pragma unroll
            for (int b = 0; b < 2; ++b)
#pragma unroll
                for (int m = 0; m < 4; ++m)
#pragma unroll
                    for (int n = 0; n < 2; ++n) acc[a][b][m][n] = (f32x4){0.f, 0.f, 0.f, 0.f};
        cur = nxt; cA = nA; cB = nB; ++ui;
        if constexpr (ALIGN_EPI) { if (wr == 1) PG8_BAR; }
    }
    PG8_WAIT_V(0);
    if constexpr (!ALIGN_EPI) { if (wr == 0) PG8_BAR; }
    PG8_BAR;
    if constexpr (Epi::AFTER_DRAIN) { E.fused(acc, cur, wr, wc, fr, fq, lds, wid, lane); S.done(cur); }
#undef PG8_SA
#undef PG8_SB
#undef PG8_STAGE
#undef PG8_LDA
#undef PG8_LDB
#undef PG8_MMA
#undef PG8_WAIT_V
#undef PG8_WAIT_L
#undef PG8_BAR
#undef PG8_SCHED
}
}
constexpr int NWAVES = 8;
constexpr int BATCH = 4, SEQ = 8192, D = 1024, M = BATCH * SEQ, CTXL = 256, MC = BATCH * CTXL;
constexpr int NINE = 1792, NEXP = 32, EH = 512;
constexpr float EPS = 1e-6f;
constexpr int N_PHASES = 18;
#ifndef MK_ONE_LAUNCH
#define MK_ONE_LAUNCH 1
#endif
constexpr size_t MiB = 1u << 20;
constexpr size_t WS_CTL = 0, CTL_ZERO_BYTES = 1 * MiB;
constexpr size_t WS_MOD = 1 * MiB;
constexpr size_t WS_MODC = WS_MOD + 2 * 4 * 6144 * 4;
constexpr size_t WS_ROPE = 1 * MiB + 256 * 1024;
constexpr size_t WS_WSP = 1 * MiB + 512 * 1024;
constexpr size_t WS_TOKE = 2 * MiB;
constexpr size_t WS_TOKP = 2 * MiB + 256 * 1024;
constexpr size_t WS_TOKW = 2 * MiB + 512 * 1024;
constexpr size_t WS_TOKS = 2 * MiB + 768 * 1024;
constexpr size_t WS_KC = 3 * MiB;
constexpr size_t WS_VCT = 3 * MiB + 256 * 1024;
constexpr size_t WS_VT = 4 * MiB;
constexpr size_t WS_WINE = 12 * MiB, WS_WOUTE = 16 * MiB, WS_WINO = 18 * MiB, WS_WOUTO = 24 * MiB;
constexpr size_t WS_WGU = 26 * MiB;
constexpr size_t WS_WD = 154 * MiB;
constexpr size_t WS_H = 218 * MiB;
constexpr size_t WS_A = 284 * MiB;
constexpr size_t WS_B = 428 * MiB;
constexpr size_t WS_END = 500 * MiB;
constexpr int CW_TMO = 0, CW_CODE = 1, CW_BAR = 4096, CW_GCNT = 8192;

constexpr int RING_BYTES = 131072;
constexpr int LDS_BYTES = 155648;
constexpr int MISC_OFF = LDS_BYTES - 256;
constexpr int MOE_TAB_OFF = RING_BYTES;
constexpr int RT_WR = 0, RT_CNT = 147456, RT_BASE = RT_CNT + 128, RT_INFO = RT_CNT + 256;
static_assert(RT_INFO + 128 * 6 * 4 <= MISC_OFF, "LDS map");

#define GAS __attribute__((address_space(1)))
#define LAS __attribute__((address_space(3)))
typedef unsigned short bf16;
typedef unsigned v4u __attribute__((ext_vector_type(4)));
typedef unsigned v2u __attribute__((ext_vector_type(2)));
typedef float f32x4 __attribute__((ext_vector_type(4)));
typedef float f32x16 __attribute__((ext_vector_type(16)));
typedef short bf16x8 __attribute__((ext_vector_type(8)));
typedef GAS unsigned gu32;
#define RLX_AGENT __ATOMIC_RELAXED, __HIP_MEMORY_SCOPE_AGENT
#define LDS_WAIT() asm volatile("s_waitcnt lgkmcnt(0)" ::: "memory")
__device__ __forceinline__ unsigned f2bf(float f) { unsigned u = __builtin_bit_cast(unsigned, f); return (u + 0x7fffu + ((u >> 16) & 1u)) >> 16; }
__device__ __forceinline__ unsigned pk2(float lo, float hi) { return f2bf(lo) | (f2bf(hi) << 16); }
__device__ __forceinline__ float bflo(unsigned w) { return __builtin_bit_cast(float, w << 16); }
__device__ __forceinline__ float bfhi(unsigned w) { return __builtin_bit_cast(float, w & 0xffff0000u); }
__device__ __forceinline__ float wave_sum(float v) {
#pragma unroll
    for (int o = 1; o < 64; o <<= 1) v += __shfl_xor(v, o);
    return v;
}
#define XB_TMO      128
#define XB_XCNT(j)  (256  + 64 * (j))
#define XB_XSUB(j)  (1280 + 64 * (j))
#define XB_XGEN(j)  (2304 + 64 * (j))
#define XB_TOP      3328
#define XB_TOPGEN   3392
#define XCD_BAR_WORDS 3456
#define XB_SPIN_CAP (1u << 18)

__device__ __forceinline__ unsigned xb_ld(unsigned* p)              { return __hip_atomic_load(p, __ATOMIC_RELAXED, __HIP_MEMORY_SCOPE_AGENT); }
__device__ __forceinline__ unsigned xb_add(unsigned* p, unsigned v) { return __hip_atomic_fetch_add(p, v, __ATOMIC_RELAXED, __HIP_MEMORY_SCOPE_AGENT); }
__device__ __forceinline__ unsigned xb_xcc_id() { return (unsigned)__builtin_amdgcn_s_getreg((3 << 11) | 20) & 0xFu; }
#define XB_SPIN(cond, bar) do { unsigned _sp = 0; while (cond) { __builtin_amdgcn_s_sleep(1); \
    if ((++_sp & 255u) == 0u) { if (xb_ld(&(bar)[XB_TMO])) break; if (_sp > XB_SPIN_CAP) { atomicAdd(&(bar)[XB_TMO], 1u); break; } } } } while (0)

struct XcdBarrier {
    unsigned* bar; unsigned x;
    volatile LAS unsigned* st;
};

__device__ __forceinline__ XcdBarrier xcd_barrier_post(unsigned* bar, volatile LAS unsigned* st) {
    XcdBarrier b; b.bar = bar; b.x = xb_xcc_id(); b.st = st;
    if (threadIdx.x == 0) (void)xb_add(&bar[XB_XCNT(b.x)], 1u);
    return b;
}
__device__ __forceinline__ void xcd_barrier_complete(unsigned* bar, unsigned x, unsigned& nloc, unsigned& nx) {
    const unsigned G = gridDim.x * gridDim.y * gridDim.z;
    unsigned sum, cnt, mine, sp = 0u;
    for (;;) {
        sum = 0u; cnt = 0u; mine = 0u;
#pragma unroll
        for (unsigned j = 0; j < 16; ++j) { const unsigned c = xb_ld(&bar[XB_XCNT(j)]); sum += c; cnt += (c > 0u) ? 1u : 0u; mine = (j == x) ? c : mine; }
        if (sum == G) break;
        __builtin_amdgcn_s_sleep(1);
        if ((++sp & 255u) == 0u) { if (xb_ld(&bar[XB_TMO])) break; if (sp > XB_SPIN_CAP) { atomicAdd(&bar[XB_TMO], 1u); break; } }
    }
    nloc = mine > 0u ? mine : 1u; nx = cnt > 0u ? cnt : 1u;
}

__device__ __forceinline__ void xcd_barrier(const XcdBarrier& b) {
    asm volatile("s_waitcnt vmcnt(0)" ::: "memory");
    __syncthreads();
    if (threadIdx.x == 0) {
        unsigned* bar = b.bar;
        __builtin_amdgcn_s_waitcnt(0);
        unsigned nloc = b.st[0], nx = b.st[1];
        if (nloc == 0u) { xcd_barrier_complete(bar, b.x, nloc, nx); b.st[0] = nloc; b.st[1] = nx; }
        const unsigned old = xb_add(&bar[XB_XSUB(b.x)], 1u);
        const unsigned gen = old / nloc;
        if (old + 1u == (gen + 1u) * nloc) {
            __builtin_amdgcn_fence(__ATOMIC_RELEASE, "agent");
            asm volatile("s_waitcnt vmcnt(0)" ::: "memory");
            const unsigned og = xb_add(&bar[XB_TOP], 1u);
            const unsigned tg = og / nx;
            if (og + 1u == (tg + 1u) * nx) xb_add(&bar[XB_TOPGEN], 1u);
            else XB_SPIN(xb_ld(&bar[XB_TOPGEN]) == tg, bar);
            __builtin_amdgcn_fence(__ATOMIC_ACQUIRE, "agent");
            xb_add(&bar[XB_XGEN(b.x)], 1u);
            asm volatile("s_waitcnt vmcnt(0)" ::: "memory");
        } else {
            XB_SPIN(xb_ld(&bar[XB_XGEN(b.x)]) == gen, bar);
            __builtin_amdgcn_fence(__ATOMIC_ACQUIRE, "agent");
            asm volatile("s_waitcnt vmcnt(0)" ::: "memory");
        }
    }
    __syncthreads();
}

struct Ctx {
    LAS unsigned char* lds; unsigned ldsaddr;
    int tid, lane, wave, G, bid;
    const float* in[25]; float* out; unsigned char* ws; gu32* ctl;
};
__device__ const float ROPE_INV[16] = {1.000000000e+00f, 5.623413324e-01f, 3.162277639e-01f, 1.778279394e-01f, 1.000000015e-01f, 5.623413250e-02f, 3.162277490e-02f, 1.778279431e-02f,
                                       9.999999776e-03f, 5.623413250e-03f, 3.162277630e-03f, 1.778279431e-03f, 1.000000047e-03f, 5.623413017e-04f, 3.162277571e-04f, 1.778279402e-04f};

__device__ __forceinline__ void transpose_item(const float* W, int K, int N, bf16* WT, int k0, int n0, int drow0, LAS float* scr, int lane) {
#pragma unroll 8
    for (int i = 0; i < 32; ++i) { const int kk = 2 * i + (lane >> 5); scr[kk * 33 + (lane & 31)] = W[(size_t)(k0 + kk) * N + n0 + (lane & 31)]; }
    LDS_WAIT(); asm volatile("" ::: "memory");
    const int c = lane & 7;
#pragma unroll
    for (int j = 0; j < 4; ++j) { const int n = (lane >> 3) + 8 * j; const LAS float* s = scr + (8 * c) * 33 + n;
        v4u o; o.x = pk2(s[0 * 33], s[1 * 33]); o.y = pk2(s[2 * 33], s[3 * 33]); o.z = pk2(s[4 * 33], s[5 * 33]); o.w = pk2(s[6 * 33], s[7 * 33]);
        *(GAS v4u*)(WT + (size_t)(drow0 + n) * K + k0 + 8 * c) = o; }
    LDS_WAIT(); asm volatile("" ::: "memory");
}
__device__ __forceinline__ void sincos_acc(float a, float& s, float& c) {
    const double x = (double)a, kf = __builtin_rint(x * 0.63661977236758134308), r = x - kf * 1.57079632679489661923, r2 = r * r;
    const double sp = r * (1.0 + r2 * (-1.0 / 6 + r2 * (1.0 / 120 + r2 * (-1.0 / 5040 + r2 * (1.0 / 362880 + r2 * (-1.0 / 39916800 + r2 * (1.0 / 6227020800.0)))))));
    const double cp = 1.0 + r2 * (-0.5 + r2 * (1.0 / 24 + r2 * (-1.0 / 720 + r2 * (1.0 / 40320 + r2 * (-1.0 / 3628800 + r2 * (1.0 / 479001600 + r2 * (-1.0 / 87178291200.0)))))));
    const int k = (int)kf & 3;
    s = (float)((k == 0) ? sp : (k == 1) ? cp : (k == 2) ? -sp : -cp);
    c = (float)((k == 0) ? cp : (k == 1) ? -sp : (k == 2) ? -cp : sp);
}
__device__ __forceinline__ void adaln_unit(const Ctx& C, int u) {
    const int l = u / 96, col = (u % 96) * 64 + C.lane;
    LAS float* sil = (LAS float*)C.lds; LAS float* red = (LAS float*)(C.lds + 5 * 1024 * 4);
    for (int idx = C.tid; idx < 5120; idx += NWAVES * 64) { const float v = (idx < 4096) ? C.in[1][idx] : C.in[3][idx - 4096]; sil[idx] = v / (1.0f + __expf(-v)); }
    __syncthreads();
    float acc[5] = {0.f, 0.f, 0.f, 0.f, 0.f};
    const int k0 = C.wave * 128; const float* wp = C.in[4] + (size_t)l * 1024 * 6144 + (size_t)k0 * 6144 + col;
#pragma unroll 8
    for (int kk = 0; kk < 128; ++kk) { const float w = wp[(size_t)kk * 6144];
#pragma unroll
        for (int v = 0; v < 5; ++v) acc[v] += sil[v * 1024 + k0 + kk] * w; }
#pragma unroll
    for (int v = 0; v < 5; ++v) red[(C.wave * 5 + v) * 64 + C.lane] = acc[v];
    __syncthreads();
    if (C.wave == 0) {
        float* MOD = (float*)(C.ws + WS_MOD); float* MODC = (float*)(C.ws + WS_MODC); const float bias = C.in[5][l * 6144 + col];
#pragma unroll
        for (int v = 0; v < 5; ++v) { float s = 0.f;
#pragma unroll
            for (int w = 0; w < NWAVES; ++w) s += red[(w * 5 + v) * 64 + C.lane];
            s += bias;
            if (v < 4) MOD[(size_t)(l * 4 + v) * 6144 + col] = s; else if (l == 0) MODC[col] = s; }
    }
    __syncthreads();
}
__device__ __forceinline__ void p0_prologue(const Ctx& C) {
    for (int u = C.bid; u < 192; u += C.G) adaln_unit(C, u);
    LAS float* scr = (LAS float*)(C.lds + C.wave * 16384);
    const int gw = C.bid * NWAVES + C.wave, NGW = C.G * NWAVES;
    constexpr int NDENSE = 896 + 512 + 1536 + 512, NITEMS = NDENSE + 64 * 768;
    for (int it = gw; it < NITEMS; it += NGW) {
        int r = it;
        if (r < 896) { transpose_item(C.in[9], 1024, 1792, (bf16*)(C.ws + WS_WINE), 64 * (r / 56), 32 * (r % 56), 32 * (r % 56), scr, C.lane); continue; } r -= 896;
        if (r < 512) { transpose_item(C.in[14], 1024, 1024, (bf16*)(C.ws + WS_WOUTE), 64 * (r / 32), 32 * (r % 32), 32 * (r % 32), scr, C.lane); continue; } r -= 512;
        if (r < 1536) { const int n0 = 32 * (r % 96), j = n0 & 1023;
            const int drow = (n0 < 1024) ? 2048 + n0 : 256 * (j >> 7) + (j & 127) + ((n0 >= 2048) ? 128 : 0);
            transpose_item(C.in[15], 1024, 3072, (bf16*)(C.ws + WS_WINO), 64 * (r / 96), n0, drow, scr, C.lane); continue; } r -= 1536;
        if (r < 512) { transpose_item(C.in[17], 1024, 1024, (bf16*)(C.ws + WS_WOUTO), 64 * (r / 32), 32 * (r % 32), 32 * (r % 32), scr, C.lane); continue; } r -= 512;
        const int me = r / 768, q = r % 768, which = q >> 8, s = q & 255;
        if (which < 2) { const int j = 32 * (s & 15);
            transpose_item((which ? C.in[23] : C.in[22]) + (size_t)me * 1024 * 512, 1024, 512, (bf16*)(C.ws + WS_WGU) + (size_t)me * 1024 * 1024, 64 * (s >> 4), j, 256 * (j >> 7) + (j & 127) + 128 * which, scr, C.lane);
        } else transpose_item(C.in[24] + (size_t)me * 512 * 1024, 512, 1024, (bf16*)(C.ws + WS_WD) + (size_t)me * 1024 * 512, 64 * (s >> 5), 32 * (s & 31), 32 * (s & 31), scr, C.lane);
    }
    for (int it = gw; it < 256; it += NGW) {
        const f32x4* src = (const f32x4*)(C.in[12] + (size_t)it * 512) + 2 * C.lane; const f32x4 a = src[0], b = src[1];
        v4u o; o.x = pk2(a.x, a.y); o.y = pk2(a.z, a.w); o.z = pk2(b.x, b.y); o.w = pk2(b.z, b.w);
        *(v4u*)((bf16*)(C.ws + WS_WSP) + (size_t)it * 512 + 8 * C.lane) = o;
    }
    { const int gt = gw * 64 + C.lane;
        if (gt < 2048) { float s, c; sincos_acc((float)(gt >> 4) * ROPE_INV[gt & 15], s, c); ((float*)(C.ws + WS_ROPE))[gt] = c; ((float*)(C.ws + WS_ROPE))[2048 + gt] = s; } }
}

__device__ __forceinline__ void load_mod(const float* gam, const float* shp, const float* scp, int lane, f32x4 (&sc)[4], f32x4 (&sh)[4]) {
#pragma unroll
    for (int j = 0; j < 4; ++j) { const int idx = lane + 64 * j; const f32x4 g = ((const f32x4*)gam)[idx], s = ((const f32x4*)scp)[idx]; sc[j] = g * (1.0f + s); sh[j] = ((const f32x4*)shp)[idx]; }
}
__device__ __forceinline__ float row_rinv(const f32x4 (&v)[4]) {
    float ss = 0.f;
#pragma unroll
    for (int j = 0; j < 4; ++j) ss += (v[j].x * v[j].x + v[j].y * v[j].y) + (v[j].z * v[j].z + v[j].w * v[j].w);
    return rsqrtf(wave_sum(ss) * (1.0f / 1024.0f) + EPS);
}
__device__ __forceinline__ void mod_store(const f32x4 (&v)[4], float rinv, const f32x4 (&sc)[4], const f32x4 (&sh)[4], bf16* orow, int lane) {
#pragma unroll
    for (int j = 0; j < 4; ++j) { const f32x4 o = v[j] * rinv * sc[j] + sh[j]; v2u w; w.x = pk2(o.x, o.y); w.y = pk2(o.z, o.w); ((v2u*)orow)[lane + 64 * j] = w; }
}
__device__ __forceinline__ void phase_norm1_l0(const Ctx& C) {
    const int gw = C.bid * NWAVES + C.wave, NGW = C.G * NWAVES;
    const float* MOD = (const float*)(C.ws + WS_MOD); const float* MODC = (const float*)(C.ws + WS_MODC); bf16* H = (bf16*)(C.ws + WS_H);
    for (int grp = gw; grp < (M + MC) / 16; grp += NGW) {
        f32x4 sc[4], sh[4]; const float* src;
        if (grp < M / 16) { const float* mod = MOD + (size_t)(grp >> 9) * 6144; load_mod(C.in[6], mod, mod + 1024, C.lane, sc, sh); src = C.in[0] + (size_t)grp * 16 * D; }
        else { load_mod(C.in[6], MODC, MODC + 1024, C.lane, sc, sh); src = C.in[2] + (size_t)(grp - M / 16) * 16 * D; }
        bf16* dst = H + (size_t)grp * 16 * D;
#pragma unroll 2
        for (int r = 0; r < 16; ++r) { f32x4 v[4];
#pragma unroll
            for (int j = 0; j < 4; ++j) v[j] = ((const f32x4*)(src + (size_t)r * D))[C.lane + 64 * j];
            mod_store(v, row_rinv(v), sc, sh, dst + (size_t)r * D, C.lane); }
    }
}
template <int N, int OFF> __device__ __forceinline__ float rs_reduce(const float (&a)[N], int lane) {
    if constexpr (N == 1) return a[0];
    else { float t[N / 2]; const bool up = (lane & OFF) != 0;
#pragma unroll
        for (int i = 0; i < N / 2; ++i) { const float send = up ? a[i] : a[i + N / 2], keep = up ? a[i + N / 2] : a[i]; t[i] = keep + __shfl_xor(send, OFF); }
        return rs_reduce<N / 2, OFF / 2>(t, lane); }
}
__device__ __forceinline__ void phase_router(const Ctx& C, int l) {
    LAS float* WR = (LAS float*)(C.lds + RT_WR); LAS int* cnt = (LAS int*)(C.lds + RT_CNT); LAS int* base = (LAS int*)(C.lds + RT_BASE); LAS int* info = (LAS int*)(C.lds + RT_INFO);
    const float* wrg = C.in[18] + l * 4096; const float* wre = C.in[20] + l * 32768; const float* brg = C.in[19] + l * 4; const float* bre = C.in[21] + l * 32;
    for (int idx = C.tid; idx < 9216; idx += NWAVES * 64) { const int k = idx / 9, q = idx - 9 * k;
        const f32x4 v = (q == 0) ? *(const f32x4*)(wrg + 4 * k) : *(const f32x4*)(wre + 32 * k + 4 * (q - 1)); const int o0 = 4 * q;
        WR[(o0 + 0) * 1024 + k] = v.x; WR[(o0 + 1) * 1024 + k] = v.y; WR[(o0 + 2) * 1024 + k] = v.z; WR[(o0 + 3) * 1024 + k] = v.w; }
    if (C.tid < 32) cnt[C.tid] = 0;
    __syncthreads();
    const float* MOD = (const float*)(C.ws + WS_MOD); bf16* H = (bf16*)(C.ws + WS_H);
    gu32* gcnt = C.ctl + CW_GCNT + l * 32;
    int* TOKE = (int*)(C.ws + WS_TOKE); int* TOKP = (int*)(C.ws + WS_TOKP); float* TOKW = (float*)(C.ws + WS_TOKW);
    for (int rb = C.bid; rb < M / 128; rb += C.G) {
        f32x4 sc[4], sh[4]; { const float* mod = MOD + (size_t)(l * 4 + (rb >> 6)) * 6144; load_mod(C.in[7] + l * 1024, mod + 3 * 1024, mod + 4 * 1024, C.lane, sc, sh); }
        for (int p = 0; p < 8; ++p) {
            const int rl = C.wave * 16 + 2 * p; const size_t r0 = (size_t)rb * 128 + rl;
            f32x4 h0[4], h1[4];
#pragma unroll
            for (int j = 0; j < 4; ++j) { h0[j] = ((const f32x4*)(C.out + r0 * D))[C.lane + 64 * j]; h1[j] = ((const f32x4*)(C.out + (r0 + 1) * D))[C.lane + 64 * j]; }
            const float ri0 = row_rinv(h0), ri1 = row_rinv(h1);
#pragma unroll
            for (int j = 0; j < 4; ++j) { h0[j] = h0[j] * ri0 * sc[j] + sh[j]; h1[j] = h1[j] * ri1 * sc[j] + sh[j];
                v2u w; w.x = pk2(h0[j].x, h0[j].y); w.y = pk2(h0[j].z, h0[j].w); ((v2u*)(H + r0 * D))[C.lane + 64 * j] = w;
                w.x = pk2(h1[j].x, h1[j].y); w.y = pk2(h1[j].z, h1[j].w); ((v2u*)(H + (r0 + 1) * D))[C.lane + 64 * j] = w; }
            float ae[64], ag[8];
#pragma unroll
            for (int o = 0; o < 36; ++o) { float d0 = 0.f, d1 = 0.f;
#pragma unroll
                for (int j = 0; j < 4; ++j) { const f32x4 w = *(const LAS f32x4*)(WR + o * 1024 + 4 * (C.lane + 64 * j));
                    d0 += (h0[j].x * w.x + h0[j].y * w.y) + (h0[j].z * w.z + h0[j].w * w.w); d1 += (h1[j].x * w.x + h1[j].y * w.y) + (h1[j].z * w.z + h1[j].w * w.w); }
                if (o < 4) { ag[o] = d0; ag[4 + o] = d1; } else { ae[o - 4] = d0; ae[32 + o - 4] = d1; } }
            const float etot = rs_reduce<64, 32>(ae, C.lane); float gtot = rs_reduce<8, 32>(ag, C.lane);
            gtot += __shfl_xor(gtot, 4); gtot += __shfl_xor(gtot, 2); gtot += __shfl_xor(gtot, 1);
            const int hb = C.lane & 32;
            float gl[4];
#pragma unroll
            for (int gi = 0; gi < 4; ++gi) gl[gi] = __shfl(gtot, hb + 8 * gi) + brg[gi];
            int gidx = 0; float gmax = gl[0];
#pragma unroll
            for (int gi = 1; gi < 4; ++gi) if (gl[gi] > gmax) { gmax = gl[gi]; gidx = gi; }
            float den = 0.f;
#pragma unroll
            for (int gi = 0; gi < 4; ++gi) den += __expf(gl[gi] - gmax);
            const float gwt = 1.0f / den, eb = etot + bre[C.lane & 31];
            float ev[8];
#pragma unroll
            for (int j = 0; j < 8; ++j) ev[j] = __shfl(eb, hb + gidx * 8 + j);
            int i0 = 0; float v0 = ev[0];
#pragma unroll
            for (int j = 1; j < 8; ++j) if (ev[j] > v0) { v0 = ev[j]; i0 = j; }
            int i1 = (i0 == 0) ? 1 : 0; float v1 = (i0 == 0) ? ev[1] : ev[0];
#pragma unroll
            for (int j = 1; j < 8; ++j) if (j != i0 && ev[j] > v1) { v1 = ev[j]; i1 = j; }
            const float t = __expf(v1 - v0), p0 = 1.0f / (1.0f + t), p1 = t * p0;
            if ((C.lane & 31) == 0) { const int rr = rl + (C.lane >> 5), e0 = gidx * 8 + i0, e1 = gidx * 8 + i1;
                const int pl0 = __hip_atomic_fetch_add(cnt + e0, 1, __ATOMIC_RELAXED, __HIP_MEMORY_SCOPE_WORKGROUP), pl1 = __hip_atomic_fetch_add(cnt + e1, 1, __ATOMIC_RELAXED, __HIP_MEMORY_SCOPE_WORKGROUP);
                info[rr * 6 + 0] = e0; info[rr * 6 + 1] = e1; info[rr * 6 + 2] = pl0; info[rr * 6 + 3] = pl1;
                info[rr * 6 + 4] = __builtin_bit_cast(int, gwt * p0); info[rr * 6 + 5] = __builtin_bit_cast(int, gwt * p1); }
        }
        __syncthreads();
        if (C.tid < 32) base[C.tid] = (int)__hip_atomic_fetch_add(gcnt + C.tid, (unsigned)cnt[C.tid], RLX_AGENT);
        __syncthreads();
        if (C.tid < 128) { const size_t row = (size_t)rb * 128 + C.tid; const int e0 = info[C.tid * 6], e1 = info[C.tid * 6 + 1];
            TOKE[row] = e0 | (e1 << 8); TOKP[row * 2] = base[e0] + info[C.tid * 6 + 2]; TOKP[row * 2 + 1] = base[e1] + info[C.tid * 6 + 3];
            TOKW[row * 2] = __builtin_bit_cast(float, info[C.tid * 6 + 4]); TOKW[row * 2 + 1] = __builtin_bit_cast(float, info[C.tid * 6 + 5]); }
        __syncthreads();
        if (C.tid < 32) cnt[C.tid] = 0;
        __syncthreads();
    }
}
__device__ __forceinline__ int moe_tables(const Ctx& C, int l) {
    LAS int* tile_e = (LAS int*)(C.lds + MOE_TAB_OFF); LAS int* seg = (LAS int*)(C.lds + MOE_TAB_OFF + 1280); LAS int* lc = (LAS int*)(C.lds + MOE_TAB_OFF + 1280 + 160);
    if (C.tid < 32) lc[C.tid] = (int)__hip_atomic_load(C.ctl + CW_GCNT + l * 32 + C.tid, RLX_AGENT);
    __syncthreads();
    if (C.tid == 0) { int t = 0;
        for (int e = 0; e < 32; ++e) { seg[e] = t * 256; const int n = (lc[e] + 255) >> 8; for (int k = 0; k < n; ++k) tile_e[t + k] = e; t += n; }
        seg[32] = t * 256; }
    __syncthreads();
    return seg[32] >> 8;
}
__device__ __forceinline__ void phase_scatter(const Ctx& C, int l) {
    (void)moe_tables(C, l);
    const LAS int* seg = (const LAS int*)(C.lds + MOE_TAB_OFF + 1280);
    const int gw = C.bid * NWAVES + C.wave, NGW = C.G * NWAVES;
    const int* TOKE = (const int*)(C.ws + WS_TOKE); const int* TOKP = (const int*)(C.ws + WS_TOKP); int* TOKS = (int*)(C.ws + WS_TOKS);
    const bf16* H = (const bf16*)(C.ws + WS_H); bf16* XS = (bf16*)(C.ws + WS_A);
    for (int grp = gw; grp < M / 16; grp += NGW) {
#pragma unroll 4
        for (int r = 0; r < 16; ++r) { const size_t row = (size_t)grp * 16 + r; const int ee = TOKE[row];
            const int s0 = seg[ee & 255] + TOKP[row * 2], s1 = seg[ee >> 8] + TOKP[row * 2 + 1];
            const v4u a = ((const v4u*)(H + row * D))[C.lane], b = ((const v4u*)(H + row * D))[C.lane + 64];
            ((v4u*)(XS + (size_t)s0 * D))[C.lane] = a; ((v4u*)(XS + (size_t)s0 * D))[C.lane + 64] = b;
            ((v4u*)(XS + (size_t)s1 * D))[C.lane] = a; ((v4u*)(XS + (size_t)s1 * D))[C.lane + 64] = b;
            if (C.lane == 0) { TOKS[row * 2] = s0; TOKS[row * 2 + 1] = s1; } }
    }
}
template <bool FINAL> __device__ __forceinline__ void phase_combine(const Ctx& C, int lp) {
    const int gw = C.bid * NWAVES + C.wave, NGW = C.G * NWAVES;
    const float* MOD = (const float*)(C.ws + WS_MOD); bf16* H = (bf16*)(C.ws + WS_H); const bf16* YB = (const bf16*)(C.ws + WS_A);
    const int* TOKS = (const int*)(C.ws + WS_TOKS); const float* TOKW = (const float*)(C.ws + WS_TOKW);
    for (int grp = gw; grp < M / 16; grp += NGW) {
        const int b = grp >> 9; f32x4 g2[4], sc[4], sh[4];
#pragma unroll
        for (int j = 0; j < 4; ++j) g2[j] = ((const f32x4*)(MOD + (size_t)(lp * 4 + b) * 6144 + 5 * 1024))[C.lane + 64 * j];
        if (FINAL) {
#pragma unroll
            for (int j = 0; j < 4; ++j) { sc[j] = ((const f32x4*)C.in[8])[C.lane + 64 * j]; sh[j] = (f32x4){0.f, 0.f, 0.f, 0.f}; }
        } else { const float* mod = MOD + (size_t)(4 + b) * 6144; load_mod(C.in[6] + 1024, mod, mod + 1024, C.lane, sc, sh); }
#pragma unroll 2
        for (int r = 0; r < 16; ++r) { const size_t row = (size_t)grp * 16 + r;
            const int s0 = TOKS[row * 2], s1 = TOKS[row * 2 + 1]; const float w0 = TOKW[row * 2], w1 = TOKW[row * 2 + 1];
            f32x4 v[4];
#pragma unroll
            for (int j = 0; j < 4; ++j) { v[j] = ((const f32x4*)(C.out + row * D))[C.lane + 64 * j];
                const v2u a = ((const v2u*)(YB + (size_t)s0 * D))[C.lane + 64 * j], c = ((const v2u*)(YB + (size_t)s1 * D))[C.lane + 64 * j];
                const f32x4 y0 = (f32x4){bflo(a.x), bfhi(a.x), bflo(a.y), bfhi(a.y)}, y1 = (f32x4){bflo(c.x), bfhi(c.x), bflo(c.y), bfhi(c.y)};
                v[j] = v[j] + g2[j] * (y0 * w0 + y1 * w1); }
            const float rinv = row_rinv(v);
            if (FINAL) {
#pragma unroll
                for (int j = 0; j < 4; ++j) ((f32x4*)(C.out + row * D))[C.lane + 64 * j] = v[j] * rinv * sc[j];
            } else {
#pragma unroll
                for (int j = 0; j < 4; ++j) ((f32x4*)(C.out + row * D))[C.lane + 64 * j] = v[j];
                mod_store(v, rinv, sc, sh, H + row * D, C.lane); }
        }
    }
}
__device__ __forceinline__ void unpack8(const v4u w, float (&f)[8]) { f[0] = bflo(w.x); f[1] = bfhi(w.x); f[2] = bflo(w.y); f[3] = bfhi(w.y); f[4] = bflo(w.z); f[5] = bfhi(w.z); f[6] = bflo(w.w); f[7] = bfhi(w.w); }
__device__ __forceinline__ void phase_conv(const Ctx& C) {
    const int gw = C.bid * NWAVES + C.wave, NGW = C.G * NWAVES;
    const bf16* BG = (const bf16*)(C.ws + WS_A); const bf16* Y = BG + (size_t)M * D; bf16* MIX = (bf16*)(C.ws + WS_B);
    float cw[3][2][8];
#pragma unroll
    for (int t = 0; t < 3; ++t)
#pragma unroll
        for (int j = 0; j < 2; ++j) { const f32x4 a = *(const f32x4*)(C.in[16] + t * 1024 + j * 512 + 8 * C.lane), b = *(const f32x4*)(C.in[16] + t * 1024 + j * 512 + 8 * C.lane + 4);
            cw[t][j][0] = a.x; cw[t][j][1] = a.y; cw[t][j][2] = a.z; cw[t][j][3] = a.w; cw[t][j][4] = b.x; cw[t][j][5] = b.y; cw[t][j][6] = b.z; cw[t][j][7] = b.w; }
    const v4u zero4 = (v4u){0u, 0u, 0u, 0u};
    for (int grp = gw; grp < M / 16; grp += NGW) {
        const size_t t0 = (size_t)grp * 16; v4u prev[2], cur[2], nxt[2];
#pragma unroll
        for (int j = 0; j < 2; ++j) { prev[j] = ((t0 & 8191) == 0) ? zero4 : ((const v4u*)(Y + (t0 - 1) * D))[C.lane + 64 * j]; cur[j] = ((const v4u*)(Y + t0 * D))[C.lane + 64 * j]; }
#pragma unroll 2
        for (int r = 0; r < 16; ++r) { const size_t row = t0 + r; const bool last = (row & 8191) == 8191;
#pragma unroll
            for (int j = 0; j < 2; ++j) { nxt[j] = last ? zero4 : ((const v4u*)(Y + (row + 1) * D))[C.lane + 64 * j];
                const v4u bgw = ((const v4u*)(BG + row * D))[C.lane + 64 * j];
                float fp[8], fc[8], fn[8], fb[8], o[8]; unpack8(prev[j], fp); unpack8(cur[j], fc); unpack8(nxt[j], fn); unpack8(bgw, fb);
#pragma unroll
                for (int e = 0; e < 8; ++e) o[e] = fb[e] * (fp[e] * cw[0][j][e] + fc[e] * cw[1][j][e] + fn[e] * cw[2][j][e]);
                v4u w; w.x = pk2(o[0], o[1]); w.y = pk2(o[2], o[3]); w.z = pk2(o[4], o[5]); w.w = pk2(o[6], o[7]);
                ((v4u*)(MIX + row * D))[C.lane + 64 * j] = w; prev[j] = cur[j]; cur[j] = nxt[j]; }
        }
    }
}
constexpr float LOG2E = 1.4426950408889634f;
constexpr float QSCALE = 0.125f * LOG2E;
constexpr int AT_K = 0, AT_V = 16384, AT_WS = 32768, AT_ST = 34816;
__device__ __forceinline__ int crow(int r, int hi) { return (r & 3) + 8 * (r >> 2) + 4 * hi; }
__device__ __forceinline__ bf16x8 pack8(float a0, float a1, float a2, float a3, float a4, float a5, float a6, float a7) {
    v4u w; w.x = pg8::cvt_pk_bf16(a0, a1); w.y = pg8::cvt_pk_bf16(a2, a3); w.z = pg8::cvt_pk_bf16(a4, a5); w.w = pg8::cvt_pk_bf16(a6, a7); return __builtin_bit_cast(bf16x8, w);
}
__device__ __forceinline__ void attn_unit(const Ctx& C, int au) {
    const int qblk = au & 127, kvh = (au >> 7) & 1, b = au >> 8;
    const int ph = C.wave & 1, head = kvh * 4 + (C.wave >> 1), q32 = C.lane & 31, hi = C.lane >> 5;
    const bf16* QK = (const bf16*)(C.ws + WS_A); const bf16* VT = (const bf16*)(C.ws + WS_VT); const bf16* KC = (const bf16*)(C.ws + WS_KC); const bf16* VCT = (const bf16*)(C.ws + WS_VCT);
    bf16* MIX = (bf16*)(C.ws + WS_B);
    const size_t qrow = (size_t)b * SEQ + 64 * qblk + 32 * ph + q32;
    bf16x8 qf[4];
#pragma unroll
    for (int ds = 0; ds < 4; ++ds) qf[ds] = *(const bf16x8*)(QK + qrow * NINE + head * 64 + 16 * ds + 8 * hi);
    float m = C.in[10][head] * LOG2E, l = (hi == 0) ? 1.0f : 0.0f;
    f32x16 o0, o1;
#pragma unroll
    for (int r = 0; r < 16; ++r) { o0[r] = 0.f; o1[r] = 0.f; }
    const int jlo = (qblk < 2) ? 2 - qblk : 0, jhi = (qblk > 125) ? 129 - qblk : 4, NT = 4 + jhi - jlo + 1;
    const int prow = C.tid >> 3, pch = C.tid & 7;
    LAS float* wsf = (LAS float*)(C.lds + AT_WS) + C.wave * 64;
    v4u kreg, vreg;
#define AT_LOAD(t) do { if ((t) < 4) { kreg = *(const v4u*)(KC + ((size_t)(b * 256 + 64 * (t) + prow) * 128 + kvh * 64 + 8 * pch)); \
            vreg = *(const v4u*)(VCT + ((size_t)((b * 2 + kvh) * 64 + prow) * 256 + 64 * (t) + 8 * pch)); } \
        else { const int kblk_ = qblk - 2 + jlo + (t) - 4; kreg = *(const v4u*)(QK + ((size_t)(b * SEQ + 64 * kblk_ + prow) * NINE + 512 + kvh * 64 + 8 * pch)); \
            vreg = *(const v4u*)(VT + ((size_t)((b * 2 + kvh) * 64 + prow) * SEQ + 64 * kblk_ + 8 * pch)); } } while (0)
    AT_LOAD(0);
    for (int t = 0; t < NT; ++t) {
        const int buf = t & 1;
        *(LAS v4u*)(C.lds + AT_K + buf * 8192 + pch * 1024 + prow * 16) = kreg;
        *(LAS v4u*)(C.lds + AT_V + buf * 8192 + pch * 1024 + prow * 16) = vreg;
        if (t + 1 < NT) AT_LOAD(t + 1);
        __syncthreads();
        const LAS unsigned char* kb = C.lds + AT_K + buf * 8192; const LAS unsigned char* vb = C.lds + AT_V + buf * 8192;
        f32x16 p0, p1;
#pragma unroll
        for (int r = 0; r < 16; ++r) { p0[r] = 0.f; p1[r] = 0.f; }
#pragma unroll
        for (int ds = 0; ds < 4; ++ds) {
            const bf16x8 a0 = *(const LAS bf16x8*)(kb + (2 * ds + hi) * 1024 + q32 * 16), a1 = *(const LAS bf16x8*)(kb + (2 * ds + hi) * 1024 + (q32 + 32) * 16);
            p0 = __builtin_amdgcn_mfma_f32_32x32x16_bf16(a0, qf[ds], p0, 0, 0, 0); p1 = __builtin_amdgcn_mfma_f32_32x32x16_bf16(a1, qf[ds], p1, 0, 0, 0);
        }
        const int j = (t < 4) ? -1 : jlo + t - 4;
        if (j == 0 || j == 4) {
            int qq = 32 * ph + q32; asm volatile("" : "+v"(qq));
#pragma unroll
            for (int r = 0; r < 16; ++r) { const int kv = crow(r, hi);
                const bool d0 = (j == 0) ? (kv < qq) : (kv > qq), d1 = (j == 0) ? (kv + 32 < qq) : (kv + 32 > qq);
                if (d0) p0[r] = -__builtin_inff(); if (d1) p1[r] = -__builtin_inff(); }
        }
        float rm = fmaxf(p0[0], p1[0]);
#pragma unroll
        for (int r = 1; r < 16; ++r) rm = fmaxf(rm, fmaxf(p0[r], p1[r]));
        rm = fmaxf(rm, __shfl_xor(rm, 32));
        if (__any(rm > m)) {
            const float mn = fmaxf(m, rm), al = __builtin_amdgcn_exp2f(m - mn); m = mn; l *= al;
            if (hi == 0) wsf[q32] = al;
#pragma unroll
            for (int r = 0; r < 16; ++r) { const float f = wsf[crow(r, hi)]; o0[r] *= f; o1[r] *= f; }
        }
        float ls = 0.f;
#pragma unroll
        for (int r = 0; r < 16; ++r) { p0[r] = __builtin_amdgcn_exp2f(p0[r] - m); p1[r] = __builtin_amdgcn_exp2f(p1[r] - m); ls += p0[r] + p1[r]; }
        l += ls;
#pragma unroll
        for (int s = 0; s < 2; ++s) {
            const bf16x8 pa = pack8(p0[8 * s], p0[8 * s + 1], p0[8 * s + 2], p0[8 * s + 3], p0[8 * s + 4], p0[8 * s + 5], p0[8 * s + 6], p0[8 * s + 7]);
            const bf16x8 pb = pack8(p1[8 * s], p1[8 * s + 1], p1[8 * s + 2], p1[8 * s + 3], p1[8 * s + 4], p1[8 * s + 5], p1[8 * s + 6], p1[8 * s + 7]);
            const bf16x8 va0 = *(const LAS bf16x8*)(vb + (2 * s + hi) * 1024 + q32 * 16), va1 = *(const LAS bf16x8*)(vb + (2 * s + hi) * 1024 + (q32 + 32) * 16);
            const bf16x8 vb0 = *(const LAS bf16x8*)(vb + (4 + 2 * s + hi) * 1024 + q32 * 16), vb1 = *(const LAS bf16x8*)(vb + (4 + 2 * s + hi) * 1024 + (q32 + 32) * 16);
            o0 = __builtin_amdgcn_mfma_f32_32x32x16_bf16(pa, va0, o0, 0, 0, 0); o1 = __builtin_amdgcn_mfma_f32_32x32x16_bf16(pa, va1, o1, 0, 0, 0);
            o0 = __builtin_amdgcn_mfma_f32_32x32x16_bf16(pb, vb0, o0, 0, 0, 0); o1 = __builtin_amdgcn_mfma_f32_32x32x16_bf16(pb, vb1, o1, 0, 0, 0);
        }
    }
#undef AT_LOAD
    l += __shfl_xor(l, 32);
    if (hi == 0) wsf[32 + q32] = l;
    LAS bf16* stg = (LAS bf16*)(C.lds + AT_ST) + C.wave * 2048;
#pragma unroll
    for (int r = 0; r < 16; ++r) { const int orow = crow(r, hi); const float rl = 1.0f / wsf[32 + orow];
        stg[orow * 64 + q32] = (bf16)f2bf(o0[r] * rl); stg[orow * 64 + 32 + q32] = (bf16)f2bf(o1[r] * rl); }
    bf16* Ow = MIX + ((size_t)b * SEQ + 64 * qblk + 32 * ph) * D + head * 64;
#pragma unroll
    for (int i = 0; i < 4; ++i) { const int pc = i * 64 + C.lane, row = pc >> 3, ch = pc & 7; const v4u v = *(const LAS v4u*)(stg + row * 64 + ch * 8); *(v4u*)(Ow + (size_t)row * D + ch * 8) = v; }
    __syncthreads();
}
constexpr int ZS = 1040;
__device__ __forceinline__ v2u tr_read(unsigned addr) { v2u r; asm volatile("ds_read_b64_tr_b16 %0, %1\n\ts_waitcnt lgkmcnt(0)" : "=&v"(r) : "v"(addr) : "memory"); return r; }
__device__ __forceinline__ void sgu_unit(const Ctx& C, int su) {
    const size_t R0 = (size_t)su * 128;
    const bf16* QK = (const bf16*)(C.ws + WS_A); bf16* MIX = (bf16*)(C.ws + WS_B); const bf16* WSP = (const bf16*)(C.ws + WS_WSP);
    { float gs[8]; const f32x4 a = *(const f32x4*)(C.in[11] + 8 * C.lane), c = *(const f32x4*)(C.in[11] + 8 * C.lane + 4);
        gs[0] = a.x; gs[1] = a.y; gs[2] = a.z; gs[3] = a.w; gs[4] = c.x; gs[5] = c.y; gs[6] = c.z; gs[7] = c.w;
#pragma unroll 4
        for (int rr = 0; rr < 16; ++rr) { const int j = C.wave * 16 + rr;
            const v4u zw = *(const v4u*)(QK + (R0 + j) * NINE + 1280 + 8 * C.lane); float x[8]; unpack8(zw, x);
            float s = 0.f;
#pragma unroll
            for (int e = 0; e < 8; ++e) s += x[e];
            const float mean = wave_sum(s) * (1.0f / 512.0f); float q = 0.f;
#pragma unroll
            for (int e = 0; e < 8; ++e) { x[e] -= mean; q += x[e] * x[e]; }
            const float rstd = rsqrtf(wave_sum(q) * (1.0f / 512.0f) + EPS);
            v4u w; w.x = pk2(x[0] * rstd * gs[0], x[1] * rstd * gs[1]); w.y = pk2(x[2] * rstd * gs[2], x[3] * rstd * gs[3]);
            w.z = pk2(x[4] * rstd * gs[4], x[5] * rstd * gs[5]); w.w = pk2(x[6] * rstd * gs[6], x[7] * rstd * gs[7]);
            *(LAS v4u*)(C.lds + j * ZS + 16 * C.lane) = w; }
    }
    __syncthreads();
    const int h = C.wave, l31 = C.lane & 31, hi = C.lane >> 5, g16 = (C.lane >> 4) & 1, q4 = (C.lane & 15) >> 2, p4 = C.lane & 3;
    f32x16 acc[2][4];
#pragma unroll
    for (int cb = 0; cb < 2; ++cb)
#pragma unroll
        for (int ib = 0; ib < 4; ++ib)
#pragma unroll
            for (int r = 0; r < 16; ++r) acc[cb][ib][r] = 0.f;
#pragma unroll 2
    for (int ks = 0; ks < 8; ++ks) {
        bf16x8 bw[4];
#pragma unroll
        for (int ib = 0; ib < 4; ++ib) bw[ib] = *(const bf16x8*)(WSP + ((size_t)h * 128 + 32 * ib + l31) * 128 + 16 * ks + 8 * hi);
        bf16x8 az[2];
#pragma unroll
        for (int cb = 0; cb < 2; ++cb) {
            const unsigned a0 = C.ldsaddr + (unsigned)((16 * ks + 8 * hi + q4) * ZS + (64 * h + 32 * cb + 16 * g16 + 4 * p4) * 2);
            const v2u lo = tr_read(a0), hi2 = tr_read(a0 + 4 * ZS);
            az[cb] = __builtin_bit_cast(bf16x8, (v4u){lo.x, lo.y, hi2.x, hi2.y});
        }
#pragma unroll
        for (int cb = 0; cb < 2; ++cb)
#pragma unroll
            for (int ib = 0; ib < 4; ++ib) acc[cb][ib] = __builtin_amdgcn_mfma_f32_32x32x16_bf16(az[cb], bw[ib], acc[cb][ib], 0, 0, 0);
    }
#pragma unroll
    for (int ib = 0; ib < 4; ++ib) {
        const int i = 32 * ib + l31; const float bias = C.in[13][h * 128 + i]; const size_t row = R0 + i;
#pragma unroll
        for (int cb = 0; cb < 2; ++cb)
#pragma unroll
            for (int rg = 0; rg < 4; ++rg) { const int c = 64 * h + 32 * cb + 8 * rg + 4 * hi;
                const v2u uw = *(const v2u*)(QK + row * NINE + 768 + c);
                const float o0 = bflo(uw.x) * (acc[cb][ib][4 * rg] + bias), o1 = bfhi(uw.x) * (acc[cb][ib][4 * rg + 1] + bias), o2 = bflo(uw.y) * (acc[cb][ib][4 * rg + 2] + bias), o3 = bfhi(uw.y) * (acc[cb][ib][4 * rg + 3] + bias);
                v2u w; w.x = pk2(o0, o1); w.y = pk2(o2, o3); *(v2u*)(MIX + row * D + 512 + c) = w; }
    }
    __syncthreads();
}
__device__ __forceinline__ void phase_attn_sgu(const Ctx& C) {
    for (int au = C.bid; au < BATCH * 2 * 128; au += C.G) attn_unit(C, au);
    for (int su = C.bid; su < M / 128; su += C.G) sgu_unit(C, su);
}
struct Args { const float* in[25]; float* out; unsigned char* ws; int ph_lo, ph_hi; };
__global__ void __launch_bounds__(NWAVES * 64, 2) mk_fwd(Args args) {
    extern __shared__ __attribute__((aligned(16))) unsigned char lds_raw[];
    Ctx C;
    C.lds = (LAS unsigned char*)lds_raw; C.ldsaddr = (unsigned)(uintptr_t)C.lds;
    C.tid = threadIdx.x; C.lane = C.tid & 63; C.wave = __builtin_amdgcn_readfirstlane(C.tid >> 6);
    C.G = gridDim.x; C.bid = blockIdx.x;
#pragma unroll
    for (int i = 0; i < 25; ++i) C.in[i] = args.in[i];
    C.out = args.out; C.ws = args.ws; C.ctl = (gu32*)(args.ws + WS_CTL);
    volatile LAS unsigned* MISC = (volatile LAS unsigned*)(C.lds + MISC_OFF);
    if (C.tid < 64) MISC[C.tid] = 0u;
    __syncthreads();
    const int lo = args.ph_lo, hi = args.ph_hi;
    const bool one = (hi - lo) > 1;
    XcdBarrier bar; bar.bar = (unsigned*)(C.ctl + CW_BAR); bar.x = 0; bar.st = nullptr;
    if (one) bar = xcd_barrier_post((unsigned*)(C.ctl + CW_BAR), MISC + 8);
#ifndef PHMASK
#define PHMASK 0x3ffff
#endif
#define IN(k) (((PHMASK >> (k)) & 1) && lo <= (k) && (k) < hi)
#define SEAM(k) do { if (IN(k) && IN((k) + 1)) xcd_barrier(bar); } while (0)
    bf16* const H = (bf16*)(C.ws + WS_H); bf16* const RA = (bf16*)(C.ws + WS_A); bf16* const RB = (bf16*)(C.ws + WS_B);
    const float* const MOD = (const float*)(C.ws + WS_MOD);

    if (IN(0)) { p0_prologue(C); } SEAM(0);
    if (IN(1)) { phase_norm1_l0(C); } SEAM(1);
    if (IN(2)) {
        pg8::Gemm g{H, (const bf16*)(C.ws + WS_WINE), M, NINE, D}; pg8::InEOrder S; S.so.init(M, NINE, C.G, C.bid); S.G = C.G; S.c = C.bid;
        pg8::EpiInE E{RA, (bf16*)(C.ws + WS_VT), (bf16*)(C.ws + WS_KC), (bf16*)(C.ws + WS_VCT), (const float*)(C.ws + WS_ROPE), (const float*)(C.ws + WS_ROPE) + 2048, QSCALE};
        pg8::gemm_phase<pg8::EpiInE, pg8::InEOrder, true, true>(C.lds, g, S, E);
    } SEAM(2);
    if (IN(3)) { phase_attn_sgu(C); } SEAM(3);
    if (IN(4)) {
        pg8::Gemm g{RB, (const bf16*)(C.ws + WS_WOUTE), M, D, D}; pg8::StaticOrder S; S.init(M, D, C.G, C.bid);
        pg8::EpiRes E{C.in[0], C.out, MOD + 2 * 1024};
        pg8::gemm_phase<pg8::EpiRes, pg8::StaticOrder, true, true>(C.lds, g, S, E);
    } SEAM(4);
    if (IN(5)) { phase_router(C, 0); } SEAM(5);
    if (IN(6)) { phase_scatter(C, 0); } SEAM(6);
    if (IN(7)) {
        const int nt = moe_tables(C, 0);
        pg8::Gemm g{RA, (const bf16*)(C.ws + WS_WGU), nt * 256, NEXP * 1024, D}; pg8::MoeOrder S{(const LAS int*)(C.lds + MOE_TAB_OFF), nt * 4, C.G, C.bid};
        pg8::EpiSwiGLU E{RB};
        pg8::gemm_phase<pg8::EpiSwiGLU, pg8::MoeOrder, true, true>(C.lds, g, S, E);
    } SEAM(7);
    if (IN(8)) {
        const int nt = moe_tables(C, 0);
        pg8::Gemm g{RB, (const bf16*)(C.ws + WS_WD), nt * 256, NEXP * 1024, EH}; pg8::MoeOrder S{(const LAS int*)(C.lds + MOE_TAB_OFF), nt * 4, C.G, C.bid};
        pg8::EpiDown E{RA};
        pg8::gemm_phase<pg8::EpiDown, pg8::MoeOrder, true, true>(C.lds, g, S, E);
    } SEAM(8);
    if (IN(9)) { phase_combine<false>(C, 0); } SEAM(9);
    if (IN(10)) {
        pg8::Gemm g{H, (const bf16*)(C.ws + WS_WINO), M, 3072, D}; pg8::StaticOrder S; S.init(M, 3072, C.G, C.bid);
        pg8::EpiInO E{RA, RA + (size_t)M * D};
        pg8::gemm_phase<pg8::EpiInO, pg8::StaticOrder, true, true>(C.lds, g, S, E);
    } SEAM(10);
    if (IN(11)) { phase_conv(C); } SEAM(11);
    if (IN(12)) {
        pg8::Gemm g{RB, (const bf16*)(C.ws + WS_WOUTO), M, D, D}; pg8::StaticOrder S; S.init(M, D, C.G, C.bid);
        pg8::EpiRes E{C.out, C.out, MOD + (size_t)4 * 6144 + 2 * 1024};
        pg8::gemm_phase<pg8::EpiRes, pg8::StaticOrder, true, true>(C.lds, g, S, E);
    } SEAM(12);
    if (IN(13)) { phase_router(C, 1); } SEAM(13);
    if (IN(14)) { phase_scatter(C, 1); } SEAM(14);
    if (IN(15)) {
        const int nt = moe_tables(C, 1);
        pg8::Gemm g{RA, (const bf16*)(C.ws + WS_WGU) + (size_t)NEXP * 1024 * 1024, nt * 256, NEXP * 1024, D}; pg8::MoeOrder S{(const LAS int*)(C.lds + MOE_TAB_OFF), nt * 4, C.G, C.bid};
        pg8::EpiSwiGLU E{RB};
        pg8::gemm_phase<pg8::EpiSwiGLU, pg8::MoeOrder, true, true>(C.lds, g, S, E);
    } SEAM(15);
    if (IN(16)) {
        const int nt = moe_tables(C, 1);
        pg8::Gemm g{RB, (const bf16*)(C.ws + WS_WD) + (size_t)NEXP * 1024 * 512, nt * 256, NEXP * 1024, EH}; pg8::MoeOrder S{(const LAS int*)(C.lds + MOE_TAB_OFF), nt * 4, C.G, C.bid};
        pg8::EpiDown E{RA};
        pg8::gemm_phase<pg8::EpiDown, pg8::MoeOrder, true, true>(C.lds, g, S, E);
    } SEAM(16);
    if (IN(17)) { phase_combine<true>(C, 1); }
#undef IN
#undef SEAM
}

extern "C" void kernel_launch(void* const* d_in, const int* in_sizes, int n_in, void* d_out, int out_size, void* d_ws, size_t ws_size, hipStream_t stream) {
    static int grid = 0;
    if (grid == 0) {
        if (n_in != 25 || in_sizes[0] != M * D || out_size != M * D || ws_size < WS_END) { fprintf(stderr, "kernel_launch: unexpected shapes (n_in %d, in0 %d, out %d, ws %zu)\n", n_in, n_in > 0 ? in_sizes[0] : -1, out_size, ws_size); grid = -1; return; }
        int dev = 0, cus = 0, per_cu = 0;
        if (hipGetDevice(&dev) != hipSuccess || hipDeviceGetAttribute(&cus, hipDeviceAttributeMultiprocessorCount, dev) != hipSuccess) { grid = -1; return; }
        if (hipFuncSetAttribute((const void*)mk_fwd, hipFuncAttributeMaxDynamicSharedMemorySize, LDS_BYTES) != hipSuccess) { fprintf(stderr, "kernel_launch: hipFuncSetAttribute failed\n"); grid = -1; return; }
        if (hipOccupancyMaxActiveBlocksPerMultiprocessor(&per_cu, (const void*)mk_fwd, NWAVES * 64, LDS_BYTES) != hipSuccess || per_cu < 1) { fprintf(stderr, "kernel_launch: occupancy query says %d\n", per_cu); }
        (void)hipGetLastError();
        grid = cus;
    }
    if (grid < 0) return;
    if (hipMemsetAsync((char*)d_ws + WS_CTL, 0, CTL_ZERO_BYTES, stream) != hipSuccess) return;
    Args a{};
    for (int i = 0; i < 25; ++i) a.in[i] = (const float*)d_in[i];
    a.out = (float*)d_out; a.ws = (unsigned char*)d_ws;
#if MK_ONE_LAUNCH
    a.ph_lo = 0; a.ph_hi = N_PHASES;
    hipLaunchKernelGGL(mk_fwd, dim3(grid), dim3(NWAVES * 64), LDS_BYTES, stream, a);
#else
    for (int p = 0; p < N_PHASES; ++p) { a.ph_lo = p; a.ph_hi = p + 1; hipLaunchKernelGGL(mk_fwd, dim3(grid), dim3(NWAVES * 64), LDS_BYTES, stream, a); }
#endif
}
```

```cpp
#include <hip/hip_runtime.h>
#include <cstdio>
#include <cstdint>
namespace pg8 {
#define PG8_LAS __attribute__((address_space(3)))
typedef unsigned short bf16_t;
typedef short bf16x8 __attribute__((ext_vector_type(8)));
typedef float f32x4 __attribute__((ext_vector_type(4)));
typedef unsigned u32x4 __attribute__((ext_vector_type(4)));
constexpr int BM = 256, BK = 64, HALF = 128, HTB = HALF * BK * 2  , STAGE_BYTES = 8 * HTB, NXCD = 8, WGM = 8;

__host__ __device__ __forceinline__ int lds_byte(int r, int c) { const int st = (r >> 4) * 2 + (c >> 5), rr = r & 15, cc = c & 31, ob = rr * 64 + cc * 2; return st * 1024 + (ob ^ (((ob >> 9) & 1) << 5)); }
__host__ __device__ __forceinline__ void stage_rc(int b, int& R, int& C) { const int st = b / 1024, sb = b % 1024, swz = sb ^ (((sb >> 9) & 1) << 5); R = (st >> 1) * 16 + swz / 64; C = (st & 1) * 32 + (swz % 64) / 2; }
__host__ __device__ __forceinline__ int perm32(int rho) { const int n = rho >> 4, i = rho & 15; return 8 * (i >> 2) + 4 * n + (i & 3); }

struct Unit { int pm, pn; };
struct Gemm { const bf16_t* A; const bf16_t* Bt; int M, N, K; };

struct StaticOrder {
    int nM, nN, nwg, G, c;
    __host__ __device__ void init(int M, int N, int G_, int c_) { nM = M / BM; nN = N / BM; nwg = nM * nN; G = G_; c = c_; }
    __host__ __device__ bool next(int i, Unit& u) const {
        const long L = (long)i * G + c; if (L >= nwg) return false;
        int wgid = (int)L; { const int q = nwg / NXCD, r = nwg % NXCD, xcd = wgid % NXCD, off = wgid / NXCD; wgid = (xcd < r ? xcd * (q + 1) : r * (q + 1) + (xcd - r) * q) + off; }
        const int nig = WGM * nN, gid = wgid / nig, fm = gid * WGM, gsz = (nM - fm) < WGM ? (nM - fm) : WGM;
        u.pm = fm + ((wgid % nig) % gsz); u.pn = (wgid % nig) / gsz; return true;
    }
    __device__ __forceinline__ void a_ready(const Unit&) const {}
    __device__ __forceinline__ void done(const Unit&) const {}
};

__device__ __forceinline__ unsigned cvt_pk_bf16(float lo, float hi) { unsigned r; asm volatile("v_cvt_pk_bf16_f32 %0, %1, %2" : "=v"(r) : "v"(lo), "v"(hi)); return r; }
typedef float f32x2 __attribute__((ext_vector_type(2)));
__device__ __forceinline__ f32x2 gelu_pk(f32x2 v) {
    const f32x2 av = __builtin_elementwise_abs(v), d = av * 0.2316418882f + 1.0f;
    f32x2 t; t.x = __builtin_amdgcn_rcpf(d.x); t.y = __builtin_amdgcn_rcpf(d.y);
    f32x2 q = t * 0.5307027145f + (-0.7265760135f); q = q * t + 0.7107068705f; q = q * t + (-0.142248368f); q = q * t + 0.127414796f; q = q * t;
    const f32x2 s = (v * v) * (-0.72134752044f);
    f32x2 e; e.x = __builtin_amdgcn_exp2f(s.x); e.y = __builtin_amdgcn_exp2f(s.y);
    const f32x2 m = v * (q * e), r = v - m;
    f32x2 o; o.x = v.x < 0.f ? m.x : r.x; o.y = v.y < 0.f ? m.y : r.y; return o;
}

typedef unsigned u32x2 __attribute__((ext_vector_type(2)));
__device__ __forceinline__ int perm16(int x) { return (x & 3) | ((x & 4) << 1) | ((x & 8) >> 1); }
__device__ __forceinline__ bf16_t bf1(float v) { return (bf16_t)(cvt_pk_bf16(v, 0.f) & 0xffffu); }
__device__ __forceinline__ u32x2 pk4(f32x4 v) { u32x2 w; w.x = cvt_pk_bf16(v[0], v[1]); w.y = cvt_pk_bf16(v[2], v[3]); return w; }
__device__ __forceinline__ f32x4 gelu4(f32x4 v) { const f32x2 a = gelu_pk((f32x2){v[0], v[1]}), b = gelu_pk((f32x2){v[2], v[3]}); return (f32x4){a.x, a.y, b.x, b.y}; }
__device__ __forceinline__ float silu1(float g) { return g * __builtin_amdgcn_rcpf(1.0f + __builtin_amdgcn_exp2f(-1.4426950408889634f * g)); }

struct EpiInE {
    static constexpr bool PERM = false, AFTER_DRAIN = false;
    bf16_t* QK; bf16_t* VT; bf16_t* KC; bf16_t* VCT; const float* rc; const float* rs; float qscale;
    __device__ __forceinline__ void operator()(const f32x4 (&acc)[2][2][4][2], const Unit& u, int wr, int wc, int fr, int fq) const {
        const int row0 = u.pm * BM + wr * 64 + fr;
        if (u.pm >= 128) {
#pragma unroll
            for (int ai = 0; ai < 2; ++ai)
#pragma unroll
                for (int m = 0; m < 4; ++m) {
                    const int row = row0 + ai * HALF + m * 16 - 32768, b = row >> 8, j = row & 255, jp = (j & ~15) | perm16(j & 15);
#pragma unroll
                    for (int n = 0; n < 2; ++n) {
                        *(u32x2*)(KC + (size_t)row * 128 + wc * 32 + n * 16 + 4 * fq) = pk4(acc[ai][0][m][n]);
#pragma unroll
                        for (int i = 0; i < 4; ++i) { const int cv = wc * 32 + n * 16 + 4 * fq + i; VCT[((size_t)(b * 2 + (cv >> 6)) * 64 + (cv & 63)) * 256 + jp] = bf1(acc[ai][1][m][n][i]); }
                    }
                }
            return;
        }
        if (u.pn <= 2) {
            const float sc = (u.pn < 2) ? qscale : 1.0f;
#pragma unroll
            for (int ai = 0; ai < 2; ++ai)
#pragma unroll
                for (int m = 0; m < 4; ++m) {
                    const int row = row0 + ai * HALF + m * 16, pos = row & 8191, pidx = (wc & 1) ? (pos & 63) : (pos >> 6);
                    const f32x4 c4 = *(const f32x4*)(rc + pidx * 16 + 4 * fq) * sc, s4 = *(const f32x4*)(rs + pidx * 16 + 4 * fq) * sc;
                    bf16_t* rowp = QK + (size_t)row * 1792 + u.pn * BM + wc * 32 + 4 * fq;
#pragma unroll
                    for (int bj = 0; bj < 2; ++bj) {
                        if (u.pn == 2 && bj == 1) break;
                        const f32x4 v0 = acc[ai][bj][m][0], v1 = acc[ai][bj][m][1];
                        *(u32x2*)(rowp + bj * HALF) = pk4(v0 * c4 - v1 * s4);
                        *(u32x2*)(rowp + bj * HALF + 16) = pk4(v1 * c4 + v0 * s4);
                    }
                    if (u.pn == 2) {
                        const int b = row >> 13, pp = (pos & ~15) | perm16(pos & 15);
#pragma unroll
                        for (int n = 0; n < 2; ++n)
#pragma unroll
                            for (int i = 0; i < 4; ++i) { const int cv = wc * 32 + n * 16 + 4 * fq + i; VT[((size_t)(b * 2 + (cv >> 6)) * 64 + (cv & 63)) * 8192 + pp] = bf1(acc[ai][1][m][n][i]); }
                    }
                }
            return;
        }
#pragma unroll
        for (int ai = 0; ai < 2; ++ai)
#pragma unroll
            for (int m = 0; m < 4; ++m) {
                bf16_t* rowp = QK + (size_t)(row0 + ai * HALF + m * 16) * 1792 + u.pn * BM + wc * 32 + 4 * fq;
#pragma unroll
                for (int bj = 0; bj < 2; ++bj)
#pragma unroll
                    for (int n = 0; n < 2; ++n) *(u32x2*)(rowp + bj * HALF + n * 16) = pk4(gelu4(acc[ai][bj][m][n]));
            }
    }
};
struct EpiRes {
    static constexpr bool PERM = false, AFTER_DRAIN = false;
    const float* base; float* out; const float* gate; float* RSS;
    __device__ __forceinline__ void operator()(const f32x4 (&acc)[2][2][4][2], const Unit& u, int wr, int wc, int fr, int fq) const {
        const int row0 = u.pm * BM + wr * 64 + fr, col0 = u.pn * BM + wc * 32 + 4 * fq, b = u.pm >> 5;
        f32x4 gv[2][2];
#pragma unroll
        for (int bj = 0; bj < 2; ++bj)
#pragma unroll
            for (int n = 0; n < 2; ++n) gv[bj][n] = *(const f32x4*)(gate + (size_t)b * 6144 + col0 + bj * HALF + n * 16);
#pragma unroll
        for (int ai = 0; ai < 2; ++ai) {
            f32x4 bs[4][2][2];
#pragma unroll
            for (int m = 0; m < 4; ++m)
#pragma unroll
                for (int bj = 0; bj < 2; ++bj)
#pragma unroll
                    for (int n = 0; n < 2; ++n) bs[m][bj][n] = *(const f32x4*)(base + (size_t)(row0 + ai * HALF + m * 16) * 1024 + col0 + bj * HALF + n * 16);
            asm volatile("" ::: "memory");
#pragma unroll
            for (int m = 0; m < 4; ++m) { const int row = row0 + ai * HALF + m * 16; float ss = 0.f;
#pragma unroll
                for (int bj = 0; bj < 2; ++bj)
#pragma unroll
                    for (int n = 0; n < 2; ++n) { const f32x4 o = bs[m][bj][n] + gv[bj][n] * acc[ai][bj][m][n]; *(f32x4*)(out + (size_t)row * 1024 + col0 + bj * HALF + n * 16) = o;
                        ss += (o[0] * o[0] + o[1] * o[1]) + (o[2] * o[2] + o[3] * o[3]); }
                ss += __shfl_xor(ss, 16); ss += __shfl_xor(ss, 32);
                if (fq == 0) RSS[(size_t)row * 16 + u.pn * 4 + wc] = ss; }
            asm volatile("" ::: "memory");
        }
    }
};
struct EpiSwiGLU {
    static constexpr bool PERM = true, AFTER_DRAIN = false;
    bf16_t* HID;
    __device__ __forceinline__ void operator()(const f32x4 (&acc)[2][2][4][2], const Unit& u, int wr, int wc, int fr, int fq) const {
        const int row0 = u.pm * BM + wr * 64 + fr, col0 = (u.pn & 3) * HALF + wc * 32 + 8 * fq;
#pragma unroll
        for (int ai = 0; ai < 2; ++ai)
#pragma unroll
            for (int m = 0; m < 4; ++m) {
                const f32x4 g0 = acc[ai][0][m][0], g1 = acc[ai][0][m][1], u0 = acc[ai][1][m][0], u1 = acc[ai][1][m][1];
                u32x4 w;
                w.x = cvt_pk_bf16(silu1(g0[0]) * u0[0], silu1(g0[1]) * u0[1]); w.y = cvt_pk_bf16(silu1(g0[2]) * u0[2], silu1(g0[3]) * u0[3]);
                w.z = cvt_pk_bf16(silu1(g1[0]) * u1[0], silu1(g1[1]) * u1[1]); w.w = cvt_pk_bf16(silu1(g1[2]) * u1[2], silu1(g1[3]) * u1[3]);
                *(u32x4*)(HID + (size_t)(row0 + ai * HALF + m * 16) * 512 + col0) = w;
            }
    }
};
struct EpiDown {
    static constexpr bool PERM = true, AFTER_DRAIN = false;
    bf16_t* Y;
    __device__ __forceinline__ void operator()(const f32x4 (&acc)[2][2][4][2], const Unit& u, int wr, int wc, int fr, int fq) const {
        const int row0 = u.pm * BM + wr * 64 + fr, col0 = (u.pn & 3) * BM + wc * 32 + 8 * fq;
#pragma unroll
        for (int ai = 0; ai < 2; ++ai)
#pragma unroll
            for (int m = 0; m < 4; ++m) { bf16_t* rowp = Y + (size_t)(row0 + ai * HALF + m * 16) * 1024 + col0;
#pragma unroll
                for (int bj = 0; bj < 2; ++bj) { const f32x4 v0 = acc[ai][bj][m][0], v1 = acc[ai][bj][m][1];
                    u32x4 w; w.x = cvt_pk_bf16(v0[0], v0[1]); w.y = cvt_pk_bf16(v0[2], v0[3]); w.z = cvt_pk_bf16(v1[0], v1[1]); w.w = cvt_pk_bf16(v1[2], v1[3]);
                    *(u32x4*)(rowp + bj * HALF) = w; } }
    }
};
struct EpiInO {
    static constexpr bool PERM = true, AFTER_DRAIN = false;
    bf16_t* BG; bf16_t* Y;
    __device__ __forceinline__ void operator()(const f32x4 (&acc)[2][2][4][2], const Unit& u, int wr, int wc, int fr, int fq) const {
        const int row0 = u.pm * BM + wr * 64 + fr;
        if (u.pn < 8) {
            const int col0 = u.pn * HALF + wc * 32 + 8 * fq;
#pragma unroll
            for (int ai = 0; ai < 2; ++ai)
#pragma unroll
                for (int m = 0; m < 4; ++m) { const f32x4 v0 = acc[ai][0][m][0] * acc[ai][1][m][0], v1 = acc[ai][0][m][1] * acc[ai][1][m][1];
                    u32x4 w; w.x = cvt_pk_bf16(v0[0], v0[1]); w.y = cvt_pk_bf16(v0[2], v0[3]); w.z = cvt_pk_bf16(v1[0], v1[1]); w.w = cvt_pk_bf16(v1[2], v1[3]);
                    *(u32x4*)(Y + (size_t)(row0 + ai * HALF + m * 16) * 1024 + col0) = w; }
        } else {
            const int col0 = (u.pn - 8) * BM + wc * 32 + 8 * fq;
#pragma unroll
            for (int ai = 0; ai < 2; ++ai)
#pragma unroll
                for (int m = 0; m < 4; ++m) { bf16_t* rowp = BG + (size_t)(row0 + ai * HALF + m * 16) * 1024 + col0;
#pragma unroll
                    for (int bj = 0; bj < 2; ++bj) { const f32x4 v0 = acc[ai][bj][m][0], v1 = acc[ai][bj][m][1];
                        u32x4 w; w.x = cvt_pk_bf16(v0[0], v0[1]); w.y = cvt_pk_bf16(v0[2], v0[3]); w.z = cvt_pk_bf16(v1[0], v1[1]); w.w = cvt_pk_bf16(v1[2], v1[3]);
                        *(u32x4*)(rowp + bj * HALF) = w; } }
        }
    }
};
struct InEOrder {
    StaticOrder so; int G, c;
    __device__ __forceinline__ bool next(int i, Unit& u) const {
        const long L = (long)i * G + c;
        if (L < 896) return so.next(i, u);
        if (L < 900) { u.pm = 128 + (int)(L - 896); u.pn = 2; return true; }
        return false;
    }
    __device__ __forceinline__ void a_ready(const Unit&) const {}
    __device__ __forceinline__ void done(const Unit&) const {}
};
struct MoeOrder {
    const PG8_LAS int* tile_e; int nunits, G, c;
    __device__ __forceinline__ bool next(int i, Unit& u) const {
        const long L = (long)i * G + c; if (L >= nunits) return false;
        const int t = (int)(L >> 2); u.pm = t; u.pn = tile_e[t] * 4 + (int)(L & 3); return true;
    }
    __device__ __forceinline__ void a_ready(const Unit&) const {}
    __device__ __forceinline__ void done(const Unit&) const {}
};
template <class Epi, class Sched, bool ALIGN_EPI = false, bool SP2 = false>
__device__ __forceinline__ void gemm_phase(PG8_LAS unsigned char* lds, const Gemm g, const Sched& S, const Epi& E, const int tid_in) {
    int tid_ = tid_in; asm volatile("" : "+v"(tid_));
    const int tid = tid_, wid = __builtin_amdgcn_readfirstlane(tid >> 6), lane = tid & 63, wr = wid >> 2, wc = wid & 3, fr = lane & 15, fq = lane >> 4;
    const int K = g.K, nt = K / BK;
    unsigned voffA[2], voffB[2];
#pragma unroll
    for (int i = 0; i < 2; ++i) { int R, C; stage_rc(tid * 16 + i * 8192, R, C); const int Rb = Epi::PERM ? ((R & ~31) + perm32(R & 31)) : R;
        voffA[i] = (unsigned)(R * K + C) * 2u; voffB[i] = (unsigned)(Rb * K + C) * 2u; }
    const size_t kstep = (size_t)(BK * 2);
    const size_t hstep = (size_t)HALF * K * 2;
    const size_t tstep = 2 * hstep;
    const unsigned ldsw = (unsigned)wid * 1024u;
    const int aoff = lds_byte(wr * 64 + fr, fq * 8), boff = lds_byte(wc * 32 + fr, fq * 8);
#define PG8_SA(b, h) (((b) * 2 + (h)) * HTB)
#define PG8_SB(b, h) ((4 + (b) * 2 + (h)) * HTB)
#define PG8_STAGE(bufoff, gbase, voff) do { _Pragma("unroll") for (int _i = 0; _i < 2; ++_i) \
        __builtin_amdgcn_global_load_lds((const unsigned*)((const char*)(gbase) + (voff)[_i]), (PG8_LAS unsigned*)(lds + (bufoff) + ldsw + _i * 8192), 16, 0, 0); } while (0)
#define PG8_LDA(dst, b, h) do { _Pragma("unroll") for (int m = 0; m < 4; ++m) _Pragma("unroll") for (int k = 0; k < 2; ++k) dst[m][k] = *(const PG8_LAS bf16x8*)(lds + PG8_SA(b, h) + aoff + m * 2048 + k * 1024); } while (0)
#define PG8_LDB(dst, b, h) do { _Pragma("unroll") for (int n = 0; n < 2; ++n) _Pragma("unroll") for (int k = 0; k < 2; ++k) dst[n][k] = *(const PG8_LAS bf16x8*)(lds + PG8_SB(b, h) + boff + n * 2048 + k * 1024); } while (0)
#define PG8_MMA(ai, bj, At, Bt) do { __builtin_amdgcn_s_setprio(1); _Pragma("unroll") for (int m = 0; m < 4; ++m) _Pragma("unroll") for (int n = 0; n < 2; ++n) _Pragma("unroll") for (int k = 0; k < 2; ++k) \
        acc[ai][bj][m][n] = __builtin_amdgcn_mfma_f32_16x16x32_bf16(Bt[n][k], At[m][k], acc[ai][bj][m][n], 0, 0, 0); __builtin_amdgcn_s_setprio(0); } while (0)
#define PG8_WAIT_V(n) asm volatile("s_waitcnt vmcnt(" #n ")" ::: "memory")
#define PG8_WAIT_L(n) asm volatile("s_waitcnt lgkmcnt(" #n ")" ::: "memory")
#define PG8_BAR __builtin_amdgcn_s_barrier()
#define PG8_SCHED __builtin_amdgcn_sched_barrier(0)
    Unit cur, nxt; int ui = 0;
    if (!S.next(0, cur)) return;
    f32x4 acc[2][2][4][2];
#pragma unroll
    for (int a = 0; a < 2; ++a)
#pragma unroll
        for (int b = 0; b < 2; ++b)
#pragma unroll
            for (int m = 0; m < 4; ++m)
#pragma unroll
                for (int n = 0; n < 2; ++n) acc[a][b][m][n] = (f32x4){0.f, 0.f, 0.f, 0.f};
    bf16x8 At[4][2], B0[2][2], B1[2][2];
    const char* cA = (const char*)g.A + (size_t)cur.pm * tstep; const char* cB = (const char*)g.Bt + (size_t)cur.pn * tstep;
    S.a_ready(cur);
    if constexpr (SP2) {
        PG8_STAGE(PG8_SB(0, 0), cB, voffB); PG8_STAGE(PG8_SB(0, 1), cB + hstep, voffB); PG8_STAGE(PG8_SA(0, 0), cA, voffA); PG8_STAGE(PG8_SA(0, 1), cA + hstep, voffA);
        if (wr == 1) PG8_BAR;
        PG8_WAIT_V(2); PG8_BAR;
        PG8_STAGE(PG8_SB(1, 0), cB + kstep, voffB); PG8_STAGE(PG8_SA(1, 0), cA + kstep, voffA); PG8_STAGE(PG8_SB(1, 1), cB + hstep + kstep, voffB);
        PG8_WAIT_V(6); PG8_BAR;
    } else {
        PG8_STAGE(PG8_SB(0, 0), cB, voffB); PG8_STAGE(PG8_SA(0, 0), cA, voffA); PG8_STAGE(PG8_SB(0, 1), cB + hstep, voffB); PG8_STAGE(PG8_SA(0, 1), cA + hstep, voffA);
        if (wr == 1) PG8_BAR;
        PG8_WAIT_V(4); PG8_BAR;
        PG8_STAGE(PG8_SB(1, 0), cB + kstep, voffB); PG8_STAGE(PG8_SA(1, 0), cA + kstep, voffA); PG8_STAGE(PG8_SB(1, 1), cB + hstep + kstep, voffB);
        PG8_WAIT_V(6); PG8_BAR;
    }
    for (;;) {
        const bool has_next = S.next(ui + 1, nxt);
        const char* nA = has_next ? (const char*)g.A + (size_t)nxt.pm * tstep : cA; const char* nB = has_next ? (const char*)g.Bt + (size_t)nxt.pn * tstep : cB;
        for (int t = 0; t < nt; t += 2) {
            const bool last = (t == nt - 2);
            const char* a1 = cA + (size_t)(t + 1) * kstep;
            const char* a2 = last ? nA : cA + (size_t)(t + 2) * kstep; const char* b2 = last ? nB : cB + (size_t)(t + 2) * kstep;
            const char* a3 = a2 + kstep; const char* b3 = b2 + kstep;
            if (last && has_next) S.a_ready(nxt);
            if constexpr (SP2) {
            PG8_LDB(B0, 0, 0); PG8_LDB(B1, 0, 1); PG8_SCHED; PG8_LDA(At, 0, 0); PG8_STAGE(PG8_SA(1, 1), a1 + hstep, voffA);
            PG8_WAIT_V(8); PG8_WAIT_L(0); PG8_BAR; PG8_MMA(0, 0, At, B0); PG8_MMA(0, 1, At, B1); PG8_BAR; PG8_SCHED;
            PG8_LDA(At, 0, 1); PG8_STAGE(PG8_SB(0, 0), b2, voffB); PG8_STAGE(PG8_SB(0, 1), b2 + hstep, voffB); PG8_STAGE(PG8_SA(0, 0), a2, voffA);
            PG8_WAIT_V(8); PG8_WAIT_L(0); PG8_BAR; PG8_MMA(1, 0, At, B0); PG8_MMA(1, 1, At, B1); PG8_BAR; PG8_SCHED;
            PG8_LDB(B0, 1, 0); PG8_LDB(B1, 1, 1); PG8_SCHED; PG8_LDA(At, 1, 0); PG8_STAGE(PG8_SA(0, 1), a2 + hstep, voffA);
            PG8_WAIT_V(8); PG8_WAIT_L(0); PG8_BAR; PG8_MMA(0, 0, At, B0); PG8_MMA(0, 1, At, B1); PG8_BAR; PG8_SCHED;
            PG8_LDA(At, 1, 1); PG8_STAGE(PG8_SB(1, 0), b3, voffB); PG8_STAGE(PG8_SB(1, 1), b3 + hstep, voffB); PG8_STAGE(PG8_SA(1, 0), a3, voffA);
            PG8_WAIT_V(8); PG8_WAIT_L(0); PG8_BAR; PG8_MMA(1, 0, At, B0); PG8_MMA(1, 1, At, B1); PG8_BAR; PG8_SCHED;
            } else {
            PG8_LDB(B0, 0, 0); PG8_SCHED; PG8_LDA(At, 0, 0); PG8_STAGE(PG8_SA(1, 1), a1 + hstep, voffA);
            PG8_WAIT_L(8); PG8_BAR; PG8_WAIT_L(0); PG8_MMA(0, 0, At, B0); PG8_BAR; PG8_SCHED;
            PG8_LDB(B1, 0, 1); PG8_STAGE(PG8_SB(0, 0), b2, voffB);
            PG8_BAR; PG8_WAIT_L(0); PG8_MMA(0, 1, At, B1); PG8_BAR;
            PG8_LDA(At, 0, 1); PG8_STAGE(PG8_SA(0, 0), a2, voffA);
            PG8_BAR; PG8_WAIT_L(0); PG8_MMA(1, 0, At, B0); PG8_BAR; PG8_SCHED;
            PG8_STAGE(PG8_SB(0, 1), b2 + hstep, voffB);
            PG8_WAIT_V(6); PG8_BAR; PG8_MMA(1, 1, At, B1); PG8_BAR;
            PG8_LDB(B0, 1, 0); PG8_SCHED; PG8_LDA(At, 1, 0); PG8_STAGE(PG8_SA(0, 1), a2 + hstep, voffA);
            PG8_WAIT_L(8); PG8_BAR; PG8_WAIT_L(0); PG8_MMA(0, 0, At, B0); PG8_BAR; PG8_SCHED;
            PG8_LDB(B1, 1, 1); PG8_STAGE(PG8_SB(1, 0), b3, voffB);
            PG8_BAR; PG8_WAIT_L(0); PG8_MMA(0, 1, At, B1); PG8_BAR;
            PG8_LDA(At, 1, 1); PG8_STAGE(PG8_SA(1, 0), a3, voffA);
            PG8_BAR; PG8_WAIT_L(0); PG8_MMA(1, 0, At, B0); PG8_BAR; PG8_SCHED;
            PG8_STAGE(PG8_SB(1, 1), b3 + hstep, voffB);
            PG8_WAIT_V(6); PG8_BAR; PG8_MMA(1, 1, At, B1); PG8_BAR;
            }
        }
        if constexpr (ALIGN_EPI) { if (wr == 0) PG8_BAR; }
        if constexpr (!Epi::AFTER_DRAIN) { E(acc, cur, wr, wc, fr, fq); S.done(cur); }
        if (!has_next) break;
#pragma unroll
        for (int a = 0; a < 2; ++a)
#pragma unroll
            for (int b = 0; b < 2; ++b)
#pragma unroll
                for (int m = 0; m < 4; ++m)
#pragma unroll
                    for (int n = 0; n < 2; ++n) acc[a][b][m][n] = (f32x4){0.f, 0.f, 0.f, 0.f};
        cur = nxt; cA = nA; cB = nB; ++ui;
        if constexpr (ALIGN_EPI) { if (wr == 1) PG8_BAR; }
    }
    PG8_WAIT_V(0);
    if constexpr (!ALIGN_EPI) { if (wr == 0) PG8_BAR; }
    PG8_BAR;
    if constexpr (Epi::AFTER_DRAIN) { E.fused(acc, cur, wr, wc, fr, fq, lds, wid, lane); S.done(cur); }
#undef PG8_SA
#undef PG8_SB
#undef PG8_STAGE
#undef PG8_LDA
#undef PG8_LDB
#undef PG8_MMA
#undef PG8_WAIT_V
#undef PG8_WAIT_L
#undef PG8_BAR
#undef PG8_SCHED
}
}
constexpr int NWAVES = 8;
constexpr int BATCH = 4, SEQ = 8192, D = 1024, M = BATCH * SEQ, CTXL = 256, MC = BATCH * CTXL;
constexpr int NINE = 1792, NEXP = 32, EH = 512;
constexpr float EPS = 1e-6f;
constexpr int N_PHASES = 18;
#ifndef MK_ONE_LAUNCH
#define MK_ONE_LAUNCH 1
#endif
constexpr size_t MiB = 1u << 20;
constexpr size_t WS_CTL = 0, CTL_ZERO_BYTES = 1 * MiB;
constexpr size_t WS_MOD = 1 * MiB;
constexpr size_t WS_MODC = WS_MOD + 2 * 4 * 6144 * 4;
constexpr size_t WS_MODP = 1 * MiB + 768 * 1024;
static_assert(WS_MODC + 6144 * 4 <= 1 * MiB + 256 * 1024, "MOD/MODC overlap the rope tables");
constexpr size_t WS_ROPE = 1 * MiB + 256 * 1024;
constexpr size_t WS_WSP = 1 * MiB + 512 * 1024;
constexpr size_t WS_TOKE = 2 * MiB;
constexpr size_t WS_TOKP = 2 * MiB + 256 * 1024;
constexpr size_t WS_TOKW = 2 * MiB + 512 * 1024;
constexpr size_t WS_TOKS = 2 * MiB + 768 * 1024;
constexpr size_t WS_KC = 3 * MiB;
constexpr size_t WS_VCT = 3 * MiB + 256 * 1024;
constexpr size_t WS_VT = 4 * MiB;
constexpr size_t WS_WINE = 12 * MiB, WS_WOUTE = 16 * MiB, WS_WINO = 18 * MiB, WS_WOUTO = 24 * MiB;
constexpr size_t WS_WGU = 26 * MiB;
constexpr size_t WS_WD = 154 * MiB;
constexpr size_t WS_H = 218 * MiB;
constexpr size_t WS_A = 284 * MiB;
constexpr size_t WS_B = 428 * MiB;
constexpr size_t WS_RSS = 500 * MiB;
constexpr size_t WS_END = 502 * MiB;
constexpr int CW_TMO = 0, CW_CODE = 1, CW_BAR = 4096, CW_GCNT = 8192;

constexpr int RING_BYTES = 131072;
constexpr int LDS_BYTES = 155648;
constexpr int MISC_OFF = LDS_BYTES - 256;
constexpr int MOE_TAB_OFF = RING_BYTES;
constexpr int RW_STRIDE = 2064;
constexpr int RT_WH = 0, RT_WL = 36 * RW_STRIDE, RT_CNT = 72 * RW_STRIDE, RT_BASE = RT_CNT + 128, RT_INFO = RT_CNT + 256;
static_assert(RT_INFO + 128 * 6 * 4 <= MISC_OFF, "LDS map");

#define GAS __attribute__((address_space(1)))
#define LAS __attribute__((address_space(3)))
typedef unsigned short bf16;
typedef unsigned v4u __attribute__((ext_vector_type(4)));
typedef unsigned v2u __attribute__((ext_vector_type(2)));
typedef float f32x4 __attribute__((ext_vector_type(4)));
typedef float f32x16 __attribute__((ext_vector_type(16)));
typedef short bf16x8 __attribute__((ext_vector_type(8)));
typedef GAS unsigned gu32;
#define RLX_AGENT __ATOMIC_RELAXED, __HIP_MEMORY_SCOPE_AGENT
#define LDS_WAIT() asm volatile("s_waitcnt lgkmcnt(0)" ::: "memory")
__device__ __forceinline__ unsigned f2bf(float f) { unsigned u = __builtin_bit_cast(unsigned, f); return (u + 0x7fffu + ((u >> 16) & 1u)) >> 16; }
__device__ __forceinline__ unsigned pk2(float lo, float hi) { return f2bf(lo) | (f2bf(hi) << 16); }
__device__ __forceinline__ float bflo(unsigned w) { return __builtin_bit_cast(float, w << 16); }
__device__ __forceinline__ float bfhi(unsigned w) { return __builtin_bit_cast(float, w & 0xffff0000u); }
__device__ __forceinline__ float wave_sum(float v) {
#pragma unroll
    for (int o = 1; o < 64; o <<= 1) v += __shfl_xor(v, o);
    return v;
}
#define XB_TMO      128
#define XB_XCNT(j)  (256  + 64 * (j))
#define XB_XSUB(j)  (1280 + 64 * (j))
#define XB_XGEN(j)  (2304 + 64 * (j))
#define XB_TOP      3328
#define XB_TOPGEN   3392
#define XCD_BAR_WORDS 3456
#define XB_SPIN_CAP (1u << 18)

__device__ __forceinline__ unsigned xb_ld(unsigned* p)              { return __hip_atomic_load(p, __ATOMIC_RELAXED, __HIP_MEMORY_SCOPE_AGENT); }
__device__ __forceinline__ unsigned xb_add(unsigned* p, unsigned v) { return __hip_atomic_fetch_add(p, v, __ATOMIC_RELAXED, __HIP_MEMORY_SCOPE_AGENT); }
__device__ __forceinline__ unsigned xb_xcc_id() { return (unsigned)__builtin_amdgcn_s_getreg((3 << 11) | 20) & 0xFu; }
#define XB_SPIN(cond, bar) do { unsigned _sp = 0; while (cond) { __builtin_amdgcn_s_sleep(1); \
    if ((++_sp & 255u) == 0u) { if (xb_ld(&(bar)[XB_TMO])) break; if (_sp > XB_SPIN_CAP) { atomicAdd(&(bar)[XB_TMO], 1u); break; } } } } while (0)

struct XcdBarrier {
    unsigned* bar; unsigned x;
    volatile LAS unsigned* st;
};

__device__ __forceinline__ XcdBarrier xcd_barrier_post(unsigned* bar, volatile LAS unsigned* st) {
    XcdBarrier b; b.bar = bar; b.x = xb_xcc_id(); b.st = st;
    if (threadIdx.x == 0) (void)xb_add(&bar[XB_XCNT(b.x)], 1u);
    return b;
}
__device__ __forceinline__ void xcd_barrier_complete(unsigned* bar, unsigned x, unsigned& nloc, unsigned& nx) {
    const unsigned G = gridDim.x * gridDim.y * gridDim.z;
    unsigned sum, cnt, mine, sp = 0u;
    for (;;) {
        sum = 0u; cnt = 0u; mine = 0u;
#pragma unroll
        for (unsigned j = 0; j < 16; ++j) { const unsigned c = xb_ld(&bar[XB_XCNT(j)]); sum += c; cnt += (c > 0u) ? 1u : 0u; mine = (j == x) ? c : mine; }
        if (sum == G) break;
        __builtin_amdgcn_s_sleep(1);
        if ((++sp & 255u) == 0u) { if (xb_ld(&bar[XB_TMO])) break; if (sp > XB_SPIN_CAP) { atomicAdd(&bar[XB_TMO], 1u); break; } }
    }
    nloc = mine > 0u ? mine : 1u; nx = cnt > 0u ? cnt : 1u;
}

__device__ __forceinline__ void xcd_barrier(const XcdBarrier& b, const int xb_tid) {
    asm volatile("s_waitcnt vmcnt(0)" ::: "memory");
    __syncthreads();
    if (xb_tid == 0) {
        unsigned* bar = b.bar;
        __builtin_amdgcn_s_waitcnt(0);
        unsigned nloc = b.st[0], nx = b.st[1];
        if (nloc == 0u) { xcd_barrier_complete(bar, b.x, nloc, nx); b.st[0] = nloc; b.st[1] = nx; }
        const unsigned old = xb_add(&bar[XB_XSUB(b.x)], 1u);
        const unsigned gen = old / nloc;
        if (old + 1u == (gen + 1u) * nloc) {
            __builtin_amdgcn_fence(__ATOMIC_RELEASE, "agent");
            asm volatile("s_waitcnt vmcnt(0)" ::: "memory");
            const unsigned og = xb_add(&bar[XB_TOP], 1u);
            const unsigned tg = og / nx;
            if (og + 1u == (tg + 1u) * nx) xb_add(&bar[XB_TOPGEN], 1u);
            else XB_SPIN(xb_ld(&bar[XB_TOPGEN]) == tg, bar);
            __builtin_amdgcn_fence(__ATOMIC_ACQUIRE, "agent");
            xb_add(&bar[XB_XGEN(b.x)], 1u);
            asm volatile("s_waitcnt vmcnt(0)" ::: "memory");
        } else {
            XB_SPIN(xb_ld(&bar[XB_XGEN(b.x)]) == gen, bar);
            __builtin_amdgcn_fence(__ATOMIC_ACQUIRE, "agent");
            asm volatile("s_waitcnt vmcnt(0)" ::: "memory");
        }
    }
    __syncthreads();
}

struct Args { const float* in[25]; float* out; unsigned char* ws; int ph_lo, ph_hi; };
struct Ctx {
    LAS unsigned char* lds; unsigned ldsaddr;
    int tid, lane, wave, G, bid;
    float* out; unsigned char* ws; gu32* ctl;
};
__device__ __forceinline__ const float* kin(int k) {
    const __attribute__((address_space(4))) Args* ka = (const __attribute__((address_space(4))) Args*)__builtin_amdgcn_kernarg_segment_ptr();
    return (const float*)(const GAS float*)ka->in[k];
}
__device__ const float ROPE_INV[16] = {1.000000000e+00f, 5.623413324e-01f, 3.162277639e-01f, 1.778279394e-01f, 1.000000015e-01f, 5.623413250e-02f, 3.162277490e-02f, 1.778279431e-02f,
                                       9.999999776e-03f, 5.623413250e-03f, 3.162277630e-03f, 1.778279431e-03f, 1.000000047e-03f, 5.623413017e-04f, 3.162277571e-04f, 1.778279402e-04f};

__device__ __forceinline__ void transpose_item(const float* W, int K, int N, bf16* WT, int k0, int n0, int drow0, LAS float* scr, int lane) {
#pragma unroll 8
    for (int i = 0; i < 32; ++i) { const int kk = 2 * i + (lane >> 5); scr[kk * 33 + (lane & 31)] = W[(size_t)(k0 + kk) * N + n0 + (lane & 31)]; }
    LDS_WAIT(); asm volatile("" ::: "memory");
    const int c = lane & 7;
#pragma unroll
    for (int j = 0; j < 4; ++j) { const int n = (lane >> 3) + 8 * j; const LAS float* s = scr + (8 * c) * 33 + n;
        v4u o; o.x = pk2(s[0 * 33], s[1 * 33]); o.y = pk2(s[2 * 33], s[3 * 33]); o.z = pk2(s[4 * 33], s[5 * 33]); o.w = pk2(s[6 * 33], s[7 * 33]);
        *(GAS v4u*)(WT + (size_t)(drow0 + n) * K + k0 + 8 * c) = o; }
    LDS_WAIT(); asm volatile("" ::: "memory");
}
__device__ __forceinline__ void sincos_acc(float a, float& s, float& c) {
    const double x = (double)a, kf = __builtin_rint(x * 0.63661977236758134308), r = x - kf * 1.57079632679489661923, r2 = r * r;
    const double sp = r * (1.0 + r2 * (-1.0 / 6 + r2 * (1.0 / 120 + r2 * (-1.0 / 5040 + r2 * (1.0 / 362880 + r2 * (-1.0 / 39916800 + r2 * (1.0 / 6227020800.0)))))));
    const double cp = 1.0 + r2 * (-0.5 + r2 * (1.0 / 24 + r2 * (-1.0 / 720 + r2 * (1.0 / 40320 + r2 * (-1.0 / 3628800 + r2 * (1.0 / 479001600 + r2 * (-1.0 / 87178291200.0)))))));
    const int k = (int)kf & 3;
    s = (float)((k == 0) ? sp : (k == 1) ? cp : (k == 2) ? -sp : -cp);
    c = (float)((k == 0) ? cp : (k == 1) ? -sp : (k == 2) ? -cp : sp);
}
__device__ __forceinline__ void adaln_unit(const Ctx& C, int u) {
    const int l = u / 96, col = (u % 96) * 64 + C.lane;
    LAS float* sil = (LAS float*)C.lds; LAS float* red = (LAS float*)(C.lds + 5 * 1024 * 4);
    for (int idx = C.tid; idx < 5120; idx += NWAVES * 64) { const float v = (idx < 4096) ? kin(1)[idx] : kin(3)[idx - 4096]; sil[idx] = v / (1.0f + __expf(-v)); }
    __syncthreads();
    float acc[5] = {0.f, 0.f, 0.f, 0.f, 0.f};
    const int k0 = C.wave * 128; const float* wp = kin(4) + (size_t)l * 1024 * 6144 + (size_t)k0 * 6144 + col;
#pragma unroll 8
    for (int kk = 0; kk < 128; ++kk) { const float w = wp[(size_t)kk * 6144];
#pragma unroll
        for (int v = 0; v < 5; ++v) acc[v] += sil[v * 1024 + k0 + kk] * w; }
#pragma unroll
    for (int v = 0; v < 5; ++v) red[(C.wave * 5 + v) * 64 + C.lane] = acc[v];
    __syncthreads();
    if (C.wave == 0) {
        float* MOD = (float*)(C.ws + WS_MOD); float* MODC = (float*)(C.ws + WS_MODC); float* MODP = (float*)(C.ws + WS_MODP); const float bias = kin(5)[l * 6144 + col];
#pragma unroll
        for (int v = 0; v < 5; ++v) { float s = 0.f;
#pragma unroll
            for (int w = 0; w < NWAVES; ++w) s += red[(w * 5 + v) * 64 + C.lane];
            s += bias;
            if (v < 4) { MOD[(size_t)(l * 4 + v) * 6144 + col] = s;
                const int ch = col >> 10;
                if (ch == 1 || ch == 4) { const int w2 = (ch == 4) ? 1 : 0; MODP[(size_t)((l * 4 + v) * 2 + w2) * 1024 + (col & 1023)] = ((w2 ? kin(7) : kin(6))[l * 1024 + (col & 1023)]) * (1.0f + s); }
            } else if (l == 0) MODC[col] = s; }
    }
    __syncthreads();
}
__device__ __forceinline__ void p0_prologue(const Ctx& C) {
    for (int u = C.bid; u < 192; u += C.G) adaln_unit(C, u);
    LAS float* scr = (LAS float*)(C.lds + C.wave * 16384);
    const int gw = C.bid * NWAVES + C.wave, NGW = C.G * NWAVES;
    constexpr int NDENSE = 896 + 512 + 1536 + 512, NITEMS = NDENSE + 64 * 768;
    for (int it = gw; it < NITEMS; it += NGW) {
        int r = it;
        if (r < 896) { transpose_item(kin(9), 1024, 1792, (bf16*)(C.ws + WS_WINE), 64 * (r / 56), 32 * (r % 56), 32 * (r % 56), scr, C.lane); continue; } r -= 896;
        if (r < 512) { transpose_item(kin(14), 1024, 1024, (bf16*)(C.ws + WS_WOUTE), 64 * (r / 32), 32 * (r % 32), 32 * (r % 32), scr, C.lane); continue; } r -= 512;
        if (r < 1536) { const int n0 = 32 * (r % 96), j = n0 & 1023;
            const int drow = (n0 < 1024) ? 2048 + n0 : 256 * (j >> 7) + (j & 127) + ((n0 >= 2048) ? 128 : 0);
            transpose_item(kin(15), 1024, 3072, (bf16*)(C.ws + WS_WINO), 64 * (r / 96), n0, drow, scr, C.lane); continue; } r -= 1536;
        if (r < 512) { transpose_item(kin(17), 1024, 1024, (bf16*)(C.ws + WS_WOUTO), 64 * (r / 32), 32 * (r % 32), 32 * (r % 32), scr, C.lane); continue; } r -= 512;
        const int me = r / 768, q = r % 768, which = q >> 8, s = q & 255;
        if (which < 2) { const int j = 32 * (s & 15);
            transpose_item((which ? kin(23) : kin(22)) + (size_t)me * 1024 * 512, 1024, 512, (bf16*)(C.ws + WS_WGU) + (size_t)me * 1024 * 1024, 64 * (s >> 4), j, 256 * (j >> 7) + (j & 127) + 128 * which, scr, C.lane);
        } else transpose_item(kin(24) + (size_t)me * 512 * 1024, 512, 1024, (bf16*)(C.ws + WS_WD) + (size_t)me * 1024 * 512, 64 * (s >> 5), 32 * (s & 31), 32 * (s & 31), scr, C.lane);
    }
    for (int it = gw; it < 256; it += NGW) {
        const f32x4* src = (const f32x4*)(kin(12) + (size_t)it * 512) + 2 * C.lane; const f32x4 a = src[0], b = src[1];
        v4u o; o.x = pk2(a.x, a.y); o.y = pk2(a.z, a.w); o.z = pk2(b.x, b.y); o.w = pk2(b.z, b.w);
        *(v4u*)((bf16*)(C.ws + WS_WSP) + (size_t)it * 512 + 8 * C.lane) = o;
    }
    { const int gt = gw * 64 + C.lane;
        if (gt < 2048) { float s, c; sincos_acc((float)(gt >> 4) * ROPE_INV[gt & 15], s, c); ((float*)(C.ws + WS_ROPE))[gt] = c; ((float*)(C.ws + WS_ROPE))[2048 + gt] = s; } }
}

__device__ __forceinline__ void load_mod(const float* gam, const float* shp, const float* scp, int lane, f32x4 (&sc)[4], f32x4 (&sh)[4]) {
#pragma unroll
    for (int j = 0; j < 4; ++j) { const int idx = lane + 64 * j; const f32x4 g = ((const f32x4*)gam)[idx], s = ((const f32x4*)scp)[idx]; sc[j] = g * (1.0f + s); sh[j] = ((const f32x4*)shp)[idx]; }
}
__device__ __forceinline__ float row_rinv(const f32x4 (&v)[4]) {
    float ss = 0.f;
#pragma unroll
    for (int j = 0; j < 4; ++j) ss += (v[j].x * v[j].x + v[j].y * v[j].y) + (v[j].z * v[j].z + v[j].w * v[j].w);
    return rsqrtf(wave_sum(ss) * (1.0f / 1024.0f) + EPS);
}
__device__ __forceinline__ void mod_store(const f32x4 (&v)[4], float rinv, const f32x4 (&sc)[4], const f32x4 (&sh)[4], bf16* orow, int lane) {
#pragma unroll
    for (int j = 0; j < 4; ++j) { const f32x4 o = v[j] * rinv * sc[j] + sh[j]; v2u w; w.x = pk2(o.x, o.y); w.y = pk2(o.z, o.w); ((v2u*)orow)[lane + 64 * j] = w; }
}
__device__ __forceinline__ void phase_norm1_l0(const Ctx& C) {
    const int gw = C.bid * NWAVES + C.wave, NGW = C.G * NWAVES;
    const float* MOD = (const float*)(C.ws + WS_MOD); const float* MODC = (const float*)(C.ws + WS_MODC); bf16* H = (bf16*)(C.ws + WS_H);
    for (int grp = gw; grp < (M + MC) / 16; grp += NGW) {
        f32x4 sc[4], sh[4]; const float* src;
        if (grp < M / 16) { const float* mod = MOD + (size_t)(grp >> 9) * 6144; load_mod(kin(6), mod, mod + 1024, C.lane, sc, sh); src = kin(0) + (size_t)grp * 16 * D; }
        else { load_mod(kin(6), MODC, MODC + 1024, C.lane, sc, sh); src = kin(2) + (size_t)(grp - M / 16) * 16 * D; }
        bf16* dst = H + (size_t)grp * 16 * D;
        f32x4 va[4][4], vb[4][4];
#define N1_LOAD(buf, r0) do { _Pragma("unroll") for (int r = 0; r < 4; ++r) _Pragma("unroll") for (int j = 0; j < 4; ++j) buf[r][j] = ((const f32x4*)(src + (size_t)((r0) + r) * D))[C.lane + 64 * j]; } while (0)
#define N1_PROC(buf, r0) do { _Pragma("unroll") for (int r = 0; r < 4; ++r) mod_store(buf[r], row_rinv(buf[r]), sc, sh, dst + (size_t)((r0) + r) * D, C.lane); } while (0)
        N1_LOAD(va, 0);
#pragma unroll 1
        for (int it = 0; it < 2; ++it) { const int r0 = 8 * it;
            N1_LOAD(vb, r0 + 4); N1_PROC(va, r0);
            if (it < 1) N1_LOAD(va, r0 + 8);
            N1_PROC(vb, r0 + 4); }
#undef N1_LOAD
#undef N1_PROC
    }
}
__device__ __forceinline__ void phase_router(const Ctx& C, int l) {
    LAS unsigned char* WH = C.lds + RT_WH; LAS unsigned char* WL = C.lds + RT_WL;
    LAS int* cnt = (LAS int*)(C.lds + RT_CNT); LAS int* base = (LAS int*)(C.lds + RT_BASE); LAS int* info = (LAS int*)(C.lds + RT_INFO);
    const float* wrg = kin(18) + l * 4096; const float* wre = kin(20) + l * 32768; const float* brg = kin(19) + l * 4; const float* bre = kin(21) + l * 32;
    for (int idx = C.tid; idx < 9216; idx += NWAVES * 64) { const int k = idx / 9, q9 = idx - 9 * k;
        const f32x4 v = (q9 == 0) ? *(const f32x4*)(wrg + 4 * k) : *(const f32x4*)(wre + 32 * k + 4 * (q9 - 1));
        const int row0 = (q9 == 0) ? 32 : 16 * ((q9 - 1) & 1) + 4 * ((q9 - 1) >> 1);
#pragma unroll
        for (int i = 0; i < 4; ++i) { const unsigned hi = f2bf(v[i]), lo = f2bf(v[i] - bflo(hi));
            *(LAS bf16*)(WH + (row0 + i) * RW_STRIDE + 2 * k) = (bf16)hi; *(LAS bf16*)(WL + (row0 + i) * RW_STRIDE + 2 * k) = (bf16)lo; } }
    if (C.tid < 32) cnt[C.tid] = 0;
    __syncthreads();
    const float* MOD = (const float*)(C.ws + WS_MOD); const float* MODP = (const float*)(C.ws + WS_MODP); const float* RSS = (const float*)(C.ws + WS_RSS); bf16* H = (bf16*)(C.ws + WS_H);
    gu32* gcnt = C.ctl + CW_GCNT + l * 32;
    int* TOKE = (int*)(C.ws + WS_TOKE); int* TOKP = (int*)(C.ws + WS_TOKP); float* TOKW = (float*)(C.ws + WS_TOKW);
    const int r = C.lane & 15, q = C.lane >> 4;
    for (int rb = C.bid; rb < M / 128; rb += C.G) {
        const int bq = rb >> 6; const size_t row = (size_t)rb * 128 + C.wave * 16 + r;
        float rinv; { const f32x4* rp = (const f32x4*)(RSS + row * 16); const f32x4 a = rp[0], b = rp[1], c = rp[2], d = rp[3];
            const f32x4 t = (a + b) + (c + d); rinv = rsqrtf(((t.x + t.y) + (t.z + t.w)) * (1.0f / 1024.0f) + EPS); }
        const f32x4* xr = (const f32x4*)(C.out + row * D + 8 * q);
        const f32x4* sp = (const f32x4*)(MODP + (size_t)((l * 4 + bq) * 2 + 1) * 1024 + 8 * q); const f32x4* hp = (const f32x4*)(MOD + (size_t)(l * 4 + bq) * 6144 + 3 * 1024 + 8 * q);
        bf16* hrow = H + row * D + 8 * q;
        const LAS unsigned char* a0 = WH + (C.lane & 15) * RW_STRIDE + 16 * q; const LAS unsigned char* a2 = WH + (32 + (C.lane & 3)) * RW_STRIDE + 16 * q;
        pg8::f32x4 acc[3];
#pragma unroll
        for (int t = 0; t < 3; ++t) acc[t] = (pg8::f32x4){0.f, 0.f, 0.f, 0.f};
        f32x4 xc[8], xn[8];
#pragma unroll
        for (int s = 0; s < 4; ++s) { xc[2 * s] = xr[8 * s]; xc[2 * s + 1] = xr[8 * s + 1]; }
        for (int kb = 0; kb < 8; ++kb) {
            if (kb < 7) {
#pragma unroll
                for (int s = 0; s < 4; ++s) { xn[2 * s] = xr[8 * (4 * (kb + 1) + s)]; xn[2 * s + 1] = xr[8 * (4 * (kb + 1) + s) + 1]; } }
            f32x4 sv[8], hv[8];
#pragma unroll
            for (int s = 0; s < 4; ++s) { sv[2 * s] = sp[8 * (4 * kb + s)]; sv[2 * s + 1] = sp[8 * (4 * kb + s) + 1]; hv[2 * s] = hp[8 * (4 * kb + s)]; hv[2 * s + 1] = hp[8 * (4 * kb + s) + 1]; }
#pragma unroll
            for (int s = 0; s < 4; ++s) { const int kk = 4 * kb + s;
                const f32x4 h0 = xc[2 * s] * rinv * sv[2 * s] + hv[2 * s], h1 = xc[2 * s + 1] * rinv * sv[2 * s + 1] + hv[2 * s + 1];
                v4u hi; hi.x = pg8::cvt_pk_bf16(h0.x, h0.y); hi.y = pg8::cvt_pk_bf16(h0.z, h0.w); hi.z = pg8::cvt_pk_bf16(h1.x, h1.y); hi.w = pg8::cvt_pk_bf16(h1.z, h1.w);
                v4u lo; lo.x = pg8::cvt_pk_bf16(h0.x - bflo(hi.x), h0.y - bfhi(hi.x)); lo.y = pg8::cvt_pk_bf16(h0.z - bflo(hi.y), h0.w - bfhi(hi.y));
                lo.z = pg8::cvt_pk_bf16(h1.x - bflo(hi.z), h1.y - bfhi(hi.z)); lo.w = pg8::cvt_pk_bf16(h1.z - bflo(hi.w), h1.w - bfhi(hi.w));
                *(v4u*)(hrow + 32 * kk) = hi;
                const bf16x8 bh = __builtin_bit_cast(bf16x8, hi), bl = __builtin_bit_cast(bf16x8, lo);
#pragma unroll
                for (int t = 0; t < 3; ++t) { const LAS unsigned char* ap = ((t == 2) ? a2 : a0 + 16 * t * RW_STRIDE) + 64 * kk;
                    const bf16x8 ah = *(const LAS bf16x8*)ap, al = *(const LAS bf16x8*)(ap + RT_WL);
                    acc[t] = __builtin_amdgcn_mfma_f32_16x16x32_bf16(ah, bh, acc[t], 0, 0, 0);
                    acc[t] = __builtin_amdgcn_mfma_f32_16x16x32_bf16(al, bh, acc[t], 0, 0, 0);
                    acc[t] = __builtin_amdgcn_mfma_f32_16x16x32_bf16(ah, bl, acc[t], 0, 0, 0); } }
            if (kb < 7) {
#pragma unroll
                for (int s = 0; s < 8; ++s) xc[s] = xn[s]; }
        }
        float gl[4];
#pragma unroll
        for (int gi = 0; gi < 4; ++gi) gl[gi] = acc[2][gi] + brg[gi];
        int gidx = 0; float gmax = gl[0];
#pragma unroll
        for (int gi = 1; gi < 4; ++gi) if (gl[gi] > gmax) { gmax = gl[gi]; gidx = gi; }
        if (q == gidx) {
            float den = 0.f;
#pragma unroll
            for (int gi = 0; gi < 4; ++gi) den += __expf(gl[gi] - gmax);
            const float gwt = 1.0f / den;
            float ev[8];
#pragma unroll
            for (int j = 0; j < 8; ++j) ev[j] = acc[j >> 2][j & 3] + bre[8 * q + j];
            int i0 = 0; float v0 = ev[0];
#pragma unroll
            for (int j = 1; j < 8; ++j) if (ev[j] > v0) { v0 = ev[j]; i0 = j; }
            int i1 = (i0 == 0) ? 1 : 0; float v1 = (i0 == 0) ? ev[1] : ev[0];
#pragma unroll
            for (int j = 1; j < 8; ++j) if (j != i0 && ev[j] > v1) { v1 = ev[j]; i1 = j; }
            const float t = __expf(v1 - v0), p0 = 1.0f / (1.0f + t), p1 = t * p0;
            const int rr = C.wave * 16 + r, e0 = gidx * 8 + i0, e1 = gidx * 8 + i1;
            const int pl0 = __hip_atomic_fetch_add(cnt + e0, 1, __ATOMIC_RELAXED, __HIP_MEMORY_SCOPE_WORKGROUP), pl1 = __hip_atomic_fetch_add(cnt + e1, 1, __ATOMIC_RELAXED, __HIP_MEMORY_SCOPE_WORKGROUP);
            info[rr * 6 + 0] = e0; info[rr * 6 + 1] = e1; info[rr * 6 + 2] = pl0; info[rr * 6 + 3] = pl1;
            info[rr * 6 + 4] = __builtin_bit_cast(int, gwt * p0); info[rr * 6 + 5] = __builtin_bit_cast(int, gwt * p1);
        }
        __syncthreads();
        if (C.tid < 32) base[C.tid] = (int)__hip_atomic_fetch_add(gcnt + C.tid, (unsigned)cnt[C.tid], RLX_AGENT);
        __syncthreads();
        if (C.tid < 128) { const size_t orow = (size_t)rb * 128 + C.tid; const int e0 = info[C.tid * 6], e1 = info[C.tid * 6 + 1];
            TOKE[orow] = e0 | (e1 << 8); TOKP[orow * 2] = base[e0] + info[C.tid * 6 + 2]; TOKP[orow * 2 + 1] = base[e1] + info[C.tid * 6 + 3];
            TOKW[orow * 2] = __builtin_bit_cast(float, info[C.tid * 6 + 4]); TOKW[orow * 2 + 1] = __builtin_bit_cast(float, info[C.tid * 6 + 5]); }
        __syncthreads();
        if (C.tid < 32) cnt[C.tid] = 0;
        __syncthreads();
    }
}
__device__ __forceinline__ int moe_tables(const Ctx& C, int l) {
    LAS int* tile_e = (LAS int*)(C.lds + MOE_TAB_OFF); LAS int* seg = (LAS int*)(C.lds + MOE_TAB_OFF + 1280); LAS int* lc = (LAS int*)(C.lds + MOE_TAB_OFF + 1280 + 160);
    if (C.tid < 32) lc[C.tid] = (int)__hip_atomic_load(C.ctl + CW_GCNT + l * 32 + C.tid, RLX_AGENT);
    __syncthreads();
    if (C.tid == 0) { int t = 0;
        for (int e = 0; e < 32; ++e) { seg[e] = t * 256; const int n = (lc[e] + 255) >> 8; for (int k = 0; k < n; ++k) tile_e[t + k] = e; t += n; }
        seg[32] = t * 256; }
    __syncthreads();
    return seg[32] >> 8;
}
__device__ __forceinline__ void phase_scatter(const Ctx& C, int l) {
    (void)moe_tables(C, l);
    const LAS int* seg = (const LAS int*)(C.lds + MOE_TAB_OFF + 1280);
    const int gw = C.bid * NWAVES + C.wave, NGW = C.G * NWAVES;
    const int* TOKE = (const int*)(C.ws + WS_TOKE); const int* TOKP = (const int*)(C.ws + WS_TOKP); int* TOKS = (int*)(C.ws + WS_TOKS);
    const bf16* H = (const bf16*)(C.ws + WS_H); bf16* XS = (bf16*)(C.ws + WS_A);
    for (int grp = gw; grp < M / 16; grp += NGW) {
#pragma unroll 4
        for (int r = 0; r < 16; ++r) { const size_t row = (size_t)grp * 16 + r; const int ee = TOKE[row];
            const int s0 = seg[ee & 255] + TOKP[row * 2], s1 = seg[ee >> 8] + TOKP[row * 2 + 1];
            const v4u a = ((const v4u*)(H + row * D))[C.lane], b = ((const v4u*)(H + row * D))[C.lane + 64];
            ((v4u*)(XS + (size_t)s0 * D))[C.lane] = a; ((v4u*)(XS + (size_t)s0 * D))[C.lane + 64] = b;
            ((v4u*)(XS + (size_t)s1 * D))[C.lane] = a; ((v4u*)(XS + (size_t)s1 * D))[C.lane + 64] = b;
            if (C.lane == 0) { TOKS[row * 2] = s0; TOKS[row * 2 + 1] = s1; } }
    }
}
template <bool FINAL> __device__ __forceinline__ void phase_combine(const Ctx& C, int lp) {
    const int gw = C.bid * NWAVES + C.wave, NGW = C.G * NWAVES;
    const float* MOD = (const float*)(C.ws + WS_MOD); bf16* H = (bf16*)(C.ws + WS_H); const bf16* YB = (const bf16*)(C.ws + WS_A);
    const int* TOKS = (const int*)(C.ws + WS_TOKS); const float* TOKW = (const float*)(C.ws + WS_TOKW);
    for (int grp = gw; grp < M / 16; grp += NGW) {
        const int b = grp >> 9; f32x4 g2[4], sc[4], sh[4];
#pragma unroll
        for (int j = 0; j < 4; ++j) g2[j] = ((const f32x4*)(MOD + (size_t)(lp * 4 + b) * 6144 + 5 * 1024))[C.lane + 64 * j];
        if (FINAL) {
#pragma unroll
            for (int j = 0; j < 4; ++j) { sc[j] = ((const f32x4*)kin(8))[C.lane + 64 * j]; sh[j] = (f32x4){0.f, 0.f, 0.f, 0.f}; }
        } else { const float* mod = MOD + (size_t)(4 + b) * 6144; load_mod(kin(6) + 1024, mod, mod + 1024, C.lane, sc, sh); }
        f32x4 xv[2][4]; v2u ya[2][4], yc[2][4]; float w0[2], w1[2];
#define CB_LOAD(buf, r0) do { const size_t row_ = (size_t)grp * 16 + (r0); \
            const int s0_ = TOKS[row_ * 2], s1_ = TOKS[row_ * 2 + 1]; w0[buf] = TOKW[row_ * 2]; w1[buf] = TOKW[row_ * 2 + 1]; \
            _Pragma("unroll") for (int j = 0; j < 4; ++j) { xv[buf][j] = ((const f32x4*)(C.out + row_ * D))[C.lane + 64 * j]; \
                ya[buf][j] = ((const v2u*)(YB + (size_t)s0_ * D))[C.lane + 64 * j]; yc[buf][j] = ((const v2u*)(YB + (size_t)s1_ * D))[C.lane + 64 * j]; } } while (0)
#define CB_PROC(buf, r0) do { const size_t row = (size_t)grp * 16 + (r0); f32x4 v[4]; \
            _Pragma("unroll") for (int j = 0; j < 4; ++j) { const v2u a = ya[buf][j], c = yc[buf][j]; \
                const f32x4 y0 = (f32x4){bflo(a.x), bfhi(a.x), bflo(a.y), bfhi(a.y)}, y1 = (f32x4){bflo(c.x), bfhi(c.x), bflo(c.y), bfhi(c.y)}; \
                v[j] = xv[buf][j] + g2[j] * (y0 * w0[buf] + y1 * w1[buf]); } \
            const float rinv = row_rinv(v); \
            if (FINAL) { _Pragma("unroll") for (int j = 0; j < 4; ++j) ((f32x4*)(C.out + row * D))[C.lane + 64 * j] = v[j] * rinv * sc[j]; } \
            else { _Pragma("unroll") for (int j = 0; j < 4; ++j) ((f32x4*)(C.out + row * D))[C.lane + 64 * j] = v[j]; mod_store(v, rinv, sc, sh, H + row * D, C.lane); } } while (0)
        CB_LOAD(0, 0);
#pragma unroll 1
        for (int it = 0; it < 8; ++it) { const int r0 = 2 * it;
            CB_LOAD(1, r0 + 1); CB_PROC(0, r0);
            if (it < 7) CB_LOAD(0, r0 + 2);
            CB_PROC(1, r0 + 1); }
#undef CB_PROC
#undef CB_LOAD
    }
}
__device__ __forceinline__ void unpack8(const v4u w, float (&f)[8]) { f[0] = bflo(w.x); f[1] = bfhi(w.x); f[2] = bflo(w.y); f[3] = bfhi(w.y); f[4] = bflo(w.z); f[5] = bfhi(w.z); f[6] = bflo(w.w); f[7] = bfhi(w.w); }
__device__ __forceinline__ void phase_conv(const Ctx& C) {
    const int gw = C.bid * NWAVES + C.wave, NGW = C.G * NWAVES;
    const bf16* BG = (const bf16*)(C.ws + WS_A); const bf16* Y = BG + (size_t)M * D; bf16* MIX = (bf16*)(C.ws + WS_B);
    float cw[3][2][8];
#pragma unroll
    for (int t = 0; t < 3; ++t)
#pragma unroll
        for (int j = 0; j < 2; ++j) { const f32x4 a = *(const f32x4*)(kin(16) + t * 1024 + j * 512 + 8 * C.lane), b = *(const f32x4*)(kin(16) + t * 1024 + j * 512 + 8 * C.lane + 4);
            cw[t][j][0] = a.x; cw[t][j][1] = a.y; cw[t][j][2] = a.z; cw[t][j][3] = a.w; cw[t][j][4] = b.x; cw[t][j][5] = b.y; cw[t][j][6] = b.z; cw[t][j][7] = b.w; }
    const v4u zero4 = (v4u){0u, 0u, 0u, 0u};
    for (int grp = gw; grp < M / 16; grp += NGW) {
        const size_t t0 = (size_t)grp * 16; v4u prev[2], cur[2];
        v4u yn[2][4][2], bgv[2][4][2];
#define CV_LOAD(buf, r0) do { _Pragma("unroll") for (int rr = 0; rr < 4; ++rr) { const size_t row_ = t0 + (r0) + rr; const bool last_ = (row_ & 8191) == 8191; \
            _Pragma("unroll") for (int j = 0; j < 2; ++j) { yn[buf][rr][j] = last_ ? zero4 : ((const v4u*)(Y + (row_ + 1) * D))[C.lane + 64 * j]; bgv[buf][rr][j] = ((const v4u*)(BG + row_ * D))[C.lane + 64 * j]; } } } while (0)
#pragma unroll
        for (int j = 0; j < 2; ++j) { prev[j] = ((t0 & 8191) == 0) ? zero4 : ((const v4u*)(Y + (t0 - 1) * D))[C.lane + 64 * j]; cur[j] = ((const v4u*)(Y + t0 * D))[C.lane + 64 * j]; }
#define CV_PROC(buf, r0) do { _Pragma("unroll") for (int rr = 0; rr < 4; ++rr) { const size_t row = t0 + (r0) + rr; \
            _Pragma("unroll") for (int j = 0; j < 2; ++j) { const v4u nx = yn[buf][rr][j]; \
                float fp[8], fc[8], fn[8], fb[8], o[8]; unpack8(prev[j], fp); unpack8(cur[j], fc); unpack8(nx, fn); unpack8(bgv[buf][rr][j], fb); \
                _Pragma("unroll") for (int e = 0; e < 8; ++e) o[e] = fb[e] * (fp[e] * cw[0][j][e] + fc[e] * cw[1][j][e] + fn[e] * cw[2][j][e]); \
                v4u w; w.x = pk2(o[0], o[1]); w.y = pk2(o[2], o[3]); w.z = pk2(o[4], o[5]); w.w = pk2(o[6], o[7]); \
                ((v4u*)(MIX + row * D))[C.lane + 64 * j] = w; prev[j] = cur[j]; cur[j] = nx; } } } while (0)
        CV_LOAD(0, 0);
#pragma unroll 1
        for (int it = 0; it < 2; ++it) { const int r0 = 8 * it;
            CV_LOAD(1, r0 + 4); CV_PROC(0, r0);
            if (it < 1) CV_LOAD(0, r0 + 8);
            CV_PROC(1, r0 + 4); }
#undef CV_PROC
#undef CV_LOAD
    }
}
constexpr float LOG2E = 1.4426950408889634f;
constexpr float QSCALE = 0.125f * LOG2E;
constexpr int AT_K = 0, AT_V = 16384, AT_WS = 32768, AT_ST = 34816;
__device__ __forceinline__ int crow(int r, int hi) { return (r & 3) + 8 * (r >> 2) + 4 * hi; }
__device__ __forceinline__ bf16x8 pack8(float a0, float a1, float a2, float a3, float a4, float a5, float a6, float a7) {
    v4u w; w.x = pg8::cvt_pk_bf16(a0, a1); w.y = pg8::cvt_pk_bf16(a2, a3); w.z = pg8::cvt_pk_bf16(a4, a5); w.w = pg8::cvt_pk_bf16(a6, a7); return __builtin_bit_cast(bf16x8, w);
}
__device__ __forceinline__ void attn_unit(const Ctx& C, int au) {
    const int qblk = au & 127, kvh = (au >> 7) & 1, b = au >> 8;
    const int ph = C.wave & 1, head = kvh * 4 + (C.wave >> 1), q32 = C.lane & 31, hi = C.lane >> 5;
    const bf16* QK = (const bf16*)(C.ws + WS_A); const bf16* VT = (const bf16*)(C.ws + WS_VT); const bf16* KC = (const bf16*)(C.ws + WS_KC); const bf16* VCT = (const bf16*)(C.ws + WS_VCT);
    bf16* MIX = (bf16*)(C.ws + WS_B);
    const size_t qrow = (size_t)b * SEQ + 64 * qblk + 32 * ph + q32;
    bf16x8 qf[4];
#pragma unroll
    for (int ds = 0; ds < 4; ++ds) qf[ds] = *(const bf16x8*)(QK + qrow * NINE + head * 64 + 16 * ds + 8 * hi);
    float m = kin(10)[head] * LOG2E, l = (hi == 0) ? 1.0f : 0.0f;
    f32x16 o0, o1;
#pragma unroll
    for (int r = 0; r < 16; ++r) { o0[r] = 0.f; o1[r] = 0.f; }
    const int jlo = (qblk < 2) ? 2 - qblk : 0, jhi = (qblk > 125) ? 129 - qblk : 4, NT = 4 + jhi - jlo + 1;
    const int prow = C.tid >> 3, pch = C.tid & 7;
    LAS float* wsf = (LAS float*)(C.lds + AT_WS) + C.wave * 64;
    v4u kreg, vreg;
#define AT_LOAD(t) do { if ((t) < 4) { kreg = *(const v4u*)(KC + ((size_t)(b * 256 + 64 * (t) + prow) * 128 + kvh * 64 + 8 * pch)); \
            vreg = *(const v4u*)(VCT + ((size_t)((b * 2 + kvh) * 64 + prow) * 256 + 64 * (t) + 8 * pch)); } \
        else { const int kblk_ = qblk - 2 + jlo + (t) - 4; kreg = *(const v4u*)(QK + ((size_t)(b * SEQ + 64 * kblk_ + prow) * NINE + 512 + kvh * 64 + 8 * pch)); \
            vreg = *(const v4u*)(VT + ((size_t)((b * 2 + kvh) * 64 + prow) * SEQ + 64 * kblk_ + 8 * pch)); } } while (0)
    AT_LOAD(0);
    for (int t = 0; t < NT; ++t) {
        const int buf = t & 1;
        *(LAS v4u*)(C.lds + AT_K + buf * 8192 + pch * 1024 + prow * 16) = kreg;
        *(LAS v4u*)(C.lds + AT_V + buf * 8192 + pch * 1024 + prow * 16) = vreg;
        if (t + 1 < NT) AT_LOAD(t + 1);
        __syncthreads();
        const LAS unsigned char* kb = C.lds + AT_K + buf * 8192; const LAS unsigned char* vb = C.lds + AT_V + buf * 8192;
        f32x16 p0, p1;
#pragma unroll
        for (int r = 0; r < 16; ++r) { p0[r] = 0.f; p1[r] = 0.f; }
#pragma unroll
        for (int ds = 0; ds < 4; ++ds) {
            const bf16x8 a0 = *(const LAS bf16x8*)(kb + (2 * ds + hi) * 1024 + q32 * 16), a1 = *(const LAS bf16x8*)(kb + (2 * ds + hi) * 1024 + (q32 + 32) * 16);
            p0 = __builtin_amdgcn_mfma_f32_32x32x16_bf16(a0, qf[ds], p0, 0, 0, 0); p1 = __builtin_amdgcn_mfma_f32_32x32x16_bf16(a1, qf[ds], p1, 0, 0, 0);
        }
        const int j = (t < 4) ? -1 : jlo + t - 4;
        if (j == 0 || j == 4) {
            int qq = 32 * ph + q32; asm volatile("" : "+v"(qq));
#pragma unroll
            for (int r = 0; r < 16; ++r) { const int kv = crow(r, hi);
                const bool d0 = (j == 0) ? (kv < qq) : (kv > qq), d1 = (j == 0) ? (kv + 32 < qq) : (kv + 32 > qq);
                if (d0) p0[r] = -__builtin_inff(); if (d1) p1[r] = -__builtin_inff(); }
        }
        float rm = fmaxf(p0[0], p1[0]);
#pragma unroll
        for (int r = 1; r < 16; ++r) rm = fmaxf(rm, fmaxf(p0[r], p1[r]));
        rm = fmaxf(rm, __shfl_xor(rm, 32));
        if (__any(rm > m)) {
            const float mn = fmaxf(m, rm), al = __builtin_amdgcn_exp2f(m - mn); m = mn; l *= al;
            if (hi == 0) wsf[q32] = al;
#pragma unroll
            for (int r = 0; r < 16; ++r) { const float f = wsf[crow(r, hi)]; o0[r] *= f; o1[r] *= f; }
        }
        float ls = 0.f;
#pragma unroll
        for (int r = 0; r < 16; ++r) { p0[r] = __builtin_amdgcn_exp2f(p0[r] - m); p1[r] = __builtin_amdgcn_exp2f(p1[r] - m); ls += p0[r] + p1[r]; }
        l += ls;
#pragma unroll
        for (int s = 0; s < 2; ++s) {
            const bf16x8 pa = pack8(p0[8 * s], p0[8 * s + 1], p0[8 * s + 2], p0[8 * s + 3], p0[8 * s + 4], p0[8 * s + 5], p0[8 * s + 6], p0[8 * s + 7]);
            const bf16x8 pb = pack8(p1[8 * s], p1[8 * s + 1], p1[8 * s + 2], p1[8 * s + 3], p1[8 * s + 4], p1[8 * s + 5], p1[8 * s + 6], p1[8 * s + 7]);
            const bf16x8 va0 = *(const LAS bf16x8*)(vb + (2 * s + hi) * 1024 + q32 * 16), va1 = *(const LAS bf16x8*)(vb + (2 * s + hi) * 1024 + (q32 + 32) * 16);
            const bf16x8 vb0 = *(const LAS bf16x8*)(vb + (4 + 2 * s + hi) * 1024 + q32 * 16), vb1 = *(const LAS bf16x8*)(vb + (4 + 2 * s + hi) * 1024 + (q32 + 32) * 16);
            o0 = __builtin_amdgcn_mfma_f32_32x32x16_bf16(pa, va0, o0, 0, 0, 0); o1 = __builtin_amdgcn_mfma_f32_32x32x16_bf16(pa, va1, o1, 0, 0, 0);
            o0 = __builtin_amdgcn_mfma_f32_32x32x16_bf16(pb, vb0, o0, 0, 0, 0); o1 = __builtin_amdgcn_mfma_f32_32x32x16_bf16(pb, vb1, o1, 0, 0, 0);
        }
    }
#undef AT_LOAD
    l += __shfl_xor(l, 32);
    if (hi == 0) wsf[32 + q32] = l;
    LAS bf16* stg = (LAS bf16*)(C.lds + AT_ST) + C.wave * 2048;
#pragma unroll
    for (int r = 0; r < 16; ++r) { const int orow = crow(r, hi); const float rl = 1.0f / wsf[32 + orow];
        stg[orow * 64 + q32] = (bf16)f2bf(o0[r] * rl); stg[orow * 64 + 32 + q32] = (bf16)f2bf(o1[r] * rl); }
    bf16* Ow = MIX + ((size_t)b * SEQ + 64 * qblk + 32 * ph) * D + head * 64;
#pragma unroll
    for (int i = 0; i < 4; ++i) { const int pc = i * 64 + C.lane, row = pc >> 3, ch = pc & 7; const v4u v = *(const LAS v4u*)(stg + row * 64 + ch * 8); *(v4u*)(Ow + (size_t)row * D + ch * 8) = v; }
    __syncthreads();
}
constexpr int ZS = 1040;
__device__ __forceinline__ v2u tr_read(unsigned addr) { v2u r; asm volatile("ds_read_b64_tr_b16 %0, %1\n\ts_waitcnt lgkmcnt(0)" : "=&v"(r) : "v"(addr) : "memory"); return r; }
__device__ __forceinline__ void sgu_unit(const Ctx& C, int su) {
    const size_t R0 = (size_t)su * 128;
    const bf16* QK = (const bf16*)(C.ws + WS_A); bf16* MIX = (bf16*)(C.ws + WS_B); const bf16* WSP = (const bf16*)(C.ws + WS_WSP);
    { float gs[8]; const f32x4 a = *(const f32x4*)(kin(11) + 8 * C.lane), c = *(const f32x4*)(kin(11) + 8 * C.lane + 4);
        gs[0] = a.x; gs[1] = a.y; gs[2] = a.z; gs[3] = a.w; gs[4] = c.x; gs[5] = c.y; gs[6] = c.z; gs[7] = c.w;
#pragma unroll 4
        for (int rr = 0; rr < 16; ++rr) { const int j = C.wave * 16 + rr;
            const v4u zw = *(const v4u*)(QK + (R0 + j) * NINE + 1280 + 8 * C.lane); float x[8]; unpack8(zw, x);
            float s = 0.f;
#pragma unroll
            for (int e = 0; e < 8; ++e) s += x[e];
            const float mean = wave_sum(s) * (1.0f / 512.0f); float q = 0.f;
#pragma unroll
            for (int e = 0; e < 8; ++e) { x[e] -= mean; q += x[e] * x[e]; }
            const float rstd = rsqrtf(wave_sum(q) * (1.0f / 512.0f) + EPS);
            v4u w; w.x = pk2(x[0] * rstd * gs[0], x[1] * rstd * gs[1]); w.y = pk2(x[2] * rstd * gs[2], x[3] * rstd * gs[3]);
            w.z = pk2(x[4] * rstd * gs[4], x[5] * rstd * gs[5]); w.w = pk2(x[6] * rstd * gs[6], x[7] * rstd * gs[7]);
            *(LAS v4u*)(C.lds + j * ZS + 16 * C.lane) = w; }
    }
    __syncthreads();
    const int h = C.wave, l31 = C.lane & 31, hi = C.lane >> 5, g16 = (C.lane >> 4) & 1, q4 = (C.lane & 15) >> 2, p4 = C.lane & 3;
    f32x16 acc[2][4];
#pragma unroll
    for (int cb = 0; cb < 2; ++cb)
#pragma unroll
        for (int ib = 0; ib < 4; ++ib)
#pragma unroll
            for (int r = 0; r < 16; ++r) acc[cb][ib][r] = 0.f;
#pragma unroll 2
    for (int ks = 0; ks < 8; ++ks) {
        bf16x8 bw[4];
#pragma unroll
        for (int ib = 0; ib < 4; ++ib) bw[ib] = *(const bf16x8*)(WSP + ((size_t)h * 128 + 32 * ib + l31) * 128 + 16 * ks + 8 * hi);
        bf16x8 az[2];
#pragma unroll
        for (int cb = 0; cb < 2; ++cb) {
            const unsigned a0 = C.ldsaddr + (unsigned)((16 * ks + 8 * hi + q4) * ZS + (64 * h + 32 * cb + 16 * g16 + 4 * p4) * 2);
            const v2u lo = tr_read(a0), hi2 = tr_read(a0 + 4 * ZS);
            az[cb] = __builtin_bit_cast(bf16x8, (v4u){lo.x, lo.y, hi2.x, hi2.y});
        }
#pragma unroll
        for (int cb = 0; cb < 2; ++cb)
#pragma unroll
            for (int ib = 0; ib < 4; ++ib) acc[cb][ib] = __builtin_amdgcn_mfma_f32_32x32x16_bf16(az[cb], bw[ib], acc[cb][ib], 0, 0, 0);
    }
#pragma unroll
    for (int ib = 0; ib < 4; ++ib) {
        const int i = 32 * ib + l31; const float bias = kin(13)[h * 128 + i]; const size_t row = R0 + i;
#pragma unroll
        for (int cb = 0; cb < 2; ++cb)
#pragma unroll
            for (int rg = 0; rg < 4; ++rg) { const int c = 64 * h + 32 * cb + 8 * rg + 4 * hi;
                const v2u uw = *(const v2u*)(QK + row * NINE + 768 + c);
                const float o0 = bflo(uw.x) * (acc[cb][ib][4 * rg] + bias), o1 = bfhi(uw.x) * (acc[cb][ib][4 * rg + 1] + bias), o2 = bflo(uw.y) * (acc[cb][ib][4 * rg + 2] + bias), o3 = bfhi(uw.y) * (acc[cb][ib][4 * rg + 3] + bias);
                v2u w; w.x = pk2(o0, o1); w.y = pk2(o2, o3); *(v2u*)(MIX + row * D + 512 + c) = w; }
    }
    __syncthreads();
}
__device__ __forceinline__ void phase_attn_sgu(const Ctx& C) {
    for (int au = C.bid; au < BATCH * 2 * 128; au += C.G) attn_unit(C, au);
    for (int su = C.bid; su < M / 128; su += C.G) sgu_unit(C, su);
}
__global__ void __launch_bounds__(NWAVES * 64, 2) mk_fwd(Args args) {
    extern __shared__ __attribute__((aligned(16))) unsigned char lds_raw[];
    Ctx C;
    C.lds = (LAS unsigned char*)lds_raw; C.ldsaddr = (unsigned)(uintptr_t)C.lds;
    C.tid = threadIdx.x; C.lane = C.tid & 63; C.wave = __builtin_amdgcn_readfirstlane(C.tid >> 6);
    C.G = gridDim.x; C.bid = blockIdx.x;
    C.out = args.out; C.ws = args.ws; C.ctl = (gu32*)(args.ws + WS_CTL);
    volatile LAS unsigned* MISC = (volatile LAS unsigned*)(C.lds + MISC_OFF);
    if (C.tid < 64) MISC[C.tid] = 0u;
    __syncthreads();
#define FRESH_IDS(Cx) do { int z_ = 0; asm volatile("" : "+s"(z_)); Cx.lane = (int)__builtin_amdgcn_mbcnt_hi(~0u, __builtin_amdgcn_mbcnt_lo(~0u, (unsigned)z_)); Cx.tid = Cx.wave * 64 + Cx.lane; } while (0)
    const int lo = args.ph_lo, hi = args.ph_hi;
    const bool one = (hi - lo) > 1;
    XcdBarrier bar; bar.bar = (unsigned*)(C.ctl + CW_BAR); bar.x = 0; bar.st = nullptr;
    if (one) bar = xcd_barrier_post((unsigned*)(C.ctl + CW_BAR), MISC + 8);
#ifndef PHMASK
#define PHMASK 0x3ffff
#endif
#define IN(k) (((PHMASK >> (k)) & 1) && lo <= (k) && (k) < hi)
#define SEAM(k) do { if (IN(k) && IN((k) + 1)) { Ctx Cb = C; FRESH_IDS(Cb); xcd_barrier(bar, Cb.tid); } } while (0)
#ifndef DUPMASK
#define DUPMASK 0
#endif
#define DUP(k) DUP_##k
#if (DUPMASK >> 0) & 1
#define DUP_0 _Pragma("unroll") for (int rep_ = 0; rep_ < 2; ++rep_)
#else
#define DUP_0
#endif
#if (DUPMASK >> 1) & 1
#define DUP_1 _Pragma("unroll") for (int rep_ = 0; rep_ < 2; ++rep_)
#else
#define DUP_1
#endif
#if (DUPMASK >> 2) & 1
#define DUP_2 _Pragma("unroll") for (int rep_ = 0; rep_ < 2; ++rep_)
#else
#define DUP_2
#endif
#if (DUPMASK >> 3) & 1
#define DUP_3 _Pragma("unroll") for (int rep_ = 0; rep_ < 2; ++rep_)
#else
#define DUP_3
#endif
#if (DUPMASK >> 4) & 1
#define DUP_4 _Pragma("unroll") for (int rep_ = 0; rep_ < 2; ++rep_)
#else
#define DUP_4
#endif
#if (DUPMASK >> 5) & 1
#define DUP_5 _Pragma("unroll") for (int rep_ = 0; rep_ < 2; ++rep_)
#else
#define DUP_5
#endif
#if (DUPMASK >> 6) & 1
#define DUP_6 _Pragma("unroll") for (int rep_ = 0; rep_ < 2; ++rep_)
#else
#define DUP_6
#endif
#if (DUPMASK >> 7) & 1
#define DUP_7 _Pragma("unroll") for (int rep_ = 0; rep_ < 2; ++rep_)
#else
#define DUP_7
#endif
#if (DUPMASK >> 8) & 1
#define DUP_8 _Pragma("unroll") for (int rep_ = 0; rep_ < 2; ++rep_)
#else
#define DUP_8
#endif
#if (DUPMASK >> 9) & 1
#define DUP_9 _Pragma("unroll") for (int rep_ = 0; rep_ < 2; ++rep_)
#else
#define DUP_9
#endif
#if (DUPMASK >> 10) & 1
#define DUP_10 _Pragma("unroll") for (int rep_ = 0; rep_ < 2; ++rep_)
#else
#define DUP_10
#endif
#if (DUPMASK >> 11) & 1
#define DUP_11 _Pragma("unroll") for (int rep_ = 0; rep_ < 2; ++rep_)
#else
#define DUP_11
#endif
#if (DUPMASK >> 12) & 1
#define DUP_12 _Pragma("unroll") for (int rep_ = 0; rep_ < 2; ++rep_)
#else
#define DUP_12
#endif
#if (DUPMASK >> 13) & 1
#define DUP_13 _Pragma("unroll") for (int rep_ = 0; rep_ < 2; ++rep_)
#else
#define DUP_13
#endif
#if (DUPMASK >> 14) & 1
#define DUP_14 _Pragma("unroll") for (int rep_ = 0; rep_ < 2; ++rep_)
#else
#define DUP_14
#endif
#if (DUPMASK >> 15) & 1
#define DUP_15 _Pragma("unroll") for (int rep_ = 0; rep_ < 2; ++rep_)
#else
#define DUP_15
#endif
#if (DUPMASK >> 16) & 1
#define DUP_16 _Pragma("unroll") for (int rep_ = 0; rep_ < 2; ++rep_)
#else
#define DUP_16
#endif
#if (DUPMASK >> 17) & 1
#define DUP_17 _Pragma("unroll") for (int rep_ = 0; rep_ < 2; ++rep_)
#else
#define DUP_17
#endif
    bf16* const H = (bf16*)(C.ws + WS_H); bf16* const RA = (bf16*)(C.ws + WS_A); bf16* const RB = (bf16*)(C.ws + WS_B);
    const float* const MOD = (const float*)(C.ws + WS_MOD);

    DUP(0) { if (IN(0)) { Ctx Cp = C; FRESH_IDS(Cp); p0_prologue(Cp); } SEAM(0); }
    DUP(1) { if (IN(1)) { Ctx Cp = C; FRESH_IDS(Cp); phase_norm1_l0(Cp); } SEAM(1); }
    DUP(2) { if (IN(2)) { Ctx Cp = C; FRESH_IDS(Cp);
        pg8::Gemm g{H, (const bf16*)(Cp.ws + WS_WINE), M, NINE, D}; pg8::InEOrder S; S.so.init(M, NINE, Cp.G, Cp.bid); S.G = Cp.G; S.c = Cp.bid;
        pg8::EpiInE E{RA, (bf16*)(Cp.ws + WS_VT), (bf16*)(Cp.ws + WS_KC), (bf16*)(Cp.ws + WS_VCT), (const float*)(Cp.ws + WS_ROPE), (const float*)(Cp.ws + WS_ROPE) + 2048, QSCALE};
        pg8::gemm_phase<pg8::EpiInE, pg8::InEOrder, true, true>(Cp.lds, g, S, E, Cp.tid);
    } SEAM(2); }
    DUP(3) { if (IN(3)) { Ctx Cp = C; FRESH_IDS(Cp); phase_attn_sgu(Cp); } SEAM(3); }
    DUP(4) { if (IN(4)) { Ctx Cp = C; FRESH_IDS(Cp);
        pg8::Gemm g{RB, (const bf16*)(Cp.ws + WS_WOUTE), M, D, D}; pg8::StaticOrder S; S.init(M, D, Cp.G, Cp.bid);
        pg8::EpiRes E{kin(0), Cp.out, MOD + 2 * 1024, (float*)(Cp.ws + WS_RSS)};
        pg8::gemm_phase<pg8::EpiRes, pg8::StaticOrder, true, true>(Cp.lds, g, S, E, Cp.tid);
    } SEAM(4); }
    DUP(5) { if (IN(5)) { Ctx Cp = C; FRESH_IDS(Cp); phase_router(Cp, 0); } SEAM(5); }
    DUP(6) { if (IN(6)) { Ctx Cp = C; FRESH_IDS(Cp); phase_scatter(Cp, 0); } SEAM(6); }
    DUP(7) { if (IN(7)) { Ctx Cp = C; FRESH_IDS(Cp);
        const int nt = moe_tables(Cp, 0);
        pg8::Gemm g{RA, (const bf16*)(Cp.ws + WS_WGU), nt * 256, NEXP * 1024, D}; pg8::MoeOrder S{(const LAS int*)(Cp.lds + MOE_TAB_OFF), nt * 4, Cp.G, Cp.bid};
        pg8::EpiSwiGLU E{RB};
        pg8::gemm_phase<pg8::EpiSwiGLU, pg8::MoeOrder, true, true>(Cp.lds, g, S, E, Cp.tid);
    } SEAM(7); }
    DUP(8) { if (IN(8)) { Ctx Cp = C; FRESH_IDS(Cp);
        const int nt = moe_tables(Cp, 0);
        pg8::Gemm g{RB, (const bf16*)(Cp.ws + WS_WD), nt * 256, NEXP * 1024, EH}; pg8::MoeOrder S{(const LAS int*)(Cp.lds + MOE_TAB_OFF), nt * 4, Cp.G, Cp.bid};
        pg8::EpiDown E{RA};
        pg8::gemm_phase<pg8::EpiDown, pg8::MoeOrder, true, true>(Cp.lds, g, S, E, Cp.tid);
    } SEAM(8); }
    DUP(9) { if (IN(9)) { Ctx Cp = C; FRESH_IDS(Cp); phase_combine<false>(Cp, 0); } SEAM(9); }
    DUP(10) { if (IN(10)) { Ctx Cp = C; FRESH_IDS(Cp);
        pg8::Gemm g{H, (const bf16*)(Cp.ws + WS_WINO), M, 3072, D}; pg8::StaticOrder S; S.init(M, 3072, Cp.G, Cp.bid);
        pg8::EpiInO E{RA, RA + (size_t)M * D};
        pg8::gemm_phase<pg8::EpiInO, pg8::StaticOrder, true, true>(Cp.lds, g, S, E, Cp.tid);
    } SEAM(10); }
    DUP(11) { if (IN(11)) { Ctx Cp = C; FRESH_IDS(Cp); phase_conv(Cp); } SEAM(11); }
    DUP(12) { if (IN(12)) { Ctx Cp = C; FRESH_IDS(Cp);
        pg8::Gemm g{RB, (const bf16*)(Cp.ws + WS_WOUTO), M, D, D}; pg8::StaticOrder S; S.init(M, D, Cp.G, Cp.bid);
        pg8::EpiRes E{Cp.out, Cp.out, MOD + (size_t)4 * 6144 + 2 * 1024, (float*)(Cp.ws + WS_RSS)};
        pg8::gemm_phase<pg8::EpiRes, pg8::StaticOrder, true, true>(Cp.lds, g, S, E, Cp.tid);
    } SEAM(12); }
    DUP(13) { if (IN(13)) { Ctx Cp = C; FRESH_IDS(Cp); phase_router(Cp, 1); } SEAM(13); }
    DUP(14) { if (IN(14)) { Ctx Cp = C; FRESH_IDS(Cp); phase_scatter(Cp, 1); } SEAM(14); }
    DUP(15) { if (IN(15)) { Ctx Cp = C; FRESH_IDS(Cp);
        const int nt = moe_tables(Cp, 1);
        pg8::Gemm g{RA, (const bf16*)(Cp.ws + WS_WGU) + (size_t)NEXP * 1024 * 1024, nt * 256, NEXP * 1024, D}; pg8::MoeOrder S{(const LAS int*)(Cp.lds + MOE_TAB_OFF), nt * 4, Cp.G, Cp.bid};
        pg8::EpiSwiGLU E{RB};
        pg8::gemm_phase<pg8::EpiSwiGLU, pg8::MoeOrder, true, true>(Cp.lds, g, S, E, Cp.tid);
    } SEAM(15); }
    DUP(16) { if (IN(16)) { Ctx Cp = C; FRESH_IDS(Cp);
        const int nt = moe_tables(Cp, 1);
        pg8::Gemm g{RB, (const bf16*)(Cp.ws + WS_WD) + (size_t)NEXP * 1024 * 512, nt * 256, NEXP * 1024, EH}; pg8::MoeOrder S{(const LAS int*)(Cp.lds + MOE_TAB_OFF), nt * 4, Cp.G, Cp.bid};
        pg8::EpiDown E{RA};
        pg8::gemm_phase<pg8::EpiDown, pg8::MoeOrder, true, true>(Cp.lds, g, S, E, Cp.tid);
    } SEAM(16); }
    DUP(17) { if (IN(17)) { Ctx Cp = C; FRESH_IDS(Cp); phase_combine<true>(Cp, 1); } }
#undef IN
#undef SEAM
}

extern "C" void kernel_launch(void* const* d_in, const int* in_sizes, int n_in, void* d_out, int out_size, void* d_ws, size_t ws_size, hipStream_t stream) {
    static int grid = 0;
    if (grid == 0) {
        if (n_in != 25 || in_sizes[0] != M * D || out_size != M * D || ws_size < WS_END) { fprintf(stderr, "kernel_launch: unexpected shapes (n_in %d, in0 %d, out %d, ws %zu)\n", n_in, n_in > 0 ? in_sizes[0] : -1, out_size, ws_size); grid = -1; return; }
        int dev = 0, cus = 0, per_cu = 0;
        if (hipGetDevice(&dev) != hipSuccess || hipDeviceGetAttribute(&cus, hipDeviceAttributeMultiprocessorCount, dev) != hipSuccess) { grid = -1; return; }
        if (hipFuncSetAttribute((const void*)mk_fwd, hipFuncAttributeMaxDynamicSharedMemorySize, LDS_BYTES) != hipSuccess) { fprintf(stderr, "kernel_launch: hipFuncSetAttribute failed\n"); grid = -1; return; }
        if (hipOccupancyMaxActiveBlocksPerMultiprocessor(&per_cu, (const void*)mk_fwd, NWAVES * 64, LDS_BYTES) != hipSuccess || per_cu < 1) { fprintf(stderr, "kernel_launch: occupancy query says %d\n", per_cu); }
        (void)hipGetLastError();
        grid = cus;
    }
    if (grid < 0) return;
    if (hipMemsetAsync((char*)d_ws + WS_CTL, 0, CTL_ZERO_BYTES, stream) != hipSuccess) return;
    Args a{};
    for (int i = 0; i < 25; ++i) a.in[i] = (const float*)d_in[i];
    a.out = (float*)d_out; a.ws = (unsigned char*)d_ws;
#if defined(PROBE_K)
    a.ph_lo = 0; a.ph_hi = PROBE_K + 1; hipLaunchKernelGGL(mk_fwd, dim3(grid), dim3(NWAVES * 64), LDS_BYTES, stream, a);
    (void)hipMemsetAsync((char*)d_ws + WS_CTL, 0, (PROBE_K == 5 || PROBE_K == 13) ? CTL_ZERO_BYTES : (size_t)4 * CW_GCNT, stream);
    a.ph_lo = PROBE_K; a.ph_hi = PROBE_K + 1; hipLaunchKernelGGL(mk_fwd, dim3(grid), dim3(NWAVES * 64), LDS_BYTES, stream, a);
    (void)hipMemsetAsync((char*)d_ws + WS_CTL, 0, 4 * CW_GCNT, stream);
    if (PROBE_K + 1 < N_PHASES) { a.ph_lo = PROBE_K + 1; a.ph_hi = N_PHASES; hipLaunchKernelGGL(mk_fwd, dim3(grid), dim3(NWAVES * 64), LDS_BYTES, stream, a); }
#elif MK_ONE_LAUNCH
    a.ph_lo = 0; a.ph_hi = N_PHASES;
    hipLaunchKernelGGL(mk_fwd, dim3(grid), dim3(NWAVES * 64), LDS_BYTES, stream, a);
#else
    for (int p = 0; p < N_PHASES; ++p) { a.ph_lo = p; a.ph_hi = p + 1; hipLaunchKernelGGL(mk_fwd, dim3(grid), dim3(NWAVES * 64), LDS_BYTES, stream, a); }
#endif
}
```

```cpp
#include <hip/hip_runtime.h>
#include <cstdio>
#include <cstdint>
namespace pg8 {
#define PG8_LAS __attribute__((address_space(3)))
typedef unsigned short bf16_t;
typedef short bf16x8 __attribute__((ext_vector_type(8)));
typedef float f32x4 __attribute__((ext_vector_type(4)));
typedef unsigned u32x4 __attribute__((ext_vector_type(4)));
constexpr int BM = 256, BK = 64, HALF = 128, HTB = HALF * BK * 2  , STAGE_BYTES = 8 * HTB, NXCD = 8, WGM = 8;

__host__ __device__ __forceinline__ int lds_byte(int r, int c) { const int st = (r >> 4) * 2 + (c >> 5), rr = r & 15, cc = c & 31, ob = rr * 64 + cc * 2; return st * 1024 + (ob ^ (((ob >> 9) & 1) << 5)); }
__host__ __device__ __forceinline__ void stage_rc(int b, int& R, int& C) { const int st = b / 1024, sb = b % 1024, swz = sb ^ (((sb >> 9) & 1) << 5); R = (st >> 1) * 16 + swz / 64; C = (st & 1) * 32 + (swz % 64) / 2; }
__host__ __device__ __forceinline__ int perm32(int rho) { const int n = rho >> 4, i = rho & 15; return 8 * (i >> 2) + 4 * n + (i & 3); }

struct Unit { int pm, pn; };
struct Gemm { const bf16_t* A; const bf16_t* Bt; int M, N, K; };

struct StaticOrder {
    int nM, nN, nwg, G, c;
    __host__ __device__ void init(int M, int N, int G_, int c_) { nM = M / BM; nN = N / BM; nwg = nM * nN; G = G_; c = c_; }
    __host__ __device__ bool next(int i, Unit& u) const {
        const long L = (long)i * G + c; if (L >= nwg) return false;
        int wgid = (int)L; { const int q = nwg / NXCD, r = nwg % NXCD, xcd = wgid % NXCD, off = wgid / NXCD; wgid = (xcd < r ? xcd * (q + 1) : r * (q + 1) + (xcd - r) * q) + off; }
        const int nig = WGM * nN, gid = wgid / nig, fm = gid * WGM, gsz = (nM - fm) < WGM ? (nM - fm) : WGM;
        u.pm = fm + ((wgid % nig) % gsz); u.pn = (wgid % nig) / gsz; return true;
    }
    __device__ __forceinline__ void a_ready(const Unit&) const {}
    __device__ __forceinline__ void done(const Unit&) const {}
};

__device__ __forceinline__ unsigned cvt_pk_bf16(float lo, float hi) { unsigned r; asm volatile("v_cvt_pk_bf16_f32 %0, %1, %2" : "=v"(r) : "v"(lo), "v"(hi)); return r; }
typedef float f32x2 __attribute__((ext_vector_type(2)));
__device__ __forceinline__ f32x2 gelu_pk(f32x2 v) {
    const f32x2 av = __builtin_elementwise_abs(v), d = av * 0.2316418882f + 1.0f;
    f32x2 t; t.x = __builtin_amdgcn_rcpf(d.x); t.y = __builtin_amdgcn_rcpf(d.y);
    f32x2 q = t * 0.5307027145f + (-0.7265760135f); q = q * t + 0.7107068705f; q = q * t + (-0.142248368f); q = q * t + 0.127414796f; q = q * t;
    const f32x2 s = (v * v) * (-0.72134752044f);
    f32x2 e; e.x = __builtin_amdgcn_exp2f(s.x); e.y = __builtin_amdgcn_exp2f(s.y);
    const f32x2 m = v * (q * e), r = v - m;
    f32x2 o; o.x = v.x < 0.f ? m.x : r.x; o.y = v.y < 0.f ? m.y : r.y; return o;
}

typedef unsigned u32x2 __attribute__((ext_vector_type(2)));
__device__ __forceinline__ int perm16(int x) { return (x & 3) | ((x & 4) << 1) | ((x & 8) >> 1); }
__device__ __forceinline__ bf16_t bf1(float v) { return (bf16_t)(cvt_pk_bf16(v, 0.f) & 0xffffu); }
__device__ __forceinline__ u32x2 pk4(f32x4 v) { u32x2 w; w.x = cvt_pk_bf16(v[0], v[1]); w.y = cvt_pk_bf16(v[2], v[3]); return w; }
__device__ __forceinline__ f32x4 gelu4(f32x4 v) { const f32x2 a = gelu_pk((f32x2){v[0], v[1]}), b = gelu_pk((f32x2){v[2], v[3]}); return (f32x4){a.x, a.y, b.x, b.y}; }
__device__ __forceinline__ float silu1(float g) { return g * __builtin_amdgcn_rcpf(1.0f + __builtin_amdgcn_exp2f(-1.4426950408889634f * g)); }

struct EpiInE {
    static constexpr bool PERM = false, AFTER_DRAIN = false;
    bf16_t* QK; bf16_t* VT; bf16_t* KC; bf16_t* VCT; const float* rc; const float* rs; float qscale;
    __device__ __forceinline__ void operator()(const f32x4 (&acc)[2][2][4][2], const Unit& u, int wr, int wc, int fr, int fq) const {
        const int row0 = u.pm * BM + wr * 64 + fr;
        if (u.pm >= 128) {
#pragma unroll
            for (int ai = 0; ai < 2; ++ai)
#pragma unroll
                for (int m = 0; m < 4; ++m) {
                    const int row = row0 + ai * HALF + m * 16 - 32768, b = row >> 8, j = row & 255, jp = (j & ~15) | perm16(j & 15);
#pragma unroll
                    for (int n = 0; n < 2; ++n) {
                        *(u32x2*)(KC + (size_t)row * 128 + wc * 32 + n * 16 + 4 * fq) = pk4(acc[ai][0][m][n]);
#pragma unroll
                        for (int i = 0; i < 4; ++i) { const int cv = wc * 32 + n * 16 + 4 * fq + i; VCT[((size_t)(b * 2 + (cv >> 6)) * 64 + (cv & 63)) * 256 + jp] = bf1(acc[ai][1][m][n][i]); }
                    }
                }
            return;
        }
        if (u.pn <= 2) {
            const float sc = (u.pn < 2) ? qscale : 1.0f;
#pragma unroll
            for (int ai = 0; ai < 2; ++ai)
#pragma unroll
                for (int m = 0; m < 4; ++m) {
                    const int row = row0 + ai * HALF + m * 16, pos = row & 8191, pidx = (wc & 1) ? (pos & 63) : (pos >> 6);
                    const f32x4 c4 = *(const f32x4*)(rc + pidx * 16 + 4 * fq) * sc, s4 = *(const f32x4*)(rs + pidx * 16 + 4 * fq) * sc;
                    bf16_t* rowp = QK + (size_t)row * 1792 + u.pn * BM + wc * 32 + 4 * fq;
#pragma unroll
                    for (int bj = 0; bj < 2; ++bj) {
                        if (u.pn == 2 && bj == 1) break;
                        const f32x4 v0 = acc[ai][bj][m][0], v1 = acc[ai][bj][m][1];
                        *(u32x2*)(rowp + bj * HALF) = pk4(v0 * c4 - v1 * s4);
                        *(u32x2*)(rowp + bj * HALF + 16) = pk4(v1 * c4 + v0 * s4);
                    }
                    if (u.pn == 2) {
                        const int b = row >> 13, pp = (pos & ~15) | perm16(pos & 15);
#pragma unroll
                        for (int n = 0; n < 2; ++n)
#pragma unroll
                            for (int i = 0; i < 4; ++i) { const int cv = wc * 32 + n * 16 + 4 * fq + i; VT[((size_t)(b * 2 + (cv >> 6)) * 64 + (cv & 63)) * 8192 + pp] = bf1(acc[ai][1][m][n][i]); }
                    }
                }
            return;
        }
#pragma unroll
        for (int ai = 0; ai < 2; ++ai)
#pragma unroll
            for (int m = 0; m < 4; ++m) {
                bf16_t* rowp = QK + (size_t)(row0 + ai * HALF + m * 16) * 1792 + u.pn * BM + wc * 32 + 4 * fq;
#pragma unroll
                for (int bj = 0; bj < 2; ++bj)
#pragma unroll
                    for (int n = 0; n < 2; ++n) *(u32x2*)(rowp + bj * HALF + n * 16) = pk4(gelu4(acc[ai][bj][m][n]));
            }
    }
};
struct EpiRes {
    static constexpr bool PERM = false, AFTER_DRAIN = false;
    const float* base; float* out; const float* gate; float* RSS;
    __device__ __forceinline__ void operator()(const f32x4 (&acc)[2][2][4][2], const Unit& u, int wr, int wc, int fr, int fq) const {
        const int row0 = u.pm * BM + wr * 64 + fr, col0 = u.pn * BM + wc * 32 + 4 * fq, b = u.pm >> 5;
        f32x4 gv[2][2];
#pragma unroll
        for (int bj = 0; bj < 2; ++bj)
#pragma unroll
            for (int n = 0; n < 2; ++n) gv[bj][n] = *(const f32x4*)(gate + (size_t)b * 6144 + col0 + bj * HALF + n * 16);
#pragma unroll
        for (int ai = 0; ai < 2; ++ai) {
            f32x4 bs[4][2][2];
#pragma unroll
            for (int m = 0; m < 4; ++m)
#pragma unroll
                for (int bj = 0; bj < 2; ++bj)
#pragma unroll
                    for (int n = 0; n < 2; ++n) bs[m][bj][n] = *(const f32x4*)(base + (size_t)(row0 + ai * HALF + m * 16) * 1024 + col0 + bj * HALF + n * 16);
            asm volatile("" ::: "memory");
#pragma unroll
            for (int m = 0; m < 4; ++m) { const int row = row0 + ai * HALF + m * 16; float ss = 0.f;
#pragma unroll
                for (int bj = 0; bj < 2; ++bj)
#pragma unroll
                    for (int n = 0; n < 2; ++n) { const f32x4 o = bs[m][bj][n] + gv[bj][n] * acc[ai][bj][m][n]; *(f32x4*)(out + (size_t)row * 1024 + col0 + bj * HALF + n * 16) = o;
                        ss += (o[0] * o[0] + o[1] * o[1]) + (o[2] * o[2] + o[3] * o[3]); }
                ss += __shfl_xor(ss, 16); ss += __shfl_xor(ss, 32);
                if (fq == 0) RSS[(size_t)row * 16 + u.pn * 4 + wc] = ss; }
            asm volatile("" ::: "memory");
        }
    }
};
struct EpiSwiGLU {
    static constexpr bool PERM = true, AFTER_DRAIN = false;
    bf16_t* HID;
    __device__ __forceinline__ void operator()(const f32x4 (&acc)[2][2][4][2], const Unit& u, int wr, int wc, int fr, int fq) const {
        const int row0 = u.pm * BM + wr * 64 + fr, col0 = (u.pn & 3) * HALF + wc * 32 + 8 * fq;
#pragma unroll
        for (int ai = 0; ai < 2; ++ai)
#pragma unroll
            for (int m = 0; m < 4; ++m) {
                const f32x4 g0 = acc[ai][0][m][0], g1 = acc[ai][0][m][1], u0 = acc[ai][1][m][0], u1 = acc[ai][1][m][1];
                u32x4 w;
                w.x = cvt_pk_bf16(silu1(g0[0]) * u0[0], silu1(g0[1]) * u0[1]); w.y = cvt_pk_bf16(silu1(g0[2]) * u0[2], silu1(g0[3]) * u0[3]);
                w.z = cvt_pk_bf16(silu1(g1[0]) * u1[0], silu1(g1[1]) * u1[1]); w.w = cvt_pk_bf16(silu1(g1[2]) * u1[2], silu1(g1[3]) * u1[3]);
                *(u32x4*)(HID + (size_t)(row0 + ai * HALF + m * 16) * 512 + col0) = w;
            }
    }
};
struct EpiDown {
    static constexpr bool PERM = true, AFTER_DRAIN = false;
    bf16_t* Y;
    __device__ __forceinline__ void operator()(const f32x4 (&acc)[2][2][4][2], const Unit& u, int wr, int wc, int fr, int fq) const {
        const int row0 = u.pm * BM + wr * 64 + fr, col0 = (u.pn & 3) * BM + wc * 32 + 8 * fq;
#pragma unroll
        for (int ai = 0; ai < 2; ++ai)
#pragma unroll
            for (int m = 0; m < 4; ++m) { bf16_t* rowp = Y + (size_t)(row0 + ai * HALF + m * 16) * 1024 + col0;
#pragma unroll
                for (int bj = 0; bj < 2; ++bj) { const f32x4 v0 = acc[ai][bj][m][0], v1 = acc[ai][bj][m][1];
                    u32x4 w; w.x = cvt_pk_bf16(v0[0], v0[1]); w.y = cvt_pk_bf16(v0[2], v0[3]); w.z = cvt_pk_bf16(v1[0], v1[1]); w.w = cvt_pk_bf16(v1[2], v1[3]);
                    *(u32x4*)(rowp + bj * HALF) = w; } }
    }
};
struct EpiInO {
    static constexpr bool PERM = true, AFTER_DRAIN = false;
    bf16_t* BG; bf16_t* Y;
    __device__ __forceinline__ void operator()(const f32x4 (&acc)[2][2][4][2], const Unit& u, int wr, int wc, int fr, int fq) const {
        const int row0 = u.pm * BM + wr * 64 + fr;
        if (u.pn < 8) {
            const int col0 = u.pn * HALF + wc * 32 + 8 * fq;
#pragma unroll
            for (int ai = 0; ai < 2; ++ai)
#pragma unroll
                for (int m = 0; m < 4; ++m) { const f32x4 v0 = acc[ai][0][m][0] * acc[ai][1][m][0], v1 = acc[ai][0][m][1] * acc[ai][1][m][1];
                    u32x4 w; w.x = cvt_pk_bf16(v0[0], v0[1]); w.y = cvt_pk_bf16(v0[2], v0[3]); w.z = cvt_pk_bf16(v1[0], v1[1]); w.w = cvt_pk_bf16(v1[2], v1[3]);
                    *(u32x4*)(Y + (size_t)(row0 + ai * HALF + m * 16) * 1024 + col0) = w; }
        } else {
            const int col0 = (u.pn - 8) * BM + wc * 32 + 8 * fq;
#pragma unroll
            for (int ai = 0; ai < 2; ++ai)
#pragma unroll
                for (int m = 0; m < 4; ++m) { bf16_t* rowp = BG + (size_t)(row0 + ai * HALF + m * 16) * 1024 + col0;
#pragma unroll
                    for (int bj = 0; bj < 2; ++bj) { const f32x4 v0 = acc[ai][bj][m][0], v1 = acc[ai][bj][m][1];
                        u32x4 w; w.x = cvt_pk_bf16(v0[0], v0[1]); w.y = cvt_pk_bf16(v0[2], v0[3]); w.z = cvt_pk_bf16(v1[0], v1[1]); w.w = cvt_pk_bf16(v1[2], v1[3]);
                        *(u32x4*)(rowp + bj * HALF) = w; } }
        }
    }
};
struct InEOrder {
    StaticOrder so; int G, c;
    __device__ __forceinline__ bool next(int i, Unit& u) const {
        const long L = (long)i * G + c;
        if (L < 896) return so.next(i, u);
        if (L < 900) { u.pm = 128 + (int)(L - 896); u.pn = 2; return true; }
        return false;
    }
    __device__ __forceinline__ void a_ready(const Unit&) const {}
    __device__ __forceinline__ void done(const Unit&) const {}
};
struct MoeOrder {
    const PG8_LAS int* tile_e; int nunits, G, c;
    __device__ __forceinline__ bool next(int i, Unit& u) const {
        const long L = (long)i * G + c; if (L >= nunits) return false;
        const int t = (int)(L >> 2); u.pm = t; u.pn = tile_e[t] * 4 + (int)(L & 3); return true;
    }
    __device__ __forceinline__ void a_ready(const Unit&) const {}
    __device__ __forceinline__ void done(const Unit&) const {}
};
template <class Epi, class Sched, bool ALIGN_EPI = false, bool SP2 = false>
__device__ __forceinline__ void gemm_phase(PG8_LAS unsigned char* lds, const Gemm g, const Sched& S, const Epi& E, const int tid_in) {
    int tid_ = tid_in; asm volatile("" : "+v"(tid_));
    const int tid = tid_, wid = __builtin_amdgcn_readfirstlane(tid >> 6), lane = tid & 63, wr = wid >> 2, wc = wid & 3, fr = lane & 15, fq = lane >> 4;
    const int K = g.K, nt = K / BK;
    unsigned voffA[2], voffB[2];
#pragma unroll
    for (int i = 0; i < 2; ++i) { int R, C; stage_rc(tid * 16 + i * 8192, R, C); const int Rb = Epi::PERM ? ((R & ~31) + perm32(R & 31)) : R;
        voffA[i] = (unsigned)(R * K + C) * 2u; voffB[i] = (unsigned)(Rb * K + C) * 2u; }
    const size_t kstep = (size_t)(BK * 2);
    const size_t hstep = (size_t)HALF * K * 2;
    const size_t tstep = 2 * hstep;
    const unsigned ldsw = (unsigned)wid * 1024u;
    const int aoff = lds_byte(wr * 64 + fr, fq * 8), boff = lds_byte(wc * 32 + fr, fq * 8);
#define PG8_SA(b, h) (((b) * 2 + (h)) * HTB)
#define PG8_SB(b, h) ((4 + (b) * 2 + (h)) * HTB)
#define PG8_STAGE(bufoff, gbase, voff) do { _Pragma("unroll") for (int _i = 0; _i < 2; ++_i) \
        __builtin_amdgcn_global_load_lds((const unsigned*)((const char*)(gbase) + (voff)[_i]), (PG8_LAS unsigned*)(lds + (bufoff) + ldsw + _i * 8192), 16, 0, 0); } while (0)
#define PG8_LDA(dst, b, h) do { _Pragma("unroll") for (int m = 0; m < 4; ++m) _Pragma("unroll") for (int k = 0; k < 2; ++k) dst[m][k] = *(const PG8_LAS bf16x8*)(lds + PG8_SA(b, h) + aoff + m * 2048 + k * 1024); } while (0)
#define PG8_LDB(dst, b, h) do { _Pragma("unroll") for (int n = 0; n < 2; ++n) _Pragma("unroll") for (int k = 0; k < 2; ++k) dst[n][k] = *(const PG8_LAS bf16x8*)(lds + PG8_SB(b, h) + boff + n * 2048 + k * 1024); } while (0)
#define PG8_MMA(ai, bj, At, Bt) do { __builtin_amdgcn_s_setprio(1); _Pragma("unroll") for (int m = 0; m < 4; ++m) _Pragma("unroll") for (int n = 0; n < 2; ++n) _Pragma("unroll") for (int k = 0; k < 2; ++k) \
        acc[ai][bj][m][n] = __builtin_amdgcn_mfma_f32_16x16x32_bf16(Bt[n][k], At[m][k], acc[ai][bj][m][n], 0, 0, 0); __builtin_amdgcn_s_setprio(0); } while (0)
#define PG8_WAIT_V(n) asm volatile("s_waitcnt vmcnt(" #n ")" ::: "memory")
#define PG8_WAIT_L(n) asm volatile("s_waitcnt lgkmcnt(" #n ")" ::: "memory")
#define PG8_BAR __builtin_amdgcn_s_barrier()
#define PG8_SCHED __builtin_amdgcn_sched_barrier(0)
    Unit cur, nxt; int ui = 0;
    if (!S.next(0, cur)) return;
    f32x4 acc[2][2][4][2];
#pragma unroll
    for (int a = 0; a < 2; ++a)
#pragma unroll
        for (int b = 0; b < 2; ++b)
#pragma unroll
            for (int m = 0; m < 4; ++m)
#pragma unroll
                for (int n = 0; n < 2; ++n) acc[a][b][m][n] = (f32x4){0.f, 0.f, 0.f, 0.f};
    bf16x8 At[4][2], B0[2][2], B1[2][2];
    const char* cA = (const char*)g.A + (size_t)cur.pm * tstep; const char* cB = (const char*)g.Bt + (size_t)cur.pn * tstep;
    S.a_ready(cur);
    if constexpr (SP2) {
        PG8_STAGE(PG8_SB(0, 0), cB, voffB); PG8_STAGE(PG8_SB(0, 1), cB + hstep, voffB); PG8_STAGE(PG8_SA(0, 0), cA, voffA); PG8_STAGE(PG8_SA(0, 1), cA + hstep, voffA);
        if (wr == 1) PG8_BAR;
        PG8_WAIT_V(2); PG8_BAR;
        PG8_STAGE(PG8_SB(1, 0), cB + kstep, voffB); PG8_STAGE(PG8_SA(1, 0), cA + kstep, voffA); PG8_STAGE(PG8_SB(1, 1), cB + hstep + kstep, voffB);
        PG8_WAIT_V(6); PG8_BAR;
    } else {
        PG8_STAGE(PG8_SB(0, 0), cB, voffB); PG8_STAGE(PG8_SA(0, 0), cA, voffA); PG8_STAGE(PG8_SB(0, 1), cB + hstep, voffB); PG8_STAGE(PG8_SA(0, 1), cA + hstep, voffA);
        if (wr == 1) PG8_BAR;
        PG8_WAIT_V(4); PG8_BAR;
        PG8_STAGE(PG8_SB(1, 0), cB + kstep, voffB); PG8_STAGE(PG8_SA(1, 0), cA + kstep, voffA); PG8_STAGE(PG8_SB(1, 1), cB + hstep + kstep, voffB);
        PG8_WAIT_V(6); PG8_BAR;
    }
    for (;;) {
        const bool has_next = S.next(ui + 1, nxt);
        const char* nA = has_next ? (const char*)g.A + (size_t)nxt.pm * tstep : cA; const char* nB = has_next ? (const char*)g.Bt + (size_t)nxt.pn * tstep : cB;
        for (int t = 0; t < nt; t += 2) {
            const bool last = (t == nt - 2);
            const char* a1 = cA + (size_t)(t + 1) * kstep;
            const char* a2 = last ? nA : cA + (size_t)(t + 2) * kstep; const char* b2 = last ? nB : cB + (size_t)(t + 2) * kstep;
            const char* a3 = a2 + kstep; const char* b3 = b2 + kstep;
            if (last && has_next) S.a_ready(nxt);
            if constexpr (SP2) {
            PG8_LDB(B0, 0, 0); PG8_LDB(B1, 0, 1); PG8_SCHED; PG8_LDA(At, 0, 0); PG8_STAGE(PG8_SA(1, 1), a1 + hstep, voffA);
            PG8_WAIT_V(8); PG8_WAIT_L(0); PG8_BAR; PG8_MMA(0, 0, At, B0); PG8_MMA(0, 1, At, B1); PG8_BAR; PG8_SCHED;
            PG8_LDA(At, 0, 1); PG8_STAGE(PG8_SB(0, 0), b2, voffB); PG8_STAGE(PG8_SB(0, 1), b2 + hstep, voffB); PG8_STAGE(PG8_SA(0, 0), a2, voffA);
            PG8_WAIT_V(8); PG8_WAIT_L(0); PG8_BAR; PG8_MMA(1, 0, At, B0); PG8_MMA(1, 1, At, B1); PG8_BAR; PG8_SCHED;
            PG8_LDB(B0, 1, 0); PG8_LDB(B1, 1, 1); PG8_SCHED; PG8_LDA(At, 1, 0); PG8_STAGE(PG8_SA(0, 1), a2 + hstep, voffA);
            PG8_WAIT_V(8); PG8_WAIT_L(0); PG8_BAR; PG8_MMA(0, 0, At, B0); PG8_MMA(0, 1, At, B1); PG8_BAR; PG8_SCHED;
            PG8_LDA(At, 1, 1); PG8_STAGE(PG8_SB(1, 0), b3, voffB); PG8_STAGE(PG8_SB(1, 1), b3 + hstep, voffB); PG8_STAGE(PG8_SA(1, 0), a3, voffA);
            PG8_WAIT_V(8); PG8_WAIT_L(0); PG8_BAR; PG8_MMA(1, 0, At, B0); PG8_MMA(1, 1, At, B1); PG8_BAR; PG8_SCHED;
            } else {
            PG8_LDB(B0, 0, 0); PG8_SCHED; PG8_LDA(At, 0, 0); PG8_STAGE(PG8_SA(1, 1), a1 + hstep, voffA);
            PG8_WAIT_L(8); PG8_BAR; PG8_WAIT_L(0); PG8_MMA(0, 0, At, B0); PG8_BAR; PG8_SCHED;
            PG8_LDB(B1, 0, 1); PG8_STAGE(PG8_SB(0, 0), b2, voffB);
            PG8_BAR; PG8_WAIT_L(0); PG8_MMA(0, 1, At, B1); PG8_BAR;
            PG8_LDA(At, 0, 1); PG8_STAGE(PG8_SA(0, 0), a2, voffA);
            PG8_BAR; PG8_WAIT_L(0); PG8_MMA(1, 0, At, B0); PG8_BAR; PG8_SCHED;
            PG8_STAGE(PG8_SB(0, 1), b2 + hstep, voffB);
            PG8_WAIT_V(6); PG8_BAR; PG8_MMA(1, 1, At, B1); PG8_BAR;
            PG8_LDB(B0, 1, 0); PG8_SCHED; PG8_LDA(At, 1, 0); PG8_STAGE(PG8_SA(0, 1), a2 + hstep, voffA);
            PG8_WAIT_L(8); PG8_BAR; PG8_WAIT_L(0); PG8_MMA(0, 0, At, B0); PG8_BAR; PG8_SCHED;
            PG8_LDB(B1, 1, 1); PG8_STAGE(PG8_SB(1, 0), b3, voffB);
            PG8_BAR; PG8_WAIT_L(0); PG8_MMA(0, 1, At, B1); PG8_BAR;
            PG8_LDA(At, 1, 1); PG8_STAGE(PG8_SA(1, 0), a3, voffA);
            PG8_BAR; PG8_WAIT_L(0); PG8_MMA(1, 0, At, B0); PG8_BAR; PG8_SCHED;
            PG8_STAGE(PG8_SB(1, 1), b3 + hstep, voffB);
            PG8_WAIT_V(6); PG8_BAR; PG8_MMA(1, 1, At, B1); PG8_BAR;
            }
        }
        if constexpr (ALIGN_EPI) { if (wr == 0) PG8_BAR; }
        if constexpr (!Epi::AFTER_DRAIN) { E(acc, cur, wr, wc, fr, fq); S.done(cur); }
        if (!has_next) break;
#pragma unroll
        for (int a = 0; a < 2; ++a)
#pragma unroll
            for (int b = 0; b < 2; ++b)
#pragma unroll
                for (int m = 0; m < 4; ++m)
#pragma unroll
                    for (int n = 0; n < 2; ++n) acc[a][b][m][n] = (f32x4){0.f, 0.f, 0.f, 0.f};
        cur = nxt; cA = nA; cB = nB; ++ui;
        if constexpr (ALIGN_EPI) { if (wr == 1) PG8_BAR; }
    }
    PG8_WAIT_V(0);
    if constexpr (!ALIGN_EPI) { if (wr == 0) PG8_BAR; }
    PG8_BAR;
    if constexpr (Epi::AFTER_DRAIN) { E.fused(acc, cur, wr, wc, fr, fq, lds, wid, lane); S.done(cur); }
#undef PG8_SA
#undef PG8_SB
#undef PG8_STAGE
#undef PG8_LDA
#undef PG8_LDB
#undef PG8_MMA
#undef PG8_WAIT_V
#undef PG8_WAIT_L
#undef PG8_BAR
#undef PG8_SCHED
}
}
constexpr int NWAVES = 8;
constexpr int BATCH = 4, SEQ = 8192, D = 1024, M = BATCH * SEQ, CTXL = 256, MC = BATCH * CTXL;
constexpr int NINE = 1792, NEXP = 32, EH = 512;
constexpr float EPS = 1e-6f;
constexpr int N_PHASES = 18;
#ifndef MK_ONE_LAUNCH
#define MK_ONE_LAUNCH 1
#endif
constexpr size_t MiB = 1u << 20;
constexpr size_t WS_CTL = 0, CTL_ZERO_BYTES = 1 * MiB;
constexpr size_t WS_MOD = 1 * MiB;
constexpr size_t WS_MODC = WS_MOD + 2 * 4 * 6144 * 4;
constexpr size_t WS_MODP = 1 * MiB + 768 * 1024;
static_assert(WS_MODC + 6144 * 4 <= 1 * MiB + 256 * 1024, "MOD/MODC overlap the rope tables");
constexpr size_t WS_ROPE = 1 * MiB + 256 * 1024;
constexpr size_t WS_WSP = 1 * MiB + 512 * 1024;
constexpr size_t WS_TOKE = 2 * MiB;
constexpr size_t WS_TOKP = 2 * MiB + 256 * 1024;
constexpr size_t WS_TOKW = 2 * MiB + 512 * 1024;
constexpr size_t WS_TOKS = 2 * MiB + 768 * 1024;
constexpr size_t WS_KC = 3 * MiB;
constexpr size_t WS_VCT = 3 * MiB + 256 * 1024;
constexpr size_t WS_VT = 4 * MiB;
constexpr size_t WS_WINE = 12 * MiB, WS_WOUTE = 16 * MiB, WS_WINO = 18 * MiB, WS_WOUTO = 24 * MiB;
constexpr size_t WS_WGU = 26 * MiB;
constexpr size_t WS_WD = 154 * MiB;
constexpr size_t WS_H = 218 * MiB;
constexpr size_t WS_A = 284 * MiB;
constexpr size_t WS_B = 428 * MiB;
constexpr size_t WS_RSS = 500 * MiB;
constexpr size_t WS_END = 502 * MiB;
constexpr int CW_TMO = 0, CW_CODE = 1, CW_BAR = 4096, CW_GCNT = 8192;

constexpr int RING_BYTES = 131072;
constexpr int LDS_BYTES = 155648;
constexpr int MISC_OFF = LDS_BYTES - 256;
constexpr int MOE_TAB_OFF = RING_BYTES;
constexpr int RW_STRIDE = 2064;
constexpr int RT_WH = 0, RT_WL = 36 * RW_STRIDE, RT_CNT = 72 * RW_STRIDE, RT_BASE = RT_CNT + 128, RT_INFO = RT_CNT + 256;
static_assert(RT_INFO + 128 * 6 * 4 <= MISC_OFF, "LDS map");

#define GAS __attribute__((address_space(1)))
#define LAS __attribute__((address_space(3)))
typedef unsigned short bf16;
typedef unsigned v4u __attribute__((ext_vector_type(4)));
typedef unsigned v2u __attribute__((ext_vector_type(2)));
typedef float f32x4 __attribute__((ext_vector_type(4)));
typedef float f32x16 __attribute__((ext_vector_type(16)));
typedef short bf16x8 __attribute__((ext_vector_type(8)));
typedef GAS unsigned gu32;
#define RLX_AGENT __ATOMIC_RELAXED, __HIP_MEMORY_SCOPE_AGENT
#define LDS_WAIT() asm volatile("s_waitcnt lgkmcnt(0)" ::: "memory")
__device__ __forceinline__ unsigned f2bf(float f) { unsigned u = __builtin_bit_cast(unsigned, f); return (u + 0x7fffu + ((u >> 16) & 1u)) >> 16; }
__device__ __forceinline__ unsigned pk2(float lo, float hi) { return f2bf(lo) | (f2bf(hi) << 16); }
__device__ __forceinline__ float bflo(unsigned w) { return __builtin_bit_cast(float, w << 16); }
__device__ __forceinline__ float bfhi(unsigned w) { return __builtin_bit_cast(float, w & 0xffff0000u); }
__device__ __forceinline__ float wave_sum(float v) {
#pragma unroll
    for (int o = 1; o < 64; o <<= 1) v += __shfl_xor(v, o);
    return v;
}
#define XB_TMO      128
#define XB_XCNT(j)  (256  + 64 * (j))
#define XB_XSUB(j)  (1280 + 64 * (j))
#define XB_XGEN(j)  (2304 + 64 * (j))
#define XB_TOP      3328
#define XB_TOPGEN   3392
#define XCD_BAR_WORDS 3456
#define XB_SPIN_CAP (1u << 18)

__device__ __forceinline__ unsigned xb_ld(unsigned* p)              { return __hip_atomic_load(p, __ATOMIC_RELAXED, __HIP_MEMORY_SCOPE_AGENT); }
__device__ __forceinline__ unsigned xb_add(unsigned* p, unsigned v) { return __hip_atomic_fetch_add(p, v, __ATOMIC_RELAXED, __HIP_MEMORY_SCOPE_AGENT); }
__device__ __forceinline__ unsigned xb_xcc_id() { return (unsigned)__builtin_amdgcn_s_getreg((3 << 11) | 20) & 0xFu; }
#define XB_SPIN(cond, bar) do { unsigned _sp = 0; while (cond) { __builtin_amdgcn_s_sleep(1); \
    if ((++_sp & 255u) == 0u) { if (xb_ld(&(bar)[XB_TMO])) break; if (_sp > XB_SPIN_CAP) { atomicAdd(&(bar)[XB_TMO], 1u); break; } } } } while (0)

struct XcdBarrier {
    unsigned* bar; unsigned x;
    volatile LAS unsigned* st;
};

__device__ __forceinline__ XcdBarrier xcd_barrier_post(unsigned* bar, volatile LAS unsigned* st) {
    XcdBarrier b; b.bar = bar; b.x = xb_xcc_id(); b.st = st;
    if (threadIdx.x == 0) (void)xb_add(&bar[XB_XCNT(b.x)], 1u);
    return b;
}
__device__ __forceinline__ void xcd_barrier_complete(unsigned* bar, unsigned x, unsigned& nloc, unsigned& nx) {
    const unsigned G = gridDim.x * gridDim.y * gridDim.z;
    unsigned sum, cnt, mine, sp = 0u;
    for (;;) {
        sum = 0u; cnt = 0u; mine = 0u;
#pragma unroll
        for (unsigned j = 0; j < 16; ++j) { const unsigned c = xb_ld(&bar[XB_XCNT(j)]); sum += c; cnt += (c > 0u) ? 1u : 0u; mine = (j == x) ? c : mine; }
        if (sum == G) break;
        __builtin_amdgcn_s_sleep(1);
        if ((++sp & 255u) == 0u) { if (xb_ld(&bar[XB_TMO])) break; if (sp > XB_SPIN_CAP) { atomicAdd(&bar[XB_TMO], 1u); break; } }
    }
    nloc = mine > 0u ? mine : 1u; nx = cnt > 0u ? cnt : 1u;
}

__device__ __forceinline__ void xcd_barrier(const XcdBarrier& b, const int xb_tid) {
    asm volatile("s_waitcnt vmcnt(0)" ::: "memory");
    __syncthreads();
    if (xb_tid == 0) {
        unsigned* bar = b.bar;
        __builtin_amdgcn_s_waitcnt(0);
        unsigned nloc = b.st[0], nx = b.st[1];
        if (nloc == 0u) { xcd_barrier_complete(bar, b.x, nloc, nx); b.st[0] = nloc; b.st[1] = nx; }
        const unsigned old = xb_add(&bar[XB_XSUB(b.x)], 1u);
        const unsigned gen = old / nloc;
        if (old + 1u == (gen + 1u) * nloc) {
            __builtin_amdgcn_fence(__ATOMIC_RELEASE, "agent");
            asm volatile("s_waitcnt vmcnt(0)" ::: "memory");
            const unsigned og = xb_add(&bar[XB_TOP], 1u);
            const unsigned tg = og / nx;
            if (og + 1u == (tg + 1u) * nx) xb_add(&bar[XB_TOPGEN], 1u);
            else XB_SPIN(xb_ld(&bar[XB_TOPGEN]) == tg, bar);
            __builtin_amdgcn_fence(__ATOMIC_ACQUIRE, "agent");
            xb_add(&bar[XB_XGEN(b.x)], 1u);
            asm volatile("s_waitcnt vmcnt(0)" ::: "memory");
        } else {
            XB_SPIN(xb_ld(&bar[XB_XGEN(b.x)]) == gen, bar);
            __builtin_amdgcn_fence(__ATOMIC_ACQUIRE, "agent");
            asm volatile("s_waitcnt vmcnt(0)" ::: "memory");
        }
    }
    __syncthreads();
}

struct Args { const float* in[25]; float* out; unsigned char* ws; int ph_lo, ph_hi; };
struct Ctx {
    LAS unsigned char* lds; unsigned ldsaddr;
    int tid, lane, wave, G, bid;
    float* out; unsigned char* ws; gu32* ctl;
};
__device__ __forceinline__ const float* kin(int k) {
    const __attribute__((address_space(4))) Args* ka = (const __attribute__((address_space(4))) Args*)__builtin_amdgcn_kernarg_segment_ptr();
    return (const float*)(const GAS float*)ka->in[k];
}
__device__ const float ROPE_INV[16] = {1.000000000e+00f, 5.623413324e-01f, 3.162277639e-01f, 1.778279394e-01f, 1.000000015e-01f, 5.623413250e-02f, 3.162277490e-02f, 1.778279431e-02f,
                                       9.999999776e-03f, 5.623413250e-03f, 3.162277630e-03f, 1.778279431e-03f, 1.000000047e-03f, 5.623413017e-04f, 3.162277571e-04f, 1.778279402e-04f};

__device__ __forceinline__ void transpose_item(const float* W, int K, int N, bf16* WT, int k0, int n0, int drow0, LAS float* scr, int lane) {
#pragma unroll 8
    for (int i = 0; i < 32; ++i) { const int kk = 2 * i + (lane >> 5); scr[kk * 33 + (lane & 31)] = W[(size_t)(k0 + kk) * N + n0 + (lane & 31)]; }
    LDS_WAIT(); asm volatile("" ::: "memory");
    const int c = lane & 7;
#pragma unroll
    for (int j = 0; j < 4; ++j) { const int n = (lane >> 3) + 8 * j; const LAS float* s = scr + (8 * c) * 33 + n;
        v4u o; o.x = pk2(s[0 * 33], s[1 * 33]); o.y = pk2(s[2 * 33], s[3 * 33]); o.z = pk2(s[4 * 33], s[5 * 33]); o.w = pk2(s[6 * 33], s[7 * 33]);
        *(GAS v4u*)(WT + (size_t)(drow0 + n) * K + k0 + 8 * c) = o; }
    LDS_WAIT(); asm volatile("" ::: "memory");
}
__device__ __forceinline__ void sincos_acc(float a, float& s, float& c) {
    const double x = (double)a, kf = __builtin_rint(x * 0.63661977236758134308), r = x - kf * 1.57079632679489661923, r2 = r * r;
    const double sp = r * (1.0 + r2 * (-1.0 / 6 + r2 * (1.0 / 120 + r2 * (-1.0 / 5040 + r2 * (1.0 / 362880 + r2 * (-1.0 / 39916800 + r2 * (1.0 / 6227020800.0)))))));
    const double cp = 1.0 + r2 * (-0.5 + r2 * (1.0 / 24 + r2 * (-1.0 / 720 + r2 * (1.0 / 40320 + r2 * (-1.0 / 3628800 + r2 * (1.0 / 479001600 + r2 * (-1.0 / 87178291200.0)))))));
    const int k = (int)kf & 3;
    s = (float)((k == 0) ? sp : (k == 1) ? cp : (k == 2) ? -sp : -cp);
    c = (float)((k == 0) ? cp : (k == 1) ? -sp : (k == 2) ? -cp : sp);
}
__device__ __forceinline__ void adaln_unit(const Ctx& C, int u) {
    const int l = u / 96, col = (u % 96) * 64 + C.lane;
    LAS float* sil = (LAS float*)C.lds; LAS float* red = (LAS float*)(C.lds + 5 * 1024 * 4);
    for (int idx = C.tid; idx < 5120; idx += NWAVES * 64) { const float v = (idx < 4096) ? kin(1)[idx] : kin(3)[idx - 4096]; sil[idx] = v / (1.0f + __expf(-v)); }
    __syncthreads();
    float acc[5] = {0.f, 0.f, 0.f, 0.f, 0.f};
    const int k0 = C.wave * 128; const float* wp = kin(4) + (size_t)l * 1024 * 6144 + (size_t)k0 * 6144 + col;
#pragma unroll 8
    for (int kk = 0; kk < 128; ++kk) { const float w = wp[(size_t)kk * 6144];
#pragma unroll
        for (int v = 0; v < 5; ++v) acc[v] += sil[v * 1024 + k0 + kk] * w; }
#pragma unroll
    for (int v = 0; v < 5; ++v) red[(C.wave * 5 + v) * 64 + C.lane] = acc[v];
    __syncthreads();
    if (C.wave == 0) {
        float* MOD = (float*)(C.ws + WS_MOD); float* MODC = (float*)(C.ws + WS_MODC); float* MODP = (float*)(C.ws + WS_MODP); const float bias = kin(5)[l * 6144 + col];
#pragma unroll
        for (int v = 0; v < 5; ++v) { float s = 0.f;
#pragma unroll
            for (int w = 0; w < NWAVES; ++w) s += red[(w * 5 + v) * 64 + C.lane];
            s += bias;
            if (v < 4) { MOD[(size_t)(l * 4 + v) * 6144 + col] = s;
                const int ch = col >> 10;
                if (ch == 1 || ch == 4) { const int w2 = (ch == 4) ? 1 : 0; MODP[(size_t)((l * 4 + v) * 2 + w2) * 1024 + (col & 1023)] = ((w2 ? kin(7) : kin(6))[l * 1024 + (col & 1023)]) * (1.0f + s); }
            } else if (l == 0) MODC[col] = s; }
    }
    __syncthreads();
}
__device__ __forceinline__ void p0_prologue(const Ctx& C) {
    for (int u = C.bid; u < 192; u += C.G) adaln_unit(C, u);
    LAS float* scr = (LAS float*)(C.lds + C.wave * 16384);
    const int gw = C.bid * NWAVES + C.wave, NGW = C.G * NWAVES;
    constexpr int NDENSE = 896 + 512 + 1536 + 512, NITEMS = NDENSE + 64 * 768;
    for (int it = gw; it < NITEMS; it += NGW) {
        int r = it;
        if (r < 896) { transpose_item(kin(9), 1024, 1792, (bf16*)(C.ws + WS_WINE), 64 * (r / 56), 32 * (r % 56), 32 * (r % 56), scr, C.lane); continue; } r -= 896;
        if (r < 512) { transpose_item(kin(14), 1024, 1024, (bf16*)(C.ws + WS_WOUTE), 64 * (r / 32), 32 * (r % 32), 32 * (r % 32), scr, C.lane); continue; } r -= 512;
        if (r < 1536) { const int n0 = 32 * (r % 96), j = n0 & 1023;
            const int drow = (n0 < 1024) ? 2048 + n0 : 256 * (j >> 7) + (j & 127) + ((n0 >= 2048) ? 128 : 0);
            transpose_item(kin(15), 1024, 3072, (bf16*)(C.ws + WS_WINO), 64 * (r / 96), n0, drow, scr, C.lane); continue; } r -= 1536;
        if (r < 512) { transpose_item(kin(17), 1024, 1024, (bf16*)(C.ws + WS_WOUTO), 64 * (r / 32), 32 * (r % 32), 32 * (r % 32), scr, C.lane); continue; } r -= 512;
        const int me = r / 768, q = r % 768, which = q >> 8, s = q & 255;
        if (which < 2) { const int j = 32 * (s & 15);
            transpose_item((which ? kin(23) : kin(22)) + (size_t)me * 1024 * 512, 1024, 512, (bf16*)(C.ws + WS_WGU) + (size_t)me * 1024 * 1024, 64 * (s >> 4), j, 256 * (j >> 7) + (j & 127) + 128 * which, scr, C.lane);
        } else transpose_item(kin(24) + (size_t)me * 512 * 1024, 512, 1024, (bf16*)(C.ws + WS_WD) + (size_t)me * 1024 * 512, 64 * (s >> 5), 32 * (s & 31), 32 * (s & 31), scr, C.lane);
    }
    for (int it = gw; it < 256; it += NGW) {
        const f32x4* src = (const f32x4*)(kin(12) + (size_t)it * 512) + 2 * C.lane; const f32x4 a = src[0], b = src[1];
        v4u o; o.x = pk2(a.x, a.y); o.y = pk2(a.z, a.w); o.z = pk2(b.x, b.y); o.w = pk2(b.z, b.w);
        *(v4u*)((bf16*)(C.ws + WS_WSP) + (size_t)it * 512 + 8 * C.lane) = o;
    }
    { const int gt = gw * 64 + C.lane;
        if (gt < 2048) { float s, c; sincos_acc((float)(gt >> 4) * ROPE_INV[gt & 15], s, c); ((float*)(C.ws + WS_ROPE))[gt] = c; ((float*)(C.ws + WS_ROPE))[2048 + gt] = s; } }
}

__device__ __forceinline__ void load_mod(const float* gam, const float* shp, const float* scp, int lane, f32x4 (&sc)[4], f32x4 (&sh)[4]) {
#pragma unroll
    for (int j = 0; j < 4; ++j) { const int idx = lane + 64 * j; const f32x4 g = ((const f32x4*)gam)[idx], s = ((const f32x4*)scp)[idx]; sc[j] = g * (1.0f + s); sh[j] = ((const f32x4*)shp)[idx]; }
}
__device__ __forceinline__ float row_rinv(const f32x4 (&v)[4]) {
    float ss = 0.f;
#pragma unroll
    for (int j = 0; j < 4; ++j) ss += (v[j].x * v[j].x + v[j].y * v[j].y) + (v[j].z * v[j].z + v[j].w * v[j].w);
    return rsqrtf(wave_sum(ss) * (1.0f / 1024.0f) + EPS);
}
__device__ __forceinline__ void mod_store(const f32x4 (&v)[4], float rinv, const f32x4 (&sc)[4], const f32x4 (&sh)[4], bf16* orow, int lane) {
#pragma unroll
    for (int j = 0; j < 4; ++j) { const f32x4 o = v[j] * rinv * sc[j] + sh[j]; v2u w; w.x = pk2(o.x, o.y); w.y = pk2(o.z, o.w); ((v2u*)orow)[lane + 64 * j] = w; }
}
__device__ __forceinline__ void phase_norm1_l0(const Ctx& C) {
    const int gw = C.bid * NWAVES + C.wave, NGW = C.G * NWAVES;
    const float* MOD = (const float*)(C.ws + WS_MOD); const float* MODC = (const float*)(C.ws + WS_MODC); bf16* H = (bf16*)(C.ws + WS_H);
    for (int grp = gw; grp < (M + MC) / 16; grp += NGW) {
        f32x4 sc[4], sh[4]; const float* src;
        if (grp < M / 16) { const float* mod = MOD + (size_t)(grp >> 9) * 6144; load_mod(kin(6), mod, mod + 1024, C.lane, sc, sh); src = kin(0) + (size_t)grp * 16 * D; }
        else { load_mod(kin(6), MODC, MODC + 1024, C.lane, sc, sh); src = kin(2) + (size_t)(grp - M / 16) * 16 * D; }
        bf16* dst = H + (size_t)grp * 16 * D;
        f32x4 va[4][4], vb[4][4];
#define N1_LOAD(buf, r0) do { _Pragma("unroll") for (int r = 0; r < 4; ++r) _Pragma("unroll") for (int j = 0; j < 4; ++j) buf[r][j] = ((const f32x4*)(src + (size_t)((r0) + r) * D))[C.lane + 64 * j]; } while (0)
#define N1_PROC(buf, r0) do { _Pragma("unroll") for (int r = 0; r < 4; ++r) mod_store(buf[r], row_rinv(buf[r]), sc, sh, dst + (size_t)((r0) + r) * D, C.lane); } while (0)
        N1_LOAD(va, 0);
#pragma unroll 1
        for (int it = 0; it < 2; ++it) { const int r0 = 8 * it;
            N1_LOAD(vb, r0 + 4); N1_PROC(va, r0);
            if (it < 1) N1_LOAD(va, r0 + 8);
            N1_PROC(vb, r0 + 4); }
#undef N1_LOAD
#undef N1_PROC
    }
}
__device__ __forceinline__ void phase_router(const Ctx& C, int l) {
    LAS unsigned char* WH = C.lds + RT_WH; LAS unsigned char* WL = C.lds + RT_WL;
    LAS int* cnt = (LAS int*)(C.lds + RT_CNT); LAS int* base = (LAS int*)(C.lds + RT_BASE); LAS int* info = (LAS int*)(C.lds + RT_INFO);
    const float* wrg = kin(18) + l * 4096; const float* wre = kin(20) + l * 32768; const float* brg = kin(19) + l * 4; const float* bre = kin(21) + l * 32;
    for (int idx = C.tid; idx < 9216; idx += NWAVES * 64) { const int k = idx / 9, q9 = idx - 9 * k;
        const f32x4 v = (q9 == 0) ? *(const f32x4*)(wrg + 4 * k) : *(const f32x4*)(wre + 32 * k + 4 * (q9 - 1));
        const int row0 = (q9 == 0) ? 32 : 16 * ((q9 - 1) & 1) + 4 * ((q9 - 1) >> 1);
#pragma unroll
        for (int i = 0; i < 4; ++i) { const unsigned hi = f2bf(v[i]), lo = f2bf(v[i] - bflo(hi));
            *(LAS bf16*)(WH + (row0 + i) * RW_STRIDE + 2 * k) = (bf16)hi; *(LAS bf16*)(WL + (row0 + i) * RW_STRIDE + 2 * k) = (bf16)lo; } }
    if (C.tid < 32) cnt[C.tid] = 0;
    __syncthreads();
    const float* MOD = (const float*)(C.ws + WS_MOD); const float* MODP = (const float*)(C.ws + WS_MODP); const float* RSS = (const float*)(C.ws + WS_RSS); bf16* H = (bf16*)(C.ws + WS_H);
    gu32* gcnt = C.ctl + CW_GCNT + l * 32;
    int* TOKE = (int*)(C.ws + WS_TOKE); int* TOKP = (int*)(C.ws + WS_TOKP); float* TOKW = (float*)(C.ws + WS_TOKW);
    const int r = C.lane & 15, q = C.lane >> 4;
    for (int rb = C.bid; rb < M / 128; rb += C.G) {
        const int bq = rb >> 6; const size_t row = (size_t)rb * 128 + C.wave * 16 + r;
        float rinv; { const f32x4* rp = (const f32x4*)(RSS + row * 16); const f32x4 a = rp[0], b = rp[1], c = rp[2], d = rp[3];
            const f32x4 t = (a + b) + (c + d); rinv = rsqrtf(((t.x + t.y) + (t.z + t.w)) * (1.0f / 1024.0f) + EPS); }
        const f32x4* xr = (const f32x4*)(C.out + row * D + 8 * q);
        const f32x4* sp = (const f32x4*)(MODP + (size_t)((l * 4 + bq) * 2 + 1) * 1024 + 8 * q); const f32x4* hp = (const f32x4*)(MOD + (size_t)(l * 4 + bq) * 6144 + 3 * 1024 + 8 * q);
        bf16* hrow = H + row * D + 8 * q;
        const LAS unsigned char* a0 = WH + (C.lane & 15) * RW_STRIDE + 16 * q; const LAS unsigned char* a2 = WH + (32 + (C.lane & 3)) * RW_STRIDE + 16 * q;
        pg8::f32x4 acc[3];
#pragma unroll
        for (int t = 0; t < 3; ++t) acc[t] = (pg8::f32x4){0.f, 0.f, 0.f, 0.f};
        f32x4 xc[8], xn[8];
#pragma unroll
        for (int s = 0; s < 4; ++s) { xc[2 * s] = xr[8 * s]; xc[2 * s + 1] = xr[8 * s + 1]; }
        for (int kb = 0; kb < 8; ++kb) {
            if (kb < 7) {
#pragma unroll
                for (int s = 0; s < 4; ++s) { xn[2 * s] = xr[8 * (4 * (kb + 1) + s)]; xn[2 * s + 1] = xr[8 * (4 * (kb + 1) + s) + 1]; } }
            f32x4 sv[8], hv[8];
#pragma unroll
            for (int s = 0; s < 4; ++s) { sv[2 * s] = sp[8 * (4 * kb + s)]; sv[2 * s + 1] = sp[8 * (4 * kb + s) + 1]; hv[2 * s] = hp[8 * (4 * kb + s)]; hv[2 * s + 1] = hp[8 * (4 * kb + s) + 1]; }
#pragma unroll
            for (int s = 0; s < 4; ++s) { const int kk = 4 * kb + s;
                const f32x4 h0 = xc[2 * s] * rinv * sv[2 * s] + hv[2 * s], h1 = xc[2 * s + 1] * rinv * sv[2 * s + 1] + hv[2 * s + 1];
                v4u hi; hi.x = pg8::cvt_pk_bf16(h0.x, h0.y); hi.y = pg8::cvt_pk_bf16(h0.z, h0.w); hi.z = pg8::cvt_pk_bf16(h1.x, h1.y); hi.w = pg8::cvt_pk_bf16(h1.z, h1.w);
                v4u lo; lo.x = pg8::cvt_pk_bf16(h0.x - bflo(hi.x), h0.y - bfhi(hi.x)); lo.y = pg8::cvt_pk_bf16(h0.z - bflo(hi.y), h0.w - bfhi(hi.y));
                lo.z = pg8::cvt_pk_bf16(h1.x - bflo(hi.z), h1.y - bfhi(hi.z)); lo.w = pg8::cvt_pk_bf16(h1.z - bflo(hi.w), h1.w - bfhi(hi.w));
                *(v4u*)(hrow + 32 * kk) = hi;
                const bf16x8 bh = __builtin_bit_cast(bf16x8, hi), bl = __builtin_bit_cast(bf16x8, lo);
#pragma unroll
                for (int t = 0; t < 3; ++t) { const LAS unsigned char* ap = ((t == 2) ? a2 : a0 + 16 * t * RW_STRIDE) + 64 * kk;
                    const bf16x8 ah = *(const LAS bf16x8*)ap, al = *(const LAS bf16x8*)(ap + RT_WL);
                    acc[t] = __builtin_amdgcn_mfma_f32_16x16x32_bf16(ah, bh, acc[t], 0, 0, 0);
                    acc[t] = __builtin_amdgcn_mfma_f32_16x16x32_bf16(al, bh, acc[t], 0, 0, 0);
                    acc[t] = __builtin_amdgcn_mfma_f32_16x16x32_bf16(ah, bl, acc[t], 0, 0, 0); } }
            if (kb < 7) {
#pragma unroll
                for (int s = 0; s < 8; ++s) xc[s] = xn[s]; }
        }
        float gl[4];
#pragma unroll
        for (int gi = 0; gi < 4; ++gi) gl[gi] = acc[2][gi] + brg[gi];
        int gidx = 0; float gmax = gl[0];
#pragma unroll
        for (int gi = 1; gi < 4; ++gi) if (gl[gi] > gmax) { gmax = gl[gi]; gidx = gi; }
        if (q == gidx) {
            float den = 0.f;
#pragma unroll
            for (int gi = 0; gi < 4; ++gi) den += __expf(gl[gi] - gmax);
            const float gwt = 1.0f / den;
            float ev[8];
#pragma unroll
            for (int j = 0; j < 8; ++j) ev[j] = acc[j >> 2][j & 3] + bre[8 * q + j];
            int i0 = 0; float v0 = ev[0];
#pragma unroll
            for (int j = 1; j < 8; ++j) if (ev[j] > v0) { v0 = ev[j]; i0 = j; }
            int i1 = (i0 == 0) ? 1 : 0; float v1 = (i0 == 0) ? ev[1] : ev[0];
#pragma unroll
            for (int j = 1; j < 8; ++j) if (j != i0 && ev[j] > v1) { v1 = ev[j]; i1 = j; }
            const float t = __expf(v1 - v0), p0 = 1.0f / (1.0f + t), p1 = t * p0;
            const int rr = C.wave * 16 + r, e0 = gidx * 8 + i0, e1 = gidx * 8 + i1;
            const int pl0 = __hip_atomic_fetch_add(cnt + e0, 1, __ATOMIC_RELAXED, __HIP_MEMORY_SCOPE_WORKGROUP), pl1 = __hip_atomic_fetch_add(cnt + e1, 1, __ATOMIC_RELAXED, __HIP_MEMORY_SCOPE_WORKGROUP);
            info[rr * 6 + 0] = e0; info[rr * 6 + 1] = e1; info[rr * 6 + 2] = pl0; info[rr * 6 + 3] = pl1;
            info[rr * 6 + 4] = __builtin_bit_cast(int, gwt * p0); info[rr * 6 + 5] = __builtin_bit_cast(int, gwt * p1);
        }
        __syncthreads();
        if (C.tid < 32) base[C.tid] = (int)__hip_atomic_fetch_add(gcnt + C.tid, (unsigned)cnt[C.tid], RLX_AGENT);
        __syncthreads();
        if (C.tid < 128) { const size_t orow = (size_t)rb * 128 + C.tid; const int e0 = info[C.tid * 6], e1 = info[C.tid * 6 + 1];
            TOKE[orow] = e0 | (e1 << 8); TOKP[orow * 2] = base[e0] + info[C.tid * 6 + 2]; TOKP[orow * 2 + 1] = base[e1] + info[C.tid * 6 + 3];
            TOKW[orow * 2] = __builtin_bit_cast(float, info[C.tid * 6 + 4]); TOKW[orow * 2 + 1] = __builtin_bit_cast(float, info[C.tid * 6 + 5]); }
        __syncthreads();
        if (C.tid < 32) cnt[C.tid] = 0;
        __syncthreads();
    }
}
__device__ __forceinline__ int moe_tables(const Ctx& C, int l) {
    LAS int* tile_e = (LAS int*)(C.lds + MOE_TAB_OFF); LAS int* seg = (LAS int*)(C.lds + MOE_TAB_OFF + 1280); LAS int* lc = (LAS int*)(C.lds + MOE_TAB_OFF + 1280 + 160);
    if (C.tid < 32) lc[C.tid] = (int)__hip_atomic_load(C.ctl + CW_GCNT + l * 32 + C.tid, RLX_AGENT);
    __syncthreads();
    if (C.tid == 0) { int t = 0;
        for (int e = 0; e < 32; ++e) { seg[e] = t * 256; const int n = (lc[e] + 255) >> 8; for (int k = 0; k < n; ++k) tile_e[t + k] = e; t += n; }
        seg[32] = t * 256; }
    __syncthreads();
    return seg[32] >> 8;
}
__device__ __forceinline__ void phase_scatter(const Ctx& C, int l) {
    (void)moe_tables(C, l);
    const LAS int* seg = (const LAS int*)(C.lds + MOE_TAB_OFF + 1280);
    const int gw = C.bid * NWAVES + C.wave, NGW = C.G * NWAVES;
    const int* TOKE = (const int*)(C.ws + WS_TOKE); const int* TOKP = (const int*)(C.ws + WS_TOKP); int* TOKS = (int*)(C.ws + WS_TOKS);
    const bf16* H = (const bf16*)(C.ws + WS_H); bf16* XS = (bf16*)(C.ws + WS_A);
    for (int grp = gw; grp < M / 16; grp += NGW) {
#pragma unroll 4
        for (int r = 0; r < 16; ++r) { const size_t row = (size_t)grp * 16 + r; const int ee = TOKE[row];
            const int s0 = seg[ee & 255] + TOKP[row * 2], s1 = seg[ee >> 8] + TOKP[row * 2 + 1];
            const v4u a = ((const v4u*)(H + row * D))[C.lane], b = ((const v4u*)(H + row * D))[C.lane + 64];
            ((v4u*)(XS + (size_t)s0 * D))[C.lane] = a; ((v4u*)(XS + (size_t)s0 * D))[C.lane + 64] = b;
            ((v4u*)(XS + (size_t)s1 * D))[C.lane] = a; ((v4u*)(XS + (size_t)s1 * D))[C.lane + 64] = b;
            if (C.lane == 0) { TOKS[row * 2] = s0; TOKS[row * 2 + 1] = s1; } }
    }
}
template <bool FINAL> __device__ __forceinline__ void phase_combine(const Ctx& C, int lp) {
    const int gw = C.bid * NWAVES + C.wave, NGW = C.G * NWAVES;
    const float* MOD = (const float*)(C.ws + WS_MOD); bf16* H = (bf16*)(C.ws + WS_H); const bf16* YB = (const bf16*)(C.ws + WS_A);
    const int* TOKS = (const int*)(C.ws + WS_TOKS); const float* TOKW = (const float*)(C.ws + WS_TOKW);
    for (int grp = gw; grp < M / 16; grp += NGW) {
        const int b = grp >> 9; f32x4 g2[4], sc[4], sh[4];
#pragma unroll
        for (int j = 0; j < 4; ++j) g2[j] = ((const f32x4*)(MOD + (size_t)(lp * 4 + b) * 6144 + 5 * 1024))[C.lane + 64 * j];
        if (FINAL) {
#pragma unroll
            for (int j = 0; j < 4; ++j) { sc[j] = ((const f32x4*)kin(8))[C.lane + 64 * j]; sh[j] = (f32x4){0.f, 0.f, 0.f, 0.f}; }
        } else { const float* mod = MOD + (size_t)(4 + b) * 6144; load_mod(kin(6) + 1024, mod, mod + 1024, C.lane, sc, sh); }
        f32x4 xv[2][4]; v2u ya[2][4], yc[2][4]; float w0[2], w1[2];
#define CB_LOAD(buf, r0) do { const size_t row_ = (size_t)grp * 16 + (r0); \
            const int s0_ = TOKS[row_ * 2], s1_ = TOKS[row_ * 2 + 1]; w0[buf] = TOKW[row_ * 2]; w1[buf] = TOKW[row_ * 2 + 1]; \
            _Pragma("unroll") for (int j = 0; j < 4; ++j) { xv[buf][j] = ((const f32x4*)(C.out + row_ * D))[C.lane + 64 * j]; \
                ya[buf][j] = ((const v2u*)(YB + (size_t)s0_ * D))[C.lane + 64 * j]; yc[buf][j] = ((const v2u*)(YB + (size_t)s1_ * D))[C.lane + 64 * j]; } } while (0)
#define CB_PROC(buf, r0) do { const size_t row = (size_t)grp * 16 + (r0); f32x4 v[4]; \
            _Pragma("unroll") for (int j = 0; j < 4; ++j) { const v2u a = ya[buf][j], c = yc[buf][j]; \
                const f32x4 y0 = (f32x4){bflo(a.x), bfhi(a.x), bflo(a.y), bfhi(a.y)}, y1 = (f32x4){bflo(c.x), bfhi(c.x), bflo(c.y), bfhi(c.y)}; \
                v[j] = xv[buf][j] + g2[j] * (y0 * w0[buf] + y1 * w1[buf]); } \
            const float rinv = row_rinv(v); \
            if (FINAL) { _Pragma("unroll") for (int j = 0; j < 4; ++j) ((f32x4*)(C.out + row * D))[C.lane + 64 * j] = v[j] * rinv * sc[j]; } \
            else { _Pragma("unroll") for (int j = 0; j < 4; ++j) ((f32x4*)(C.out + row * D))[C.lane + 64 * j] = v[j]; mod_store(v, rinv, sc, sh, H + row * D, C.lane); } } while (0)
        CB_LOAD(0, 0);
#pragma unroll 1
        for (int it = 0; it < 8; ++it) { const int r0 = 2 * it;
            CB_LOAD(1, r0 + 1); CB_PROC(0, r0);
            if (it < 7) CB_LOAD(0, r0 + 2);
            CB_PROC(1, r0 + 1); }
#undef CB_PROC
#undef CB_LOAD
    }
}
__device__ __forceinline__ void unpack8(const v4u w, float (&f)[8]) { f[0] = bflo(w.x); f[1] = bfhi(w.x); f[2] = bflo(w.y); f[3] = bfhi(w.y); f[4] = bflo(w.z); f[5] = bfhi(w.z); f[6] = bflo(w.w); f[7] = bfhi(w.w); }
__device__ __forceinline__ void phase_conv(const Ctx& C) {
    const int gw = C.bid * NWAVES + C.wave, NGW = C.G * NWAVES;
    const bf16* BG = (const bf16*)(C.ws + WS_A); const bf16* Y = BG + (size_t)M * D; bf16* MIX = (bf16*)(C.ws + WS_B);
    float cw[3][2][8];
#pragma unroll
    for (int t = 0; t < 3; ++t)
#pragma unroll
        for (int j = 0; j < 2; ++j) { const f32x4 a = *(const f32x4*)(kin(16) + t * 1024 + j * 512 + 8 * C.lane), b = *(const f32x4*)(kin(16) + t * 1024 + j * 512 + 8 * C.lane + 4);
            cw[t][j][0] = a.x; cw[t][j][1] = a.y; cw[t][j][2] = a.z; cw[t][j][3] = a.w; cw[t][j][4] = b.x; cw[t][j][5] = b.y; cw[t][j][6] = b.z; cw[t][j][7] = b.w; }
    const v4u zero4 = (v4u){0u, 0u, 0u, 0u};
    for (int grp = gw; grp < M / 16; grp += NGW) {
        const size_t t0 = (size_t)grp * 16; v4u prev[2], cur[2];
        v4u yn[2][4][2], bgv[2][4][2];
#define CV_LOAD(buf, r0) do { _Pragma("unroll") for (int rr = 0; rr < 4; ++rr) { const size_t row_ = t0 + (r0) + rr; const bool last_ = (row_ & 8191) == 8191; \
            _Pragma("unroll") for (int j = 0; j < 2; ++j) { yn[buf][rr][j] = last_ ? zero4 : ((const v4u*)(Y + (row_ + 1) * D))[C.lane + 64 * j]; bgv[buf][rr][j] = ((const v4u*)(BG + row_ * D))[C.lane + 64 * j]; } } } while (0)
#pragma unroll
        for (int j = 0; j < 2; ++j) { prev[j] = ((t0 & 8191) == 0) ? zero4 : ((const v4u*)(Y + (t0 - 1) * D))[C.lane + 64 * j]; cur[j] = ((const v4u*)(Y + t0 * D))[C.lane + 64 * j]; }
#define CV_PROC(buf, r0) do { _Pragma("unroll") for (int rr = 0; rr < 4; ++rr) { const size_t row = t0 + (r0) + rr; \
            _Pragma("unroll") for (int j = 0; j < 2; ++j) { const v4u nx = yn[buf][rr][j]; \
                float fp[8], fc[8], fn[8], fb[8], o[8]; unpack8(prev[j], fp); unpack8(cur[j], fc); unpack8(nx, fn); unpack8(bgv[buf][rr][j], fb); \
                _Pragma("unroll") for (int e = 0; e < 8; ++e) o[e] = fb[e] * (fp[e] * cw[0][j][e] + fc[e] * cw[1][j][e] + fn[e] * cw[2][j][e]); \
                v4u w; w.x = pk2(o[0], o[1]); w.y = pk2(o[2], o[3]); w.z = pk2(o[4], o[5]); w.w = pk2(o[6], o[7]); \
                ((v4u*)(MIX + row * D))[C.lane + 64 * j] = w; prev[j] = cur[j]; cur[j] = nx; } } } while (0)
        CV_LOAD(0, 0);
#pragma unroll 1
        for (int it = 0; it < 2; ++it) { const int r0 = 8 * it;
            CV_LOAD(1, r0 + 4); CV_PROC(0, r0);
            if (it < 1) CV_LOAD(0, r0 + 8);
            CV_PROC(1, r0 + 4); }
#undef CV_PROC
#undef CV_LOAD
    }
}
constexpr float LOG2E = 1.4426950408889634f;
constexpr float QSCALE = 0.125f * LOG2E;
constexpr int AT_K = 0, AT_V = 16384, AT_WS = 32768, AT_ST = 34816;
__device__ __forceinline__ int crow(int r, int hi) { return (r & 3) + 8 * (r >> 2) + 4 * hi; }
__device__ __forceinline__ bf16x8 pack8(float a0, float a1, float a2, float a3, float a4, float a5, float a6, float a7) {
    v4u w; w.x = pg8::cvt_pk_bf16(a0, a1); w.y = pg8::cvt_pk_bf16(a2, a3); w.z = pg8::cvt_pk_bf16(a4, a5); w.w = pg8::cvt_pk_bf16(a6, a7); return __builtin_bit_cast(bf16x8, w);
}
__device__ __forceinline__ void attn_unit(const Ctx& C, int au) {
    const int qblk = au & 127, kvh = (au >> 7) & 1, b = au >> 8;
    const int ph = C.wave & 1, head = kvh * 4 + (C.wave >> 1), q32 = C.lane & 31, hi = C.lane >> 5;
    const bf16* QK = (const bf16*)(C.ws + WS_A); const bf16* VT = (const bf16*)(C.ws + WS_VT); const bf16* KC = (const bf16*)(C.ws + WS_KC); const bf16* VCT = (const bf16*)(C.ws + WS_VCT);
    bf16* MIX = (bf16*)(C.ws + WS_B);
    const size_t qrow = (size_t)b * SEQ + 64 * qblk + 32 * ph + q32;
    bf16x8 qf[4];
#pragma unroll
    for (int ds = 0; ds < 4; ++ds) qf[ds] = *(const bf16x8*)(QK + qrow * NINE + head * 64 + 16 * ds + 8 * hi);
    float m = kin(10)[head] * LOG2E, l = (hi == 0) ? 1.0f : 0.0f;
    f32x16 o0, o1;
#pragma unroll
    for (int r = 0; r < 16; ++r) { o0[r] = 0.f; o1[r] = 0.f; }
    const int jlo = (qblk < 2) ? 2 - qblk : 0, jhi = (qblk > 125) ? 129 - qblk : 4, NT = 4 + jhi - jlo + 1;
    const int prow = C.tid >> 3, pch = C.tid & 7;
    LAS float* wsf = (LAS float*)(C.lds + AT_WS) + C.wave * 64;
    v4u kr0, vr0, kr1, vr1;
#define AT_LOAD(t, kreg, vreg) do { if ((t) < 4) { kreg = *(const v4u*)(KC + ((size_t)(b * 256 + 64 * (t) + prow) * 128 + kvh * 64 + 8 * pch)); \
            vreg = *(const v4u*)(VCT + ((size_t)((b * 2 + kvh) * 64 + prow) * 256 + 64 * (t) + 8 * pch)); } \
        else { const int kblk_ = qblk - 2 + jlo + (t) - 4; kreg = *(const v4u*)(QK + ((size_t)(b * SEQ + 64 * kblk_ + prow) * NINE + 512 + kvh * 64 + 8 * pch)); \
            vreg = *(const v4u*)(VT + ((size_t)((b * 2 + kvh) * 64 + prow) * SEQ + 64 * kblk_ + 8 * pch)); } } while (0)
#define AT_WRITE(bufi, kreg, vreg) do { *(LAS v4u*)(C.lds + AT_K + (bufi) * 8192 + pch * 1024 + prow * 16) = kreg; *(LAS v4u*)(C.lds + AT_V + (bufi) * 8192 + pch * 1024 + prow * 16) = vreg; } while (0)
    AT_LOAD(0, kr0, vr0); AT_LOAD(1, kr1, vr1);
    AT_WRITE(0, kr0, vr0); AT_LOAD(2, kr0, vr0);
    __syncthreads();
    for (int t = 0; t < NT; ++t) {
        const int buf = t & 1;
        if (t + 1 < NT) {
            if (buf == 0) { AT_WRITE(1, kr1, vr1); if (t + 3 < NT) AT_LOAD(t + 3, kr1, vr1); }
            else { AT_WRITE(0, kr0, vr0); if (t + 3 < NT) AT_LOAD(t + 3, kr0, vr0); }
        }
        const LAS unsigned char* kb = C.lds + AT_K + buf * 8192; const LAS unsigned char* vb = C.lds + AT_V + buf * 8192;
        f32x16 p0, p1;
#pragma unroll
        for (int r = 0; r < 16; ++r) { p0[r] = 0.f; p1[r] = 0.f; }
#pragma unroll
        for (int ds = 0; ds < 4; ++ds) {
            const bf16x8 a0 = *(const LAS bf16x8*)(kb + (2 * ds + hi) * 1024 + q32 * 16), a1 = *(const LAS bf16x8*)(kb + (2 * ds + hi) * 1024 + (q32 + 32) * 16);
            p0 = __builtin_amdgcn_mfma_f32_32x32x16_bf16(a0, qf[ds], p0, 0, 0, 0); p1 = __builtin_amdgcn_mfma_f32_32x32x16_bf16(a1, qf[ds], p1, 0, 0, 0);
        }
        const int j = (t < 4) ? -1 : jlo + t - 4;
        if (j == 0 || j == 4) {
            int qq = 32 * ph + q32; asm volatile("" : "+v"(qq));
#pragma unroll
            for (int r = 0; r < 16; ++r) { const int kv = crow(r, hi);
                const bool d0 = (j == 0) ? (kv < qq) : (kv > qq), d1 = (j == 0) ? (kv + 32 < qq) : (kv + 32 > qq);
                if (d0) p0[r] = -__builtin_inff(); if (d1) p1[r] = -__builtin_inff(); }
        }
        float rm = fmaxf(p0[0], p1[0]);
#pragma unroll
        for (int r = 1; r < 16; ++r) rm = fmaxf(rm, fmaxf(p0[r], p1[r]));
        rm = fmaxf(rm, __shfl_xor(rm, 32));
        if (__any(rm > m)) {
            const float mn = fmaxf(m, rm), al = __builtin_amdgcn_exp2f(m - mn); m = mn; l *= al;
            if (hi == 0) wsf[q32] = al;
#pragma unroll
            for (int r = 0; r < 16; ++r) { const float f = wsf[crow(r, hi)]; o0[r] *= f; o1[r] *= f; }
        }
        float ls = 0.f;
#pragma unroll
        for (int r = 0; r < 16; ++r) { p0[r] = __builtin_amdgcn_exp2f(p0[r] - m); p1[r] = __builtin_amdgcn_exp2f(p1[r] - m); ls += p0[r] + p1[r]; }
        l += ls;
#pragma unroll
        for (int s = 0; s < 2; ++s) {
            const bf16x8 pa = pack8(p0[8 * s], p0[8 * s + 1], p0[8 * s + 2], p0[8 * s + 3], p0[8 * s + 4], p0[8 * s + 5], p0[8 * s + 6], p0[8 * s + 7]);
            const bf16x8 pb = pack8(p1[8 * s], p1[8 * s + 1], p1[8 * s + 2], p1[8 * s + 3], p1[8 * s + 4], p1[8 * s + 5], p1[8 * s + 6], p1[8 * s + 7]);
            const bf16x8 va0 = *(const LAS bf16x8*)(vb + (2 * s + hi) * 1024 + q32 * 16), va1 = *(const LAS bf16x8*)(vb + (2 * s + hi) * 1024 + (q32 + 32) * 16);
            const bf16x8 vb0 = *(const LAS bf16x8*)(vb + (4 + 2 * s + hi) * 1024 + q32 * 16), vb1 = *(const LAS bf16x8*)(vb + (4 + 2 * s + hi) * 1024 + (q32 + 32) * 16);
            o0 = __builtin_amdgcn_mfma_f32_32x32x16_bf16(pa, va0, o0, 0, 0, 0); o1 = __builtin_amdgcn_mfma_f32_32x32x16_bf16(pa, va1, o1, 0, 0, 0);
            o0 = __builtin_amdgcn_mfma_f32_32x32x16_bf16(pb, vb0, o0, 0, 0, 0); o1 = __builtin_amdgcn_mfma_f32_32x32x16_bf16(pb, vb1, o1, 0, 0, 0);
        }
        __syncthreads();
    }
#undef AT_LOAD
#undef AT_WRITE
    l += __shfl_xor(l, 32);
    if (hi == 0) wsf[32 + q32] = l;
    LAS bf16* stg = (LAS bf16*)(C.lds + AT_ST) + C.wave * 2048;
#pragma unroll
    for (int r = 0; r < 16; ++r) { const int orow = crow(r, hi); const float rl = 1.0f / wsf[32 + orow];
        stg[orow * 64 + q32] = (bf16)f2bf(o0[r] * rl); stg[orow * 64 + 32 + q32] = (bf16)f2bf(o1[r] * rl); }
    bf16* Ow = MIX + ((size_t)b * SEQ + 64 * qblk + 32 * ph) * D + head * 64;
#pragma unroll
    for (int i = 0; i < 4; ++i) { const int pc = i * 64 + C.lane, row = pc >> 3, ch = pc & 7; const v4u v = *(const LAS v4u*)(stg + row * 64 + ch * 8); *(v4u*)(Ow + (size_t)row * D + ch * 8) = v; }
    __syncthreads();
}
constexpr int ZS = 1040;
__device__ __forceinline__ v2u tr_read(unsigned addr) { v2u r; asm volatile("ds_read_b64_tr_b16 %0, %1\n\ts_waitcnt lgkmcnt(0)" : "=&v"(r) : "v"(addr) : "memory"); return r; }
__device__ __forceinline__ void sgu_unit(const Ctx& C, int su) {
    const size_t R0 = (size_t)su * 128;
    const bf16* QK = (const bf16*)(C.ws + WS_A); bf16* MIX = (bf16*)(C.ws + WS_B); const bf16* WSP = (const bf16*)(C.ws + WS_WSP);
    { float gs[8]; const f32x4 a = *(const f32x4*)(kin(11) + 8 * C.lane), c = *(const f32x4*)(kin(11) + 8 * C.lane + 4);
        gs[0] = a.x; gs[1] = a.y; gs[2] = a.z; gs[3] = a.w; gs[4] = c.x; gs[5] = c.y; gs[6] = c.z; gs[7] = c.w;
#pragma unroll 4
        for (int rr = 0; rr < 16; ++rr) { const int j = C.wave * 16 + rr;
            const v4u zw = *(const v4u*)(QK + (R0 + j) * NINE + 1280 + 8 * C.lane); float x[8]; unpack8(zw, x);
            float s = 0.f;
#pragma unroll
            for (int e = 0; e < 8; ++e) s += x[e];
            const float mean = wave_sum(s) * (1.0f / 512.0f); float q = 0.f;
#pragma unroll
            for (int e = 0; e < 8; ++e) { x[e] -= mean; q += x[e] * x[e]; }
            const float rstd = rsqrtf(wave_sum(q) * (1.0f / 512.0f) + EPS);
            v4u w; w.x = pk2(x[0] * rstd * gs[0], x[1] * rstd * gs[1]); w.y = pk2(x[2] * rstd * gs[2], x[3] * rstd * gs[3]);
            w.z = pk2(x[4] * rstd * gs[4], x[5] * rstd * gs[5]); w.w = pk2(x[6] * rstd * gs[6], x[7] * rstd * gs[7]);
            *(LAS v4u*)(C.lds + j * ZS + 16 * C.lane) = w; }
    }
    __syncthreads();
    const int h = C.wave, l31 = C.lane & 31, hi = C.lane >> 5, g16 = (C.lane >> 4) & 1, q4 = (C.lane & 15) >> 2, p4 = C.lane & 3;
    f32x16 acc[2][4];
#pragma unroll
    for (int cb = 0; cb < 2; ++cb)
#pragma unroll
        for (int ib = 0; ib < 4; ++ib)
#pragma unroll
            for (int r = 0; r < 16; ++r) acc[cb][ib][r] = 0.f;
#pragma unroll 2
    for (int ks = 0; ks < 8; ++ks) {
        bf16x8 bw[4];
#pragma unroll
        for (int ib = 0; ib < 4; ++ib) bw[ib] = *(const bf16x8*)(WSP + ((size_t)h * 128 + 32 * ib + l31) * 128 + 16 * ks + 8 * hi);
        bf16x8 az[2];
#pragma unroll
        for (int cb = 0; cb < 2; ++cb) {
            const unsigned a0 = C.ldsaddr + (unsigned)((16 * ks + 8 * hi + q4) * ZS + (64 * h + 32 * cb + 16 * g16 + 4 * p4) * 2);
            const v2u lo = tr_read(a0), hi2 = tr_read(a0 + 4 * ZS);
            az[cb] = __builtin_bit_cast(bf16x8, (v4u){lo.x, lo.y, hi2.x, hi2.y});
        }
#pragma unroll
        for (int cb = 0; cb < 2; ++cb)
#pragma unroll
            for (int ib = 0; ib < 4; ++ib) acc[cb][ib] = __builtin_amdgcn_mfma_f32_32x32x16_bf16(az[cb], bw[ib], acc[cb][ib], 0, 0, 0);
    }
#pragma unroll
    for (int ib = 0; ib < 4; ++ib) {
        const int i = 32 * ib + l31; const float bias = kin(13)[h * 128 + i]; const size_t row = R0 + i;
#pragma unroll
        for (int cb = 0; cb < 2; ++cb)
#pragma unroll
            for (int rg = 0; rg < 4; ++rg) { const int c = 64 * h + 32 * cb + 8 * rg + 4 * hi;
                const v2u uw = *(const v2u*)(QK + row * NINE + 768 + c);
                const float o0 = bflo(uw.x) * (acc[cb][ib][4 * rg] + bias), o1 = bfhi(uw.x) * (acc[cb][ib][4 * rg + 1] + bias), o2 = bflo(uw.y) * (acc[cb][ib][4 * rg + 2] + bias), o3 = bfhi(uw.y) * (acc[cb][ib][4 * rg + 3] + bias);
                v2u w; w.x = pk2(o0, o1); w.y = pk2(o2, o3); *(v2u*)(MIX + row * D + 512 + c) = w; }
    }
    __syncthreads();
}
__device__ __forceinline__ void phase_attn_sgu(const Ctx& C) {
    for (int au = C.bid; au < BATCH * 2 * 128; au += C.G) attn_unit(C, au);
    for (int su = C.bid; su < M / 128; su += C.G) sgu_unit(C, su);
}
__global__ void __launch_bounds__(NWAVES * 64, 2) mk_fwd(Args args) {
    extern __shared__ __attribute__((aligned(16))) unsigned char lds_raw[];
    Ctx C;
    C.lds = (LAS unsigned char*)lds_raw; C.ldsaddr = (unsigned)(uintptr_t)C.lds;
    C.tid = threadIdx.x; C.lane = C.tid & 63; C.wave = __builtin_amdgcn_readfirstlane(C.tid >> 6);
    C.G = gridDim.x; C.bid = blockIdx.x;
    C.out = args.out; C.ws = args.ws; C.ctl = (gu32*)(args.ws + WS_CTL);
    volatile LAS unsigned* MISC = (volatile LAS unsigned*)(C.lds + MISC_OFF);
    if (C.tid < 64) MISC[C.tid] = 0u;
    __syncthreads();
#define FRESH_IDS(Cx) do { int z_ = 0; asm volatile("" : "+s"(z_)); Cx.lane = (int)__builtin_amdgcn_mbcnt_hi(~0u, __builtin_amdgcn_mbcnt_lo(~0u, (unsigned)z_)); Cx.tid = Cx.wave * 64 + Cx.lane; } while (0)
    const int lo = args.ph_lo, hi = args.ph_hi;
    const bool one = (hi - lo) > 1;
    XcdBarrier bar; bar.bar = (unsigned*)(C.ctl + CW_BAR); bar.x = 0; bar.st = nullptr;
    if (one) bar = xcd_barrier_post((unsigned*)(C.ctl + CW_BAR), MISC + 8);
#ifndef PHMASK
#define PHMASK 0x3ffff
#endif
#define IN(k) (((PHMASK >> (k)) & 1) && lo <= (k) && (k) < hi)
#define SEAM(k) do { if (IN(k) && IN((k) + 1)) { Ctx Cb = C; FRESH_IDS(Cb); xcd_barrier(bar, Cb.tid); } } while (0)
#ifndef DUPMASK
#define DUPMASK 0
#endif
#define DUP(k) DUP_##k
#if (DUPMASK >> 0) & 1
#define DUP_0 _Pragma("unroll") for (int rep_ = 0; rep_ < 2; ++rep_)
#else
#define DUP_0
#endif
#if (DUPMASK >> 1) & 1
#define DUP_1 _Pragma("unroll") for (int rep_ = 0; rep_ < 2; ++rep_)
#else
#define DUP_1
#endif
#if (DUPMASK >> 2) & 1
#define DUP_2 _Pragma("unroll") for (int rep_ = 0; rep_ < 2; ++rep_)
#else
#define DUP_2
#endif
#if (DUPMASK >> 3) & 1
#define DUP_3 _Pragma("unroll") for (int rep_ = 0; rep_ < 2; ++rep_)
#else
#define DUP_3
#endif
#if (DUPMASK >> 4) & 1
#define DUP_4 _Pragma("unroll") for (int rep_ = 0; rep_ < 2; ++rep_)
#else
#define DUP_4
#endif
#if (DUPMASK >> 5) & 1
#define DUP_5 _Pragma("unroll") for (int rep_ = 0; rep_ < 2; ++rep_)
#else
#define DUP_5
#endif
#if (DUPMASK >> 6) & 1
#define DUP_6 _Pragma("unroll") for (int rep_ = 0; rep_ < 2; ++rep_)
#else
#define DUP_6
#endif
#if (DUPMASK >> 7) & 1
#define DUP_7 _Pragma("unroll") for (int rep_ = 0; rep_ < 2; ++rep_)
#else
#define DUP_7
#endif
#if (DUPMASK >> 8) & 1
#define DUP_8 _Pragma("unroll") for (int rep_ = 0; rep_ < 2; ++rep_)
#else
#define DUP_8
#endif
#if (DUPMASK >> 9) & 1
#define DUP_9 _Pragma("unroll") for (int rep_ = 0; rep_ < 2; ++rep_)
#else
#define DUP_9
#endif
#if (DUPMASK >> 10) & 1
#define DUP_10 _Pragma("unroll") for (int rep_ = 0; rep_ < 2; ++rep_)
#else
#define DUP_10
#endif
#if (DUPMASK >> 11) & 1
#define DUP_11 _Pragma("unroll") for (int rep_ = 0; rep_ < 2; ++rep_)
#else
#define DUP_11
#endif
#if (DUPMASK >> 12) & 1
#define DUP_12 _Pragma("unroll") for (int rep_ = 0; rep_ < 2; ++rep_)
#else
#define DUP_12
#endif
#if (DUPMASK >> 13) & 1
#define DUP_13 _Pragma("unroll") for (int rep_ = 0; rep_ < 2; ++rep_)
#else
#define DUP_13
#endif
#if (DUPMASK >> 14) & 1
#define DUP_14 _Pragma("unroll") for (int rep_ = 0; rep_ < 2; ++rep_)
#else
#define DUP_14
#endif
#if (DUPMASK >> 15) & 1
#define DUP_15 _Pragma("unroll") for (int rep_ = 0; rep_ < 2; ++rep_)
#else
#define DUP_15
#endif
#if (DUPMASK >> 16) & 1
#define DUP_16 _Pragma("unroll") for (int rep_ = 0; rep_ < 2; ++rep_)
#else
#define DUP_16
#endif
#if (DUPMASK >> 17) & 1
#define DUP_17 _Pragma("unroll") for (int rep_ = 0; rep_ < 2; ++rep_)
#else
#define DUP_17
#endif
    bf16* const H = (bf16*)(C.ws + WS_H); bf16* const RA = (bf16*)(C.ws + WS_A); bf16* const RB = (bf16*)(C.ws + WS_B);
    const float* const MOD = (const float*)(C.ws + WS_MOD);

    DUP(0) { if (IN(0)) { Ctx Cp = C; FRESH_IDS(Cp); p0_prologue(Cp); } SEAM(0); }
    DUP(1) { if (IN(1)) { Ctx Cp = C; FRESH_IDS(Cp); phase_norm1_l0(Cp); } SEAM(1); }
    DUP(2) { if (IN(2)) { Ctx Cp = C; FRESH_IDS(Cp);
        pg8::Gemm g{H, (const bf16*)(Cp.ws + WS_WINE), M, NINE, D}; pg8::InEOrder S; S.so.init(M, NINE, Cp.G, Cp.bid); S.G = Cp.G; S.c = Cp.bid;
        pg8::EpiInE E{RA, (bf16*)(Cp.ws + WS_VT), (bf16*)(Cp.ws + WS_KC), (bf16*)(Cp.ws + WS_VCT), (const float*)(Cp.ws + WS_ROPE), (const float*)(Cp.ws + WS_ROPE) + 2048, QSCALE};
        pg8::gemm_phase<pg8::EpiInE, pg8::InEOrder, true, true>(Cp.lds, g, S, E, Cp.tid);
    } SEAM(2); }
    DUP(3) { if (IN(3)) { Ctx Cp = C; FRESH_IDS(Cp); phase_attn_sgu(Cp); } SEAM(3); }
    DUP(4) { if (IN(4)) { Ctx Cp = C; FRESH_IDS(Cp);
        pg8::Gemm g{RB, (const bf16*)(Cp.ws + WS_WOUTE), M, D, D}; pg8::StaticOrder S; S.init(M, D, Cp.G, Cp.bid);
        pg8::EpiRes E{kin(0), Cp.out, MOD + 2 * 1024, (float*)(Cp.ws + WS_RSS)};
        pg8::gemm_phase<pg8::EpiRes, pg8::StaticOrder, true, true>(Cp.lds, g, S, E, Cp.tid);
    } SEAM(4); }
    DUP(5) { if (IN(5)) { Ctx Cp = C; FRESH_IDS(Cp); phase_router(Cp, 0); } SEAM(5); }
    DUP(6) { if (IN(6)) { Ctx Cp = C; FRESH_IDS(Cp); phase_scatter(Cp, 0); } SEAM(6); }
    DUP(7) { if (IN(7)) { Ctx Cp = C; FRESH_IDS(Cp);
        const int nt = moe_tables(Cp, 0);
        pg8::Gemm g{RA, (const bf16*)(Cp.ws + WS_WGU), nt * 256, NEXP * 1024, D}; pg8::MoeOrder S{(const LAS int*)(Cp.lds + MOE_TAB_OFF), nt * 4, Cp.G, Cp.bid};
        pg8::EpiSwiGLU E{RB};
        pg8::gemm_phase<pg8::EpiSwiGLU, pg8::MoeOrder, true, true>(Cp.lds, g, S, E, Cp.tid);
    } SEAM(7); }
    DUP(8) { if (IN(8)) { Ctx Cp = C; FRESH_IDS(Cp);
        const int nt = moe_tables(Cp, 0);
        pg8::Gemm g{RB, (const bf16*)(Cp.ws + WS_WD), nt * 256, NEXP * 1024, EH}; pg8::MoeOrder S{(const LAS int*)(Cp.lds + MOE_TAB_OFF), nt * 4, Cp.G, Cp.bid};
        pg8::EpiDown E{RA};
        pg8::gemm_phase<pg8::EpiDown, pg8::MoeOrder, true, true>(Cp.lds, g, S, E, Cp.tid);
    } SEAM(8); }
    DUP(9) { if (IN(9)) { Ctx Cp = C; FRESH_IDS(Cp); phase_combine<false>(Cp, 0); } SEAM(9); }
    DUP(10) { if (IN(10)) { Ctx Cp = C; FRESH_IDS(Cp);
        pg8::Gemm g{H, (const bf16*)(Cp.ws + WS_WINO), M, 3072, D}; pg8::StaticOrder S; S.init(M, 3072, Cp.G, Cp.bid);
        pg8::EpiInO E{RA, RA + (size_t)M * D};
        pg8::gemm_phase<pg8::EpiInO, pg8::StaticOrder, true, true>(Cp.lds, g, S, E, Cp.tid);
    } SEAM(10); }
    DUP(11) { if (IN(11)) { Ctx Cp = C; FRESH_IDS(Cp); phase_conv(Cp); } SEAM(11); }
    DUP(12) { if (IN(12)) { Ctx Cp = C; FRESH_IDS(Cp);
        pg8::Gemm g{RB, (const bf16*)(Cp.ws + WS_WOUTO), M, D, D}; pg8::StaticOrder S; S.init(M, D, Cp.G, Cp.bid);
        pg8::EpiRes E{Cp.out, Cp.out, MOD + (size_t)4 * 6144 + 2 * 1024, (float*)(Cp.ws + WS_RSS)};
        pg8::gemm_phase<pg8::EpiRes, pg8::StaticOrder, true, true>(Cp.lds, g, S, E, Cp.tid);
    } SEAM(12); }
    DUP(13) { if (IN(13)) { Ctx Cp = C; FRESH_IDS(Cp); phase_router(Cp, 1); } SEAM(13); }
    DUP(14) { if (IN(14)) { Ctx Cp = C; FRESH_IDS(Cp); phase_scatter(Cp, 1); } SEAM(14); }
    DUP(15) { if (IN(15)) { Ctx Cp = C; FRESH_IDS(Cp);
        const int nt = moe_tables(Cp, 1);
        pg8::Gemm g{RA, (const bf16*)(Cp.ws + WS_WGU) + (size_t)NEXP * 1024 * 1024, nt * 256, NEXP * 1024, D}; pg8::MoeOrder S{(const LAS int*)(Cp.lds + MOE_TAB_OFF), nt * 4, Cp.G, Cp.bid};
        pg8::EpiSwiGLU E{RB};
        pg8::gemm_phase<pg8::EpiSwiGLU, pg8::MoeOrder, true, true>(Cp.lds, g, S, E, Cp.tid);
    } SEAM(15); }
    DUP(16) { if (IN(16)) { Ctx Cp = C; FRESH_IDS(Cp);
        const int nt = moe_tables(Cp, 1);
        pg8::Gemm g{RB, (const bf16*)(Cp.ws + WS_WD) + (size_t)NEXP * 1024 * 512, nt * 256, NEXP * 1024, EH}; pg8::MoeOrder S{(const LAS int*)(Cp.lds + MOE_TAB_OFF), nt * 4, Cp.G, Cp.bid};
        pg8::EpiDown E{RA};
        pg8::gemm_phase<pg8::EpiDown, pg8::MoeOrder, true, true>(Cp.lds, g, S, E, Cp.tid);
    } SEAM(16); }
    DUP(17) { if (IN(17)) { Ctx Cp = C; FRESH_IDS(Cp); phase_combine<true>(Cp, 1); } }
#undef IN
#undef SEAM
}

extern "C" void kernel_launch(void* const* d_in, const int* in_sizes, int n_in, void* d_out, int out_size, void* d_ws, size_t ws_size, hipStream_t stream) {
    static int grid = 0;
    if (grid == 0) {
        if (n_in != 25 || in_sizes[0] != M * D || out_size != M * D || ws_size < WS_END) { fprintf(stderr, "kernel_launch: unexpected shapes (n_in %d, in0 %d, out %d, ws %zu)\n", n_in, n_in > 0 ? in_sizes[0] : -1, out_size, ws_size); grid = -1; return; }
        int dev = 0, cus = 0, per_cu = 0;
        if (hipGetDevice(&dev) != hipSuccess || hipDeviceGetAttribute(&cus, hipDeviceAttributeMultiprocessorCount, dev) != hipSuccess) { grid = -1; return; }
        if (hipFuncSetAttribute((const void*)mk_fwd, hipFuncAttributeMaxDynamicSharedMemorySize, LDS_BYTES) != hipSuccess) { fprintf(stderr, "kernel_launch: hipFuncSetAttribute failed\n"); grid = -1; return; }
        if (hipOccupancyMaxActiveBlocksPerMultiprocessor(&per_cu, (const void*)mk_fwd, NWAVES * 64, LDS_BYTES) != hipSuccess || per_cu < 1) { fprintf(stderr, "kernel_launch: occupancy query says %d\n", per_cu); }
        (void)hipGetLastError();
        grid = cus;
    }
    if (grid < 0) return;
    if (hipMemsetAsync((char*)d_ws + WS_CTL, 0, CTL_ZERO_BYTES, stream) != hipSuccess) return;
    Args a{};
    for (int i = 0; i < 25; ++i) a.in[i] = (const float*)d_in[i];
    a.out = (float*)d_out; a.ws = (unsigned char*)d_ws;
#if defined(PROBE_K)
    a.ph_lo = 0; a.ph_hi = PROBE_K + 1; hipLaunchKernelGGL(mk_fwd, dim3(grid), dim3(NWAVES * 64), LDS_BYTES, stream, a);
    (void)hipMemsetAsync((char*)d_ws + WS_CTL, 0, (PROBE_K == 5 || PROBE_K == 13) ? CTL_ZERO_BYTES : (size_t)4 * CW_GCNT, stream);
    a.ph_lo = PROBE_K; a.ph_hi = PROBE_K + 1; hipLaunchKernelGGL(mk_fwd, dim3(grid), dim3(NWAVES * 64), LDS_BYTES, stream, a);
    (void)hipMemsetAsync((char*)d_ws + WS_CTL, 0, 4 * CW_GCNT, stream);
    if (PROBE_K + 1 < N_PHASES) { a.ph_lo = PROBE_K + 1; a.ph_hi = N_PHASES; hipLaunchKernelGGL(mk_fwd, dim3(grid), dim3(NWAVES * 64), LDS_BYTES, stream, a); }
#elif MK_ONE_LAUNCH
    a.ph_lo = 0; a.ph_hi = N_PHASES;
    hipLaunchKernelGGL(mk_fwd, dim3(grid), dim3(NWAVES * 64), LDS_BYTES, stream, a);
#else
    for (int p = 0; p < N_PHASES; ++p) { a.ph_lo = p; a.ph_hi = p + 1; hipLaunchKernelGGL(mk_fwd, dim3(grid), dim3(NWAVES * 64), LDS_BYTES, stream, a); }
#endif
}
```

```cpp
#include <hip/hip_runtime.h>
#include <cstdio>
#include <cstdint>
namespace pg8 {
#define PG8_LAS __attribute__((address_space(3)))
typedef unsigned short bf16_t;
typedef short bf16x8 __attribute__((ext_vector_type(8)));
typedef float f32x4 __attribute__((ext_vector_type(4)));
typedef unsigned u32x4 __attribute__((ext_vector_type(4)));
constexpr int BM = 256, BK = 64, HALF = 128, HTB = HALF * BK * 2  , STAGE_BYTES = 8 * HTB, NXCD = 8, WGM = 8;

__host__ __device__ __forceinline__ int lds_byte(int r, int c) { const int st = (r >> 4) * 2 + (c >> 5), rr = r & 15, cc = c & 31, ob = rr * 64 + cc * 2; return st * 1024 + (ob ^ (((ob >> 9) & 1) << 5)); }
__host__ __device__ __forceinline__ void stage_rc(int b, int& R, int& C) { const int st = b / 1024, sb = b % 1024, swz = sb ^ (((sb >> 9) & 1) << 5); R = (st >> 1) * 16 + swz / 64; C = (st & 1) * 32 + (swz % 64) / 2; }
__host__ __device__ __forceinline__ int perm32(int rho) { const int n = rho >> 4, i = rho & 15; return 8 * (i >> 2) + 4 * n + (i & 3); }

struct Unit { int pm, pn; };
struct Gemm { const bf16_t* A; const bf16_t* Bt; int M, N, K; };

struct StaticOrder {
    int nM, nN, nwg, G, c;
    __host__ __device__ void init(int M, int N, int G_, int c_) { nM = M / BM; nN = N / BM; nwg = nM * nN; G = G_; c = c_; }
    __host__ __device__ bool next(int i, Unit& u) const {
        const long L = (long)i * G + c; if (L >= nwg) return false;
        int wgid = (int)L; { const int q = nwg / NXCD, r = nwg % NXCD, xcd = wgid % NXCD, off = wgid / NXCD; wgid = (xcd < r ? xcd * (q + 1) : r * (q + 1) + (xcd - r) * q) + off; }
        const int nig = WGM * nN, gid = wgid / nig, fm = gid * WGM, gsz = (nM - fm) < WGM ? (nM - fm) : WGM;
        u.pm = fm + ((wgid % nig) % gsz); u.pn = (wgid % nig) / gsz; return true;
    }
    __device__ __forceinline__ void a_ready(const Unit&) const {}
    __device__ __forceinline__ void done(const Unit&) const {}
};

__device__ __forceinline__ unsigned cvt_pk_bf16(float lo, float hi) { unsigned r; asm volatile("v_cvt_pk_bf16_f32 %0, %1, %2" : "=v"(r) : "v"(lo), "v"(hi)); return r; }
typedef float f32x2 __attribute__((ext_vector_type(2)));
__device__ __forceinline__ f32x2 gelu_pk(f32x2 v) {
    const f32x2 av = __builtin_elementwise_abs(v), d = av * 0.2316418882f + 1.0f;
    f32x2 t; t.x = __builtin_amdgcn_rcpf(d.x); t.y = __builtin_amdgcn_rcpf(d.y);
    f32x2 q = t * 0.5307027145f + (-0.7265760135f); q = q * t + 0.7107068705f; q = q * t + (-0.142248368f); q = q * t + 0.127414796f; q = q * t;
    const f32x2 s = (v * v) * (-0.72134752044f);
    f32x2 e; e.x = __builtin_amdgcn_exp2f(s.x); e.y = __builtin_amdgcn_exp2f(s.y);
    const f32x2 m = v * (q * e), r = v - m;
    f32x2 o; o.x = v.x < 0.f ? m.x : r.x; o.y = v.y < 0.f ? m.y : r.y; return o;
}

typedef int i32x4 __attribute__((ext_vector_type(4)));
template <bool I8> struct AccSel { typedef f32x4 t; };
template <> struct AccSel<true> { typedef i32x4 t; };
__device__ __forceinline__ f32x4 mma16(bf16x8 a, bf16x8 b, f32x4 c) { return __builtin_amdgcn_mfma_f32_16x16x32_bf16(a, b, c, 0, 0, 0); }
__device__ __forceinline__ i32x4 mma16(bf16x8 a, bf16x8 b, i32x4 c) { return __builtin_amdgcn_mfma_i32_16x16x64_i8(__builtin_bit_cast(i32x4, a), __builtin_bit_cast(i32x4, b), c, 0, 0, 0); }
typedef unsigned u32x2 __attribute__((ext_vector_type(2)));
__device__ __forceinline__ int perm16(int x) { return (x & 3) | ((x & 4) << 1) | ((x & 8) >> 1); }
__device__ __forceinline__ bf16_t bf1(float v) { return (bf16_t)(cvt_pk_bf16(v, 0.f) & 0xffffu); }
__device__ __forceinline__ u32x2 pk4(f32x4 v) { u32x2 w; w.x = cvt_pk_bf16(v[0], v[1]); w.y = cvt_pk_bf16(v[2], v[3]); return w; }
__device__ __forceinline__ f32x4 gelu4(f32x4 v) { const f32x2 a = gelu_pk((f32x2){v[0], v[1]}), b = gelu_pk((f32x2){v[2], v[3]}); return (f32x4){a.x, a.y, b.x, b.y}; }
__device__ __forceinline__ float silu1(float g) { return g * __builtin_amdgcn_rcpf(1.0f + __builtin_amdgcn_exp2f(-1.4426950408889634f * g)); }

struct EpiInE {
    static constexpr bool PERM = false, AFTER_DRAIN = false, I8 = false;
    bf16_t* QK; bf16_t* VT; bf16_t* KC; bf16_t* VCT; const float* rc; const float* rs; float qscale;
    __device__ __forceinline__ void operator()(const f32x4 (&acc)[2][2][4][2], const Unit& u, int wr, int wc, int fr, int fq) const {
        const int row0 = u.pm * BM + wr * 64 + fr;
        if (u.pm >= 128) {
#pragma unroll
            for (int ai = 0; ai < 2; ++ai)
#pragma unroll
                for (int m = 0; m < 4; ++m) {
                    const int row = row0 + ai * HALF + m * 16 - 32768, b = row >> 8, j = row & 255, jp = (j & ~15) | perm16(j & 15);
#pragma unroll
                    for (int n = 0; n < 2; ++n) {
                        *(u32x2*)(KC + (size_t)row * 128 + wc * 32 + n * 16 + 4 * fq) = pk4(acc[ai][0][m][n]);
#pragma unroll
                        for (int i = 0; i < 4; ++i) { const int cv = wc * 32 + n * 16 + 4 * fq + i; VCT[((size_t)(b * 2 + (cv >> 6)) * 64 + (cv & 63)) * 256 + jp] = bf1(acc[ai][1][m][n][i]); }
                    }
                }
            return;
        }
        if (u.pn <= 2) {
            const float sc = (u.pn < 2) ? qscale : 1.0f;
#pragma unroll
            for (int ai = 0; ai < 2; ++ai)
#pragma unroll
                for (int m = 0; m < 4; ++m) {
                    const int row = row0 + ai * HALF + m * 16, pos = row & 8191, pidx = (wc & 1) ? (pos & 63) : (pos >> 6);
                    const f32x4 c4 = *(const f32x4*)(rc + pidx * 16 + 4 * fq) * sc, s4 = *(const f32x4*)(rs + pidx * 16 + 4 * fq) * sc;
                    bf16_t* rowp = QK + (size_t)row * 1792 + u.pn * BM + wc * 32 + 4 * fq;
#pragma unroll
                    for (int bj = 0; bj < 2; ++bj) {
                        if (u.pn == 2 && bj == 1) break;
                        const f32x4 v0 = acc[ai][bj][m][0], v1 = acc[ai][bj][m][1];
                        *(u32x2*)(rowp + bj * HALF) = pk4(v0 * c4 - v1 * s4);
                        *(u32x2*)(rowp + bj * HALF + 16) = pk4(v1 * c4 + v0 * s4);
                    }
                    if (u.pn == 2) {
                        const int b = row >> 13, pp = (pos & ~15) | perm16(pos & 15);
#pragma unroll
                        for (int n = 0; n < 2; ++n)
#pragma unroll
                            for (int i = 0; i < 4; ++i) { const int cv = wc * 32 + n * 16 + 4 * fq + i; VT[((size_t)(b * 2 + (cv >> 6)) * 64 + (cv & 63)) * 8192 + pp] = bf1(acc[ai][1][m][n][i]); }
                    }
                }
            return;
        }
#pragma unroll
        for (int ai = 0; ai < 2; ++ai)
#pragma unroll
            for (int m = 0; m < 4; ++m) {
                bf16_t* rowp = QK + (size_t)(row0 + ai * HALF + m * 16) * 1792 + u.pn * BM + wc * 32 + 4 * fq;
#pragma unroll
                for (int bj = 0; bj < 2; ++bj)
#pragma unroll
                    for (int n = 0; n < 2; ++n) *(u32x2*)(rowp + bj * HALF + n * 16) = pk4(gelu4(acc[ai][bj][m][n]));
            }
    }
};
struct EpiRes {
    static constexpr bool PERM = false, AFTER_DRAIN = false, I8 = false;
    const float* base; float* out; const float* gate; float* RSS;
    __device__ __forceinline__ void operator()(const f32x4 (&acc)[2][2][4][2], const Unit& u, int wr, int wc, int fr, int fq) const {
        const int row0 = u.pm * BM + wr * 64 + fr, col0 = u.pn * BM + wc * 32 + 4 * fq, b = u.pm >> 5;
        f32x4 gv[2][2];
#pragma unroll
        for (int bj = 0; bj < 2; ++bj)
#pragma unroll
            for (int n = 0; n < 2; ++n) gv[bj][n] = *(const f32x4*)(gate + (size_t)b * 6144 + col0 + bj * HALF + n * 16);
#pragma unroll
        for (int ai = 0; ai < 2; ++ai) {
            f32x4 bs[4][2][2];
#pragma unroll
            for (int m = 0; m < 4; ++m)
#pragma unroll
                for (int bj = 0; bj < 2; ++bj)
#pragma unroll
                    for (int n = 0; n < 2; ++n) bs[m][bj][n] = *(const f32x4*)(base + (size_t)(row0 + ai * HALF + m * 16) * 1024 + col0 + bj * HALF + n * 16);
            asm volatile("" ::: "memory");
#pragma unroll
            for (int m = 0; m < 4; ++m) { const int row = row0 + ai * HALF + m * 16; float ss = 0.f;
#pragma unroll
                for (int bj = 0; bj < 2; ++bj)
#pragma unroll
                    for (int n = 0; n < 2; ++n) { const f32x4 o = bs[m][bj][n] + gv[bj][n] * acc[ai][bj][m][n]; *(f32x4*)(out + (size_t)row * 1024 + col0 + bj * HALF + n * 16) = o;
                        ss += (o[0] * o[0] + o[1] * o[1]) + (o[2] * o[2] + o[3] * o[3]); }
                ss += __shfl_xor(ss, 16); ss += __shfl_xor(ss, 32);
                if (fq == 0) RSS[(size_t)row * 16 + u.pn * 4 + wc] = ss; }
            asm volatile("" ::: "memory");
        }
    }
};
struct EpiSwiGLU {
    static constexpr bool PERM = true, AFTER_DRAIN = false, I8 = false;
    bf16_t* HID;
    __device__ __forceinline__ void operator()(const f32x4 (&acc)[2][2][4][2], const Unit& u, int wr, int wc, int fr, int fq) const {
        const int row0 = u.pm * BM + wr * 64 + fr, col0 = (u.pn & 3) * HALF + wc * 32 + 8 * fq;
#pragma unroll
        for (int ai = 0; ai < 2; ++ai)
#pragma unroll
            for (int m = 0; m < 4; ++m) {
                const f32x4 g0 = acc[ai][0][m][0], g1 = acc[ai][0][m][1], u0 = acc[ai][1][m][0], u1 = acc[ai][1][m][1];
                u32x4 w;
                w.x = cvt_pk_bf16(silu1(g0[0]) * u0[0], silu1(g0[1]) * u0[1]); w.y = cvt_pk_bf16(silu1(g0[2]) * u0[2], silu1(g0[3]) * u0[3]);
                w.z = cvt_pk_bf16(silu1(g1[0]) * u1[0], silu1(g1[1]) * u1[1]); w.w = cvt_pk_bf16(silu1(g1[2]) * u1[2], silu1(g1[3]) * u1[3]);
                *(u32x4*)(HID + (size_t)(row0 + ai * HALF + m * 16) * 512 + col0) = w;
            }
    }
};
struct EpiSwiGLU8 {
    static constexpr bool PERM = true, AFTER_DRAIN = false, I8 = true;
    bf16_t* HID; const float* RSC; const float* CSC;
    __device__ __forceinline__ void operator()(const i32x4 (&acc)[2][2][4][2], const Unit& u, int wr, int wc, int fr, int fq) const {
        const int row0 = u.pm * BM + wr * 64 + fr, ct = u.pn & 3, col0 = ct * HALF + wc * 32 + 8 * fq;
        const float* cs = CSC + (size_t)(u.pn >> 2) * 1024 + ct * BM + wc * 32 + 8 * fq;
        const f32x4 cg0 = *(const f32x4*)(cs), cg1 = *(const f32x4*)(cs + 4), cu0 = *(const f32x4*)(cs + HALF), cu1 = *(const f32x4*)(cs + HALF + 4);
#pragma unroll
        for (int ai = 0; ai < 2; ++ai)
#pragma unroll
            for (int m = 0; m < 4; ++m) { const int row = row0 + ai * HALF + m * 16; const float rs = RSC[row];
                const f32x4 g0 = __builtin_convertvector(acc[ai][0][m][0], f32x4) * cg0 * rs, g1 = __builtin_convertvector(acc[ai][0][m][1], f32x4) * cg1 * rs;
                const f32x4 u0 = __builtin_convertvector(acc[ai][1][m][0], f32x4) * cu0 * rs, u1 = __builtin_convertvector(acc[ai][1][m][1], f32x4) * cu1 * rs;
                u32x4 w;
                w.x = cvt_pk_bf16(silu1(g0[0]) * u0[0], silu1(g0[1]) * u0[1]); w.y = cvt_pk_bf16(silu1(g0[2]) * u0[2], silu1(g0[3]) * u0[3]);
                w.z = cvt_pk_bf16(silu1(g1[0]) * u1[0], silu1(g1[1]) * u1[1]); w.w = cvt_pk_bf16(silu1(g1[2]) * u1[2], silu1(g1[3]) * u1[3]);
                *(u32x4*)(HID + (size_t)row * 512 + col0) = w;
            }
    }
};
struct EpiDown {
    static constexpr bool PERM = true, AFTER_DRAIN = false, I8 = false;
    bf16_t* Y;
    __device__ __forceinline__ void operator()(const f32x4 (&acc)[2][2][4][2], const Unit& u, int wr, int wc, int fr, int fq) const {
        const int row0 = u.pm * BM + wr * 64 + fr, col0 = (u.pn & 3) * BM + wc * 32 + 8 * fq;
#pragma unroll
        for (int ai = 0; ai < 2; ++ai)
#pragma unroll
            for (int m = 0; m < 4; ++m) { bf16_t* rowp = Y + (size_t)(row0 + ai * HALF + m * 16) * 1024 + col0;
#pragma unroll
                for (int bj = 0; bj < 2; ++bj) { const f32x4 v0 = acc[ai][bj][m][0], v1 = acc[ai][bj][m][1];
                    u32x4 w; w.x = cvt_pk_bf16(v0[0], v0[1]); w.y = cvt_pk_bf16(v0[2], v0[3]); w.z = cvt_pk_bf16(v1[0], v1[1]); w.w = cvt_pk_bf16(v1[2], v1[3]);
                    *(u32x4*)(rowp + bj * HALF) = w; } }
    }
};
struct EpiInO {
    static constexpr bool PERM = true, AFTER_DRAIN = false, I8 = false;
    bf16_t* BG; bf16_t* Y;
    __device__ __forceinline__ void operator()(const f32x4 (&acc)[2][2][4][2], const Unit& u, int wr, int wc, int fr, int fq) const {
        const int row0 = u.pm * BM + wr * 64 + fr;
        if (u.pn < 8) {
            const int col0 = u.pn * HALF + wc * 32 + 8 * fq;
#pragma unroll
            for (int ai = 0; ai < 2; ++ai)
#pragma unroll
                for (int m = 0; m < 4; ++m) { const f32x4 v0 = acc[ai][0][m][0] * acc[ai][1][m][0], v1 = acc[ai][0][m][1] * acc[ai][1][m][1];
                    u32x4 w; w.x = cvt_pk_bf16(v0[0], v0[1]); w.y = cvt_pk_bf16(v0[2], v0[3]); w.z = cvt_pk_bf16(v1[0], v1[1]); w.w = cvt_pk_bf16(v1[2], v1[3]);
                    *(u32x4*)(Y + (size_t)(row0 + ai * HALF + m * 16) * 1024 + col0) = w; }
        } else {
            const int col0 = (u.pn - 8) * BM + wc * 32 + 8 * fq;
#pragma unroll
            for (int ai = 0; ai < 2; ++ai)
#pragma unroll
                for (int m = 0; m < 4; ++m) { bf16_t* rowp = BG + (size_t)(row0 + ai * HALF + m * 16) * 1024 + col0;
#pragma unroll
                    for (int bj = 0; bj < 2; ++bj) { const f32x4 v0 = acc[ai][bj][m][0], v1 = acc[ai][bj][m][1];
                        u32x4 w; w.x = cvt_pk_bf16(v0[0], v0[1]); w.y = cvt_pk_bf16(v0[2], v0[3]); w.z = cvt_pk_bf16(v1[0], v1[1]); w.w = cvt_pk_bf16(v1[2], v1[3]);
                        *(u32x4*)(rowp + bj * HALF) = w; } }
        }
    }
};
struct InEOrder {
    StaticOrder so; int G, c;
    __device__ __forceinline__ bool next(int i, Unit& u) const {
        const long L = (long)i * G + c;
        if (L < 896) return so.next(i, u);
        if (L < 900) { u.pm = 128 + (int)(L - 896); u.pn = 2; return true; }
        return false;
    }
    __device__ __forceinline__ void a_ready(const Unit&) const {}
    __device__ __forceinline__ void done(const Unit&) const {}
};
struct MoeOrder {
    const PG8_LAS int* tile_e; int nunits, G, c;
    __device__ __forceinline__ bool next(int i, Unit& u) const {
        const long L = (long)i * G + c; if (L >= nunits) return false;
        const int t = (int)(L >> 2); u.pm = t; u.pn = tile_e[t] * 4 + (int)(L & 3); return true;
    }
    __device__ __forceinline__ void a_ready(const Unit&) const {}
    __device__ __forceinline__ void done(const Unit&) const {}
};
template <class Epi, class Sched, bool ALIGN_EPI = false, bool SP2 = false>
__device__ __forceinline__ void gemm_phase(PG8_LAS unsigned char* lds, const Gemm g, const Sched& S, const Epi& E, const int tid_in) {
    int tid_ = tid_in; asm volatile("" : "+v"(tid_));
    const int tid = tid_, wid = __builtin_amdgcn_readfirstlane(tid >> 6), lane = tid & 63, wr = wid >> 2, wc = wid & 3, fr = lane & 15, fq = lane >> 4;
    const int K = g.K, nt = K / BK;
    unsigned voffA[2], voffB[2];
#pragma unroll
    for (int i = 0; i < 2; ++i) { int R, C; stage_rc(tid * 16 + i * 8192, R, C); const int Rb = Epi::PERM ? ((R & ~31) + perm32(R & 31)) : R;
        voffA[i] = (unsigned)(R * K + C) * 2u; voffB[i] = (unsigned)(Rb * K + C) * 2u; }
    const size_t kstep = (size_t)(BK * 2);
    const size_t hstep = (size_t)HALF * K * 2;
    const size_t tstep = 2 * hstep;
    const unsigned ldsw = (unsigned)wid * 1024u;
    const int aoff = lds_byte(wr * 64 + fr, fq * 8), boff = lds_byte(wc * 32 + fr, fq * 8);
#define PG8_SA(b, h) (((b) * 2 + (h)) * HTB)
#define PG8_SB(b, h) ((4 + (b) * 2 + (h)) * HTB)
#define PG8_STAGE(bufoff, gbase, voff) do { _Pragma("unroll") for (int _i = 0; _i < 2; ++_i) \
        __builtin_amdgcn_global_load_lds((const unsigned*)((const char*)(gbase) + (voff)[_i]), (PG8_LAS unsigned*)(lds + (bufoff) + ldsw + _i * 8192), 16, 0, 0); } while (0)
#define PG8_LDA(dst, b, h) do { _Pragma("unroll") for (int m = 0; m < 4; ++m) _Pragma("unroll") for (int k = 0; k < 2; ++k) dst[m][k] = *(const PG8_LAS bf16x8*)(lds + PG8_SA(b, h) + aoff + m * 2048 + k * 1024); } while (0)
#define PG8_LDB(dst, b, h) do { _Pragma("unroll") for (int n = 0; n < 2; ++n) _Pragma("unroll") for (int k = 0; k < 2; ++k) dst[n][k] = *(const PG8_LAS bf16x8*)(lds + PG8_SB(b, h) + boff + n * 2048 + k * 1024); } while (0)
#define PG8_MMA(ai, bj, At, Bt) do { __builtin_amdgcn_s_setprio(1); _Pragma("unroll") for (int m = 0; m < 4; ++m) _Pragma("unroll") for (int n = 0; n < 2; ++n) _Pragma("unroll") for (int k = 0; k < 2; ++k) \
        acc[ai][bj][m][n] = mma16(Bt[n][k], At[m][k], acc[ai][bj][m][n]); __builtin_amdgcn_s_setprio(0); } while (0)
#define PG8_WAIT_V(n) asm volatile("s_waitcnt vmcnt(" #n ")" ::: "memory")
#define PG8_WAIT_L(n) asm volatile("s_waitcnt lgkmcnt(" #n ")" ::: "memory")
#define PG8_BAR __builtin_amdgcn_s_barrier()
#define PG8_SCHED __builtin_amdgcn_sched_barrier(0)
    Unit cur, nxt; int ui = 0;
    if (!S.next(0, cur)) return;
    typedef typename AccSel<Epi::I8>::t acc_t;
    acc_t acc[2][2][4][2];
#pragma unroll
    for (int a = 0; a < 2; ++a)
#pragma unroll
        for (int b = 0; b < 2; ++b)
#pragma unroll
            for (int m = 0; m < 4; ++m)
#pragma unroll
                for (int n = 0; n < 2; ++n) acc[a][b][m][n] = acc_t{};
    bf16x8 At[4][2], B0[2][2], B1[2][2];
    const char* cA = (const char*)g.A + (size_t)cur.pm * tstep; const char* cB = (const char*)g.Bt + (size_t)cur.pn * tstep;
    S.a_ready(cur);
    if constexpr (SP2) {
        PG8_STAGE(PG8_SB(0, 0), cB, voffB); PG8_STAGE(PG8_SB(0, 1), cB + hstep, voffB); PG8_STAGE(PG8_SA(0, 0), cA, voffA); PG8_STAGE(PG8_SA(0, 1), cA + hstep, voffA);
        if (wr == 1) PG8_BAR;
        PG8_WAIT_V(2); PG8_BAR;
        PG8_STAGE(PG8_SB(1, 0), cB + kstep, voffB); PG8_STAGE(PG8_SA(1, 0), cA + kstep, voffA); PG8_STAGE(PG8_SB(1, 1), cB + hstep + kstep, voffB);
        PG8_WAIT_V(6); PG8_BAR;
    } else {
        PG8_STAGE(PG8_SB(0, 0), cB, voffB); PG8_STAGE(PG8_SA(0, 0), cA, voffA); PG8_STAGE(PG8_SB(0, 1), cB + hstep, voffB); PG8_STAGE(PG8_SA(0, 1), cA + hstep, voffA);
        if (wr == 1) PG8_BAR;
        PG8_WAIT_V(4); PG8_BAR;
        PG8_STAGE(PG8_SB(1, 0), cB + kstep, voffB); PG8_STAGE(PG8_SA(1, 0), cA + kstep, voffA); PG8_STAGE(PG8_SB(1, 1), cB + hstep + kstep, voffB);
        PG8_WAIT_V(6); PG8_BAR;
    }
    for (;;) {
        const bool has_next = S.next(ui + 1, nxt);
        const char* nA = has_next ? (const char*)g.A + (size_t)nxt.pm * tstep : cA; const char* nB = has_next ? (const char*)g.Bt + (size_t)nxt.pn * tstep : cB;
        for (int t = 0; t < nt; t += 2) {
            const bool last = (t == nt - 2);
            const char* a1 = cA + (size_t)(t + 1) * kstep;
            const char* a2 = last ? nA : cA + (size_t)(t + 2) * kstep; const char* b2 = last ? nB : cB + (size_t)(t + 2) * kstep;
            const char* a3 = a2 + kstep; const char* b3 = b2 + kstep;
            if (last && has_next) S.a_ready(nxt);
            if constexpr (SP2) {
            PG8_LDB(B0, 0, 0); PG8_LDB(B1, 0, 1); PG8_SCHED; PG8_LDA(At, 0, 0); PG8_STAGE(PG8_SA(1, 1), a1 + hstep, voffA);
            PG8_WAIT_V(8); PG8_WAIT_L(0); PG8_BAR; PG8_MMA(0, 0, At, B0); PG8_MMA(0, 1, At, B1); PG8_BAR; PG8_SCHED;
            PG8_LDA(At, 0, 1); PG8_STAGE(PG8_SB(0, 0), b2, voffB); PG8_STAGE(PG8_SB(0, 1), b2 + hstep, voffB); PG8_STAGE(PG8_SA(0, 0), a2, voffA);
            PG8_WAIT_V(8); PG8_WAIT_L(0); PG8_BAR; PG8_MMA(1, 0, At, B0); PG8_MMA(1, 1, At, B1); PG8_BAR; PG8_SCHED;
            PG8_LDB(B0, 1, 0); PG8_LDB(B1, 1, 1); PG8_SCHED; PG8_LDA(At, 1, 0); PG8_STAGE(PG8_SA(0, 1), a2 + hstep, voffA);
            PG8_WAIT_V(8); PG8_WAIT_L(0); PG8_BAR; PG8_MMA(0, 0, At, B0); PG8_MMA(0, 1, At, B1); PG8_BAR; PG8_SCHED;
            PG8_LDA(At, 1, 1); PG8_STAGE(PG8_SB(1, 0), b3, voffB); PG8_STAGE(PG8_SB(1, 1), b3 + hstep, voffB); PG8_STAGE(PG8_SA(1, 0), a3, voffA);
            PG8_WAIT_V(8); PG8_WAIT_L(0); PG8_BAR; PG8_MMA(1, 0, At, B0); PG8_MMA(1, 1, At, B1); PG8_BAR; PG8_SCHED;
            } else {
            PG8_LDB(B0, 0, 0); PG8_SCHED; PG8_LDA(At, 0, 0); PG8_STAGE(PG8_SA(1, 1), a1 + hstep, voffA);
            PG8_WAIT_L(8); PG8_BAR; PG8_WAIT_L(0); PG8_MMA(0, 0, At, B0); PG8_BAR; PG8_SCHED;
            PG8_LDB(B1, 0, 1); PG8_STAGE(PG8_SB(0, 0), b2, voffB);
            PG8_BAR; PG8_WAIT_L(0); PG8_MMA(0, 1, At, B1); PG8_BAR;
            PG8_LDA(At, 0, 1); PG8_STAGE(PG8_SA(0, 0), a2, voffA);
            PG8_BAR; PG8_WAIT_L(0); PG8_MMA(1, 0, At, B0); PG8_BAR; PG8_SCHED;
            PG8_STAGE(PG8_SB(0, 1), b2 + hstep, voffB);
            PG8_WAIT_V(6); PG8_BAR; PG8_MMA(1, 1, At, B1); PG8_BAR;
            PG8_LDB(B0, 1, 0); PG8_SCHED; PG8_LDA(At, 1, 0); PG8_STAGE(PG8_SA(0, 1), a2 + hstep, voffA);
            PG8_WAIT_L(8); PG8_BAR; PG8_WAIT_L(0); PG8_MMA(0, 0, At, B0); PG8_BAR; PG8_SCHED;
            PG8_LDB(B1, 1, 1); PG8_STAGE(PG8_SB(1, 0), b3, voffB);
            PG8_BAR; PG8_WAIT_L(0); PG8_MMA(0, 1, At, B1); PG8_BAR;
            PG8_LDA(At, 1, 1); PG8_STAGE(PG8_SA(1, 0), a3, voffA);
            PG8_BAR; PG8_WAIT_L(0); PG8_MMA(1, 0, At, B0); PG8_BAR; PG8_SCHED;
            PG8_STAGE(PG8_SB(1, 1), b3 + hstep, voffB);
            PG8_WAIT_V(6); PG8_BAR; PG8_MMA(1, 1, At, B1); PG8_BAR;
            }
        }
        if constexpr (ALIGN_EPI) { if (wr == 0) PG8_BAR; }
        if constexpr (!Epi::AFTER_DRAIN) { E(acc, cur, wr, wc, fr, fq); S.done(cur); }
        if (!has_next) break;
#pragma unroll
        for (int a = 0; a < 2; ++a)
#pragma unroll
            for (int b = 0; b < 2; ++b)
#pragma unroll
                for (int m = 0; m < 4; ++m)
#pragma unroll
                    for (int n = 0; n < 2; ++n) acc[a][b][m][n] = acc_t{};
        cur = nxt; cA = nA; cB = nB; ++ui;
        if constexpr (ALIGN_EPI) { if (wr == 1) PG8_BAR; }
    }
    PG8_WAIT_V(0);
    if constexpr (!ALIGN_EPI) { if (wr == 0) PG8_BAR; }
    PG8_BAR;
    if constexpr (Epi::AFTER_DRAIN) { E.fused(acc, cur, wr, wc, fr, fq, lds, wid, lane); S.done(cur); }
#undef PG8_SA
#undef PG8_SB
#undef PG8_STAGE
#undef PG8_LDA
#undef PG8_LDB
#undef PG8_MMA
#undef PG8_WAIT_V
#undef PG8_WAIT_L
#undef PG8_BAR
#undef PG8_SCHED
}
}
constexpr int NWAVES = 8;
constexpr int BATCH = 4, SEQ = 8192, D = 1024, M = BATCH * SEQ, CTXL = 256, MC = BATCH * CTXL;
constexpr int NINE = 1792, NEXP = 32, EH = 512;
constexpr float EPS = 1e-6f;
constexpr int N_PHASES = 18;
#ifndef MK_ONE_LAUNCH
#define MK_ONE_LAUNCH 1
#endif
constexpr size_t MiB = 1u << 20;
constexpr size_t WS_CTL = 0, CTL_ZERO_BYTES = 1 * MiB;
constexpr size_t WS_MOD = 1 * MiB;
constexpr size_t WS_MODC = WS_MOD + 2 * 4 * 6144 * 4;
constexpr size_t WS_MODP = 1 * MiB + 768 * 1024;
static_assert(WS_MODC + 6144 * 4 <= 1 * MiB + 256 * 1024, "MOD/MODC overlap the rope tables");
constexpr size_t WS_ROPE = 1 * MiB + 256 * 1024;
constexpr size_t WS_WSP = 1 * MiB + 512 * 1024;
constexpr size_t WS_TOKE = 2 * MiB;
constexpr size_t WS_TOKP = 2 * MiB + 256 * 1024;
constexpr size_t WS_TOKW = 2 * MiB + 512 * 1024;
constexpr size_t WS_TOKS = 2 * MiB + 768 * 1024;
constexpr size_t WS_KC = 3 * MiB;
constexpr size_t WS_VCT = 3 * MiB + 256 * 1024;
constexpr size_t WS_VT = 4 * MiB;
constexpr size_t WS_WINE = 12 * MiB, WS_WOUTE = 16 * MiB, WS_WINO = 18 * MiB, WS_WOUTO = 24 * MiB;
constexpr size_t WS_WGU = 26 * MiB;
constexpr size_t WS_WD = 154 * MiB;
constexpr size_t WS_H = 218 * MiB;
constexpr size_t WS_A = 284 * MiB;
constexpr size_t WS_B = 428 * MiB;
constexpr size_t WS_RSS = 500 * MiB;
constexpr size_t WS_CSC = 502 * MiB;
constexpr size_t WS_RSC = 502 * MiB + 512 * 1024;
constexpr size_t WS_END = 503 * MiB;
constexpr int CW_TMO = 0, CW_CODE = 1, CW_BAR = 4096, CW_GCNT = 8192;

constexpr int RING_BYTES = 131072;
constexpr int LDS_BYTES = 155648;
constexpr int MISC_OFF = LDS_BYTES - 256;
constexpr int MOE_TAB_OFF = RING_BYTES;
constexpr int RW_STRIDE = 2064;
constexpr int RT_WH = 0, RT_WL = 36 * RW_STRIDE, RT_CNT = 72 * RW_STRIDE, RT_BASE = RT_CNT + 128, RT_INFO = RT_CNT + 256;
static_assert(RT_INFO + 128 * 6 * 4 <= MISC_OFF, "LDS map");

#define GAS __attribute__((address_space(1)))
#define LAS __attribute__((address_space(3)))
typedef unsigned short bf16;
typedef unsigned v4u __attribute__((ext_vector_type(4)));
typedef unsigned v2u __attribute__((ext_vector_type(2)));
typedef float f32x4 __attribute__((ext_vector_type(4)));
typedef float f32x16 __attribute__((ext_vector_type(16)));
typedef short bf16x8 __attribute__((ext_vector_type(8)));
typedef GAS unsigned gu32;
#define RLX_AGENT __ATOMIC_RELAXED, __HIP_MEMORY_SCOPE_AGENT
#define LDS_WAIT() asm volatile("s_waitcnt lgkmcnt(0)" ::: "memory")
__device__ __forceinline__ unsigned f2bf(float f) { unsigned u = __builtin_bit_cast(unsigned, f); return (u + 0x7fffu + ((u >> 16) & 1u)) >> 16; }
__device__ __forceinline__ unsigned pk2(float lo, float hi) { return f2bf(lo) | (f2bf(hi) << 16); }
__device__ __forceinline__ float bflo(unsigned w) { return __builtin_bit_cast(float, w << 16); }
__device__ __forceinline__ float bfhi(unsigned w) { return __builtin_bit_cast(float, w & 0xffff0000u); }
__device__ __forceinline__ float wave_sum(float v) {
#pragma unroll
    for (int o = 1; o < 64; o <<= 1) v += __shfl_xor(v, o);
    return v;
}
#define XB_TMO      128
#define XB_XCNT(j)  (256  + 64 * (j))
#define XB_XSUB(j)  (1280 + 64 * (j))
#define XB_XGEN(j)  (2304 + 64 * (j))
#define XB_TOP      3328
#define XB_TOPGEN   3392
#define XCD_BAR_WORDS 3456
#define XB_SPIN_CAP (1u << 18)

__device__ __forceinline__ unsigned xb_ld(unsigned* p)              { return __hip_atomic_load(p, __ATOMIC_RELAXED, __HIP_MEMORY_SCOPE_AGENT); }
__device__ __forceinline__ unsigned xb_add(unsigned* p, unsigned v) { return __hip_atomic_fetch_add(p, v, __ATOMIC_RELAXED, __HIP_MEMORY_SCOPE_AGENT); }
__device__ __forceinline__ unsigned xb_xcc_id() { return (unsigned)__builtin_amdgcn_s_getreg((3 << 11) | 20) & 0xFu; }
#define XB_SPIN(cond, bar) do { unsigned _sp = 0; while (cond) { __builtin_amdgcn_s_sleep(1); \
    if ((++_sp & 255u) == 0u) { if (xb_ld(&(bar)[XB_TMO])) break; if (_sp > XB_SPIN_CAP) { atomicAdd(&(bar)[XB_TMO], 1u); break; } } } } while (0)

struct XcdBarrier {
    unsigned* bar; unsigned x;
    volatile LAS unsigned* st;
};

__device__ __forceinline__ XcdBarrier xcd_barrier_post(unsigned* bar, volatile LAS unsigned* st) {
    XcdBarrier b; b.bar = bar; b.x = xb_xcc_id(); b.st = st;
    if (threadIdx.x == 0) (void)xb_add(&bar[XB_XCNT(b.x)], 1u);
    return b;
}
__device__ __forceinline__ void xcd_barrier_complete(unsigned* bar, unsigned x, unsigned& nloc, unsigned& nx) {
    const unsigned G = gridDim.x * gridDim.y * gridDim.z;
    unsigned sum, cnt, mine, sp = 0u;
    for (;;) {
        sum = 0u; cnt = 0u; mine = 0u;
#pragma unroll
        for (unsigned j = 0; j < 16; ++j) { const unsigned c = xb_ld(&bar[XB_XCNT(j)]); sum += c; cnt += (c > 0u) ? 1u : 0u; mine = (j == x) ? c : mine; }
        if (sum == G) break;
        __builtin_amdgcn_s_sleep(1);
        if ((++sp & 255u) == 0u) { if (xb_ld(&bar[XB_TMO])) break; if (sp > XB_SPIN_CAP) { atomicAdd(&bar[XB_TMO], 1u); break; } }
    }
    nloc = mine > 0u ? mine : 1u; nx = cnt > 0u ? cnt : 1u;
}

__device__ __forceinline__ void xcd_barrier(const XcdBarrier& b, const int xb_tid) {
    asm volatile("s_waitcnt vmcnt(0)" ::: "memory");
    __syncthreads();
    if (xb_tid == 0) {
        unsigned* bar = b.bar;
        __builtin_amdgcn_s_waitcnt(0);
        unsigned nloc = b.st[0], nx = b.st[1];
        if (nloc == 0u) { xcd_barrier_complete(bar, b.x, nloc, nx); b.st[0] = nloc; b.st[1] = nx; }
        const unsigned old = xb_add(&bar[XB_XSUB(b.x)], 1u);
        const unsigned gen = old / nloc;
        if (old + 1u == (gen + 1u) * nloc) {
            __builtin_amdgcn_fence(__ATOMIC_RELEASE, "agent");
            asm volatile("s_waitcnt vmcnt(0)" ::: "memory");
            const unsigned og = xb_add(&bar[XB_TOP], 1u);
            const unsigned tg = og / nx;
            if (og + 1u == (tg + 1u) * nx) xb_add(&bar[XB_TOPGEN], 1u);
            else XB_SPIN(xb_ld(&bar[XB_TOPGEN]) == tg, bar);
            __builtin_amdgcn_fence(__ATOMIC_ACQUIRE, "agent");
            xb_add(&bar[XB_XGEN(b.x)], 1u);
            asm volatile("s_waitcnt vmcnt(0)" ::: "memory");
        } else {
            XB_SPIN(xb_ld(&bar[XB_XGEN(b.x)]) == gen, bar);
            __builtin_amdgcn_fence(__ATOMIC_ACQUIRE, "agent");
            asm volatile("s_waitcnt vmcnt(0)" ::: "memory");
        }
    }
    __syncthreads();
}

struct Args { const float* in[25]; float* out; unsigned char* ws; int ph_lo, ph_hi; };
struct Ctx {
    LAS unsigned char* lds; unsigned ldsaddr;
    int tid, lane, wave, G, bid;
    float* out; unsigned char* ws; gu32* ctl;
};
__device__ __forceinline__ const float* kin(int k) {
    const __attribute__((address_space(4))) Args* ka = (const __attribute__((address_space(4))) Args*)__builtin_amdgcn_kernarg_segment_ptr();
    return (const float*)(const GAS float*)ka->in[k];
}
__device__ const float ROPE_INV[16] = {1.000000000e+00f, 5.623413324e-01f, 3.162277639e-01f, 1.778279394e-01f, 1.000000015e-01f, 5.623413250e-02f, 3.162277490e-02f, 1.778279431e-02f,
                                       9.999999776e-03f, 5.623413250e-03f, 3.162277630e-03f, 1.778279431e-03f, 1.000000047e-03f, 5.623413017e-04f, 3.162277571e-04f, 1.778279402e-04f};

__device__ __forceinline__ void transpose_item(const float* W, int K, int N, bf16* WT, int k0, int n0, int drow0, LAS float* scr, int lane) {
#pragma unroll 8
    for (int i = 0; i < 32; ++i) { const int kk = 2 * i + (lane >> 5); scr[kk * 33 + (lane & 31)] = W[(size_t)(k0 + kk) * N + n0 + (lane & 31)]; }
    LDS_WAIT(); asm volatile("" ::: "memory");
    const int c = lane & 7;
#pragma unroll
    for (int j = 0; j < 4; ++j) { const int n = (lane >> 3) + 8 * j; const LAS float* s = scr + (8 * c) * 33 + n;
        v4u o; o.x = pk2(s[0 * 33], s[1 * 33]); o.y = pk2(s[2 * 33], s[3 * 33]); o.z = pk2(s[4 * 33], s[5 * 33]); o.w = pk2(s[6 * 33], s[7 * 33]);
        *(GAS v4u*)(WT + (size_t)(drow0 + n) * K + k0 + 8 * c) = o; }
    LDS_WAIT(); asm volatile("" ::: "memory");
}
__device__ __forceinline__ void sincos_acc(float a, float& s, float& c) {
    const double x = (double)a, kf = __builtin_rint(x * 0.63661977236758134308), r = x - kf * 1.57079632679489661923, r2 = r * r;
    const double sp = r * (1.0 + r2 * (-1.0 / 6 + r2 * (1.0 / 120 + r2 * (-1.0 / 5040 + r2 * (1.0 / 362880 + r2 * (-1.0 / 39916800 + r2 * (1.0 / 6227020800.0)))))));
    const double cp = 1.0 + r2 * (-0.5 + r2 * (1.0 / 24 + r2 * (-1.0 / 720 + r2 * (1.0 / 40320 + r2 * (-1.0 / 3628800 + r2 * (1.0 / 479001600 + r2 * (-1.0 / 87178291200.0)))))));
    const int k = (int)kf & 3;
    s = (float)((k == 0) ? sp : (k == 1) ? cp : (k == 2) ? -sp : -cp);
    c = (float)((k == 0) ? cp : (k == 1) ? -sp : (k == 2) ? -cp : sp);
}
__device__ __forceinline__ void adaln_unit(const Ctx& C, int u) {
    const int l = u / 96, col = (u % 96) * 64 + C.lane;
    LAS float* sil = (LAS float*)C.lds; LAS float* red = (LAS float*)(C.lds + 5 * 1024 * 4);
    for (int idx = C.tid; idx < 5120; idx += NWAVES * 64) { const float v = (idx < 4096) ? kin(1)[idx] : kin(3)[idx - 4096]; sil[idx] = v / (1.0f + __expf(-v)); }
    __syncthreads();
    float acc[5] = {0.f, 0.f, 0.f, 0.f, 0.f};
    const int k0 = C.wave * 128; const float* wp = kin(4) + (size_t)l * 1024 * 6144 + (size_t)k0 * 6144 + col;
#pragma unroll 8
    for (int kk = 0; kk < 128; ++kk) { const float w = wp[(size_t)kk * 6144];
#pragma unroll
        for (int v = 0; v < 5; ++v) acc[v] += sil[v * 1024 + k0 + kk] * w; }
#pragma unroll
    for (int v = 0; v < 5; ++v) red[(C.wave * 5 + v) * 64 + C.lane] = acc[v];
    __syncthreads();
    if (C.wave == 0) {
        float* MOD = (float*)(C.ws + WS_MOD); float* MODC = (float*)(C.ws + WS_MODC); float* MODP = (float*)(C.ws + WS_MODP); const float bias = kin(5)[l * 6144 + col];
#pragma unroll
        for (int v = 0; v < 5; ++v) { float s = 0.f;
#pragma unroll
            for (int w = 0; w < NWAVES; ++w) s += red[(w * 5 + v) * 64 + C.lane];
            s += bias;
            if (v < 4) { MOD[(size_t)(l * 4 + v) * 6144 + col] = s;
                const int ch = col >> 10;
                if (ch == 1 || ch == 4) { const int w2 = (ch == 4) ? 1 : 0; MODP[(size_t)((l * 4 + v) * 2 + w2) * 1024 + (col & 1023)] = ((w2 ? kin(7) : kin(6))[l * 1024 + (col & 1023)]) * (1.0f + s); }
            } else if (l == 0) MODC[col] = s; }
    }
    __syncthreads();
}
__device__ __forceinline__ void quant_strip(const Ctx& C, int st) {
    const int me = st >> 5, which = (st >> 4) & 1, sc = st & 15, n0 = 32 * sc;
    const float* W = (which ? kin(23) : kin(22)) + (size_t)me * 1024 * 512;
    LAS float* tile = (LAS float*)C.lds; LAS unsigned* cmax = (LAS unsigned*)(C.lds + 1024 * 33 * 4);
    if (C.tid < 32) cmax[C.tid] = 0u;
    __syncthreads();
    { const int c4 = C.tid & 7, kr = C.tid >> 3; f32x4 v[16]; f32x4 mx = (f32x4){0.f, 0.f, 0.f, 0.f};
#pragma unroll
        for (int i = 0; i < 16; ++i) v[i] = *(const f32x4*)(W + (size_t)(kr + 64 * i) * 512 + n0 + 4 * c4);
#pragma unroll
        for (int i = 0; i < 16; ++i) { LAS float* t = tile + (kr + 64 * i) * 33 + 4 * c4; t[0] = v[i].x; t[1] = v[i].y; t[2] = v[i].z; t[3] = v[i].w;
            mx = __builtin_elementwise_max(mx, __builtin_elementwise_abs(v[i])); }
        LAS float* part = (LAS float*)(C.lds + 1024 * 33 * 4 + 256);
#pragma unroll
        for (int j = 0; j < 4; ++j) part[kr * 32 + 4 * c4 + j] = mx[j]; }
    __syncthreads();
    if (C.tid < 32) { const LAS float* part = (const LAS float*)(C.lds + 1024 * 33 * 4 + 256); float m = 0.f;
        for (int g = 0; g < 64; ++g) m = fmaxf(m, part[g * 32 + C.tid]);
        cmax[C.tid] = __builtin_bit_cast(unsigned, m); }
    __syncthreads();
    const int j0 = 32 * sc, drow0 = 256 * (j0 >> 7) + (j0 & 127) + 128 * which;
    unsigned char* W8 = (unsigned char*)(C.ws + WS_WGU) + (size_t)me * 1024 * 1024; float* CSC = (float*)(C.ws + WS_CSC) + (size_t)me * 1024;
#pragma unroll
    for (int r = 0; r < 4; ++r) { const int n = 4 * C.wave + r; const float am = __builtin_bit_cast(float, cmax[n]), inv = am > 0.f ? 127.0f / am : 0.f;
        unsigned w[4];
#pragma unroll
        for (int g = 0; g < 4; ++g) { unsigned acc = 0u;
#pragma unroll
            for (int e = 0; e < 4; ++e) { const int q = (int)__builtin_rintf(tile[(16 * C.lane + 4 * g + e) * 33 + n] * inv); acc |= ((unsigned)q & 0xffu) << (8 * e); }
            w[g] = acc; }
        *(v4u*)(W8 + (size_t)(drow0 + n) * 1024 + 16 * C.lane) = (v4u){w[0], w[1], w[2], w[3]};
        if (C.lane == 0) CSC[drow0 + n] = am > 0.f ? am * (1.0f / 127.0f) : 1.0f; }
    __syncthreads();
}
__device__ __forceinline__ void p0_prologue(const Ctx& C) {
    for (int u = C.bid; u < 192; u += C.G) adaln_unit(C, u);
    for (int st = C.bid; st < 2048; st += C.G) quant_strip(C, st);
    LAS float* scr = (LAS float*)(C.lds + C.wave * 16384);
    const int gw = C.bid * NWAVES + C.wave, NGW = C.G * NWAVES;
    constexpr int NDENSE = 896 + 512 + 1536 + 512, NITEMS = NDENSE + 64 * 256;
    for (int it = gw; it < NITEMS; it += NGW) {
        int r = it;
        if (r < 896) { transpose_item(kin(9), 1024, 1792, (bf16*)(C.ws + WS_WINE), 64 * (r / 56), 32 * (r % 56), 32 * (r % 56), scr, C.lane); continue; } r -= 896;
        if (r < 512) { transpose_item(kin(14), 1024, 1024, (bf16*)(C.ws + WS_WOUTE), 64 * (r / 32), 32 * (r % 32), 32 * (r % 32), scr, C.lane); continue; } r -= 512;
        if (r < 1536) { const int n0 = 32 * (r % 96), j = n0 & 1023;
            const int drow = (n0 < 1024) ? 2048 + n0 : 256 * (j >> 7) + (j & 127) + ((n0 >= 2048) ? 128 : 0);
            transpose_item(kin(15), 1024, 3072, (bf16*)(C.ws + WS_WINO), 64 * (r / 96), n0, drow, scr, C.lane); continue; } r -= 1536;
        if (r < 512) { transpose_item(kin(17), 1024, 1024, (bf16*)(C.ws + WS_WOUTO), 64 * (r / 32), 32 * (r % 32), 32 * (r % 32), scr, C.lane); continue; } r -= 512;
        const int me = r >> 8, s = r & 255;
        transpose_item(kin(24) + (size_t)me * 512 * 1024, 512, 1024, (bf16*)(C.ws + WS_WD) + (size_t)me * 1024 * 512, 64 * (s >> 5), 32 * (s & 31), 32 * (s & 31), scr, C.lane);
    }
    for (int it = gw; it < 256; it += NGW) {
        const f32x4* src = (const f32x4*)(kin(12) + (size_t)it * 512) + 2 * C.lane; const f32x4 a = src[0], b = src[1];
        v4u o; o.x = pk2(a.x, a.y); o.y = pk2(a.z, a.w); o.z = pk2(b.x, b.y); o.w = pk2(b.z, b.w);
        *(v4u*)((bf16*)(C.ws + WS_WSP) + (size_t)it * 512 + 8 * C.lane) = o;
    }
    { const int gt = gw * 64 + C.lane;
        if (gt < 2048) { float s, c; sincos_acc((float)(gt >> 4) * ROPE_INV[gt & 15], s, c); ((float*)(C.ws + WS_ROPE))[gt] = c; ((float*)(C.ws + WS_ROPE))[2048 + gt] = s; } }
}

__device__ __forceinline__ void unpack8(const v4u w, float (&f)[8]) { f[0] = bflo(w.x); f[1] = bfhi(w.x); f[2] = bflo(w.y); f[3] = bfhi(w.y); f[4] = bflo(w.z); f[5] = bfhi(w.z); f[6] = bflo(w.w); f[7] = bfhi(w.w); }
__device__ __forceinline__ void load_mod(const float* gam, const float* shp, const float* scp, int lane, f32x4 (&sc)[4], f32x4 (&sh)[4]) {
#pragma unroll
    for (int j = 0; j < 4; ++j) { const int idx = lane + 64 * j; const f32x4 g = ((const f32x4*)gam)[idx], s = ((const f32x4*)scp)[idx]; sc[j] = g * (1.0f + s); sh[j] = ((const f32x4*)shp)[idx]; }
}
__device__ __forceinline__ float row_rinv(const f32x4 (&v)[4]) {
    float ss = 0.f;
#pragma unroll
    for (int j = 0; j < 4; ++j) ss += (v[j].x * v[j].x + v[j].y * v[j].y) + (v[j].z * v[j].z + v[j].w * v[j].w);
    return rsqrtf(wave_sum(ss) * (1.0f / 1024.0f) + EPS);
}
__device__ __forceinline__ void mod_store(const f32x4 (&v)[4], float rinv, const f32x4 (&sc)[4], const f32x4 (&sh)[4], bf16* orow, int lane) {
#pragma unroll
    for (int j = 0; j < 4; ++j) { const f32x4 o = v[j] * rinv * sc[j] + sh[j]; v2u w; w.x = pk2(o.x, o.y); w.y = pk2(o.z, o.w); ((v2u*)orow)[lane + 64 * j] = w; }
}
__device__ __forceinline__ void phase_norm1_l0(const Ctx& C) {
    const int gw = C.bid * NWAVES + C.wave, NGW = C.G * NWAVES;
    const float* MOD = (const float*)(C.ws + WS_MOD); const float* MODC = (const float*)(C.ws + WS_MODC); bf16* H = (bf16*)(C.ws + WS_H);
    for (int grp = gw; grp < (M + MC) / 16; grp += NGW) {
        f32x4 sc[4], sh[4]; const float* src;
        if (grp < M / 16) { const float* mod = MOD + (size_t)(grp >> 9) * 6144; load_mod(kin(6), mod, mod + 1024, C.lane, sc, sh); src = kin(0) + (size_t)grp * 16 * D; }
        else { load_mod(kin(6), MODC, MODC + 1024, C.lane, sc, sh); src = kin(2) + (size_t)(grp - M / 16) * 16 * D; }
        bf16* dst = H + (size_t)grp * 16 * D;
        f32x4 va[4][4], vb[4][4];
#define N1_LOAD(buf, r0) do { _Pragma("unroll") for (int r = 0; r < 4; ++r) _Pragma("unroll") for (int j = 0; j < 4; ++j) buf[r][j] = ((const f32x4*)(src + (size_t)((r0) + r) * D))[C.lane + 64 * j]; } while (0)
#define N1_PROC(buf, r0) do { _Pragma("unroll") for (int r = 0; r < 4; ++r) mod_store(buf[r], row_rinv(buf[r]), sc, sh, dst + (size_t)((r0) + r) * D, C.lane); } while (0)
        N1_LOAD(va, 0);
#pragma unroll 1
        for (int it = 0; it < 2; ++it) { const int r0 = 8 * it;
            N1_LOAD(vb, r0 + 4); N1_PROC(va, r0);
            if (it < 1) N1_LOAD(va, r0 + 8);
            N1_PROC(vb, r0 + 4); }
#undef N1_LOAD
#undef N1_PROC
    }
}
__device__ __forceinline__ void phase_router(const Ctx& C, int l) {
    LAS unsigned char* WH = C.lds + RT_WH; LAS unsigned char* WL = C.lds + RT_WL;
    LAS int* cnt = (LAS int*)(C.lds + RT_CNT); LAS int* base = (LAS int*)(C.lds + RT_BASE); LAS int* info = (LAS int*)(C.lds + RT_INFO);
    const float* wrg = kin(18) + l * 4096; const float* wre = kin(20) + l * 32768; const float* brg = kin(19) + l * 4; const float* bre = kin(21) + l * 32;
    for (int idx = C.tid; idx < 9216; idx += NWAVES * 64) { const int k = idx / 9, q9 = idx - 9 * k;
        const f32x4 v = (q9 == 0) ? *(const f32x4*)(wrg + 4 * k) : *(const f32x4*)(wre + 32 * k + 4 * (q9 - 1));
        const int row0 = (q9 == 0) ? 32 : 16 * ((q9 - 1) & 1) + 4 * ((q9 - 1) >> 1);
#pragma unroll
        for (int i = 0; i < 4; ++i) { const unsigned hi = f2bf(v[i]), lo = f2bf(v[i] - bflo(hi));
            *(LAS bf16*)(WH + (row0 + i) * RW_STRIDE + 2 * k) = (bf16)hi; *(LAS bf16*)(WL + (row0 + i) * RW_STRIDE + 2 * k) = (bf16)lo; } }
    if (C.tid < 32) cnt[C.tid] = 0;
    __syncthreads();
    const float* MOD = (const float*)(C.ws + WS_MOD); const float* MODP = (const float*)(C.ws + WS_MODP); const float* RSS = (const float*)(C.ws + WS_RSS); bf16* H = (bf16*)(C.ws + WS_H);
    gu32* gcnt = C.ctl + CW_GCNT + l * 32;
    int* TOKE = (int*)(C.ws + WS_TOKE); int* TOKP = (int*)(C.ws + WS_TOKP); float* TOKW = (float*)(C.ws + WS_TOKW);
    const int r = C.lane & 15, q = C.lane >> 4;
    for (int rb = C.bid; rb < M / 128; rb += C.G) {
        const int bq = rb >> 6; const size_t row = (size_t)rb * 128 + C.wave * 16 + r;
        float rinv; { const f32x4* rp = (const f32x4*)(RSS + row * 16); const f32x4 a = rp[0], b = rp[1], c = rp[2], d = rp[3];
            const f32x4 t = (a + b) + (c + d); rinv = rsqrtf(((t.x + t.y) + (t.z + t.w)) * (1.0f / 1024.0f) + EPS); }
        const f32x4* xr = (const f32x4*)(C.out + row * D + 8 * q);
        const f32x4* sp = (const f32x4*)(MODP + (size_t)((l * 4 + bq) * 2 + 1) * 1024 + 8 * q); const f32x4* hp = (const f32x4*)(MOD + (size_t)(l * 4 + bq) * 6144 + 3 * 1024 + 8 * q);
        bf16* hrow = H + row * D + 8 * q;
        const LAS unsigned char* a0 = WH + (C.lane & 15) * RW_STRIDE + 16 * q; const LAS unsigned char* a2 = WH + (32 + (C.lane & 3)) * RW_STRIDE + 16 * q;
        pg8::f32x4 acc[3];
#pragma unroll
        for (int t = 0; t < 3; ++t) acc[t] = (pg8::f32x4){0.f, 0.f, 0.f, 0.f};
        f32x4 xc[8], xn[8];
#pragma unroll
        for (int s = 0; s < 4; ++s) { xc[2 * s] = xr[8 * s]; xc[2 * s + 1] = xr[8 * s + 1]; }
        for (int kb = 0; kb < 8; ++kb) {
            if (kb < 7) {
#pragma unroll
                for (int s = 0; s < 4; ++s) { xn[2 * s] = xr[8 * (4 * (kb + 1) + s)]; xn[2 * s + 1] = xr[8 * (4 * (kb + 1) + s) + 1]; } }
            f32x4 sv[8], hv[8];
#pragma unroll
            for (int s = 0; s < 4; ++s) { sv[2 * s] = sp[8 * (4 * kb + s)]; sv[2 * s + 1] = sp[8 * (4 * kb + s) + 1]; hv[2 * s] = hp[8 * (4 * kb + s)]; hv[2 * s + 1] = hp[8 * (4 * kb + s) + 1]; }
#pragma unroll
            for (int s = 0; s < 4; ++s) { const int kk = 4 * kb + s;
                const f32x4 h0 = xc[2 * s] * rinv * sv[2 * s] + hv[2 * s], h1 = xc[2 * s + 1] * rinv * sv[2 * s + 1] + hv[2 * s + 1];
                v4u hi; hi.x = pg8::cvt_pk_bf16(h0.x, h0.y); hi.y = pg8::cvt_pk_bf16(h0.z, h0.w); hi.z = pg8::cvt_pk_bf16(h1.x, h1.y); hi.w = pg8::cvt_pk_bf16(h1.z, h1.w);
                v4u lo; lo.x = pg8::cvt_pk_bf16(h0.x - bflo(hi.x), h0.y - bfhi(hi.x)); lo.y = pg8::cvt_pk_bf16(h0.z - bflo(hi.y), h0.w - bfhi(hi.y));
                lo.z = pg8::cvt_pk_bf16(h1.x - bflo(hi.z), h1.y - bfhi(hi.z)); lo.w = pg8::cvt_pk_bf16(h1.z - bflo(hi.w), h1.w - bfhi(hi.w));
                *(v4u*)(hrow + 32 * kk) = hi;
                const bf16x8 bh = __builtin_bit_cast(bf16x8, hi), bl = __builtin_bit_cast(bf16x8, lo);
#pragma unroll
                for (int t = 0; t < 3; ++t) { const LAS unsigned char* ap = ((t == 2) ? a2 : a0 + 16 * t * RW_STRIDE) + 64 * kk;
                    const bf16x8 ah = *(const LAS bf16x8*)ap, al = *(const LAS bf16x8*)(ap + RT_WL);
                    acc[t] = __builtin_amdgcn_mfma_f32_16x16x32_bf16(ah, bh, acc[t], 0, 0, 0);
                    acc[t] = __builtin_amdgcn_mfma_f32_16x16x32_bf16(al, bh, acc[t], 0, 0, 0);
                    acc[t] = __builtin_amdgcn_mfma_f32_16x16x32_bf16(ah, bl, acc[t], 0, 0, 0); } }
            if (kb < 7) {
#pragma unroll
                for (int s = 0; s < 8; ++s) xc[s] = xn[s]; }
        }
        float gl[4];
#pragma unroll
        for (int gi = 0; gi < 4; ++gi) gl[gi] = acc[2][gi] + brg[gi];
        int gidx = 0; float gmax = gl[0];
#pragma unroll
        for (int gi = 1; gi < 4; ++gi) if (gl[gi] > gmax) { gmax = gl[gi]; gidx = gi; }
        if (q == gidx) {
            float den = 0.f;
#pragma unroll
            for (int gi = 0; gi < 4; ++gi) den += __expf(gl[gi] - gmax);
            const float gwt = 1.0f / den;
            float ev[8];
#pragma unroll
            for (int j = 0; j < 8; ++j) ev[j] = acc[j >> 2][j & 3] + bre[8 * q + j];
            int i0 = 0; float v0 = ev[0];
#pragma unroll
            for (int j = 1; j < 8; ++j) if (ev[j] > v0) { v0 = ev[j]; i0 = j; }
            int i1 = (i0 == 0) ? 1 : 0; float v1 = (i0 == 0) ? ev[1] : ev[0];
#pragma unroll
            for (int j = 1; j < 8; ++j) if (j != i0 && ev[j] > v1) { v1 = ev[j]; i1 = j; }
            const float t = __expf(v1 - v0), p0 = 1.0f / (1.0f + t), p1 = t * p0;
            const int rr = C.wave * 16 + r, e0 = gidx * 8 + i0, e1 = gidx * 8 + i1;
            const int pl0 = __hip_atomic_fetch_add(cnt + e0, 1, __ATOMIC_RELAXED, __HIP_MEMORY_SCOPE_WORKGROUP), pl1 = __hip_atomic_fetch_add(cnt + e1, 1, __ATOMIC_RELAXED, __HIP_MEMORY_SCOPE_WORKGROUP);
            info[rr * 6 + 0] = e0; info[rr * 6 + 1] = e1; info[rr * 6 + 2] = pl0; info[rr * 6 + 3] = pl1;
            info[rr * 6 + 4] = __builtin_bit_cast(int, gwt * p0); info[rr * 6 + 5] = __builtin_bit_cast(int, gwt * p1);
        }
        __syncthreads();
        if (C.tid < 32) base[C.tid] = (int)__hip_atomic_fetch_add(gcnt + C.tid, (unsigned)cnt[C.tid], RLX_AGENT);
        __syncthreads();
        if (C.tid < 128) { const size_t orow = (size_t)rb * 128 + C.tid; const int e0 = info[C.tid * 6], e1 = info[C.tid * 6 + 1];
            TOKE[orow] = e0 | (e1 << 8); TOKP[orow * 2] = base[e0] + info[C.tid * 6 + 2]; TOKP[orow * 2 + 1] = base[e1] + info[C.tid * 6 + 3];
            TOKW[orow * 2] = __builtin_bit_cast(float, info[C.tid * 6 + 4]); TOKW[orow * 2 + 1] = __builtin_bit_cast(float, info[C.tid * 6 + 5]); }
        __syncthreads();
        if (C.tid < 32) cnt[C.tid] = 0;
        __syncthreads();
    }
}
__device__ __forceinline__ int moe_tables(const Ctx& C, int l) {
    LAS int* tile_e = (LAS int*)(C.lds + MOE_TAB_OFF); LAS int* seg = (LAS int*)(C.lds + MOE_TAB_OFF + 1280); LAS int* lc = (LAS int*)(C.lds + MOE_TAB_OFF + 1280 + 160);
    if (C.tid < 32) lc[C.tid] = (int)__hip_atomic_load(C.ctl + CW_GCNT + l * 32 + C.tid, RLX_AGENT);
    __syncthreads();
    if (C.tid == 0) { int t = 0;
        for (int e = 0; e < 32; ++e) { seg[e] = t * 256; const int n = (lc[e] + 255) >> 8; for (int k = 0; k < n; ++k) tile_e[t + k] = e; t += n; }
        seg[32] = t * 256; }
    __syncthreads();
    return seg[32] >> 8;
}
__device__ __forceinline__ void phase_scatter(const Ctx& C, int l) {
    (void)moe_tables(C, l);
    const LAS int* seg = (const LAS int*)(C.lds + MOE_TAB_OFF + 1280);
    const int gw = C.bid * NWAVES + C.wave, NGW = C.G * NWAVES;
    const int* TOKE = (const int*)(C.ws + WS_TOKE); const int* TOKP = (const int*)(C.ws + WS_TOKP); int* TOKS = (int*)(C.ws + WS_TOKS);
    const bf16* H = (const bf16*)(C.ws + WS_H); unsigned char* XS = (unsigned char*)(C.ws + WS_A); float* RSC = (float*)(C.ws + WS_RSC);
    for (int grp = gw; grp < M / 16; grp += NGW) {
        v4u ha[4][2];
#define SC_LOAD(r0) do { _Pragma("unroll") for (int r = 0; r < 4; ++r) { ha[r][0] = ((const v4u*)(H + ((size_t)grp * 16 + (r0) + r) * D))[C.lane]; ha[r][1] = ((const v4u*)(H + ((size_t)grp * 16 + (r0) + r) * D))[C.lane + 64]; } } while (0)
#pragma unroll 1
        for (int r0 = 0; r0 < 16; r0 += 4) {
            SC_LOAD(r0);
#pragma unroll
            for (int r = 0; r < 4; ++r) { const size_t row = (size_t)grp * 16 + r0 + r; const int ee = TOKE[row];
                const int s0 = seg[ee & 255] + TOKP[row * 2], s1 = seg[ee >> 8] + TOKP[row * 2 + 1];
                float f[2][8]; unpack8(ha[r][0], f[0]); unpack8(ha[r][1], f[1]);
                float am = 0.f;
#pragma unroll
                for (int j = 0; j < 2; ++j)
#pragma unroll
                    for (int e = 0; e < 8; ++e) am = fmaxf(am, fabsf(f[j][e]));
#pragma unroll
                for (int o = 1; o < 64; o <<= 1) am = fmaxf(am, __shfl_xor(am, o));
                const float inv = am > 0.f ? 127.0f / am : 0.f;
                v2u q[2];
#pragma unroll
                for (int j = 0; j < 2; ++j) { unsigned w0 = 0u, w1 = 0u;
#pragma unroll
                    for (int e = 0; e < 4; ++e) { w0 |= ((unsigned)(int)__builtin_rintf(f[j][e] * inv) & 0xffu) << (8 * e); w1 |= ((unsigned)(int)__builtin_rintf(f[j][4 + e] * inv) & 0xffu) << (8 * e); }
                    q[j] = (v2u){w0, w1}; }
                ((v2u*)(XS + (size_t)s0 * 1024))[C.lane] = q[0]; ((v2u*)(XS + (size_t)s0 * 1024))[C.lane + 64] = q[1];
                ((v2u*)(XS + (size_t)s1 * 1024))[C.lane] = q[0]; ((v2u*)(XS + (size_t)s1 * 1024))[C.lane + 64] = q[1];
                if (C.lane == 0) { const float sc = am > 0.f ? am * (1.0f / 127.0f) : 1.0f; TOKS[row * 2] = s0; TOKS[row * 2 + 1] = s1; RSC[s0] = sc; RSC[s1] = sc; } }
        }
#undef SC_LOAD
    }
}
template <bool FINAL> __device__ __forceinline__ void phase_combine(const Ctx& C, int lp) {
    const int gw = C.bid * NWAVES + C.wave, NGW = C.G * NWAVES;
    const float* MOD = (const float*)(C.ws + WS_MOD); bf16* H = (bf16*)(C.ws + WS_H); const bf16* YB = (const bf16*)(C.ws + WS_A);
    const int* TOKS = (const int*)(C.ws + WS_TOKS); const float* TOKW = (const float*)(C.ws + WS_TOKW);
    for (int grp = gw; grp < M / 16; grp += NGW) {
        const int b = grp >> 9; f32x4 g2[4], sc[4], sh[4];
#pragma unroll
        for (int j = 0; j < 4; ++j) g2[j] = ((const f32x4*)(MOD + (size_t)(lp * 4 + b) * 6144 + 5 * 1024))[C.lane + 64 * j];
        if (FINAL) {
#pragma unroll
            for (int j = 0; j < 4; ++j) { sc[j] = ((const f32x4*)kin(8))[C.lane + 64 * j]; sh[j] = (f32x4){0.f, 0.f, 0.f, 0.f}; }
        } else { const float* mod = MOD + (size_t)(4 + b) * 6144; load_mod(kin(6) + 1024, mod, mod + 1024, C.lane, sc, sh); }
        f32x4 xv[2][4]; v2u ya[2][4], yc[2][4]; float w0[2], w1[2];
#define CB_LOAD(buf, r0) do { const size_t row_ = (size_t)grp * 16 + (r0); \
            const int s0_ = TOKS[row_ * 2], s1_ = TOKS[row_ * 2 + 1]; w0[buf] = TOKW[row_ * 2]; w1[buf] = TOKW[row_ * 2 + 1]; \
            _Pragma("unroll") for (int j = 0; j < 4; ++j) { xv[buf][j] = ((const f32x4*)(C.out + row_ * D))[C.lane + 64 * j]; \
                ya[buf][j] = ((const v2u*)(YB + (size_t)s0_ * D))[C.lane + 64 * j]; yc[buf][j] = ((const v2u*)(YB + (size_t)s1_ * D))[C.lane + 64 * j]; } } while (0)
#define CB_PROC(buf, r0) do { const size_t row = (size_t)grp * 16 + (r0); f32x4 v[4]; \
            _Pragma("unroll") for (int j = 0; j < 4; ++j) { const v2u a = ya[buf][j], c = yc[buf][j]; \
                const f32x4 y0 = (f32x4){bflo(a.x), bfhi(a.x), bflo(a.y), bfhi(a.y)}, y1 = (f32x4){bflo(c.x), bfhi(c.x), bflo(c.y), bfhi(c.y)}; \
                v[j] = xv[buf][j] + g2[j] * (y0 * w0[buf] + y1 * w1[buf]); } \
            const float rinv = row_rinv(v); \
            if (FINAL) { _Pragma("unroll") for (int j = 0; j < 4; ++j) ((f32x4*)(C.out + row * D))[C.lane + 64 * j] = v[j] * rinv * sc[j]; } \
            else { _Pragma("unroll") for (int j = 0; j < 4; ++j) ((f32x4*)(C.out + row * D))[C.lane + 64 * j] = v[j]; mod_store(v, rinv, sc, sh, H + row * D, C.lane); } } while (0)
        CB_LOAD(0, 0);
#pragma unroll 1
        for (int it = 0; it < 8; ++it) { const int r0 = 2 * it;
            CB_LOAD(1, r0 + 1); CB_PROC(0, r0);
            if (it < 7) CB_LOAD(0, r0 + 2);
            CB_PROC(1, r0 + 1); }
#undef CB_PROC
#undef CB_LOAD
    }
}
__device__ __forceinline__ void phase_conv(const Ctx& C) {
    const int gw = C.bid * NWAVES + C.wave, NGW = C.G * NWAVES;
    const bf16* BG = (const bf16*)(C.ws + WS_A); const bf16* Y = BG + (size_t)M * D; bf16* MIX = (bf16*)(C.ws + WS_B);
    float cw[3][2][8];
#pragma unroll
    for (int t = 0; t < 3; ++t)
#pragma unroll
        for (int j = 0; j < 2; ++j) { const f32x4 a = *(const f32x4*)(kin(16) + t * 1024 + j * 512 + 8 * C.lane), b = *(const f32x4*)(kin(16) + t * 1024 + j * 512 + 8 * C.lane + 4);
            cw[t][j][0] = a.x; cw[t][j][1] = a.y; cw[t][j][2] = a.z; cw[t][j][3] = a.w; cw[t][j][4] = b.x; cw[t][j][5] = b.y; cw[t][j][6] = b.z; cw[t][j][7] = b.w; }
    const v4u zero4 = (v4u){0u, 0u, 0u, 0u};
    for (int grp = gw; grp < M / 16; grp += NGW) {
        const size_t t0 = (size_t)grp * 16; v4u prev[2], cur[2];
        v4u yn[2][4][2], bgv[2][4][2];
#define CV_LOAD(buf, r0) do { _Pragma("unroll") for (int rr = 0; rr < 4; ++rr) { const size_t row_ = t0 + (r0) + rr; const bool last_ = (row_ & 8191) == 8191; \
            _Pragma("unroll") for (int j = 0; j < 2; ++j) { yn[buf][rr][j] = last_ ? zero4 : ((const v4u*)(Y + (row_ + 1) * D))[C.lane + 64 * j]; bgv[buf][rr][j] = ((const v4u*)(BG + row_ * D))[C.lane + 64 * j]; } } } while (0)
#pragma unroll
        for (int j = 0; j < 2; ++j) { prev[j] = ((t0 & 8191) == 0) ? zero4 : ((const v4u*)(Y + (t0 - 1) * D))[C.lane + 64 * j]; cur[j] = ((const v4u*)(Y + t0 * D))[C.lane + 64 * j]; }
#define CV_PROC(buf, r0) do { _Pragma("unroll") for (int rr = 0; rr < 4; ++rr) { const size_t row = t0 + (r0) + rr; \
            _Pragma("unroll") for (int j = 0; j < 2; ++j) { const v4u nx = yn[buf][rr][j]; \
                float fp[8], fc[8], fn[8], fb[8], o[8]; unpack8(prev[j], fp); unpack8(cur[j], fc); unpack8(nx, fn); unpack8(bgv[buf][rr][j], fb); \
                _Pragma("unroll") for (int e = 0; e < 8; ++e) o[e] = fb[e] * (fp[e] * cw[0][j][e] + fc[e] * cw[1][j][e] + fn[e] * cw[2][j][e]); \
                v4u w; w.x = pk2(o[0], o[1]); w.y = pk2(o[2], o[3]); w.z = pk2(o[4], o[5]); w.w = pk2(o[6], o[7]); \
                ((v4u*)(MIX + row * D))[C.lane + 64 * j] = w; prev[j] = cur[j]; cur[j] = nx; } } } while (0)
        CV_LOAD(0, 0);
#pragma unroll 1
        for (int it = 0; it < 2; ++it) { const int r0 = 8 * it;
            CV_LOAD(1, r0 + 4); CV_PROC(0, r0);
            if (it < 1) CV_LOAD(0, r0 + 8);
            CV_PROC(1, r0 + 4); }
#undef CV_PROC
#undef CV_LOAD
    }
}
constexpr float LOG2E = 1.4426950408889634f;
constexpr float QSCALE = 0.125f * LOG2E;
constexpr int AT_K = 0, AT_V = 16384, AT_WS = 32768, AT_ST = 34816;
__device__ __forceinline__ int crow(int r, int hi) { return (r & 3) + 8 * (r >> 2) + 4 * hi; }
__device__ __forceinline__ bf16x8 pack8(float a0, float a1, float a2, float a3, float a4, float a5, float a6, float a7) {
    v4u w; w.x = pg8::cvt_pk_bf16(a0, a1); w.y = pg8::cvt_pk_bf16(a2, a3); w.z = pg8::cvt_pk_bf16(a4, a5); w.w = pg8::cvt_pk_bf16(a6, a7); return __builtin_bit_cast(bf16x8, w);
}
__device__ __forceinline__ void attn_unit(const Ctx& C, int au) {
    const int qblk = au & 127, kvh = (au >> 7) & 1, b = au >> 8;
    const int ph = C.wave & 1, head = kvh * 4 + (C.wave >> 1), q32 = C.lane & 31, hi = C.lane >> 5;
    const bf16* QK = (const bf16*)(C.ws + WS_A); const bf16* VT = (const bf16*)(C.ws + WS_VT); const bf16* KC = (const bf16*)(C.ws + WS_KC); const bf16* VCT = (const bf16*)(C.ws + WS_VCT);
    bf16* MIX = (bf16*)(C.ws + WS_B);
    const size_t qrow = (size_t)b * SEQ + 64 * qblk + 32 * ph + q32;
    bf16x8 qf[4];
#pragma unroll
    for (int ds = 0; ds < 4; ++ds) qf[ds] = *(const bf16x8*)(QK + qrow * NINE + head * 64 + 16 * ds + 8 * hi);
    float m = kin(10)[head] * LOG2E, l = (hi == 0) ? 1.0f : 0.0f;
    f32x16 o0, o1;
#pragma unroll
    for (int r = 0; r < 16; ++r) { o0[r] = 0.f; o1[r] = 0.f; }
    const int jlo = (qblk < 2) ? 2 - qblk : 0, jhi = (qblk > 125) ? 129 - qblk : 4, NT = 4 + jhi - jlo + 1;
    const int prow = C.tid >> 3, pch = C.tid & 7;
    LAS float* wsf = (LAS float*)(C.lds + AT_WS) + C.wave * 64;
    v4u kr0, vr0, kr1, vr1;
#define AT_LOAD(t, kreg, vreg) do { if ((t) < 4) { kreg = *(const v4u*)(KC + ((size_t)(b * 256 + 64 * (t) + prow) * 128 + kvh * 64 + 8 * pch)); \
            vreg = *(const v4u*)(VCT + ((size_t)((b * 2 + kvh) * 64 + prow) * 256 + 64 * (t) + 8 * pch)); } \
        else { const int kblk_ = qblk - 2 + jlo + (t) - 4; kreg = *(const v4u*)(QK + ((size_t)(b * SEQ + 64 * kblk_ + prow) * NINE + 512 + kvh * 64 + 8 * pch)); \
            vreg = *(const v4u*)(VT + ((size_t)((b * 2 + kvh) * 64 + prow) * SEQ + 64 * kblk_ + 8 * pch)); } } while (0)
#define AT_WRITE(bufi, kreg, vreg) do { *(LAS v4u*)(C.lds + AT_K + (bufi) * 8192 + pch * 1024 + prow * 16) = kreg; *(LAS v4u*)(C.lds + AT_V + (bufi) * 8192 + pch * 1024 + prow * 16) = vreg; } while (0)
    AT_LOAD(0, kr0, vr0); AT_LOAD(1, kr1, vr1);
    AT_WRITE(0, kr0, vr0); AT_LOAD(2, kr0, vr0);
    __syncthreads();
    for (int t = 0; t < NT; ++t) {
        const int buf = t & 1;
        if (t + 1 < NT) {
            if (buf == 0) { AT_WRITE(1, kr1, vr1); if (t + 3 < NT) AT_LOAD(t + 3, kr1, vr1); }
            else { AT_WRITE(0, kr0, vr0); if (t + 3 < NT) AT_LOAD(t + 3, kr0, vr0); }
        }
        const LAS unsigned char* kb = C.lds + AT_K + buf * 8192; const LAS unsigned char* vb = C.lds + AT_V + buf * 8192;
        f32x16 p0, p1;
#pragma unroll
        for (int r = 0; r < 16; ++r) { p0[r] = 0.f; p1[r] = 0.f; }
#pragma unroll
        for (int ds = 0; ds < 4; ++ds) {
            const bf16x8 a0 = *(const LAS bf16x8*)(kb + (2 * ds + hi) * 1024 + q32 * 16), a1 = *(const LAS bf16x8*)(kb + (2 * ds + hi) * 1024 + (q32 + 32) * 16);
            p0 = __builtin_amdgcn_mfma_f32_32x32x16_bf16(a0, qf[ds], p0, 0, 0, 0); p1 = __builtin_amdgcn_mfma_f32_32x32x16_bf16(a1, qf[ds], p1, 0, 0, 0);
        }
        const int j = (t < 4) ? -1 : jlo + t - 4;
        if (j == 0 || j == 4) {
            int qq = 32 * ph + q32; asm volatile("" : "+v"(qq));
#pragma unroll
            for (int r = 0; r < 16; ++r) { const int kv = crow(r, hi);
                const bool d0 = (j == 0) ? (kv < qq) : (kv > qq), d1 = (j == 0) ? (kv + 32 < qq) : (kv + 32 > qq);
                if (d0) p0[r] = -__builtin_inff(); if (d1) p1[r] = -__builtin_inff(); }
        }
        float rm = fmaxf(p0[0], p1[0]);
#pragma unroll
        for (int r = 1; r < 16; ++r) rm = fmaxf(rm, fmaxf(p0[r], p1[r]));
        rm = fmaxf(rm, __shfl_xor(rm, 32));
        if (__any(rm > m)) {
            const float mn = fmaxf(m, rm), al = __builtin_amdgcn_exp2f(m - mn); m = mn; l *= al;
            if (hi == 0) wsf[q32] = al;
#pragma unroll
            for (int r = 0; r < 16; ++r) { const float f = wsf[crow(r, hi)]; o0[r] *= f; o1[r] *= f; }
        }
        float ls = 0.f;
#pragma unroll
        for (int r = 0; r < 16; ++r) { p0[r] = __builtin_amdgcn_exp2f(p0[r] - m); p1[r] = __builtin_amdgcn_exp2f(p1[r] - m); ls += p0[r] + p1[r]; }
        l += ls;
#pragma unroll
        for (int s = 0; s < 2; ++s) {
            const bf16x8 pa = pack8(p0[8 * s], p0[8 * s + 1], p0[8 * s + 2], p0[8 * s + 3], p0[8 * s + 4], p0[8 * s + 5], p0[8 * s + 6], p0[8 * s + 7]);
            const bf16x8 pb = pack8(p1[8 * s], p1[8 * s + 1], p1[8 * s + 2], p1[8 * s + 3], p1[8 * s + 4], p1[8 * s + 5], p1[8 * s + 6], p1[8 * s + 7]);
            const bf16x8 va0 = *(const LAS bf16x8*)(vb + (2 * s + hi) * 1024 + q32 * 16), va1 = *(const LAS bf16x8*)(vb + (2 * s + hi) * 1024 + (q32 + 32) * 16);
            const bf16x8 vb0 = *(const LAS bf16x8*)(vb + (4 + 2 * s + hi) * 1024 + q32 * 16), vb1 = *(const LAS bf16x8*)(vb + (4 + 2 * s + hi) * 1024 + (q32 + 32) * 16);
            o0 = __builtin_amdgcn_mfma_f32_32x32x16_bf16(pa, va0, o0, 0, 0, 0); o1 = __builtin_amdgcn_mfma_f32_32x32x16_bf16(pa, va1, o1, 0, 0, 0);
            o0 = __builtin_amdgcn_mfma_f32_32x32x16_bf16(pb, vb0, o0, 0, 0, 0); o1 = __builtin_amdgcn_mfma_f32_32x32x16_bf16(pb, vb1, o1, 0, 0, 0);
        }
        __syncthreads();
    }
#undef AT_LOAD
#undef AT_WRITE
    l += __shfl_xor(l, 32);
    if (hi == 0) wsf[32 + q32] = l;
    LAS bf16* stg = (LAS bf16*)(C.lds + AT_ST) + C.wave * 2048;
#pragma unroll
    for (int r = 0; r < 16; ++r) { const int orow = crow(r, hi); const float rl = 1.0f / wsf[32 + orow];
        stg[orow * 64 + q32] = (bf16)f2bf(o0[r] * rl); stg[orow * 64 + 32 + q32] = (bf16)f2bf(o1[r] * rl); }
    bf16* Ow = MIX + ((size_t)b * SEQ + 64 * qblk + 32 * ph) * D + head * 64;
#pragma unroll
    for (int i = 0; i < 4; ++i) { const int pc = i * 64 + C.lane, row = pc >> 3, ch = pc & 7; const v4u v = *(const LAS v4u*)(stg + row * 64 + ch * 8); *(v4u*)(Ow + (size_t)row * D + ch * 8) = v; }
    __syncthreads();
}
constexpr int ZS = 1040;
__device__ __forceinline__ v2u tr_read(unsigned addr) { v2u r; asm volatile("ds_read_b64_tr_b16 %0, %1\n\ts_waitcnt lgkmcnt(0)" : "=&v"(r) : "v"(addr) : "memory"); return r; }
__device__ __forceinline__ void sgu_unit(const Ctx& C, int su) {
    const size_t R0 = (size_t)su * 128;
    const bf16* QK = (const bf16*)(C.ws + WS_A); bf16* MIX = (bf16*)(C.ws + WS_B); const bf16* WSP = (const bf16*)(C.ws + WS_WSP);
    { float gs[8]; const f32x4 a = *(const f32x4*)(kin(11) + 8 * C.lane), c = *(const f32x4*)(kin(11) + 8 * C.lane + 4);
        gs[0] = a.x; gs[1] = a.y; gs[2] = a.z; gs[3] = a.w; gs[4] = c.x; gs[5] = c.y; gs[6] = c.z; gs[7] = c.w;
#pragma unroll 4
        for (int rr = 0; rr < 16; ++rr) { const int j = C.wave * 16 + rr;
            const v4u zw = *(const v4u*)(QK + (R0 + j) * NINE + 1280 + 8 * C.lane); float x[8]; unpack8(zw, x);
            float s = 0.f;
#pragma unroll
            for (int e = 0; e < 8; ++e) s += x[e];
            const float mean = wave_sum(s) * (1.0f / 512.0f); float q = 0.f;
#pragma unroll
            for (int e = 0; e < 8; ++e) { x[e] -= mean; q += x[e] * x[e]; }
            const float rstd = rsqrtf(wave_sum(q) * (1.0f / 512.0f) + EPS);
            v4u w; w.x = pk2(x[0] * rstd * gs[0], x[1] * rstd * gs[1]); w.y = pk2(x[2] * rstd * gs[2], x[3] * rstd * gs[3]);
            w.z = pk2(x[4] * rstd * gs[4], x[5] * rstd * gs[5]); w.w = pk2(x[6] * rstd * gs[6], x[7] * rstd * gs[7]);
            *(LAS v4u*)(C.lds + j * ZS + 16 * C.lane) = w; }
    }
    __syncthreads();
    const int h = C.wave, l31 = C.lane & 31, hi = C.lane >> 5, g16 = (C.lane >> 4) & 1, q4 = (C.lane & 15) >> 2, p4 = C.lane & 3;
    f32x16 acc[2][4];
#pragma unroll
    for (int cb = 0; cb < 2; ++cb)
#pragma unroll
        for (int ib = 0; ib < 4; ++ib)
#pragma unroll
            for (int r = 0; r < 16; ++r) acc[cb][ib][r] = 0.f;
#pragma unroll 2
    for (int ks = 0; ks < 8; ++ks) {
        bf16x8 bw[4];
#pragma unroll
        for (int ib = 0; ib < 4; ++ib) bw[ib] = *(const bf16x8*)(WSP + ((size_t)h * 128 + 32 * ib + l31) * 128 + 16 * ks + 8 * hi);
        bf16x8 az[2];
#pragma unroll
        for (int cb = 0; cb < 2; ++cb) {
            const unsigned a0 = C.ldsaddr + (unsigned)((16 * ks + 8 * hi + q4) * ZS + (64 * h + 32 * cb + 16 * g16 + 4 * p4) * 2);
            const v2u lo = tr_read(a0), hi2 = tr_read(a0 + 4 * ZS);
            az[cb] = __builtin_bit_cast(bf16x8, (v4u){lo.x, lo.y, hi2.x, hi2.y});
        }
#pragma unroll
        for (int cb = 0; cb < 2; ++cb)
#pragma unroll
            for (int ib = 0; ib < 4; ++ib) acc[cb][ib] = __builtin_amdgcn_mfma_f32_32x32x16_bf16(az[cb], bw[ib], acc[cb][ib], 0, 0, 0);
    }
#pragma unroll
    for (int ib = 0; ib < 4; ++ib) {
        const int i = 32 * ib + l31; const float bias = kin(13)[h * 128 + i]; const size_t row = R0 + i;
#pragma unroll
        for (int cb = 0; cb < 2; ++cb)
#pragma unroll
            for (int rg = 0; rg < 4; ++rg) { const int c = 64 * h + 32 * cb + 8 * rg + 4 * hi;
                const v2u uw = *(const v2u*)(QK + row * NINE + 768 + c);
                const float o0 = bflo(uw.x) * (acc[cb][ib][4 * rg] + bias), o1 = bfhi(uw.x) * (acc[cb][ib][4 * rg + 1] + bias), o2 = bflo(uw.y) * (acc[cb][ib][4 * rg + 2] + bias), o3 = bfhi(uw.y) * (acc[cb][ib][4 * rg + 3] + bias);
                v2u w; w.x = pk2(o0, o1); w.y = pk2(o2, o3); *(v2u*)(MIX + row * D + 512 + c) = w; }
    }
    __syncthreads();
}
__device__ __forceinline__ void phase_attn_sgu(const Ctx& C) {
    for (int au = C.bid; au < BATCH * 2 * 128; au += C.G) attn_unit(C, au);
    for (int su = C.bid; su < M / 128; su += C.G) sgu_unit(C, su);
}
__global__ void __launch_bounds__(NWAVES * 64, 2) mk_fwd(Args args) {
    extern __shared__ __attribute__((aligned(16))) unsigned char lds_raw[];
    Ctx C;
    C.lds = (LAS unsigned char*)lds_raw; C.ldsaddr = (unsigned)(uintptr_t)C.lds;
    C.tid = threadIdx.x; C.lane = C.tid & 63; C.wave = __builtin_amdgcn_readfirstlane(C.tid >> 6);
    C.G = gridDim.x; C.bid = blockIdx.x;
    C.out = args.out; C.ws = args.ws; C.ctl = (gu32*)(args.ws + WS_CTL);
    volatile LAS unsigned* MISC = (volatile LAS unsigned*)(C.lds + MISC_OFF);
    if (C.tid < 64) MISC[C.tid] = 0u;
    __syncthreads();
#define FRESH_IDS(Cx) do { int z_ = 0; asm volatile("" : "+s"(z_)); Cx.lane = (int)__builtin_amdgcn_mbcnt_hi(~0u, __builtin_amdgcn_mbcnt_lo(~0u, (unsigned)z_)); Cx.tid = Cx.wave * 64 + Cx.lane; } while (0)
    const int lo = args.ph_lo, hi = args.ph_hi;
    const bool one = (hi - lo) > 1;
    XcdBarrier bar; bar.bar = (unsigned*)(C.ctl + CW_BAR); bar.x = 0; bar.st = nullptr;
    if (one) bar = xcd_barrier_post((unsigned*)(C.ctl + CW_BAR), MISC + 8);
#ifndef PHMASK
#define PHMASK 0x3ffff
#endif
#define IN(k) (((PHMASK >> (k)) & 1) && lo <= (k) && (k) < hi)
#define SEAM(k) do { if (IN(k) && IN((k) + 1)) { Ctx Cb = C; FRESH_IDS(Cb); xcd_barrier(bar, Cb.tid); } } while (0)
#ifndef DUPMASK
#define DUPMASK 0
#endif
#define DUP(k) DUP_##k
#if (DUPMASK >> 0) & 1
#define DUP_0 _Pragma("unroll") for (int rep_ = 0; rep_ < 2; ++rep_)
#else
#define DUP_0
#endif
#if (DUPMASK >> 1) & 1
#define DUP_1 _Pragma("unroll") for (int rep_ = 0; rep_ < 2; ++rep_)
#else
#define DUP_1
#endif
#if (DUPMASK >> 2) & 1
#define DUP_2 _Pragma("unroll") for (int rep_ = 0; rep_ < 2; ++rep_)
#else
#define DUP_2
#endif
#if (DUPMASK >> 3) & 1
#define DUP_3 _Pragma("unroll") for (int rep_ = 0; rep_ < 2; ++rep_)
#else
#define DUP_3
#endif
#if (DUPMASK >> 4) & 1
#define DUP_4 _Pragma("unroll") for (int rep_ = 0; rep_ < 2; ++rep_)
#else
#define DUP_4
#endif
#if (DUPMASK >> 5) & 1
#define DUP_5 _Pragma("unroll") for (int rep_ = 0; rep_ < 2; ++rep_)
#else
#define DUP_5
#endif
#if (DUPMASK >> 6) & 1
#define DUP_6 _Pragma("unroll") for (int rep_ = 0; rep_ < 2; ++rep_)
#else
#define DUP_6
#endif
#if (DUPMASK >> 7) & 1
#define DUP_7 _Pragma("unroll") for (int rep_ = 0; rep_ < 2; ++rep_)
#else
#define DUP_7
#endif
#if (DUPMASK >> 8) & 1
#define DUP_8 _Pragma("unroll") for (int rep_ = 0; rep_ < 2; ++rep_)
#else
#define DUP_8
#endif
#if (DUPMASK >> 9) & 1
#define DUP_9 _Pragma("unroll") for (int rep_ = 0; rep_ < 2; ++rep_)
#else
#define DUP_9
#endif
#if (DUPMASK >> 10) & 1
#define DUP_10 _Pragma("unroll") for (int rep_ = 0; rep_ < 2; ++rep_)
#else
#define DUP_10
#endif
#if (DUPMASK >> 11) & 1
#define DUP_11 _Pragma("unroll") for (int rep_ = 0; rep_ < 2; ++rep_)
#else
#define DUP_11
#endif
#if (DUPMASK >> 12) & 1
#define DUP_12 _Pragma("unroll") for (int rep_ = 0; rep_ < 2; ++rep_)
#else
#define DUP_12
#endif
#if (DUPMASK >> 13) & 1
#define DUP_13 _Pragma("unroll") for (int rep_ = 0; rep_ < 2; ++rep_)
#else
#define DUP_13
#endif
#if (DUPMASK >> 14) & 1
#define DUP_14 _Pragma("unroll") for (int rep_ = 0; rep_ < 2; ++rep_)
#else
#define DUP_14
#endif
#if (DUPMASK >> 15) & 1
#define DUP_15 _Pragma("unroll") for (int rep_ = 0; rep_ < 2; ++rep_)
#else
#define DUP_15
#endif
#if (DUPMASK >> 16) & 1
#define DUP_16 _Pragma("unroll") for (int rep_ = 0; rep_ < 2; ++rep_)
#else
#define DUP_16
#endif
#if (DUPMASK >> 17) & 1
#define DUP_17 _Pragma("unroll") for (int rep_ = 0; rep_ < 2; ++rep_)
#else
#define DUP_17
#endif
    bf16* const H = (bf16*)(C.ws + WS_H); bf16* const RA = (bf16*)(C.ws + WS_A); bf16* const RB = (bf16*)(C.ws + WS_B);
    const float* const MOD = (const float*)(C.ws + WS_MOD);

    DUP(0) { if (IN(0)) { Ctx Cp = C; FRESH_IDS(Cp); p0_prologue(Cp); } SEAM(0); }
    DUP(1) { if (IN(1)) { Ctx Cp = C; FRESH_IDS(Cp); phase_norm1_l0(Cp); } SEAM(1); }
    DUP(2) { if (IN(2)) { Ctx Cp = C; FRESH_IDS(Cp);
        pg8::Gemm g{H, (const bf16*)(Cp.ws + WS_WINE), M, NINE, D}; pg8::InEOrder S; S.so.init(M, NINE, Cp.G, Cp.bid); S.G = Cp.G; S.c = Cp.bid;
        pg8::EpiInE E{RA, (bf16*)(Cp.ws + WS_VT), (bf16*)(Cp.ws + WS_KC), (bf16*)(Cp.ws + WS_VCT), (const float*)(Cp.ws + WS_ROPE), (const float*)(Cp.ws + WS_ROPE) + 2048, QSCALE};
        pg8::gemm_phase<pg8::EpiInE, pg8::InEOrder, true, true>(Cp.lds, g, S, E, Cp.tid);
    } SEAM(2); }
    DUP(3) { if (IN(3)) { Ctx Cp = C; FRESH_IDS(Cp); phase_attn_sgu(Cp); } SEAM(3); }
    DUP(4) { if (IN(4)) { Ctx Cp = C; FRESH_IDS(Cp);
        pg8::Gemm g{RB, (const bf16*)(Cp.ws + WS_WOUTE), M, D, D}; pg8::StaticOrder S; S.init(M, D, Cp.G, Cp.bid);
        pg8::EpiRes E{kin(0), Cp.out, MOD + 2 * 1024, (float*)(Cp.ws + WS_RSS)};
        pg8::gemm_phase<pg8::EpiRes, pg8::StaticOrder, true, true>(Cp.lds, g, S, E, Cp.tid);
    } SEAM(4); }
    DUP(5) { if (IN(5)) { Ctx Cp = C; FRESH_IDS(Cp); phase_router(Cp, 0); } SEAM(5); }
    DUP(6) { if (IN(6)) { Ctx Cp = C; FRESH_IDS(Cp); phase_scatter(Cp, 0); } SEAM(6); }
    DUP(7) { if (IN(7)) { Ctx Cp = C; FRESH_IDS(Cp);
        const int nt = moe_tables(Cp, 0);
        pg8::Gemm g{RA, (const bf16*)(Cp.ws + WS_WGU), nt * 256, NEXP * 1024, D / 2}; pg8::MoeOrder S{(const LAS int*)(Cp.lds + MOE_TAB_OFF), nt * 4, Cp.G, Cp.bid};
        pg8::EpiSwiGLU8 E{RB, (const float*)(Cp.ws + WS_RSC), (const float*)(Cp.ws + WS_CSC)};
        pg8::gemm_phase<pg8::EpiSwiGLU8, pg8::MoeOrder, true, true>(Cp.lds, g, S, E, Cp.tid);
    } SEAM(7); }
    DUP(8) { if (IN(8)) { Ctx Cp = C; FRESH_IDS(Cp);
        const int nt = moe_tables(Cp, 0);
        pg8::Gemm g{RB, (const bf16*)(Cp.ws + WS_WD), nt * 256, NEXP * 1024, EH}; pg8::MoeOrder S{(const LAS int*)(Cp.lds + MOE_TAB_OFF), nt * 4, Cp.G, Cp.bid};
        pg8::EpiDown E{RA};
        pg8::gemm_phase<pg8::EpiDown, pg8::MoeOrder, true, true>(Cp.lds, g, S, E, Cp.tid);
    } SEAM(8); }
    DUP(9) { if (IN(9)) { Ctx Cp = C; FRESH_IDS(Cp); phase_combine<false>(Cp, 0); } SEAM(9); }
    DUP(10) { if (IN(10)) { Ctx Cp = C; FRESH_IDS(Cp);
        pg8::Gemm g{H, (const bf16*)(Cp.ws + WS_WINO), M, 3072, D}; pg8::StaticOrder S; S.init(M, 3072, Cp.G, Cp.bid);
        pg8::EpiInO E{RA, RA + (size_t)M * D};
        pg8::gemm_phase<pg8::EpiInO, pg8::StaticOrder, true, true>(Cp.lds, g, S, E, Cp.tid);
    } SEAM(10); }
    DUP(11) { if (IN(11)) { Ctx Cp = C; FRESH_IDS(Cp); phase_conv(Cp); } SEAM(11); }
    DUP(12) { if (IN(12)) { Ctx Cp = C; FRESH_IDS(Cp);
        pg8::Gemm g{RB, (const bf16*)(Cp.ws + WS_WOUTO), M, D, D}; pg8::StaticOrder S; S.init(M, D, Cp.G, Cp.bid);
        pg8::EpiRes E{Cp.out, Cp.out, MOD + (size_t)4 * 6144 + 2 * 1024, (float*)(Cp.ws + WS_RSS)};
        pg8::gemm_phase<pg8::EpiRes, pg8::StaticOrder, true, true>(Cp.lds, g, S, E, Cp.tid);
    } SEAM(12); }
    DUP(13) { if (IN(13)) { Ctx Cp = C; FRESH_IDS(Cp); phase_router(Cp, 1); } SEAM(13); }
    DUP(14) { if (IN(14)) { Ctx Cp = C; FRESH_IDS(Cp); phase_scatter(Cp, 1); } SEAM(14); }
    DUP(15) { if (IN(15)) { Ctx Cp = C; FRESH_IDS(Cp);
        const int nt = moe_tables(Cp, 1);
        pg8::Gemm g{RA, (const bf16*)(Cp.ws + WS_WGU + (size_t)NEXP * 1024 * 1024), nt * 256, NEXP * 1024, D / 2}; pg8::MoeOrder S{(const LAS int*)(Cp.lds + MOE_TAB_OFF), nt * 4, Cp.G, Cp.bid};
        pg8::EpiSwiGLU8 E{RB, (const float*)(Cp.ws + WS_RSC), (const float*)(Cp.ws + WS_CSC) + (size_t)NEXP * 1024};
        pg8::gemm_phase<pg8::EpiSwiGLU8, pg8::MoeOrder, true, true>(Cp.lds, g, S, E, Cp.tid);
    } SEAM(15); }
    DUP(16) { if (IN(16)) { Ctx Cp = C; FRESH_IDS(Cp);
        const int nt = moe_tables(Cp, 1);
        pg8::Gemm g{RB, (const bf16*)(Cp.ws + WS_WD) + (size_t)NEXP * 1024 * 512, nt * 256, NEXP * 1024, EH}; pg8::MoeOrder S{(const LAS int*)(Cp.lds + MOE_TAB_OFF), nt * 4, Cp.G, Cp.bid};
        pg8::EpiDown E{RA};
        pg8::gemm_phase<pg8::EpiDown, pg8::MoeOrder, true, true>(Cp.lds, g, S, E, Cp.tid);
    } SEAM(16); }
    DUP(17) { if (IN(17)) { Ctx Cp = C; FRESH_IDS(Cp); phase_combine<true>(Cp, 1); } }
#undef IN
#undef SEAM
}

extern "C" void kernel_launch(void* const* d_in, const int* in_sizes, int n_in, void* d_out, int out_size, void* d_ws, size_t ws_size, hipStream_t stream) {
    static int grid = 0;
    if (grid == 0) {
        if (n_in != 25 || in_sizes[0] != M * D || out_size != M * D || ws_size < WS_END) { fprintf(stderr, "kernel_launch: unexpected shapes (n_in %d, in0 %d, out %d, ws %zu)\n", n_in, n_in > 0 ? in_sizes[0] : -1, out_size, ws_size); grid = -1; return; }
        int dev = 0, cus = 0, per_cu = 0;
        if (hipGetDevice(&dev) != hipSuccess || hipDeviceGetAttribute(&cus, hipDeviceAttributeMultiprocessorCount, dev) != hipSuccess) { grid = -1; return; }
        if (hipFuncSetAttribute((const void*)mk_fwd, hipFuncAttributeMaxDynamicSharedMemorySize, LDS_BYTES) != hipSuccess) { fprintf(stderr, "kernel_launch: hipFuncSetAttribute failed\n"); grid = -1; return; }
        if (hipOccupancyMaxActiveBlocksPerMultiprocessor(&per_cu, (const void*)mk_fwd, NWAVES * 64, LDS_BYTES) != hipSuccess || per_cu < 1) { fprintf(stderr, "kernel_launch: occupancy query says %d\n", per_cu); }
        (void)hipGetLastError();
        grid = cus;
    }
    if (grid < 0) return;
    if (hipMemsetAsync((char*)d_ws + WS_CTL, 0, CTL_ZERO_BYTES, stream) != hipSuccess) return;
    Args a{};
    for (int i = 0; i < 25; ++i) a.in[i] = (const float*)d_in[i];
    a.out = (float*)d_out; a.ws = (unsigned char*)d_ws;
#if defined(PROBE_K)
    a.ph_lo = 0; a.ph_hi = PROBE_K + 1; hipLaunchKernelGGL(mk_fwd, dim3(grid), dim3(NWAVES * 64), LDS_BYTES, stream, a);
    (void)hipMemsetAsync((char*)d_ws + WS_CTL, 0, (PROBE_K == 5 || PROBE_K == 13) ? CTL_ZERO_BYTES : (size_t)4 * CW_GCNT, stream);
    a.ph_lo = PROBE_K; a.ph_hi = PROBE_K + 1; hipLaunchKernelGGL(mk_fwd, dim3(grid), dim3(NWAVES * 64), LDS_BYTES, stream, a);
    (void)hipMemsetAsync((char*)d_ws + WS_CTL, 0, 4 * CW_GCNT, stream);
    if (PROBE_K + 1 < N_PHASES) { a.ph_lo = PROBE_K + 1; a.ph_hi = N_PHASES; hipLaunchKernelGGL(mk_fwd, dim3(grid), dim3(NWAVES * 64), LDS_BYTES, stream, a); }
#elif MK_ONE_LAUNCH
    a.ph_lo = 0; a.ph_hi = N_PHASES;
    hipLaunchKernelGGL(mk_fwd, dim3(grid), dim3(NWAVES * 64), LDS_BYTES, stream, a);
#else
    for (int p = 0; p < N_PHASES; ++p) { a.ph_lo = p; a.ph_hi = p + 1; hipLaunchKernelGGL(mk_fwd, dim3(grid), dim3(NWAVES * 64), LDS_BYTES, stream, a); }
#endif
}
```

```cpp
#include <hip/hip_runtime.h>
#include <cstdio>
#include <cstdint>
namespace pg8 {
#define PG8_LAS __attribute__((address_space(3)))
typedef unsigned short bf16_t;
typedef short bf16x8 __attribute__((ext_vector_type(8)));
typedef float f32x4 __attribute__((ext_vector_type(4)));
typedef unsigned u32x4 __attribute__((ext_vector_type(4)));
constexpr int BM = 256, BK = 64, HALF = 128, HTB = HALF * BK * 2  , STAGE_BYTES = 8 * HTB, NXCD = 8, WGM = 8;

__host__ __device__ __forceinline__ int lds_byte(int r, int c) { const int st = (r >> 4) * 2 + (c >> 5), rr = r & 15, cc = c & 31, ob = rr * 64 + cc * 2; return st * 1024 + (ob ^ (((ob >> 9) & 1) << 5)); }
__host__ __device__ __forceinline__ void stage_rc(int b, int& R, int& C) { const int st = b / 1024, sb = b % 1024, swz = sb ^ (((sb >> 9) & 1) << 5); R = (st >> 1) * 16 + swz / 64; C = (st & 1) * 32 + (swz % 64) / 2; }
__host__ __device__ __forceinline__ int perm32(int rho) { const int n = rho >> 4, i = rho & 15; return 8 * (i >> 2) + 4 * n + (i & 3); }

struct Unit { int pm, pn; };
struct Gemm { const bf16_t* A; const bf16_t* Bt; int M, N, K; };

struct StaticOrder {
    int nM, nN, nwg, G, c;
    __host__ __device__ void init(int M, int N, int G_, int c_) { nM = M / BM; nN = N / BM; nwg = nM * nN; G = G_; c = c_; }
    __host__ __device__ bool next(int i, Unit& u) const {
        const long L = (long)i * G + c; if (L >= nwg) return false;
        int wgid = (int)L; { const int q = nwg / NXCD, r = nwg % NXCD, xcd = wgid % NXCD, off = wgid / NXCD; wgid = (xcd < r ? xcd * (q + 1) : r * (q + 1) + (xcd - r) * q) + off; }
        const int nig = WGM * nN, gid = wgid / nig, fm = gid * WGM, gsz = (nM - fm) < WGM ? (nM - fm) : WGM;
        u.pm = fm + ((wgid % nig) % gsz); u.pn = (wgid % nig) / gsz; return true;
    }
    __device__ __forceinline__ void a_ready(const Unit&) const {}
    __device__ __forceinline__ void done(const Unit&) const {}
};

__device__ __forceinline__ unsigned cvt_pk_bf16(float lo, float hi) { unsigned r; asm volatile("v_cvt_pk_bf16_f32 %0, %1, %2" : "=v"(r) : "v"(lo), "v"(hi)); return r; }
typedef float f32x2 __attribute__((ext_vector_type(2)));
__device__ __forceinline__ f32x2 gelu_pk(f32x2 v) {
    const f32x2 av = __builtin_elementwise_abs(v), d = av * 0.2316418882f + 1.0f;
    f32x2 t; t.x = __builtin_amdgcn_rcpf(d.x); t.y = __builtin_amdgcn_rcpf(d.y);
    f32x2 q = t * 0.5307027145f + (-0.7265760135f); q = q * t + 0.7107068705f; q = q * t + (-0.142248368f); q = q * t + 0.127414796f; q = q * t;
    const f32x2 s = (v * v) * (-0.72134752044f);
    f32x2 e; e.x = __builtin_amdgcn_exp2f(s.x); e.y = __builtin_amdgcn_exp2f(s.y);
    const f32x2 m = v * (q * e), r = v - m;
    f32x2 o; o.x = v.x < 0.f ? m.x : r.x; o.y = v.y < 0.f ? m.y : r.y; return o;
}

typedef int i32x4 __attribute__((ext_vector_type(4)));
template <bool I8> struct AccSel { typedef f32x4 t; };
template <> struct AccSel<true> { typedef i32x4 t; };
__device__ __forceinline__ f32x4 mma16(bf16x8 a, bf16x8 b, f32x4 c) { return __builtin_amdgcn_mfma_f32_16x16x32_bf16(a, b, c, 0, 0, 0); }
__device__ __forceinline__ i32x4 mma16(bf16x8 a, bf16x8 b, i32x4 c) { return __builtin_amdgcn_mfma_i32_16x16x64_i8(__builtin_bit_cast(i32x4, a), __builtin_bit_cast(i32x4, b), c, 0, 0, 0); }
typedef unsigned u32x2 __attribute__((ext_vector_type(2)));
__device__ __forceinline__ int perm16(int x) { return (x & 3) | ((x & 4) << 1) | ((x & 8) >> 1); }
__device__ __forceinline__ bf16_t bf1(float v) { return (bf16_t)(cvt_pk_bf16(v, 0.f) & 0xffffu); }
__device__ __forceinline__ u32x2 pk4(f32x4 v) { u32x2 w; w.x = cvt_pk_bf16(v[0], v[1]); w.y = cvt_pk_bf16(v[2], v[3]); return w; }
__device__ __forceinline__ f32x4 gelu4(f32x4 v) { const f32x2 a = gelu_pk((f32x2){v[0], v[1]}), b = gelu_pk((f32x2){v[2], v[3]}); return (f32x4){a.x, a.y, b.x, b.y}; }
__device__ __forceinline__ float silu1(float g) { return g * __builtin_amdgcn_rcpf(1.0f + __builtin_amdgcn_exp2f(-1.4426950408889634f * g)); }

struct EpiInE {
    static constexpr bool PERM = false, AFTER_DRAIN = false, I8 = false;
    bf16_t* QK; bf16_t* VT; bf16_t* KC; bf16_t* VCT; const float* rc; const float* rs; float qscale;
    __device__ __forceinline__ void operator()(const f32x4 (&acc)[2][2][4][2], const Unit& u, int wr, int wc, int fr, int fq) const {
        const int row0 = u.pm * BM + wr * 64 + fr;
        if (u.pm >= 128) {
#pragma unroll
            for (int ai = 0; ai < 2; ++ai)
#pragma unroll
                for (int m = 0; m < 4; ++m) {
                    const int row = row0 + ai * HALF + m * 16 - 32768, b = row >> 8, j = row & 255, jp = (j & ~15) | perm16(j & 15);
#pragma unroll
                    for (int n = 0; n < 2; ++n) {
                        *(u32x2*)(KC + (size_t)row * 128 + wc * 32 + n * 16 + 4 * fq) = pk4(acc[ai][0][m][n]);
#pragma unroll
                        for (int i = 0; i < 4; ++i) { const int cv = wc * 32 + n * 16 + 4 * fq + i; VCT[((size_t)(b * 2 + (cv >> 6)) * 64 + (cv & 63)) * 256 + jp] = bf1(acc[ai][1][m][n][i]); }
                    }
                }
            return;
        }
        if (u.pn <= 2) {
            const float sc = (u.pn < 2) ? qscale : 1.0f;
#pragma unroll
            for (int ai = 0; ai < 2; ++ai)
#pragma unroll
                for (int m = 0; m < 4; ++m) {
                    const int row = row0 + ai * HALF + m * 16, pos = row & 8191, pidx = (wc & 1) ? (pos & 63) : (pos >> 6);
                    const f32x4 c4 = *(const f32x4*)(rc + pidx * 16 + 4 * fq) * sc, s4 = *(const f32x4*)(rs + pidx * 16 + 4 * fq) * sc;
                    bf16_t* rowp = QK + (size_t)row * 1792 + u.pn * BM + wc * 32 + 4 * fq;
#pragma unroll
                    for (int bj = 0; bj < 2; ++bj) {
                        if (u.pn == 2 && bj == 1) break;
                        const f32x4 v0 = acc[ai][bj][m][0], v1 = acc[ai][bj][m][1];
                        *(u32x2*)(rowp + bj * HALF) = pk4(v0 * c4 - v1 * s4);
                        *(u32x2*)(rowp + bj * HALF + 16) = pk4(v1 * c4 + v0 * s4);
                    }
                    if (u.pn == 2) {
                        const int b = row >> 13, pp = (pos & ~15) | perm16(pos & 15);
#pragma unroll
                        for (int n = 0; n < 2; ++n)
#pragma unroll
                            for (int i = 0; i < 4; ++i) { const int cv = wc * 32 + n * 16 + 4 * fq + i; VT[((size_t)(b * 2 + (cv >> 6)) * 64 + (cv & 63)) * 8192 + pp] = bf1(acc[ai][1][m][n][i]); }
                    }
                }
            return;
        }
#pragma unroll
        for (int ai = 0; ai < 2; ++ai)
#pragma unroll
            for (int m = 0; m < 4; ++m) {
                bf16_t* rowp = QK + (size_t)(row0 + ai * HALF + m * 16) * 1792 + u.pn * BM + wc * 32 + 4 * fq;
#pragma unroll
                for (int bj = 0; bj < 2; ++bj)
#pragma unroll
                    for (int n = 0; n < 2; ++n) *(u32x2*)(rowp + bj * HALF + n * 16) = pk4(gelu4(acc[ai][bj][m][n]));
            }
    }
};
struct EpiRes {
    static constexpr bool PERM = false, AFTER_DRAIN = false, I8 = false;
    const float* base; float* out; const float* gate; float* RSS;
    __device__ __forceinline__ void operator()(const f32x4 (&acc)[2][2][4][2], const Unit& u, int wr, int wc, int fr, int fq) const {
        const int row0 = u.pm * BM + wr * 64 + fr, col0 = u.pn * BM + wc * 32 + 4 * fq, b = u.pm >> 5;
        f32x4 gv[2][2];
#pragma unroll
        for (int bj = 0; bj < 2; ++bj)
#pragma unroll
            for (int n = 0; n < 2; ++n) gv[bj][n] = *(const f32x4*)(gate + (size_t)b * 6144 + col0 + bj * HALF + n * 16);
#pragma unroll
        for (int ai = 0; ai < 2; ++ai) {
            f32x4 bs[4][2][2];
#pragma unroll
            for (int m = 0; m < 4; ++m)
#pragma unroll
                for (int bj = 0; bj < 2; ++bj)
#pragma unroll
                    for (int n = 0; n < 2; ++n) bs[m][bj][n] = *(const f32x4*)(base + (size_t)(row0 + ai * HALF + m * 16) * 1024 + col0 + bj * HALF + n * 16);
            asm volatile("" ::: "memory");
#pragma unroll
            for (int m = 0; m < 4; ++m) { const int row = row0 + ai * HALF + m * 16; float ss = 0.f;
#pragma unroll
                for (int bj = 0; bj < 2; ++bj)
#pragma unroll
                    for (int n = 0; n < 2; ++n) { const f32x4 o = bs[m][bj][n] + gv[bj][n] * acc[ai][bj][m][n]; *(f32x4*)(out + (size_t)row * 1024 + col0 + bj * HALF + n * 16) = o;
                        ss += (o[0] * o[0] + o[1] * o[1]) + (o[2] * o[2] + o[3] * o[3]); }
                ss += __shfl_xor(ss, 16); ss += __shfl_xor(ss, 32);
                if (fq == 0) RSS[(size_t)row * 16 + u.pn * 4 + wc] = ss; }
            asm volatile("" ::: "memory");
        }
    }
};
struct EpiSwiGLU {
    static constexpr bool PERM = true, AFTER_DRAIN = false, I8 = false;
    bf16_t* HID;
    __device__ __forceinline__ void operator()(const f32x4 (&acc)[2][2][4][2], const Unit& u, int wr, int wc, int fr, int fq) const {
        const int row0 = u.pm * BM + wr * 64 + fr, col0 = (u.pn & 3) * HALF + wc * 32 + 8 * fq;
#pragma unroll
        for (int ai = 0; ai < 2; ++ai)
#pragma unroll
            for (int m = 0; m < 4; ++m) {
                const f32x4 g0 = acc[ai][0][m][0], g1 = acc[ai][0][m][1], u0 = acc[ai][1][m][0], u1 = acc[ai][1][m][1];
                u32x4 w;
                w.x = cvt_pk_bf16(silu1(g0[0]) * u0[0], silu1(g0[1]) * u0[1]); w.y = cvt_pk_bf16(silu1(g0[2]) * u0[2], silu1(g0[3]) * u0[3]);
                w.z = cvt_pk_bf16(silu1(g1[0]) * u1[0], silu1(g1[1]) * u1[1]); w.w = cvt_pk_bf16(silu1(g1[2]) * u1[2], silu1(g1[3]) * u1[3]);
                *(u32x4*)(HID + (size_t)(row0 + ai * HALF + m * 16) * 512 + col0) = w;
            }
    }
};
struct EpiSwiGLU8 {
    static constexpr bool PERM = true, AFTER_DRAIN = false, I8 = true;
    bf16_t* HID; const float* RSC; const float* CSC;
    __device__ __forceinline__ void operator()(const i32x4 (&acc)[2][2][4][2], const Unit& u, int wr, int wc, int fr, int fq) const {
        const int row0 = u.pm * BM + wr * 64 + fr, ct = u.pn & 3, col0 = ct * HALF + wc * 32 + 8 * fq;
        const float* cs = CSC + (size_t)(u.pn >> 2) * 1024 + ct * BM + wc * 32 + 8 * fq;
        const f32x4 cg0 = *(const f32x4*)(cs), cg1 = *(const f32x4*)(cs + 4), cu0 = *(const f32x4*)(cs + HALF), cu1 = *(const f32x4*)(cs + HALF + 4);
#pragma unroll
        for (int ai = 0; ai < 2; ++ai)
#pragma unroll
            for (int m = 0; m < 4; ++m) { const int row = row0 + ai * HALF + m * 16; const float rs = RSC[row];
                const f32x4 g0 = __builtin_convertvector(acc[ai][0][m][0], f32x4) * cg0 * rs, g1 = __builtin_convertvector(acc[ai][0][m][1], f32x4) * cg1 * rs;
                const f32x4 u0 = __builtin_convertvector(acc[ai][1][m][0], f32x4) * cu0 * rs, u1 = __builtin_convertvector(acc[ai][1][m][1], f32x4) * cu1 * rs;
                u32x4 w;
                w.x = cvt_pk_bf16(silu1(g0[0]) * u0[0], silu1(g0[1]) * u0[1]); w.y = cvt_pk_bf16(silu1(g0[2]) * u0[2], silu1(g0[3]) * u0[3]);
                w.z = cvt_pk_bf16(silu1(g1[0]) * u1[0], silu1(g1[1]) * u1[1]); w.w = cvt_pk_bf16(silu1(g1[2]) * u1[2], silu1(g1[3]) * u1[3]);
                *(u32x4*)(HID + (size_t)row * 512 + col0) = w;
            }
    }
};
struct EpiDown {
    static constexpr bool PERM = true, AFTER_DRAIN = false, I8 = false;
    bf16_t* Y;
    __device__ __forceinline__ void operator()(const f32x4 (&acc)[2][2][4][2], const Unit& u, int wr, int wc, int fr, int fq) const {
        const int row0 = u.pm * BM + wr * 64 + fr, col0 = (u.pn & 3) * BM + wc * 32 + 8 * fq;
#pragma unroll
        for (int ai = 0; ai < 2; ++ai)
#pragma unroll
            for (int m = 0; m < 4; ++m) { bf16_t* rowp = Y + (size_t)(row0 + ai * HALF + m * 16) * 1024 + col0;
#pragma unroll
                for (int bj = 0; bj < 2; ++bj) { const f32x4 v0 = acc[ai][bj][m][0], v1 = acc[ai][bj][m][1];
                    u32x4 w; w.x = cvt_pk_bf16(v0[0], v0[1]); w.y = cvt_pk_bf16(v0[2], v0[3]); w.z = cvt_pk_bf16(v1[0], v1[1]); w.w = cvt_pk_bf16(v1[2], v1[3]);
                    *(u32x4*)(rowp + bj * HALF) = w; } }
    }
};
struct EpiInO {
    static constexpr bool PERM = true, AFTER_DRAIN = false, I8 = false;
    bf16_t* BG; bf16_t* Y;
    __device__ __forceinline__ void operator()(const f32x4 (&acc)[2][2][4][2], const Unit& u, int wr, int wc, int fr, int fq) const {
        const int row0 = u.pm * BM + wr * 64 + fr;
        if (u.pn < 8) {
            const int col0 = u.pn * HALF + wc * 32 + 8 * fq;
#pragma unroll
            for (int ai = 0; ai < 2; ++ai)
#pragma unroll
                for (int m = 0; m < 4; ++m) { const f32x4 v0 = acc[ai][0][m][0] * acc[ai][1][m][0], v1 = acc[ai][0][m][1] * acc[ai][1][m][1];
                    u32x4 w; w.x = cvt_pk_bf16(v0[0], v0[1]); w.y = cvt_pk_bf16(v0[2], v0[3]); w.z = cvt_pk_bf16(v1[0], v1[1]); w.w = cvt_pk_bf16(v1[2], v1[3]);
                    *(u32x4*)(Y + (size_t)(row0 + ai * HALF + m * 16) * 1024 + col0) = w; }
        } else {
            const int col0 = (u.pn - 8) * BM + wc * 32 + 8 * fq;
#pragma unroll
            for (int ai = 0; ai < 2; ++ai)
#pragma unroll
                for (int m = 0; m < 4; ++m) { bf16_t* rowp = BG + (size_t)(row0 + ai * HALF + m * 16) * 1024 + col0;
#pragma unroll
                    for (int bj = 0; bj < 2; ++bj) { const f32x4 v0 = acc[ai][bj][m][0], v1 = acc[ai][bj][m][1];
                        u32x4 w; w.x = cvt_pk_bf16(v0[0], v0[1]); w.y = cvt_pk_bf16(v0[2], v0[3]); w.z = cvt_pk_bf16(v1[0], v1[1]); w.w = cvt_pk_bf16(v1[2], v1[3]);
                        *(u32x4*)(rowp + bj * HALF) = w; } }
        }
    }
};
struct EpiInO8 {
    static constexpr bool PERM = true, AFTER_DRAIN = false, I8 = true;
    bf16_t* BG; bf16_t* Y; const float* RSC; const float* CSC;
    __device__ __forceinline__ void operator()(const i32x4 (&acc)[2][2][4][2], const Unit& u, int wr, int wc, int fr, int fq) const {
        const int row0 = u.pm * BM + wr * 64 + fr;
        const float* cs = CSC + u.pn * BM + wc * 32 + 8 * fq;
        const f32x4 c00 = *(const f32x4*)(cs), c01 = *(const f32x4*)(cs + 4), c10 = *(const f32x4*)(cs + HALF), c11 = *(const f32x4*)(cs + HALF + 4);
        if (u.pn < 8) {
            const int col0 = u.pn * HALF + wc * 32 + 8 * fq;
#pragma unroll
            for (int ai = 0; ai < 2; ++ai)
#pragma unroll
                for (int m = 0; m < 4; ++m) { const int row = row0 + ai * HALF + m * 16; const float rs = RSC[row], rs2 = rs * rs;
                    const f32x4 v0 = __builtin_convertvector(acc[ai][0][m][0], f32x4) * __builtin_convertvector(acc[ai][1][m][0], f32x4) * (c00 * c10) * rs2;
                    const f32x4 v1 = __builtin_convertvector(acc[ai][0][m][1], f32x4) * __builtin_convertvector(acc[ai][1][m][1], f32x4) * (c01 * c11) * rs2;
                    u32x4 w; w.x = cvt_pk_bf16(v0[0], v0[1]); w.y = cvt_pk_bf16(v0[2], v0[3]); w.z = cvt_pk_bf16(v1[0], v1[1]); w.w = cvt_pk_bf16(v1[2], v1[3]);
                    *(u32x4*)(Y + (size_t)row * 1024 + col0) = w; }
        } else {
            const int col0 = (u.pn - 8) * BM + wc * 32 + 8 * fq;
#pragma unroll
            for (int ai = 0; ai < 2; ++ai)
#pragma unroll
                for (int m = 0; m < 4; ++m) { const int row = row0 + ai * HALF + m * 16; const float rs = RSC[row]; bf16_t* rowp = BG + (size_t)row * 1024 + col0;
#pragma unroll
                    for (int bj = 0; bj < 2; ++bj) { const f32x4 v0 = __builtin_convertvector(acc[ai][bj][m][0], f32x4) * (bj ? c10 : c00) * rs, v1 = __builtin_convertvector(acc[ai][bj][m][1], f32x4) * (bj ? c11 : c01) * rs;
                        u32x4 w; w.x = cvt_pk_bf16(v0[0], v0[1]); w.y = cvt_pk_bf16(v0[2], v0[3]); w.z = cvt_pk_bf16(v1[0], v1[1]); w.w = cvt_pk_bf16(v1[2], v1[3]);
                        *(u32x4*)(rowp + bj * HALF) = w; } }
        }
    }
};
struct EpiRes8 {
    static constexpr bool PERM = false, AFTER_DRAIN = false, I8 = true;
    const float* base; float* out; const float* gate; float* RSS; const float* RSC; const float* CSC;
    __device__ __forceinline__ void operator()(const i32x4 (&acc)[2][2][4][2], const Unit& u, int wr, int wc, int fr, int fq) const {
        const int row0 = u.pm * BM + wr * 64 + fr, col0 = u.pn * BM + wc * 32 + 4 * fq, b = u.pm >> 5;
        f32x4 gv[2][2];
#pragma unroll
        for (int bj = 0; bj < 2; ++bj)
#pragma unroll
            for (int n = 0; n < 2; ++n) gv[bj][n] = *(const f32x4*)(gate + (size_t)b * 6144 + col0 + bj * HALF + n * 16) * *(const f32x4*)(CSC + col0 + bj * HALF + n * 16);
#pragma unroll
        for (int ai = 0; ai < 2; ++ai) {
            f32x4 bs[4][2][2]; float rs[4];
#pragma unroll
            for (int m = 0; m < 4; ++m) { rs[m] = RSC[row0 + ai * HALF + m * 16];
#pragma unroll
                for (int bj = 0; bj < 2; ++bj)
#pragma unroll
                    for (int n = 0; n < 2; ++n) bs[m][bj][n] = *(const f32x4*)(base + (size_t)(row0 + ai * HALF + m * 16) * 1024 + col0 + bj * HALF + n * 16); }
            asm volatile("" ::: "memory");
#pragma unroll
            for (int m = 0; m < 4; ++m) { const int row = row0 + ai * HALF + m * 16; float ss = 0.f;
#pragma unroll
                for (int bj = 0; bj < 2; ++bj)
#pragma unroll
                    for (int n = 0; n < 2; ++n) { const f32x4 o = bs[m][bj][n] + gv[bj][n] * (__builtin_convertvector(acc[ai][bj][m][n], f32x4) * rs[m]); *(f32x4*)(out + (size_t)row * 1024 + col0 + bj * HALF + n * 16) = o;
                        ss += (o[0] * o[0] + o[1] * o[1]) + (o[2] * o[2] + o[3] * o[3]); }
                ss += __shfl_xor(ss, 16); ss += __shfl_xor(ss, 32);
                if (fq == 0) RSS[(size_t)row * 16 + u.pn * 4 + wc] = ss; }
            asm volatile("" ::: "memory");
        }
    }
};
struct InEOrder {
    StaticOrder so; int G, c;
    __device__ __forceinline__ bool next(int i, Unit& u) const {
        const long L = (long)i * G + c;
        if (L < 896) return so.next(i, u);
        if (L < 900) { u.pm = 128 + (int)(L - 896); u.pn = 2; return true; }
        return false;
    }
    __device__ __forceinline__ void a_ready(const Unit&) const {}
    __device__ __forceinline__ void done(const Unit&) const {}
};
struct MoeOrder {
    const PG8_LAS int* tile_e; int nunits, G, c;
    __device__ __forceinline__ bool next(int i, Unit& u) const {
        const long L = (long)i * G + c; if (L >= nunits) return false;
        const int t = (int)(L >> 2); u.pm = t; u.pn = tile_e[t] * 4 + (int)(L & 3); return true;
    }
    __device__ __forceinline__ void a_ready(const Unit&) const {}
    __device__ __forceinline__ void done(const Unit&) const {}
};
template <class Epi, class Sched, bool ALIGN_EPI = false, bool SP2 = false>
__device__ __forceinline__ void gemm_phase(PG8_LAS unsigned char* lds, const Gemm g, const Sched& S, const Epi& E, const int tid_in) {
    int tid_ = tid_in; asm volatile("" : "+v"(tid_));
    const int tid = tid_, wid = __builtin_amdgcn_readfirstlane(tid >> 6), lane = tid & 63, wr = wid >> 2, wc = wid & 3, fr = lane & 15, fq = lane >> 4;
    const int K = g.K, nt = K / BK;
    unsigned voffA[2], voffB[2];
#pragma unroll
    for (int i = 0; i < 2; ++i) { int R, C; stage_rc(tid * 16 + i * 8192, R, C); const int Rb = Epi::PERM ? ((R & ~31) + perm32(R & 31)) : R;
        voffA[i] = (unsigned)(R * K + C) * 2u; voffB[i] = (unsigned)(Rb * K + C) * 2u; }
    const size_t kstep = (size_t)(BK * 2);
    const size_t hstep = (size_t)HALF * K * 2;
    const size_t tstep = 2 * hstep;
    const unsigned ldsw = (unsigned)wid * 1024u;
    const int aoff = lds_byte(wr * 64 + fr, fq * 8), boff = lds_byte(wc * 32 + fr, fq * 8);
#define PG8_SA(b, h) (((b) * 2 + (h)) * HTB)
#define PG8_SB(b, h) ((4 + (b) * 2 + (h)) * HTB)
#define PG8_STAGE(bufoff, gbase, voff) do { _Pragma("unroll") for (int _i = 0; _i < 2; ++_i) \
        __builtin_amdgcn_global_load_lds((const unsigned*)((const char*)(gbase) + (voff)[_i]), (PG8_LAS unsigned*)(lds + (bufoff) + ldsw + _i * 8192), 16, 0, 0); } while (0)
#define PG8_LDA(dst, b, h) do { _Pragma("unroll") for (int m = 0; m < 4; ++m) _Pragma("unroll") for (int k = 0; k < 2; ++k) dst[m][k] = *(const PG8_LAS bf16x8*)(lds + PG8_SA(b, h) + aoff + m * 2048 + k * 1024); } while (0)
#define PG8_LDB(dst, b, h) do { _Pragma("unroll") for (int n = 0; n < 2; ++n) _Pragma("unroll") for (int k = 0; k < 2; ++k) dst[n][k] = *(const PG8_LAS bf16x8*)(lds + PG8_SB(b, h) + boff + n * 2048 + k * 1024); } while (0)
#define PG8_MMA(ai, bj, At, Bt) do { __builtin_amdgcn_s_setprio(1); _Pragma("unroll") for (int m = 0; m < 4; ++m) _Pragma("unroll") for (int n = 0; n < 2; ++n) _Pragma("unroll") for (int k = 0; k < 2; ++k) \
        acc[ai][bj][m][n] = mma16(Bt[n][k], At[m][k], acc[ai][bj][m][n]); __builtin_amdgcn_s_setprio(0); } while (0)
#define PG8_WAIT_V(n) asm volatile("s_waitcnt vmcnt(" #n ")" ::: "memory")
#define PG8_WAIT_L(n) asm volatile("s_waitcnt lgkmcnt(" #n ")" ::: "memory")
#define PG8_BAR __builtin_amdgcn_s_barrier()
#define PG8_SCHED __builtin_amdgcn_sched_barrier(0)
    Unit cur, nxt; int ui = 0;
    if (!S.next(0, cur)) return;
    typedef typename AccSel<Epi::I8>::t acc_t;
    acc_t acc[2][2][4][2];
#pragma unroll
    for (int a = 0; a < 2; ++a)
#pragma unroll
        for (int b = 0; b < 2; ++b)
#pragma unroll
            for (int m = 0; m < 4; ++m)
#pragma unroll
                for (int n = 0; n < 2; ++n) acc[a][b][m][n] = acc_t{};
    bf16x8 At[4][2], B0[2][2], B1[2][2];
    const char* cA = (const char*)g.A + (size_t)cur.pm * tstep; const char* cB = (const char*)g.Bt + (size_t)cur.pn * tstep;
    S.a_ready(cur);
    if constexpr (SP2) {
        PG8_STAGE(PG8_SB(0, 0), cB, voffB); PG8_STAGE(PG8_SB(0, 1), cB + hstep, voffB); PG8_STAGE(PG8_SA(0, 0), cA, voffA); PG8_STAGE(PG8_SA(0, 1), cA + hstep, voffA);
        if (wr == 1) PG8_BAR;
        PG8_WAIT_V(2); PG8_BAR;
        PG8_STAGE(PG8_SB(1, 0), cB + kstep, voffB); PG8_STAGE(PG8_SA(1, 0), cA + kstep, voffA); PG8_STAGE(PG8_SB(1, 1), cB + hstep + kstep, voffB);
        PG8_WAIT_V(6); PG8_BAR;
    } else {
        PG8_STAGE(PG8_SB(0, 0), cB, voffB); PG8_STAGE(PG8_SA(0, 0), cA, voffA); PG8_STAGE(PG8_SB(0, 1), cB + hstep, voffB); PG8_STAGE(PG8_SA(0, 1), cA + hstep, voffA);
        if (wr == 1) PG8_BAR;
        PG8_WAIT_V(4); PG8_BAR;
        PG8_STAGE(PG8_SB(1, 0), cB + kstep, voffB); PG8_STAGE(PG8_SA(1, 0), cA + kstep, voffA); PG8_STAGE(PG8_SB(1, 1), cB + hstep + kstep, voffB);
        PG8_WAIT_V(6); PG8_BAR;
    }
    for (;;) {
        const bool has_next = S.next(ui + 1, nxt);
        const char* nA = has_next ? (const char*)g.A + (size_t)nxt.pm * tstep : cA; const char* nB = has_next ? (const char*)g.Bt + (size_t)nxt.pn * tstep : cB;
        for (int t = 0; t < nt; t += 2) {
            const bool last = (t == nt - 2);
            const char* a1 = cA + (size_t)(t + 1) * kstep;
            const char* a2 = last ? nA : cA + (size_t)(t + 2) * kstep; const char* b2 = last ? nB : cB + (size_t)(t + 2) * kstep;
            const char* a3 = a2 + kstep; const char* b3 = b2 + kstep;
            if (last && has_next) S.a_ready(nxt);
            if constexpr (SP2) {
            PG8_LDB(B0, 0, 0); PG8_LDB(B1, 0, 1); PG8_SCHED; PG8_LDA(At, 0, 0); PG8_STAGE(PG8_SA(1, 1), a1 + hstep, voffA);
            PG8_WAIT_V(8); PG8_WAIT_L(0); PG8_BAR; PG8_MMA(0, 0, At, B0); PG8_MMA(0, 1, At, B1); PG8_BAR; PG8_SCHED;
            PG8_LDA(At, 0, 1); PG8_STAGE(PG8_SB(0, 0), b2, voffB); PG8_STAGE(PG8_SB(0, 1), b2 + hstep, voffB); PG8_STAGE(PG8_SA(0, 0), a2, voffA);
            PG8_WAIT_V(8); PG8_WAIT_L(0); PG8_BAR; PG8_MMA(1, 0, At, B0); PG8_MMA(1, 1, At, B1); PG8_BAR; PG8_SCHED;
            PG8_LDB(B0, 1, 0); PG8_LDB(B1, 1, 1); PG8_SCHED; PG8_LDA(At, 1, 0); PG8_STAGE(PG8_SA(0, 1), a2 + hstep, voffA);
            PG8_WAIT_V(8); PG8_WAIT_L(0); PG8_BAR; PG8_MMA(0, 0, At, B0); PG8_MMA(0, 1, At, B1); PG8_BAR; PG8_SCHED;
            PG8_LDA(At, 1, 1); PG8_STAGE(PG8_SB(1, 0), b3, voffB); PG8_STAGE(PG8_SB(1, 1), b3 + hstep, voffB); PG8_STAGE(PG8_SA(1, 0), a3, voffA);
            PG8_WAIT_V(8); PG8_WAIT_L(0); PG8_BAR; PG8_MMA(1, 0, At, B0); PG8_MMA(1, 1, At, B1); PG8_BAR; PG8_SCHED;
            } else {
            PG8_LDB(B0, 0, 0); PG8_SCHED; PG8_LDA(At, 0, 0); PG8_STAGE(PG8_SA(1, 1), a1 + hstep, voffA);
            PG8_WAIT_L(8); PG8_BAR; PG8_WAIT_L(0); PG8_MMA(0, 0, At, B0); PG8_BAR; PG8_SCHED;
            PG8_LDB(B1, 0, 1); PG8_STAGE(PG8_SB(0, 0), b2, voffB);
            PG8_BAR; PG8_WAIT_L(0); PG8_MMA(0, 1, At, B1); PG8_BAR;
            PG8_LDA(At, 0, 1); PG8_STAGE(PG8_SA(0, 0), a2, voffA);
            PG8_BAR; PG8_WAIT_L(0); PG8_MMA(1, 0, At, B0); PG8_BAR; PG8_SCHED;
            PG8_STAGE(PG8_SB(0, 1), b2 + hstep, voffB);
            PG8_WAIT_V(6); PG8_BAR; PG8_MMA(1, 1, At, B1); PG8_BAR;
            PG8_LDB(B0, 1, 0); PG8_SCHED; PG8_LDA(At, 1, 0); PG8_STAGE(PG8_SA(0, 1), a2 + hstep, voffA);
            PG8_WAIT_L(8); PG8_BAR; PG8_WAIT_L(0); PG8_MMA(0, 0, At, B0); PG8_BAR; PG8_SCHED;
            PG8_LDB(B1, 1, 1); PG8_STAGE(PG8_SB(1, 0), b3, voffB);
            PG8_BAR; PG8_WAIT_L(0); PG8_MMA(0, 1, At, B1); PG8_BAR;
            PG8_LDA(At, 1, 1); PG8_STAGE(PG8_SA(1, 0), a3, voffA);
            PG8_BAR; PG8_WAIT_L(0); PG8_MMA(1, 0, At, B0); PG8_BAR; PG8_SCHED;
            PG8_STAGE(PG8_SB(1, 1), b3 + hstep, voffB);
            PG8_WAIT_V(6); PG8_BAR; PG8_MMA(1, 1, At, B1); PG8_BAR;
            }
        }
        if constexpr (ALIGN_EPI) { if (wr == 0) PG8_BAR; }
        if constexpr (!Epi::AFTER_DRAIN) { E(acc, cur, wr, wc, fr, fq); S.done(cur); }
        if (!has_next) break;
#pragma unroll
        for (int a = 0; a < 2; ++a)
#pragma unroll
            for (int b = 0; b < 2; ++b)
#pragma unroll
                for (int m = 0; m < 4; ++m)
#pragma unroll
                    for (int n = 0; n < 2; ++n) acc[a][b][m][n] = acc_t{};
        cur = nxt; cA = nA; cB = nB; ++ui;
        if constexpr (ALIGN_EPI) { if (wr == 1) PG8_BAR; }
    }
    PG8_WAIT_V(0);
    if constexpr (!ALIGN_EPI) { if (wr == 0) PG8_BAR; }
    PG8_BAR;
    if constexpr (Epi::AFTER_DRAIN) { E.fused(acc, cur, wr, wc, fr, fq, lds, wid, lane); S.done(cur); }
#undef PG8_SA
#undef PG8_SB
#undef PG8_STAGE
#undef PG8_LDA
#undef PG8_LDB
#undef PG8_MMA
#undef PG8_WAIT_V
#undef PG8_WAIT_L
#undef PG8_BAR
#undef PG8_SCHED
}
}
constexpr int NWAVES = 8;
constexpr int BATCH = 4, SEQ = 8192, D = 1024, M = BATCH * SEQ, CTXL = 256, MC = BATCH * CTXL;
constexpr int NINE = 1792, NEXP = 32, EH = 512;
constexpr float EPS = 1e-6f;
constexpr int N_PHASES = 18;
#ifndef MK_ONE_LAUNCH
#define MK_ONE_LAUNCH 1
#endif
constexpr size_t MiB = 1u << 20;
constexpr size_t WS_CTL = 0, CTL_ZERO_BYTES = 1 * MiB;
constexpr size_t WS_MOD = 1 * MiB;
constexpr size_t WS_MODC = WS_MOD + 2 * 4 * 6144 * 4;
constexpr size_t WS_MODP = 1 * MiB + 768 * 1024;
static_assert(WS_MODC + 6144 * 4 <= 1 * MiB + 256 * 1024, "MOD/MODC overlap the rope tables");
constexpr size_t WS_ROPE = 1 * MiB + 256 * 1024;
constexpr size_t WS_WSP = 1 * MiB + 512 * 1024;
constexpr size_t WS_TOKE = 2 * MiB;
constexpr size_t WS_TOKP = 2 * MiB + 256 * 1024;
constexpr size_t WS_TOKW = 2 * MiB + 512 * 1024;
constexpr size_t WS_TOKS = 2 * MiB + 768 * 1024;
constexpr size_t WS_KC = 3 * MiB;
constexpr size_t WS_VCT = 3 * MiB + 256 * 1024;
constexpr size_t WS_VT = 4 * MiB;
constexpr size_t WS_WINE = 12 * MiB, WS_WOUTE = 16 * MiB, WS_WINO = 18 * MiB, WS_WOUTO = 24 * MiB;
constexpr size_t WS_WGU = 26 * MiB;
constexpr size_t WS_WD = 154 * MiB;
constexpr size_t WS_H = 218 * MiB;
constexpr size_t WS_A = 284 * MiB;
constexpr size_t WS_B = 428 * MiB;
constexpr size_t WS_RSS = 500 * MiB;
constexpr size_t WS_CSC = 502 * MiB;
constexpr size_t WS_CSC2 = 502 * MiB + 256 * 1024;
constexpr size_t WS_RSC = 502 * MiB + 512 * 1024;
constexpr size_t WS_END = 503 * MiB;
constexpr int CW_TMO = 0, CW_CODE = 1, CW_BAR = 4096, CW_GCNT = 8192;

constexpr int RING_BYTES = 131072;
constexpr int LDS_BYTES = 155648;
constexpr int MISC_OFF = LDS_BYTES - 256;
constexpr int MOE_TAB_OFF = RING_BYTES;
constexpr int RW_STRIDE = 2064;
constexpr int RT_WH = 0, RT_WL = 36 * RW_STRIDE, RT_CNT = 72 * RW_STRIDE, RT_BASE = RT_CNT + 128, RT_INFO = RT_CNT + 256;
static_assert(RT_INFO + 128 * 6 * 4 <= MISC_OFF, "LDS map");

#define GAS __attribute__((address_space(1)))
#define LAS __attribute__((address_space(3)))
typedef unsigned short bf16;
typedef unsigned v4u __attribute__((ext_vector_type(4)));
typedef unsigned v2u __attribute__((ext_vector_type(2)));
typedef float f32x4 __attribute__((ext_vector_type(4)));
typedef float f32x16 __attribute__((ext_vector_type(16)));
typedef short bf16x8 __attribute__((ext_vector_type(8)));
typedef GAS unsigned gu32;
#define RLX_AGENT __ATOMIC_RELAXED, __HIP_MEMORY_SCOPE_AGENT
#define LDS_WAIT() asm volatile("s_waitcnt lgkmcnt(0)" ::: "memory")
__device__ __forceinline__ unsigned f2bf(float f) { unsigned u = __builtin_bit_cast(unsigned, f); return (u + 0x7fffu + ((u >> 16) & 1u)) >> 16; }
__device__ __forceinline__ unsigned pk2(float lo, float hi) { return f2bf(lo) | (f2bf(hi) << 16); }
__device__ __forceinline__ float bflo(unsigned w) { return __builtin_bit_cast(float, w << 16); }
__device__ __forceinline__ float bfhi(unsigned w) { return __builtin_bit_cast(float, w & 0xffff0000u); }
__device__ __forceinline__ float wave_sum(float v) {
#pragma unroll
    for (int o = 1; o < 64; o <<= 1) v += __shfl_xor(v, o);
    return v;
}
#define XB_TMO      128
#define XB_XCNT(j)  (256  + 64 * (j))
#define XB_XSUB(j)  (1280 + 64 * (j))
#define XB_XGEN(j)  (2304 + 64 * (j))
#define XB_TOP      3328
#define XB_TOPGEN   3392
#define XCD_BAR_WORDS 3456
#define XB_SPIN_CAP (1u << 18)

__device__ __forceinline__ unsigned xb_ld(unsigned* p)              { return __hip_atomic_load(p, __ATOMIC_RELAXED, __HIP_MEMORY_SCOPE_AGENT); }
__device__ __forceinline__ unsigned xb_add(unsigned* p, unsigned v) { return __hip_atomic_fetch_add(p, v, __ATOMIC_RELAXED, __HIP_MEMORY_SCOPE_AGENT); }
__device__ __forceinline__ unsigned xb_xcc_id() { return (unsigned)__builtin_amdgcn_s_getreg((3 << 11) | 20) & 0xFu; }
#define XB_SPIN(cond, bar) do { unsigned _sp = 0; while (cond) { __builtin_amdgcn_s_sleep(1); \
    if ((++_sp & 255u) == 0u) { if (xb_ld(&(bar)[XB_TMO])) break; if (_sp > XB_SPIN_CAP) { atomicAdd(&(bar)[XB_TMO], 1u); break; } } } } while (0)

struct XcdBarrier {
    unsigned* bar; unsigned x;
    volatile LAS unsigned* st;
};

__device__ __forceinline__ XcdBarrier xcd_barrier_post(unsigned* bar, volatile LAS unsigned* st) {
    XcdBarrier b; b.bar = bar; b.x = xb_xcc_id(); b.st = st;
    if (threadIdx.x == 0) (void)xb_add(&bar[XB_XCNT(b.x)], 1u);
    return b;
}
__device__ __forceinline__ void xcd_barrier_complete(unsigned* bar, unsigned x, unsigned& nloc, unsigned& nx) {
    const unsigned G = gridDim.x * gridDim.y * gridDim.z;
    unsigned sum, cnt, mine, sp = 0u;
    for (;;) {
        sum = 0u; cnt = 0u; mine = 0u;
#pragma unroll
        for (unsigned j = 0; j < 16; ++j) { const unsigned c = xb_ld(&bar[XB_XCNT(j)]); sum += c; cnt += (c > 0u) ? 1u : 0u; mine = (j == x) ? c : mine; }
        if (sum == G) break;
        __builtin_amdgcn_s_sleep(1);
        if ((++sp & 255u) == 0u) { if (xb_ld(&bar[XB_TMO])) break; if (sp > XB_SPIN_CAP) { atomicAdd(&bar[XB_TMO], 1u); break; } }
    }
    nloc = mine > 0u ? mine : 1u; nx = cnt > 0u ? cnt : 1u;
}

__device__ __forceinline__ void xcd_barrier(const XcdBarrier& b, const int xb_tid) {
    asm volatile("s_waitcnt vmcnt(0)" ::: "memory");
    __syncthreads();
    if (xb_tid == 0) {
        unsigned* bar = b.bar;
        __builtin_amdgcn_s_waitcnt(0);
        unsigned nloc = b.st[0], nx = b.st[1];
        if (nloc == 0u) { xcd_barrier_complete(bar, b.x, nloc, nx); b.st[0] = nloc; b.st[1] = nx; }
        const unsigned old = xb_add(&bar[XB_XSUB(b.x)], 1u);
        const unsigned gen = old / nloc;
        if (old + 1u == (gen + 1u) * nloc) {
            __builtin_amdgcn_fence(__ATOMIC_RELEASE, "agent");
            asm volatile("s_waitcnt vmcnt(0)" ::: "memory");
            const unsigned og = xb_add(&bar[XB_TOP], 1u);
            const unsigned tg = og / nx;
            if (og + 1u == (tg + 1u) * nx) xb_add(&bar[XB_TOPGEN], 1u);
            else XB_SPIN(xb_ld(&bar[XB_TOPGEN]) == tg, bar);
            __builtin_amdgcn_fence(__ATOMIC_ACQUIRE, "agent");
            xb_add(&bar[XB_XGEN(b.x)], 1u);
            asm volatile("s_waitcnt vmcnt(0)" ::: "memory");
        } else {
            XB_SPIN(xb_ld(&bar[XB_XGEN(b.x)]) == gen, bar);
            __builtin_amdgcn_fence(__ATOMIC_ACQUIRE, "agent");
            asm volatile("s_waitcnt vmcnt(0)" ::: "memory");
        }
    }
    __syncthreads();
}

struct Args { const float* in[25]; float* out; unsigned char* ws; int ph_lo, ph_hi; };
struct Ctx {
    LAS unsigned char* lds; unsigned ldsaddr;
    int tid, lane, wave, G, bid;
    float* out; unsigned char* ws; gu32* ctl;
};
__device__ __forceinline__ const float* kin(int k) {
    const __attribute__((address_space(4))) Args* ka = (const __attribute__((address_space(4))) Args*)__builtin_amdgcn_kernarg_segment_ptr();
    return (const float*)(const GAS float*)ka->in[k];
}
__device__ const float ROPE_INV[16] = {1.000000000e+00f, 5.623413324e-01f, 3.162277639e-01f, 1.778279394e-01f, 1.000000015e-01f, 5.623413250e-02f, 3.162277490e-02f, 1.778279431e-02f,
                                       9.999999776e-03f, 5.623413250e-03f, 3.162277630e-03f, 1.778279431e-03f, 1.000000047e-03f, 5.623413017e-04f, 3.162277571e-04f, 1.778279402e-04f};

__device__ __forceinline__ void transpose_item(const float* W, int K, int N, bf16* WT, int k0, int n0, int drow0, LAS float* scr, int lane) {
#pragma unroll 8
    for (int i = 0; i < 32; ++i) { const int kk = 2 * i + (lane >> 5); scr[kk * 33 + (lane & 31)] = W[(size_t)(k0 + kk) * N + n0 + (lane & 31)]; }
    LDS_WAIT(); asm volatile("" ::: "memory");
    const int c = lane & 7;
#pragma unroll
    for (int j = 0; j < 4; ++j) { const int n = (lane >> 3) + 8 * j; const LAS float* s = scr + (8 * c) * 33 + n;
        v4u o; o.x = pk2(s[0 * 33], s[1 * 33]); o.y = pk2(s[2 * 33], s[3 * 33]); o.z = pk2(s[4 * 33], s[5 * 33]); o.w = pk2(s[6 * 33], s[7 * 33]);
        *(GAS v4u*)(WT + (size_t)(drow0 + n) * K + k0 + 8 * c) = o; }
    LDS_WAIT(); asm volatile("" ::: "memory");
}
__device__ __forceinline__ void sincos_acc(float a, float& s, float& c) {
    const double x = (double)a, kf = __builtin_rint(x * 0.63661977236758134308), r = x - kf * 1.57079632679489661923, r2 = r * r;
    const double sp = r * (1.0 + r2 * (-1.0 / 6 + r2 * (1.0 / 120 + r2 * (-1.0 / 5040 + r2 * (1.0 / 362880 + r2 * (-1.0 / 39916800 + r2 * (1.0 / 6227020800.0)))))));
    const double cp = 1.0 + r2 * (-0.5 + r2 * (1.0 / 24 + r2 * (-1.0 / 720 + r2 * (1.0 / 40320 + r2 * (-1.0 / 3628800 + r2 * (1.0 / 479001600 + r2 * (-1.0 / 87178291200.0)))))));
    const int k = (int)kf & 3;
    s = (float)((k == 0) ? sp : (k == 1) ? cp : (k == 2) ? -sp : -cp);
    c = (float)((k == 0) ? cp : (k == 1) ? -sp : (k == 2) ? -cp : sp);
}
__device__ __forceinline__ void adaln_unit(const Ctx& C, int u) {
    const int l = u / 96, col = (u % 96) * 64 + C.lane;
    LAS float* sil = (LAS float*)C.lds; LAS float* red = (LAS float*)(C.lds + 5 * 1024 * 4);
    for (int idx = C.tid; idx < 5120; idx += NWAVES * 64) { const float v = (idx < 4096) ? kin(1)[idx] : kin(3)[idx - 4096]; sil[idx] = v / (1.0f + __expf(-v)); }
    __syncthreads();
    float acc[5] = {0.f, 0.f, 0.f, 0.f, 0.f};
    const int k0 = C.wave * 128; const float* wp = kin(4) + (size_t)l * 1024 * 6144 + (size_t)k0 * 6144 + col;
#pragma unroll 8
    for (int kk = 0; kk < 128; ++kk) { const float w = wp[(size_t)kk * 6144];
#pragma unroll
        for (int v = 0; v < 5; ++v) acc[v] += sil[v * 1024 + k0 + kk] * w; }
#pragma unroll
    for (int v = 0; v < 5; ++v) red[(C.wave * 5 + v) * 64 + C.lane] = acc[v];
    __syncthreads();
    if (C.wave == 0) {
        float* MOD = (float*)(C.ws + WS_MOD); float* MODC = (float*)(C.ws + WS_MODC); float* MODP = (float*)(C.ws + WS_MODP); const float bias = kin(5)[l * 6144 + col];
#pragma unroll
        for (int v = 0; v < 5; ++v) { float s = 0.f;
#pragma unroll
            for (int w = 0; w < NWAVES; ++w) s += red[(w * 5 + v) * 64 + C.lane];
            s += bias;
            if (v < 4) { MOD[(size_t)(l * 4 + v) * 6144 + col] = s;
                const int ch = col >> 10;
                if (ch == 1 || ch == 4) { const int w2 = (ch == 4) ? 1 : 0; MODP[(size_t)((l * 4 + v) * 2 + w2) * 1024 + (col & 1023)] = ((w2 ? kin(7) : kin(6))[l * 1024 + (col & 1023)]) * (1.0f + s); }
            } else if (l == 0) MODC[col] = s; }
    }
    __syncthreads();
}
__device__ __forceinline__ void quant_strip_w(const Ctx& C, const float* W, int N, int n0, unsigned char* W8, float* CSC, int drow0) {
    LAS float* tile = (LAS float*)C.lds; LAS unsigned* cmax = (LAS unsigned*)(C.lds + 1024 * 33 * 4);
    { const int c4 = C.tid & 7, kr = C.tid >> 3; f32x4 v[16]; f32x4 mx = (f32x4){0.f, 0.f, 0.f, 0.f};
#pragma unroll
        for (int i = 0; i < 16; ++i) v[i] = *(const f32x4*)(W + (size_t)(kr + 64 * i) * N + n0 + 4 * c4);
#pragma unroll
        for (int i = 0; i < 16; ++i) { LAS float* t = tile + (kr + 64 * i) * 33 + 4 * c4; t[0] = v[i].x; t[1] = v[i].y; t[2] = v[i].z; t[3] = v[i].w;
            mx = __builtin_elementwise_max(mx, __builtin_elementwise_abs(v[i])); }
        LAS float* part = (LAS float*)(C.lds + 1024 * 33 * 4 + 256);
#pragma unroll
        for (int j = 0; j < 4; ++j) part[kr * 32 + 4 * c4 + j] = mx[j]; }
    __syncthreads();
    if (C.tid < 32) { const LAS float* part = (const LAS float*)(C.lds + 1024 * 33 * 4 + 256); float m = 0.f;
        for (int g = 0; g < 64; ++g) m = fmaxf(m, part[g * 32 + C.tid]);
        cmax[C.tid] = __builtin_bit_cast(unsigned, m); }
    __syncthreads();
#pragma unroll
    for (int r = 0; r < 4; ++r) { const int n = 4 * C.wave + r; const float am = __builtin_bit_cast(float, cmax[n]), inv = am > 0.f ? 127.0f / am : 0.f;
        unsigned w[4];
#pragma unroll
        for (int g = 0; g < 4; ++g) { unsigned acc = 0u;
#pragma unroll
            for (int e = 0; e < 4; ++e) { const int q = (int)__builtin_rintf(tile[(16 * C.lane + 4 * g + e) * 33 + n] * inv); acc |= ((unsigned)q & 0xffu) << (8 * e); }
            w[g] = acc; }
        *(v4u*)(W8 + (size_t)(drow0 + n) * 1024 + 16 * C.lane) = (v4u){w[0], w[1], w[2], w[3]};
        if (C.lane == 0) CSC[drow0 + n] = am > 0.f ? am * (1.0f / 127.0f) : 1.0f; }
    __syncthreads();
}
constexpr int N_STRIPS = 2048 + 96 + 32;
__device__ __forceinline__ void quant_strip(const Ctx& C, int st) {
    if (st < 2048) { const int me = st >> 5, which = (st >> 4) & 1, j0 = 32 * (st & 15);
        quant_strip_w(C, (which ? kin(23) : kin(22)) + (size_t)me * 1024 * 512, 512, j0, (unsigned char*)(C.ws + WS_WGU) + (size_t)me * 1024 * 1024, (float*)(C.ws + WS_CSC) + (size_t)me * 1024,
                      256 * (j0 >> 7) + (j0 & 127) + 128 * which);
    } else if (st < 2048 + 96) { const int n0 = 32 * (st - 2048), j = n0 & 1023;
        quant_strip_w(C, kin(15), 3072, n0, (unsigned char*)(C.ws + WS_WINO), (float*)(C.ws + WS_CSC2), (n0 < 1024) ? 2048 + n0 : 256 * (j >> 7) + (j & 127) + ((n0 >= 2048) ? 128 : 0));
    } else { const int n0 = 32 * (st - 2048 - 96);
        quant_strip_w(C, kin(17), 1024, n0, (unsigned char*)(C.ws + WS_WOUTO), (float*)(C.ws + WS_CSC2) + 3072, n0); }
}
__device__ __forceinline__ void p0_prologue(const Ctx& C) {
    for (int u = C.bid; u < 192; u += C.G) adaln_unit(C, u);
    for (int st = C.bid; st < N_STRIPS; st += C.G) quant_strip(C, st);
    LAS float* scr = (LAS float*)(C.lds + C.wave * 16384);
    const int gw = C.bid * NWAVES + C.wave, NGW = C.G * NWAVES;
    constexpr int NDENSE = 896 + 512, NITEMS = NDENSE + 64 * 256;
    for (int it = gw; it < NITEMS; it += NGW) {
        int r = it;
        if (r < 896) { transpose_item(kin(9), 1024, 1792, (bf16*)(C.ws + WS_WINE), 64 * (r / 56), 32 * (r % 56), 32 * (r % 56), scr, C.lane); continue; } r -= 896;
        if (r < 512) { transpose_item(kin(14), 1024, 1024, (bf16*)(C.ws + WS_WOUTE), 64 * (r / 32), 32 * (r % 32), 32 * (r % 32), scr, C.lane); continue; } r -= 512;
        const int me = r >> 8, s = r & 255;
        transpose_item(kin(24) + (size_t)me * 512 * 1024, 512, 1024, (bf16*)(C.ws + WS_WD) + (size_t)me * 1024 * 512, 64 * (s >> 5), 32 * (s & 31), 32 * (s & 31), scr, C.lane);
    }
    for (int it = gw; it < 256; it += NGW) {
        const f32x4* src = (const f32x4*)(kin(12) + (size_t)it * 512) + 2 * C.lane; const f32x4 a = src[0], b = src[1];
        v4u o; o.x = pk2(a.x, a.y); o.y = pk2(a.z, a.w); o.z = pk2(b.x, b.y); o.w = pk2(b.z, b.w);
        *(v4u*)((bf16*)(C.ws + WS_WSP) + (size_t)it * 512 + 8 * C.lane) = o;
    }
    { const int gt = gw * 64 + C.lane;
        if (gt < 2048) { float s, c; sincos_acc((float)(gt >> 4) * ROPE_INV[gt & 15], s, c); ((float*)(C.ws + WS_ROPE))[gt] = c; ((float*)(C.ws + WS_ROPE))[2048 + gt] = s; } }
}

__device__ __forceinline__ void unpack8(const v4u w, float (&f)[8]) { f[0] = bflo(w.x); f[1] = bfhi(w.x); f[2] = bflo(w.y); f[3] = bfhi(w.y); f[4] = bflo(w.z); f[5] = bfhi(w.z); f[6] = bflo(w.w); f[7] = bfhi(w.w); }
__device__ __forceinline__ void load_mod(const float* gam, const float* shp, const float* scp, int lane, f32x4 (&sc)[4], f32x4 (&sh)[4]) {
#pragma unroll
    for (int j = 0; j < 4; ++j) { const int idx = lane + 64 * j; const f32x4 g = ((const f32x4*)gam)[idx], s = ((const f32x4*)scp)[idx]; sc[j] = g * (1.0f + s); sh[j] = ((const f32x4*)shp)[idx]; }
}
__device__ __forceinline__ float row_rinv(const f32x4 (&v)[4]) {
    float ss = 0.f;
#pragma unroll
    for (int j = 0; j < 4; ++j) ss += (v[j].x * v[j].x + v[j].y * v[j].y) + (v[j].z * v[j].z + v[j].w * v[j].w);
    return rsqrtf(wave_sum(ss) * (1.0f / 1024.0f) + EPS);
}
__device__ __forceinline__ void mod_store(const f32x4 (&v)[4], float rinv, const f32x4 (&sc)[4], const f32x4 (&sh)[4], bf16* orow, int lane) {
#pragma unroll
    for (int j = 0; j < 4; ++j) { const f32x4 o = v[j] * rinv * sc[j] + sh[j]; v2u w; w.x = pk2(o.x, o.y); w.y = pk2(o.z, o.w); ((v2u*)orow)[lane + 64 * j] = w; }
}
__device__ __forceinline__ void mod_store8(const f32x4 (&v)[4], float rinv, const f32x4 (&sc)[4], const f32x4 (&sh)[4], unsigned char* orow8, float* rsc, int lane) {
    f32x4 o[4]; float am = 0.f;
#pragma unroll
    for (int j = 0; j < 4; ++j) { o[j] = v[j] * rinv * sc[j] + sh[j]; am = fmaxf(am, fmaxf(fmaxf(fabsf(o[j].x), fabsf(o[j].y)), fmaxf(fabsf(o[j].z), fabsf(o[j].w)))); }
#pragma unroll
    for (int s = 1; s < 64; s <<= 1) am = fmaxf(am, __shfl_xor(am, s));
    const float inv = am > 0.f ? 127.0f / am : 0.f;
#pragma unroll
    for (int j = 0; j < 4; ++j) { const unsigned w = ((unsigned)(int)__builtin_rintf(o[j].x * inv) & 0xffu) | (((unsigned)(int)__builtin_rintf(o[j].y * inv) & 0xffu) << 8) | (((unsigned)(int)__builtin_rintf(o[j].z * inv) & 0xffu) << 16) | (((unsigned)(int)__builtin_rintf(o[j].w * inv) & 0xffu) << 24);
        ((unsigned*)orow8)[lane + 64 * j] = w; }
    if (lane == 0) *rsc = am > 0.f ? am * (1.0f / 127.0f) : 1.0f;
}
__device__ __forceinline__ void phase_norm1_l0(const Ctx& C) {
    const int gw = C.bid * NWAVES + C.wave, NGW = C.G * NWAVES;
    const float* MOD = (const float*)(C.ws + WS_MOD); const float* MODC = (const float*)(C.ws + WS_MODC); bf16* H = (bf16*)(C.ws + WS_H);
    for (int grp = gw; grp < (M + MC) / 16; grp += NGW) {
        f32x4 sc[4], sh[4]; const float* src;
        if (grp < M / 16) { const float* mod = MOD + (size_t)(grp >> 9) * 6144; load_mod(kin(6), mod, mod + 1024, C.lane, sc, sh); src = kin(0) + (size_t)grp * 16 * D; }
        else { load_mod(kin(6), MODC, MODC + 1024, C.lane, sc, sh); src = kin(2) + (size_t)(grp - M / 16) * 16 * D; }
        bf16* dst = H + (size_t)grp * 16 * D;
        f32x4 va[4][4], vb[4][4];
#define N1_LOAD(buf, r0) do { _Pragma("unroll") for (int r = 0; r < 4; ++r) _Pragma("unroll") for (int j = 0; j < 4; ++j) buf[r][j] = ((const f32x4*)(src + (size_t)((r0) + r) * D))[C.lane + 64 * j]; } while (0)
#define N1_PROC(buf, r0) do { _Pragma("unroll") for (int r = 0; r < 4; ++r) mod_store(buf[r], row_rinv(buf[r]), sc, sh, dst + (size_t)((r0) + r) * D, C.lane); } while (0)
        N1_LOAD(va, 0);
#pragma unroll 1
        for (int it = 0; it < 2; ++it) { const int r0 = 8 * it;
            N1_LOAD(vb, r0 + 4); N1_PROC(va, r0);
            if (it < 1) N1_LOAD(va, r0 + 8);
            N1_PROC(vb, r0 + 4); }
#undef N1_LOAD
#undef N1_PROC
    }
}
__device__ __forceinline__ void phase_router(const Ctx& C, int l) {
    LAS unsigned char* WH = C.lds + RT_WH; LAS unsigned char* WL = C.lds + RT_WL;
    LAS int* cnt = (LAS int*)(C.lds + RT_CNT); LAS int* base = (LAS int*)(C.lds + RT_BASE); LAS int* info = (LAS int*)(C.lds + RT_INFO);
    const float* wrg = kin(18) + l * 4096; const float* wre = kin(20) + l * 32768; const float* brg = kin(19) + l * 4; const float* bre = kin(21) + l * 32;
    for (int idx = C.tid; idx < 9216; idx += NWAVES * 64) { const int k = idx / 9, q9 = idx - 9 * k;
        const f32x4 v = (q9 == 0) ? *(const f32x4*)(wrg + 4 * k) : *(const f32x4*)(wre + 32 * k + 4 * (q9 - 1));
        const int row0 = (q9 == 0) ? 32 : 16 * ((q9 - 1) & 1) + 4 * ((q9 - 1) >> 1);
#pragma unroll
        for (int i = 0; i < 4; ++i) { const unsigned hi = f2bf(v[i]), lo = f2bf(v[i] - bflo(hi));
            *(LAS bf16*)(WH + (row0 + i) * RW_STRIDE + 2 * k) = (bf16)hi; *(LAS bf16*)(WL + (row0 + i) * RW_STRIDE + 2 * k) = (bf16)lo; } }
    if (C.tid < 32) cnt[C.tid] = 0;
    __syncthreads();
    const float* MOD = (const float*)(C.ws + WS_MOD); const float* MODP = (const float*)(C.ws + WS_MODP); const float* RSS = (const float*)(C.ws + WS_RSS); bf16* H = (bf16*)(C.ws + WS_H);
    gu32* gcnt = C.ctl + CW_GCNT + l * 32;
    int* TOKE = (int*)(C.ws + WS_TOKE); int* TOKP = (int*)(C.ws + WS_TOKP); float* TOKW = (float*)(C.ws + WS_TOKW);
    const int r = C.lane & 15, q = C.lane >> 4;
    for (int rb = C.bid; rb < M / 128; rb += C.G) {
        const int bq = rb >> 6; const size_t row = (size_t)rb * 128 + C.wave * 16 + r;
        float rinv; { const f32x4* rp = (const f32x4*)(RSS + row * 16); const f32x4 a = rp[0], b = rp[1], c = rp[2], d = rp[3];
            const f32x4 t = (a + b) + (c + d); rinv = rsqrtf(((t.x + t.y) + (t.z + t.w)) * (1.0f / 1024.0f) + EPS); }
        const f32x4* xr = (const f32x4*)(C.out + row * D + 8 * q);
        const f32x4* sp = (const f32x4*)(MODP + (size_t)((l * 4 + bq) * 2 + 1) * 1024 + 8 * q); const f32x4* hp = (const f32x4*)(MOD + (size_t)(l * 4 + bq) * 6144 + 3 * 1024 + 8 * q);
        bf16* hrow = H + row * D + 8 * q;
        const LAS unsigned char* a0 = WH + (C.lane & 15) * RW_STRIDE + 16 * q; const LAS unsigned char* a2 = WH + (32 + (C.lane & 3)) * RW_STRIDE + 16 * q;
        pg8::f32x4 acc[3];
#pragma unroll
        for (int t = 0; t < 3; ++t) acc[t] = (pg8::f32x4){0.f, 0.f, 0.f, 0.f};
        f32x4 xc[8], xn[8];
#pragma unroll
        for (int s = 0; s < 4; ++s) { xc[2 * s] = xr[8 * s]; xc[2 * s + 1] = xr[8 * s + 1]; }
        for (int kb = 0; kb < 8; ++kb) {
            if (kb < 7) {
#pragma unroll
                for (int s = 0; s < 4; ++s) { xn[2 * s] = xr[8 * (4 * (kb + 1) + s)]; xn[2 * s + 1] = xr[8 * (4 * (kb + 1) + s) + 1]; } }
            f32x4 sv[8], hv[8];
#pragma unroll
            for (int s = 0; s < 4; ++s) { sv[2 * s] = sp[8 * (4 * kb + s)]; sv[2 * s + 1] = sp[8 * (4 * kb + s) + 1]; hv[2 * s] = hp[8 * (4 * kb + s)]; hv[2 * s + 1] = hp[8 * (4 * kb + s) + 1]; }
#pragma unroll
            for (int s = 0; s < 4; ++s) { const int kk = 4 * kb + s;
                const f32x4 h0 = xc[2 * s] * rinv * sv[2 * s] + hv[2 * s], h1 = xc[2 * s + 1] * rinv * sv[2 * s + 1] + hv[2 * s + 1];
                v4u hi; hi.x = pg8::cvt_pk_bf16(h0.x, h0.y); hi.y = pg8::cvt_pk_bf16(h0.z, h0.w); hi.z = pg8::cvt_pk_bf16(h1.x, h1.y); hi.w = pg8::cvt_pk_bf16(h1.z, h1.w);
                v4u lo; lo.x = pg8::cvt_pk_bf16(h0.x - bflo(hi.x), h0.y - bfhi(hi.x)); lo.y = pg8::cvt_pk_bf16(h0.z - bflo(hi.y), h0.w - bfhi(hi.y));
                lo.z = pg8::cvt_pk_bf16(h1.x - bflo(hi.z), h1.y - bfhi(hi.z)); lo.w = pg8::cvt_pk_bf16(h1.z - bflo(hi.w), h1.w - bfhi(hi.w));
                *(v4u*)(hrow + 32 * kk) = hi;
                const bf16x8 bh = __builtin_bit_cast(bf16x8, hi), bl = __builtin_bit_cast(bf16x8, lo);
#pragma unroll
                for (int t = 0; t < 3; ++t) { const LAS unsigned char* ap = ((t == 2) ? a2 : a0 + 16 * t * RW_STRIDE) + 64 * kk;
                    const bf16x8 ah = *(const LAS bf16x8*)ap, al = *(const LAS bf16x8*)(ap + RT_WL);
                    acc[t] = __builtin_amdgcn_mfma_f32_16x16x32_bf16(ah, bh, acc[t], 0, 0, 0);
                    acc[t] = __builtin_amdgcn_mfma_f32_16x16x32_bf16(al, bh, acc[t], 0, 0, 0);
                    acc[t] = __builtin_amdgcn_mfma_f32_16x16x32_bf16(ah, bl, acc[t], 0, 0, 0); } }
            if (kb < 7) {
#pragma unroll
                for (int s = 0; s < 8; ++s) xc[s] = xn[s]; }
        }
        float gl[4];
#pragma unroll
        for (int gi = 0; gi < 4; ++gi) gl[gi] = acc[2][gi] + brg[gi];
        int gidx = 0; float gmax = gl[0];
#pragma unroll
        for (int gi = 1; gi < 4; ++gi) if (gl[gi] > gmax) { gmax = gl[gi]; gidx = gi; }
        if (q == gidx) {
            float den = 0.f;
#pragma unroll
            for (int gi = 0; gi < 4; ++gi) den += __expf(gl[gi] - gmax);
            const float gwt = 1.0f / den;
            float ev[8];
#pragma unroll
            for (int j = 0; j < 8; ++j) ev[j] = acc[j >> 2][j & 3] + bre[8 * q + j];
            int i0 = 0; float v0 = ev[0];
#pragma unroll
            for (int j = 1; j < 8; ++j) if (ev[j] > v0) { v0 = ev[j]; i0 = j; }
            int i1 = (i0 == 0) ? 1 : 0; float v1 = (i0 == 0) ? ev[1] : ev[0];
#pragma unroll
            for (int j = 1; j < 8; ++j) if (j != i0 && ev[j] > v1) { v1 = ev[j]; i1 = j; }
            const float t = __expf(v1 - v0), p0 = 1.0f / (1.0f + t), p1 = t * p0;
            const int rr = C.wave * 16 + r, e0 = gidx * 8 + i0, e1 = gidx * 8 + i1;
            const int pl0 = __hip_atomic_fetch_add(cnt + e0, 1, __ATOMIC_RELAXED, __HIP_MEMORY_SCOPE_WORKGROUP), pl1 = __hip_atomic_fetch_add(cnt + e1, 1, __ATOMIC_RELAXED, __HIP_MEMORY_SCOPE_WORKGROUP);
            info[rr * 6 + 0] = e0; info[rr * 6 + 1] = e1; info[rr * 6 + 2] = pl0; info[rr * 6 + 3] = pl1;
            info[rr * 6 + 4] = __builtin_bit_cast(int, gwt * p0); info[rr * 6 + 5] = __builtin_bit_cast(int, gwt * p1);
        }
        __syncthreads();
        if (C.tid < 32) base[C.tid] = (int)__hip_atomic_fetch_add(gcnt + C.tid, (unsigned)cnt[C.tid], RLX_AGENT);
        __syncthreads();
        if (C.tid < 128) { const size_t orow = (size_t)rb * 128 + C.tid; const int e0 = info[C.tid * 6], e1 = info[C.tid * 6 + 1];
            TOKE[orow] = e0 | (e1 << 8); TOKP[orow * 2] = base[e0] + info[C.tid * 6 + 2]; TOKP[orow * 2 + 1] = base[e1] + info[C.tid * 6 + 3];
            TOKW[orow * 2] = __builtin_bit_cast(float, info[C.tid * 6 + 4]); TOKW[orow * 2 + 1] = __builtin_bit_cast(float, info[C.tid * 6 + 5]); }
        __syncthreads();
        if (C.tid < 32) cnt[C.tid] = 0;
        __syncthreads();
    }
}
__device__ __forceinline__ int moe_tables(const Ctx& C, int l) {
    LAS int* tile_e = (LAS int*)(C.lds + MOE_TAB_OFF); LAS int* seg = (LAS int*)(C.lds + MOE_TAB_OFF + 1280); LAS int* lc = (LAS int*)(C.lds + MOE_TAB_OFF + 1280 + 160);
    if (C.tid < 32) lc[C.tid] = (int)__hip_atomic_load(C.ctl + CW_GCNT + l * 32 + C.tid, RLX_AGENT);
    __syncthreads();
    if (C.tid == 0) { int t = 0;
        for (int e = 0; e < 32; ++e) { seg[e] = t * 256; const int n = (lc[e] + 255) >> 8; for (int k = 0; k < n; ++k) tile_e[t + k] = e; t += n; }
        seg[32] = t * 256; }
    __syncthreads();
    return seg[32] >> 8;
}
__device__ __forceinline__ void phase_scatter(const Ctx& C, int l) {
    (void)moe_tables(C, l);
    const LAS int* seg = (const LAS int*)(C.lds + MOE_TAB_OFF + 1280);
    const int gw = C.bid * NWAVES + C.wave, NGW = C.G * NWAVES;
    const int* TOKE = (const int*)(C.ws + WS_TOKE); const int* TOKP = (const int*)(C.ws + WS_TOKP); int* TOKS = (int*)(C.ws + WS_TOKS);
    const bf16* H = (const bf16*)(C.ws + WS_H); unsigned char* XS = (unsigned char*)(C.ws + WS_A); float* RSC = (float*)(C.ws + WS_RSC);
    for (int grp = gw; grp < M / 16; grp += NGW) {
        v4u ha[4][2];
#define SC_LOAD(r0) do { _Pragma("unroll") for (int r = 0; r < 4; ++r) { ha[r][0] = ((const v4u*)(H + ((size_t)grp * 16 + (r0) + r) * D))[C.lane]; ha[r][1] = ((const v4u*)(H + ((size_t)grp * 16 + (r0) + r) * D))[C.lane + 64]; } } while (0)
#pragma unroll 1
        for (int r0 = 0; r0 < 16; r0 += 4) {
            SC_LOAD(r0);
#pragma unroll
            for (int r = 0; r < 4; ++r) { const size_t row = (size_t)grp * 16 + r0 + r; const int ee = TOKE[row];
                const int s0 = seg[ee & 255] + TOKP[row * 2], s1 = seg[ee >> 8] + TOKP[row * 2 + 1];
                float f[2][8]; unpack8(ha[r][0], f[0]); unpack8(ha[r][1], f[1]);
                float am = 0.f;
#pragma unroll
                for (int j = 0; j < 2; ++j)
#pragma unroll
                    for (int e = 0; e < 8; ++e) am = fmaxf(am, fabsf(f[j][e]));
#pragma unroll
                for (int o = 1; o < 64; o <<= 1) am = fmaxf(am, __shfl_xor(am, o));
                const float inv = am > 0.f ? 127.0f / am : 0.f;
                v2u q[2];
#pragma unroll
                for (int j = 0; j < 2; ++j) { unsigned w0 = 0u, w1 = 0u;
#pragma unroll
                    for (int e = 0; e < 4; ++e) { w0 |= ((unsigned)(int)__builtin_rintf(f[j][e] * inv) & 0xffu) << (8 * e); w1 |= ((unsigned)(int)__builtin_rintf(f[j][4 + e] * inv) & 0xffu) << (8 * e); }
                    q[j] = (v2u){w0, w1}; }
                ((v2u*)(XS + (size_t)s0 * 1024))[C.lane] = q[0]; ((v2u*)(XS + (size_t)s0 * 1024))[C.lane + 64] = q[1];
                ((v2u*)(XS + (size_t)s1 * 1024))[C.lane] = q[0]; ((v2u*)(XS + (size_t)s1 * 1024))[C.lane + 64] = q[1];
                if (C.lane == 0) { const float sc = am > 0.f ? am * (1.0f / 127.0f) : 1.0f; TOKS[row * 2] = s0; TOKS[row * 2 + 1] = s1; RSC[s0] = sc; RSC[s1] = sc; } }
        }
#undef SC_LOAD
    }
}
template <bool FINAL> __device__ __forceinline__ void phase_combine(const Ctx& C, int lp) {
    const int gw = C.bid * NWAVES + C.wave, NGW = C.G * NWAVES;
    const float* MOD = (const float*)(C.ws + WS_MOD); bf16* H = (bf16*)(C.ws + WS_H); const bf16* YB = (const bf16*)(C.ws + WS_A);
    const int* TOKS = (const int*)(C.ws + WS_TOKS); const float* TOKW = (const float*)(C.ws + WS_TOKW);
    for (int grp = gw; grp < M / 16; grp += NGW) {
        const int b = grp >> 9; f32x4 g2[4], sc[4], sh[4];
#pragma unroll
        for (int j = 0; j < 4; ++j) g2[j] = ((const f32x4*)(MOD + (size_t)(lp * 4 + b) * 6144 + 5 * 1024))[C.lane + 64 * j];
        if (FINAL) {
#pragma unroll
            for (int j = 0; j < 4; ++j) { sc[j] = ((const f32x4*)kin(8))[C.lane + 64 * j]; sh[j] = (f32x4){0.f, 0.f, 0.f, 0.f}; }
        } else { const float* mod = MOD + (size_t)(4 + b) * 6144; load_mod(kin(6) + 1024, mod, mod + 1024, C.lane, sc, sh); }
        f32x4 xv[2][4]; v2u ya[2][4], yc[2][4]; float w0[2], w1[2];
#define CB_LOAD(buf, r0) do { const size_t row_ = (size_t)grp * 16 + (r0); \
            const int s0_ = TOKS[row_ * 2], s1_ = TOKS[row_ * 2 + 1]; w0[buf] = TOKW[row_ * 2]; w1[buf] = TOKW[row_ * 2 + 1]; \
            _Pragma("unroll") for (int j = 0; j < 4; ++j) { xv[buf][j] = ((const f32x4*)(C.out + row_ * D))[C.lane + 64 * j]; \
                ya[buf][j] = ((const v2u*)(YB + (size_t)s0_ * D))[C.lane + 64 * j]; yc[buf][j] = ((const v2u*)(YB + (size_t)s1_ * D))[C.lane + 64 * j]; } } while (0)
#define CB_PROC(buf, r0) do { const size_t row = (size_t)grp * 16 + (r0); f32x4 v[4]; \
            _Pragma("unroll") for (int j = 0; j < 4; ++j) { const v2u a = ya[buf][j], c = yc[buf][j]; \
                const f32x4 y0 = (f32x4){bflo(a.x), bfhi(a.x), bflo(a.y), bfhi(a.y)}, y1 = (f32x4){bflo(c.x), bfhi(c.x), bflo(c.y), bfhi(c.y)}; \
                v[j] = xv[buf][j] + g2[j] * (y0 * w0[buf] + y1 * w1[buf]); } \
            const float rinv = row_rinv(v); \
            if (FINAL) { _Pragma("unroll") for (int j = 0; j < 4; ++j) ((f32x4*)(C.out + row * D))[C.lane + 64 * j] = v[j] * rinv * sc[j]; } \
            else { _Pragma("unroll") for (int j = 0; j < 4; ++j) ((f32x4*)(C.out + row * D))[C.lane + 64 * j] = v[j]; mod_store8(v, rinv, sc, sh, (unsigned char*)H + row * D, (float*)(C.ws + WS_RSC) + row, C.lane); } } while (0)
        CB_LOAD(0, 0);
#pragma unroll 1
        for (int it = 0; it < 8; ++it) { const int r0 = 2 * it;
            CB_LOAD(1, r0 + 1); CB_PROC(0, r0);
            if (it < 7) CB_LOAD(0, r0 + 2);
            CB_PROC(1, r0 + 1); }
#undef CB_PROC
#undef CB_LOAD
    }
}
__device__ __forceinline__ void phase_conv(const Ctx& C) {
    const int gw = C.bid * NWAVES + C.wave, NGW = C.G * NWAVES;
    const bf16* BG = (const bf16*)(C.ws + WS_A); const bf16* Y = BG + (size_t)M * D; unsigned char* MIX8 = (unsigned char*)(C.ws + WS_B); float* RSC = (float*)(C.ws + WS_RSC);
    float cw[3][2][8];
#pragma unroll
    for (int t = 0; t < 3; ++t)
#pragma unroll
        for (int j = 0; j < 2; ++j) { const f32x4 a = *(const f32x4*)(kin(16) + t * 1024 + j * 512 + 8 * C.lane), b = *(const f32x4*)(kin(16) + t * 1024 + j * 512 + 8 * C.lane + 4);
            cw[t][j][0] = a.x; cw[t][j][1] = a.y; cw[t][j][2] = a.z; cw[t][j][3] = a.w; cw[t][j][4] = b.x; cw[t][j][5] = b.y; cw[t][j][6] = b.z; cw[t][j][7] = b.w; }
    const v4u zero4 = (v4u){0u, 0u, 0u, 0u};
    for (int grp = gw; grp < M / 16; grp += NGW) {
        const size_t t0 = (size_t)grp * 16; v4u prev[2], cur[2];
        v4u yn[2][2], bgv[2][2];
#define CV_LOAD(buf, r0) do { const size_t row_ = t0 + (r0); const bool last_ = (row_ & 8191) == 8191; \
            _Pragma("unroll") for (int j = 0; j < 2; ++j) { yn[buf][j] = last_ ? zero4 : ((const v4u*)(Y + (row_ + 1) * D))[C.lane + 64 * j]; bgv[buf][j] = ((const v4u*)(BG + row_ * D))[C.lane + 64 * j]; } } while (0)
#pragma unroll
        for (int j = 0; j < 2; ++j) { prev[j] = ((t0 & 8191) == 0) ? zero4 : ((const v4u*)(Y + (t0 - 1) * D))[C.lane + 64 * j]; cur[j] = ((const v4u*)(Y + t0 * D))[C.lane + 64 * j]; }
#define CV_PROC(buf, r0) do { const size_t row = t0 + (r0); float ov[2][8]; float am = 0.f; \
            _Pragma("unroll") for (int j = 0; j < 2; ++j) { const v4u nx = yn[buf][j]; \
                float fp[8], fc[8], fn[8], fb[8]; unpack8(prev[j], fp); unpack8(cur[j], fc); unpack8(nx, fn); unpack8(bgv[buf][j], fb); \
                _Pragma("unroll") for (int e = 0; e < 8; ++e) { ov[j][e] = fb[e] * (fp[e] * cw[0][j][e] + fc[e] * cw[1][j][e] + fn[e] * cw[2][j][e]); am = fmaxf(am, fabsf(ov[j][e])); } \
                prev[j] = cur[j]; cur[j] = nx; } \
            _Pragma("unroll") for (int s_ = 1; s_ < 64; s_ <<= 1) am = fmaxf(am, __shfl_xor(am, s_)); \
            const float inv = am > 0.f ? 127.0f / am : 0.f; \
            _Pragma("unroll") for (int j = 0; j < 2; ++j) { unsigned w0 = 0u, w1 = 0u; \
                _Pragma("unroll") for (int e = 0; e < 4; ++e) { w0 |= ((unsigned)(int)__builtin_rintf(ov[j][e] * inv) & 0xffu) << (8 * e); w1 |= ((unsigned)(int)__builtin_rintf(ov[j][4 + e] * inv) & 0xffu) << (8 * e); } \
                ((v2u*)(MIX8 + row * D))[C.lane + 64 * j] = (v2u){w0, w1}; } \
            if (C.lane == 0) RSC[row] = am > 0.f ? am * (1.0f / 127.0f) : 1.0f; } while (0)
        CV_LOAD(0, 0);
#pragma unroll 1
        for (int it = 0; it < 8; ++it) { const int r0 = 2 * it;
            CV_LOAD(1, r0 + 1); CV_PROC(0, r0);
            if (it < 7) CV_LOAD(0, r0 + 2);
            CV_PROC(1, r0 + 1); }
#undef CV_PROC
#undef CV_LOAD
    }
}
constexpr float LOG2E = 1.4426950408889634f;
constexpr float QSCALE = 0.125f * LOG2E;
constexpr int AT_K = 0, AT_V = 16384, AT_WS = 32768, AT_ST = 34816;
__device__ __forceinline__ int crow(int r, int hi) { return (r & 3) + 8 * (r >> 2) + 4 * hi; }
__device__ __forceinline__ bf16x8 pack8(float a0, float a1, float a2, float a3, float a4, float a5, float a6, float a7) {
    v4u w; w.x = pg8::cvt_pk_bf16(a0, a1); w.y = pg8::cvt_pk_bf16(a2, a3); w.z = pg8::cvt_pk_bf16(a4, a5); w.w = pg8::cvt_pk_bf16(a6, a7); return __builtin_bit_cast(bf16x8, w);
}
__device__ __forceinline__ void attn_unit(const Ctx& C, int au) {
    const int qblk = au & 127, kvh = (au >> 7) & 1, b = au >> 8;
    const int ph = C.wave & 1, head = kvh * 4 + (C.wave >> 1), q32 = C.lane & 31, hi = C.lane >> 5;
    const bf16* QK = (const bf16*)(C.ws + WS_A); const bf16* VT = (const bf16*)(C.ws + WS_VT); const bf16* KC = (const bf16*)(C.ws + WS_KC); const bf16* VCT = (const bf16*)(C.ws + WS_VCT);
    bf16* MIX = (bf16*)(C.ws + WS_B);
    const size_t qrow = (size_t)b * SEQ + 64 * qblk + 32 * ph + q32;
    bf16x8 qf[4];
#pragma unroll
    for (int ds = 0; ds < 4; ++ds) qf[ds] = *(const bf16x8*)(QK + qrow * NINE + head * 64 + 16 * ds + 8 * hi);
    float m = kin(10)[head] * LOG2E, l = (hi == 0) ? 1.0f : 0.0f;
    f32x16 o0, o1;
#pragma unroll
    for (int r = 0; r < 16; ++r) { o0[r] = 0.f; o1[r] = 0.f; }
    const int jlo = (qblk < 2) ? 2 - qblk : 0, jhi = (qblk > 125) ? 129 - qblk : 4, NT = 4 + jhi - jlo + 1;
    const int prow = C.tid >> 3, pch = C.tid & 7;
    LAS float* wsf = (LAS float*)(C.lds + AT_WS) + C.wave * 64;
    v4u kr0, vr0, kr1, vr1;
#define AT_LOAD(t, kreg, vreg) do { if ((t) < 4) { kreg = *(const v4u*)(KC + ((size_t)(b * 256 + 64 * (t) + prow) * 128 + kvh * 64 + 8 * pch)); \
            vreg = *(const v4u*)(VCT + ((size_t)((b * 2 + kvh) * 64 + prow) * 256 + 64 * (t) + 8 * pch)); } \
        else { const int kblk_ = qblk - 2 + jlo + (t) - 4; kreg = *(const v4u*)(QK + ((size_t)(b * SEQ + 64 * kblk_ + prow) * NINE + 512 + kvh * 64 + 8 * pch)); \
            vreg = *(const v4u*)(VT + ((size_t)((b * 2 + kvh) * 64 + prow) * SEQ + 64 * kblk_ + 8 * pch)); } } while (0)
#define AT_WRITE(bufi, kreg, vreg) do { *(LAS v4u*)(C.lds + AT_K + (bufi) * 8192 + pch * 1024 + prow * 16) = kreg; *(LAS v4u*)(C.lds + AT_V + (bufi) * 8192 + pch * 1024 + prow * 16) = vreg; } while (0)
    AT_LOAD(0, kr0, vr0); AT_LOAD(1, kr1, vr1);
    AT_WRITE(0, kr0, vr0); AT_LOAD(2, kr0, vr0);
    __syncthreads();
    for (int t = 0; t < NT; ++t) {
        const int buf = t & 1;
        if (t + 1 < NT) {
            if (buf == 0) { AT_WRITE(1, kr1, vr1); if (t + 3 < NT) AT_LOAD(t + 3, kr1, vr1); }
            else { AT_WRITE(0, kr0, vr0); if (t + 3 < NT) AT_LOAD(t + 3, kr0, vr0); }
        }
        const LAS unsigned char* kb = C.lds + AT_K + buf * 8192; const LAS unsigned char* vb = C.lds + AT_V + buf * 8192;
        f32x16 p0, p1;
#pragma unroll
        for (int r = 0; r < 16; ++r) { p0[r] = 0.f; p1[r] = 0.f; }
#pragma unroll
        for (int ds = 0; ds < 4; ++ds) {
            const bf16x8 a0 = *(const LAS bf16x8*)(kb + (2 * ds + hi) * 1024 + q32 * 16), a1 = *(const LAS bf16x8*)(kb + (2 * ds + hi) * 1024 + (q32 + 32) * 16);
            p0 = __builtin_amdgcn_mfma_f32_32x32x16_bf16(a0, qf[ds], p0, 0, 0, 0); p1 = __builtin_amdgcn_mfma_f32_32x32x16_bf16(a1, qf[ds], p1, 0, 0, 0);
        }
        const int j = (t < 4) ? -1 : jlo + t - 4;
        if (j == 0 || j == 4) {
            int qq = 32 * ph + q32; asm volatile("" : "+v"(qq));
#pragma unroll
            for (int r = 0; r < 16; ++r) { const int kv = crow(r, hi);
                const bool d0 = (j == 0) ? (kv < qq) : (kv > qq), d1 = (j == 0) ? (kv + 32 < qq) : (kv + 32 > qq);
                if (d0) p0[r] = -__builtin_inff(); if (d1) p1[r] = -__builtin_inff(); }
        }
        float rm = fmaxf(p0[0], p1[0]);
#pragma unroll
        for (int r = 1; r < 16; ++r) rm = fmaxf(rm, fmaxf(p0[r], p1[r]));
        rm = fmaxf(rm, __shfl_xor(rm, 32));
        if (__any(rm > m)) {
            const float mn = fmaxf(m, rm), al = __builtin_amdgcn_exp2f(m - mn); m = mn; l *= al;
            if (hi == 0) wsf[q32] = al;
#pragma unroll
            for (int r = 0; r < 16; ++r) { const float f = wsf[crow(r, hi)]; o0[r] *= f; o1[r] *= f; }
        }
        float ls = 0.f;
#pragma unroll
        for (int r = 0; r < 16; ++r) { p0[r] = __builtin_amdgcn_exp2f(p0[r] - m); p1[r] = __builtin_amdgcn_exp2f(p1[r] - m); ls += p0[r] + p1[r]; }
        l += ls;
#pragma unroll
        for (int s = 0; s < 2; ++s) {
            const bf16x8 pa = pack8(p0[8 * s], p0[8 * s + 1], p0[8 * s + 2], p0[8 * s + 3], p0[8 * s + 4], p0[8 * s + 5], p0[8 * s + 6], p0[8 * s + 7]);
            const bf16x8 pb = pack8(p1[8 * s], p1[8 * s + 1], p1[8 * s + 2], p1[8 * s + 3], p1[8 * s + 4], p1[8 * s + 5], p1[8 * s + 6], p1[8 * s + 7]);
            const bf16x8 va0 = *(const LAS bf16x8*)(vb + (2 * s + hi) * 1024 + q32 * 16), va1 = *(const LAS bf16x8*)(vb + (2 * s + hi) * 1024 + (q32 + 32) * 16);
            const bf16x8 vb0 = *(const LAS bf16x8*)(vb + (4 + 2 * s + hi) * 1024 + q32 * 16), vb1 = *(const LAS bf16x8*)(vb + (4 + 2 * s + hi) * 1024 + (q32 + 32) * 16);
            o0 = __builtin_amdgcn_mfma_f32_32x32x16_bf16(pa, va0, o0, 0, 0, 0); o1 = __builtin_amdgcn_mfma_f32_32x32x16_bf16(pa, va1, o1, 0, 0, 0);
            o0 = __builtin_amdgcn_mfma_f32_32x32x16_bf16(pb, vb0, o0, 0, 0, 0); o1 = __builtin_amdgcn_mfma_f32_32x32x16_bf16(pb, vb1, o1, 0, 0, 0);
        }
        __syncthreads();
    }
#undef AT_LOAD
#undef AT_WRITE
    l += __shfl_xor(l, 32);
    if (hi == 0) wsf[32 + q32] = l;
    LAS bf16* stg = (LAS bf16*)(C.lds + AT_ST) + C.wave * 2048;
#pragma unroll
    for (int r = 0; r < 16; ++r) { const int orow = crow(r, hi); const float rl = 1.0f / wsf[32 + orow];
        stg[orow * 64 + q32] = (bf16)f2bf(o0[r] * rl); stg[orow * 64 + 32 + q32] = (bf16)f2bf(o1[r] * rl); }
    bf16* Ow = MIX + ((size_t)b * SEQ + 64 * qblk + 32 * ph) * D + head * 64;
#pragma unroll
    for (int i = 0; i < 4; ++i) { const int pc = i * 64 + C.lane, row = pc >> 3, ch = pc & 7; const v4u v = *(const LAS v4u*)(stg + row * 64 + ch * 8); *(v4u*)(Ow + (size_t)row * D + ch * 8) = v; }
    __syncthreads();
}
constexpr int ZS = 1040;
__device__ __forceinline__ v2u tr_read(unsigned addr) { v2u r; asm volatile("ds_read_b64_tr_b16 %0, %1\n\ts_waitcnt lgkmcnt(0)" : "=&v"(r) : "v"(addr) : "memory"); return r; }
__device__ __forceinline__ void sgu_unit(const Ctx& C, int su) {
    const size_t R0 = (size_t)su * 128;
    const bf16* QK = (const bf16*)(C.ws + WS_A); bf16* MIX = (bf16*)(C.ws + WS_B); const bf16* WSP = (const bf16*)(C.ws + WS_WSP);
    { float gs[8]; const f32x4 a = *(const f32x4*)(kin(11) + 8 * C.lane), c = *(const f32x4*)(kin(11) + 8 * C.lane + 4);
        gs[0] = a.x; gs[1] = a.y; gs[2] = a.z; gs[3] = a.w; gs[4] = c.x; gs[5] = c.y; gs[6] = c.z; gs[7] = c.w;
#pragma unroll 4
        for (int rr = 0; rr < 16; ++rr) { const int j = C.wave * 16 + rr;
            const v4u zw = *(const v4u*)(QK + (R0 + j) * NINE + 1280 + 8 * C.lane); float x[8]; unpack8(zw, x);
            float s = 0.f;
#pragma unroll
            for (int e = 0; e < 8; ++e) s += x[e];
            const float mean = wave_sum(s) * (1.0f / 512.0f); float q = 0.f;
#pragma unroll
            for (int e = 0; e < 8; ++e) { x[e] -= mean; q += x[e] * x[e]; }
            const float rstd = rsqrtf(wave_sum(q) * (1.0f / 512.0f) + EPS);
            v4u w; w.x = pk2(x[0] * rstd * gs[0], x[1] * rstd * gs[1]); w.y = pk2(x[2] * rstd * gs[2], x[3] * rstd * gs[3]);
            w.z = pk2(x[4] * rstd * gs[4], x[5] * rstd * gs[5]); w.w = pk2(x[6] * rstd * gs[6], x[7] * rstd * gs[7]);
            *(LAS v4u*)(C.lds + j * ZS + 16 * C.lane) = w; }
    }
    __syncthreads();
    const int h = C.wave, l31 = C.lane & 31, hi = C.lane >> 5, g16 = (C.lane >> 4) & 1, q4 = (C.lane & 15) >> 2, p4 = C.lane & 3;
    f32x16 acc[2][4];
#pragma unroll
    for (int cb = 0; cb < 2; ++cb)
#pragma unroll
        for (int ib = 0; ib < 4; ++ib)
#pragma unroll
            for (int r = 0; r < 16; ++r) acc[cb][ib][r] = 0.f;
#pragma unroll 2
    for (int ks = 0; ks < 8; ++ks) {
        bf16x8 bw[4];
#pragma unroll
        for (int ib = 0; ib < 4; ++ib) bw[ib] = *(const bf16x8*)(WSP + ((size_t)h * 128 + 32 * ib + l31) * 128 + 16 * ks + 8 * hi);
        bf16x8 az[2];
#pragma unroll
        for (int cb = 0; cb < 2; ++cb) {
            const unsigned a0 = C.ldsaddr + (unsigned)((16 * ks + 8 * hi + q4) * ZS + (64 * h + 32 * cb + 16 * g16 + 4 * p4) * 2);
            const v2u lo = tr_read(a0), hi2 = tr_read(a0 + 4 * ZS);
            az[cb] = __builtin_bit_cast(bf16x8, (v4u){lo.x, lo.y, hi2.x, hi2.y});
        }
#pragma unroll
        for (int cb = 0; cb < 2; ++cb)
#pragma unroll
            for (int ib = 0; ib < 4; ++ib) acc[cb][ib] = __builtin_amdgcn_mfma_f32_32x32x16_bf16(az[cb], bw[ib], acc[cb][ib], 0, 0, 0);
    }
#pragma unroll
    for (int ib = 0; ib < 4; ++ib) {
        const int i = 32 * ib + l31; const float bias = kin(13)[h * 128 + i]; const size_t row = R0 + i;
#pragma unroll
        for (int cb = 0; cb < 2; ++cb)
#pragma unroll
            for (int rg = 0; rg < 4; ++rg) { const int c = 64 * h + 32 * cb + 8 * rg + 4 * hi;
                const v2u uw = *(const v2u*)(QK + row * NINE + 768 + c);
                const float o0 = bflo(uw.x) * (acc[cb][ib][4 * rg] + bias), o1 = bfhi(uw.x) * (acc[cb][ib][4 * rg + 1] + bias), o2 = bflo(uw.y) * (acc[cb][ib][4 * rg + 2] + bias), o3 = bfhi(uw.y) * (acc[cb][ib][4 * rg + 3] + bias);
                v2u w; w.x = pk2(o0, o1); w.y = pk2(o2, o3); *(v2u*)(MIX + row * D + 512 + c) = w; }
    }
    __syncthreads();
}
__device__ __forceinline__ void phase_attn_sgu(const Ctx& C) {
    for (int au = C.bid; au < BATCH * 2 * 128; au += C.G) attn_unit(C, au);
    for (int su = C.bid; su < M / 128; su += C.G) sgu_unit(C, su);
}
__global__ void __launch_bounds__(NWAVES * 64, 2) mk_fwd(Args args) {
    extern __shared__ __attribute__((aligned(16))) unsigned char lds_raw[];
    Ctx C;
    C.lds = (LAS unsigned char*)lds_raw; C.ldsaddr = (unsigned)(uintptr_t)C.lds;
    C.tid = threadIdx.x; C.lane = C.tid & 63; C.wave = __builtin_amdgcn_readfirstlane(C.tid >> 6);
    C.G = gridDim.x; C.bid = blockIdx.x;
    C.out = args.out; C.ws = args.ws; C.ctl = (gu32*)(args.ws + WS_CTL);
    volatile LAS unsigned* MISC = (volatile LAS unsigned*)(C.lds + MISC_OFF);
    if (C.tid < 64) MISC[C.tid] = 0u;
    __syncthreads();
#define FRESH_IDS(Cx) do { int z_ = 0; asm volatile("" : "+s"(z_)); Cx.lane = (int)__builtin_amdgcn_mbcnt_hi(~0u, __builtin_amdgcn_mbcnt_lo(~0u, (unsigned)z_)); Cx.tid = Cx.wave * 64 + Cx.lane; } while (0)
    const int lo = args.ph_lo, hi = args.ph_hi;
    const bool one = (hi - lo) > 1;
    XcdBarrier bar; bar.bar = (unsigned*)(C.ctl + CW_BAR); bar.x = 0; bar.st = nullptr;
    if (one) bar = xcd_barrier_post((unsigned*)(C.ctl + CW_BAR), MISC + 8);
#ifndef PHMASK
#define PHMASK 0x3ffff
#endif
#define IN(k) (((PHMASK >> (k)) & 1) && lo <= (k) && (k) < hi)
#define SEAM(k) do { if (IN(k) && IN((k) + 1)) { Ctx Cb = C; FRESH_IDS(Cb); xcd_barrier(bar, Cb.tid); } } while (0)
#ifndef DUPMASK
#define DUPMASK 0
#endif
#define DUP(k) DUP_##k
#if (DUPMASK >> 0) & 1
#define DUP_0 _Pragma("unroll") for (int rep_ = 0; rep_ < 2; ++rep_)
#else
#define DUP_0
#endif
#if (DUPMASK >> 1) & 1
#define DUP_1 _Pragma("unroll") for (int rep_ = 0; rep_ < 2; ++rep_)
#else
#define DUP_1
#endif
#if (DUPMASK >> 2) & 1
#define DUP_2 _Pragma("unroll") for (int rep_ = 0; rep_ < 2; ++rep_)
#else
#define DUP_2
#endif
#if (DUPMASK >> 3) & 1
#define DUP_3 _Pragma("unroll") for (int rep_ = 0; rep_ < 2; ++rep_)
#else
#define DUP_3
#endif
#if (DUPMASK >> 4) & 1
#define DUP_4 _Pragma("unroll") for (int rep_ = 0; rep_ < 2; ++rep_)
#else
#define DUP_4
#endif
#if (DUPMASK >> 5) & 1
#define DUP_5 _Pragma("unroll") for (int rep_ = 0; rep_ < 2; ++rep_)
#else
#define DUP_5
#endif
#if (DUPMASK >> 6) & 1
#define DUP_6 _Pragma("unroll") for (int rep_ = 0; rep_ < 2; ++rep_)
#else
#define DUP_6
#endif
#if (DUPMASK >> 7) & 1
#define DUP_7 _Pragma("unroll") for (int rep_ = 0; rep_ < 2; ++rep_)
#else
#define DUP_7
#endif
#if (DUPMASK >> 8) & 1
#define DUP_8 _Pragma("unroll") for (int rep_ = 0; rep_ < 2; ++rep_)
#else
#define DUP_8
#endif
#if (DUPMASK >> 9) & 1
#define DUP_9 _Pragma("unroll") for (int rep_ = 0; rep_ < 2; ++rep_)
#else
#define DUP_9
#endif
#if (DUPMASK >> 10) & 1
#define DUP_10 _Pragma("unroll") for (int rep_ = 0; rep_ < 2; ++rep_)
#else
#define DUP_10
#endif
#if (DUPMASK >> 11) & 1
#define DUP_11 _Pragma("unroll") for (int rep_ = 0; rep_ < 2; ++rep_)
#else
#define DUP_11
#endif
#if (DUPMASK >> 12) & 1
#define DUP_12 _Pragma("unroll") for (int rep_ = 0; rep_ < 2; ++rep_)
#else
#define DUP_12
#endif
#if (DUPMASK >> 13) & 1
#define DUP_13 _Pragma("unroll") for (int rep_ = 0; rep_ < 2; ++rep_)
#else
#define DUP_13
#endif
#if (DUPMASK >> 14) & 1
#define DUP_14 _Pragma("unroll") for (int rep_ = 0; rep_ < 2; ++rep_)
#else
#define DUP_14
#endif
#if (DUPMASK >> 15) & 1
#define DUP_15 _Pragma("unroll") for (int rep_ = 0; rep_ < 2; ++rep_)
#else
#define DUP_15
#endif
#if (DUPMASK >> 16) & 1
#define DUP_16 _Pragma("unroll") for (int rep_ = 0; rep_ < 2; ++rep_)
#else
#define DUP_16
#endif
#if (DUPMASK >> 17) & 1
#define DUP_17 _Pragma("unroll") for (int rep_ = 0; rep_ < 2; ++rep_)
#else
#define DUP_17
#endif
    bf16* const H = (bf16*)(C.ws + WS_H); bf16* const RA = (bf16*)(C.ws + WS_A); bf16* const RB = (bf16*)(C.ws + WS_B);
    const float* const MOD = (const float*)(C.ws + WS_MOD);

    DUP(0) { if (IN(0)) { Ctx Cp = C; FRESH_IDS(Cp); p0_prologue(Cp); } SEAM(0); }
    DUP(1) { if (IN(1)) { Ctx Cp = C; FRESH_IDS(Cp); phase_norm1_l0(Cp); } SEAM(1); }
    DUP(2) { if (IN(2)) { Ctx Cp = C; FRESH_IDS(Cp);
        pg8::Gemm g{H, (const bf16*)(Cp.ws + WS_WINE), M, NINE, D}; pg8::InEOrder S; S.so.init(M, NINE, Cp.G, Cp.bid); S.G = Cp.G; S.c = Cp.bid;
        pg8::EpiInE E{RA, (bf16*)(Cp.ws + WS_VT), (bf16*)(Cp.ws + WS_KC), (bf16*)(Cp.ws + WS_VCT), (const float*)(Cp.ws + WS_ROPE), (const float*)(Cp.ws + WS_ROPE) + 2048, QSCALE};
        pg8::gemm_phase<pg8::EpiInE, pg8::InEOrder, true, true>(Cp.lds, g, S, E, Cp.tid);
    } SEAM(2); }
    DUP(3) { if (IN(3)) { Ctx Cp = C; FRESH_IDS(Cp); phase_attn_sgu(Cp); } SEAM(3); }
    DUP(4) { if (IN(4)) { Ctx Cp = C; FRESH_IDS(Cp);
        pg8::Gemm g{RB, (const bf16*)(Cp.ws + WS_WOUTE), M, D, D}; pg8::StaticOrder S; S.init(M, D, Cp.G, Cp.bid);
        pg8::EpiRes E{kin(0), Cp.out, MOD + 2 * 1024, (float*)(Cp.ws + WS_RSS)};
        pg8::gemm_phase<pg8::EpiRes, pg8::StaticOrder, true, true>(Cp.lds, g, S, E, Cp.tid);
    } SEAM(4); }
    DUP(5) { if (IN(5)) { Ctx Cp = C; FRESH_IDS(Cp); phase_router(Cp, 0); } SEAM(5); }
    DUP(6) { if (IN(6)) { Ctx Cp = C; FRESH_IDS(Cp); phase_scatter(Cp, 0); } SEAM(6); }
    DUP(7) { if (IN(7)) { Ctx Cp = C; FRESH_IDS(Cp);
        const int nt = moe_tables(Cp, 0);
        pg8::Gemm g{RA, (const bf16*)(Cp.ws + WS_WGU), nt * 256, NEXP * 1024, D / 2}; pg8::MoeOrder S{(const LAS int*)(Cp.lds + MOE_TAB_OFF), nt * 4, Cp.G, Cp.bid};
        pg8::EpiSwiGLU8 E{RB, (const float*)(Cp.ws + WS_RSC), (const float*)(Cp.ws + WS_CSC)};
        pg8::gemm_phase<pg8::EpiSwiGLU8, pg8::MoeOrder, true, true>(Cp.lds, g, S, E, Cp.tid);
    } SEAM(7); }
    DUP(8) { if (IN(8)) { Ctx Cp = C; FRESH_IDS(Cp);
        const int nt = moe_tables(Cp, 0);
        pg8::Gemm g{RB, (const bf16*)(Cp.ws + WS_WD), nt * 256, NEXP * 1024, EH}; pg8::MoeOrder S{(const LAS int*)(Cp.lds + MOE_TAB_OFF), nt * 4, Cp.G, Cp.bid};
        pg8::EpiDown E{RA};
        pg8::gemm_phase<pg8::EpiDown, pg8::MoeOrder, true, true>(Cp.lds, g, S, E, Cp.tid);
    } SEAM(8); }
    DUP(9) { if (IN(9)) { Ctx Cp = C; FRESH_IDS(Cp); phase_combine<false>(Cp, 0); } SEAM(9); }
    DUP(10) { if (IN(10)) { Ctx Cp = C; FRESH_IDS(Cp);
        pg8::Gemm g{H, (const bf16*)(Cp.ws + WS_WINO), M, 3072, D / 2}; pg8::StaticOrder S; S.init(M, 3072, Cp.G, Cp.bid);
        pg8::EpiInO8 E{RA, RA + (size_t)M * D, (const float*)(Cp.ws + WS_RSC), (const float*)(Cp.ws + WS_CSC2)};
        pg8::gemm_phase<pg8::EpiInO8, pg8::StaticOrder, true, true>(Cp.lds, g, S, E, Cp.tid);
    } SEAM(10); }
    DUP(11) { if (IN(11)) { Ctx Cp = C; FRESH_IDS(Cp); phase_conv(Cp); } SEAM(11); }
    DUP(12) { if (IN(12)) { Ctx Cp = C; FRESH_IDS(Cp);
        pg8::Gemm g{RB, (const bf16*)(Cp.ws + WS_WOUTO), M, D, D / 2}; pg8::StaticOrder S; S.init(M, D, Cp.G, Cp.bid);
        pg8::EpiRes8 E{Cp.out, Cp.out, MOD + (size_t)4 * 6144 + 2 * 1024, (float*)(Cp.ws + WS_RSS), (const float*)(Cp.ws + WS_RSC), (const float*)(Cp.ws + WS_CSC2) + 3072};
        pg8::gemm_phase<pg8::EpiRes8, pg8::StaticOrder, true, true>(Cp.lds, g, S, E, Cp.tid);
    } SEAM(12); }
    DUP(13) { if (IN(13)) { Ctx Cp = C; FRESH_IDS(Cp); phase_router(Cp, 1); } SEAM(13); }
    DUP(14) { if (IN(14)) { Ctx Cp = C; FRESH_IDS(Cp); phase_scatter(Cp, 1); } SEAM(14); }
    DUP(15) { if (IN(15)) { Ctx Cp = C; FRESH_IDS(Cp);
        const int nt = moe_tables(Cp, 1);
        pg8::Gemm g{RA, (const bf16*)(Cp.ws + WS_WGU + (size_t)NEXP * 1024 * 1024), nt * 256, NEXP * 1024, D / 2}; pg8::MoeOrder S{(const LAS int*)(Cp.lds + MOE_TAB_OFF), nt * 4, Cp.G, Cp.bid};
        pg8::EpiSwiGLU8 E{RB, (const float*)(Cp.ws + WS_RSC), (const float*)(Cp.ws + WS_CSC) + (size_t)NEXP * 1024};
        pg8::gemm_phase<pg8::EpiSwiGLU8, pg8::MoeOrder, true, true>(Cp.lds, g, S, E, Cp.tid);
    } SEAM(15); }
    DUP(16) { if (IN(16)) { Ctx Cp = C; FRESH_IDS(Cp);
        const int nt = moe_tables(Cp, 1);
        pg8::Gemm g{RB, (const bf16*)(Cp.ws + WS_WD) + (size_t)NEXP * 1024 * 512, nt * 256, NEXP * 1024, EH}; pg8::MoeOrder S{(const LAS int*)(Cp.lds + MOE_TAB_OFF), nt * 4, Cp.G, Cp.bid};
        pg8::EpiDown E{RA};
        pg8::gemm_phase<pg8::EpiDown, pg8::MoeOrder, true, true>(Cp.lds, g, S, E, Cp.tid);
    } SEAM(16); }
    DUP(17) { if (IN(17)) { Ctx Cp = C; FRESH_IDS(Cp); phase_combine<true>(Cp, 1); } }
#undef IN
#undef SEAM
}

extern "C" void kernel_launch(void* const* d_in, const int* in_sizes, int n_in, void* d_out, int out_size, void* d_ws, size_t ws_size, hipStream_t stream) {
    static int grid = 0;
    if (grid == 0) {
        if (n_in != 25 || in_sizes[0] != M * D || out_size != M * D || ws_size < WS_END) { fprintf(stderr, "kernel_launch: unexpected shapes (n_in %d, in0 %d, out %d, ws %zu)\n", n_in, n_in > 0 ? in_sizes[0] : -1, out_size, ws_size); grid = -1; return; }
        int dev = 0, cus = 0, per_cu = 0;
        if (hipGetDevice(&dev) != hipSuccess || hipDeviceGetAttribute(&cus, hipDeviceAttributeMultiprocessorCount, dev) != hipSuccess) { grid = -1; return; }
        if (hipFuncSetAttribute((const void*)mk_fwd, hipFuncAttributeMaxDynamicSharedMemorySize, LDS_BYTES) != hipSuccess) { fprintf(stderr, "kernel_launch: hipFuncSetAttribute failed\n"); grid = -1; return; }
        if (hipOccupancyMaxActiveBlocksPerMultiprocessor(&per_cu, (const void*)mk_fwd, NWAVES * 64, LDS_BYTES) != hipSuccess || per_cu < 1) { fprintf(stderr, "kernel_launch: occupancy query says %d\n", per_cu); }
        (void)hipGetLastError();
        grid = cus;
    }
    if (grid < 0) return;
    if (hipMemsetAsync((char*)d_ws + WS_CTL, 0, CTL_ZERO_BYTES, stream) != hipSuccess) return;
    Args a{};
    for (int i = 0; i < 25; ++i) a.in[i] = (const float*)d_in[i];
    a.out = (float*)d_out; a.ws = (unsigned char*)d_ws;
#if defined(PROBE_K)
    a.ph_lo = 0; a.ph_hi = PROBE_K + 1; hipLaunchKernelGGL(mk_fwd, dim3(grid), dim3(NWAVES * 64), LDS_BYTES, stream, a);
    (void)hipMemsetAsync((char*)d_ws + WS_CTL, 0, (PROBE_K == 5 || PROBE_K == 13) ? CTL_ZERO_BYTES : (size_t)4 * CW_GCNT, stream);
    a.ph_lo = PROBE_K; a.ph_hi = PROBE_K + 1; hipLaunchKernelGGL(mk_fwd, dim3(grid), dim3(NWAVES * 64), LDS_BYTES, stream, a);
    (void)hipMemsetAsync((char*)d_ws + WS_CTL, 0, 4 * CW_GCNT, stream);
    if (PROBE_K + 1 < N_PHASES) { a.ph_lo = PROBE_K + 1; a.ph_hi = N_PHASES; hipLaunchKernelGGL(mk_fwd, dim3(grid), dim3(NWAVES * 64), LDS_BYTES, stream, a); }
#elif MK_ONE_LAUNCH
    a.ph_lo = 0; a.ph_hi = N_PHASES;
    hipLaunchKernelGGL(mk_fwd, dim3(grid), dim3(NWAVES * 64), LDS_BYTES, stream, a);
#else
    for (int p = 0; p < N_PHASES; ++p) { a.ph_lo = p; a.ph_hi = p + 1; hipLaunchKernelGGL(mk_fwd, dim3(grid), dim3(NWAVES * 64), LDS_BYTES, stream, a); }
#endif
}
```

```cpp
#include <hip/hip_runtime.h>
#include <cstdio>
#include <cstdint>
namespace pg8 {
#define PG8_LAS __attribute__((address_space(3)))
typedef unsigned short bf16_t;
typedef short bf16x8 __attribute__((ext_vector_type(8)));
typedef float f32x4 __attribute__((ext_vector_type(4)));
typedef unsigned u32x4 __attribute__((ext_vector_type(4)));
constexpr int BM = 256, BK = 64, HALF = 128, HTB = HALF * BK * 2  , STAGE_BYTES = 8 * HTB, NXCD = 8, WGM = 8;

__host__ __device__ __forceinline__ int lds_byte(int r, int c) { const int st = (r >> 4) * 2 + (c >> 5), rr = r & 15, cc = c & 31, ob = rr * 64 + cc * 2; return st * 1024 + (ob ^ (((ob >> 9) & 1) << 5)); }
__host__ __device__ __forceinline__ void stage_rc(int b, int& R, int& C) { const int st = b / 1024, sb = b % 1024, swz = sb ^ (((sb >> 9) & 1) << 5); R = (st >> 1) * 16 + swz / 64; C = (st & 1) * 32 + (swz % 64) / 2; }
__host__ __device__ __forceinline__ int perm32(int rho) { const int n = rho >> 4, i = rho & 15; return 8 * (i >> 2) + 4 * n + (i & 3); }

struct Unit { int pm, pn; };
struct Gemm { const bf16_t* A; const bf16_t* Bt; int M, N, K; };

struct StaticOrder {
    int nM, nN, nwg, G, c;
    __host__ __device__ void init(int M, int N, int G_, int c_) { nM = M / BM; nN = N / BM; nwg = nM * nN; G = G_; c = c_; }
    __host__ __device__ bool next(int i, Unit& u) const {
        const long L = (long)i * G + c; if (L >= nwg) return false;
        int wgid = (int)L; { const int q = nwg / NXCD, r = nwg % NXCD, xcd = wgid % NXCD, off = wgid / NXCD; wgid = (xcd < r ? xcd * (q + 1) : r * (q + 1) + (xcd - r) * q) + off; }
        const int nig = WGM * nN, gid = wgid / nig, fm = gid * WGM, gsz = (nM - fm) < WGM ? (nM - fm) : WGM;
        u.pm = fm + ((wgid % nig) % gsz); u.pn = (wgid % nig) / gsz; return true;
    }
    __device__ __forceinline__ void a_ready(const Unit&) const {}
    __device__ __forceinline__ void done(const Unit&) const {}
};

__device__ __forceinline__ unsigned cvt_pk_bf16(float lo, float hi) { unsigned r; asm volatile("v_cvt_pk_bf16_f32 %0, %1, %2" : "=v"(r) : "v"(lo), "v"(hi)); return r; }
typedef float f32x2 __attribute__((ext_vector_type(2)));
__device__ __forceinline__ f32x2 gelu_pk(f32x2 v) {
    const f32x2 av = __builtin_elementwise_abs(v), d = av * 0.2316418882f + 1.0f;
    f32x2 t; t.x = __builtin_amdgcn_rcpf(d.x); t.y = __builtin_amdgcn_rcpf(d.y);
    f32x2 q = t * 0.5307027145f + (-0.7265760135f); q = q * t + 0.7107068705f; q = q * t + (-0.142248368f); q = q * t + 0.127414796f; q = q * t;
    const f32x2 s = (v * v) * (-0.72134752044f);
    f32x2 e; e.x = __builtin_amdgcn_exp2f(s.x); e.y = __builtin_amdgcn_exp2f(s.y);
    const f32x2 m = v * (q * e), r = v - m;
    f32x2 o; o.x = v.x < 0.f ? m.x : r.x; o.y = v.y < 0.f ? m.y : r.y; return o;
}

typedef int i32x4 __attribute__((ext_vector_type(4)));
template <bool I8> struct AccSel { typedef f32x4 t; };
template <> struct AccSel<true> { typedef i32x4 t; };
__device__ __forceinline__ f32x4 mma16(bf16x8 a, bf16x8 b, f32x4 c) { return __builtin_amdgcn_mfma_f32_16x16x32_bf16(a, b, c, 0, 0, 0); }
__device__ __forceinline__ i32x4 mma16(bf16x8 a, bf16x8 b, i32x4 c) { return __builtin_amdgcn_mfma_i32_16x16x64_i8(__builtin_bit_cast(i32x4, a), __builtin_bit_cast(i32x4, b), c, 0, 0, 0); }
typedef unsigned u32x2 __attribute__((ext_vector_type(2)));
__device__ __forceinline__ int perm16(int x) { return (x & 3) | ((x & 4) << 1) | ((x & 8) >> 1); }
__device__ __forceinline__ bf16_t bf1(float v) { return (bf16_t)(cvt_pk_bf16(v, 0.f) & 0xffffu); }
__device__ __forceinline__ u32x2 pk4(f32x4 v) { u32x2 w; w.x = cvt_pk_bf16(v[0], v[1]); w.y = cvt_pk_bf16(v[2], v[3]); return w; }
__device__ __forceinline__ f32x4 gelu4(f32x4 v) { const f32x2 a = gelu_pk((f32x2){v[0], v[1]}), b = gelu_pk((f32x2){v[2], v[3]}); return (f32x4){a.x, a.y, b.x, b.y}; }
__device__ __forceinline__ float silu1(float g) { return g * __builtin_amdgcn_rcpf(1.0f + __builtin_amdgcn_exp2f(-1.4426950408889634f * g)); }

struct EpiInE {
    static constexpr bool PERM = false, AFTER_DRAIN = false, I8 = false;
    bf16_t* QK; bf16_t* VT; bf16_t* KC; bf16_t* VCT; const float* rc; const float* rs; float qscale;
    __device__ __forceinline__ void operator()(const f32x4 (&acc)[2][2][4][2], const Unit& u, int wr, int wc, int fr, int fq) const {
        const int row0 = u.pm * BM + wr * 64 + fr;
        if (u.pm >= 128) {
#pragma unroll
            for (int ai = 0; ai < 2; ++ai)
#pragma unroll
                for (int m = 0; m < 4; ++m) {
                    const int row = row0 + ai * HALF + m * 16 - 32768, b = row >> 8, j = row & 255, jp = (j & ~15) | perm16(j & 15);
#pragma unroll
                    for (int n = 0; n < 2; ++n) {
                        *(u32x2*)(KC + (size_t)row * 128 + wc * 32 + n * 16 + 4 * fq) = pk4(acc[ai][0][m][n]);
#pragma unroll
                        for (int i = 0; i < 4; ++i) { const int cv = wc * 32 + n * 16 + 4 * fq + i; VCT[((size_t)(b * 2 + (cv >> 6)) * 64 + (cv & 63)) * 256 + jp] = bf1(acc[ai][1][m][n][i]); }
                    }
                }
            return;
        }
        if (u.pn <= 2) {
            const float sc = (u.pn < 2) ? qscale : 1.0f;
#pragma unroll
            for (int ai = 0; ai < 2; ++ai)
#pragma unroll
                for (int m = 0; m < 4; ++m) {
                    const int row = row0 + ai * HALF + m * 16, pos = row & 8191, pidx = (wc & 1) ? (pos & 63) : (pos >> 6);
                    const f32x4 c4 = *(const f32x4*)(rc + pidx * 16 + 4 * fq) * sc, s4 = *(const f32x4*)(rs + pidx * 16 + 4 * fq) * sc;
                    bf16_t* rowp = QK + (size_t)row * 1792 + u.pn * BM + wc * 32 + 4 * fq;
#pragma unroll
                    for (int bj = 0; bj < 2; ++bj) {
                        if (u.pn == 2 && bj == 1) break;
                        const f32x4 v0 = acc[ai][bj][m][0], v1 = acc[ai][bj][m][1];
                        *(u32x2*)(rowp + bj * HALF) = pk4(v0 * c4 - v1 * s4);
                        *(u32x2*)(rowp + bj * HALF + 16) = pk4(v1 * c4 + v0 * s4);
                    }
                    if (u.pn == 2) {
                        const int b = row >> 13, pp = (pos & ~15) | perm16(pos & 15);
#pragma unroll
                        for (int n = 0; n < 2; ++n)
#pragma unroll
                            for (int i = 0; i < 4; ++i) { const int cv = wc * 32 + n * 16 + 4 * fq + i; VT[((size_t)(b * 2 + (cv >> 6)) * 64 + (cv & 63)) * 8192 + pp] = bf1(acc[ai][1][m][n][i]); }
                    }
                }
            return;
        }
#pragma unroll
        for (int ai = 0; ai < 2; ++ai)
#pragma unroll
            for (int m = 0; m < 4; ++m) {
                bf16_t* rowp = QK + (size_t)(row0 + ai * HALF + m * 16) * 1792 + u.pn * BM + wc * 32 + 4 * fq;
#pragma unroll
                for (int bj = 0; bj < 2; ++bj)
#pragma unroll
                    for (int n = 0; n < 2; ++n) *(u32x2*)(rowp + bj * HALF + n * 16) = pk4(gelu4(acc[ai][bj][m][n]));
            }
    }
};
struct EpiRes {
    static constexpr bool PERM = false, AFTER_DRAIN = false, I8 = false;
    const float* base; float* out; const float* gate; float* RSS;
    __device__ __forceinline__ void operator()(const f32x4 (&acc)[2][2][4][2], const Unit& u, int wr, int wc, int fr, int fq) const {
        const int row0 = u.pm * BM + wr * 64 + fr, col0 = u.pn * BM + wc * 32 + 4 * fq, b = u.pm >> 5;
        f32x4 gv[2][2];
#pragma unroll
        for (int bj = 0; bj < 2; ++bj)
#pragma unroll
            for (int n = 0; n < 2; ++n) gv[bj][n] = *(const f32x4*)(gate + (size_t)b * 6144 + col0 + bj * HALF + n * 16);
#pragma unroll
        for (int ai = 0; ai < 2; ++ai) {
            f32x4 bs[4][2][2];
#pragma unroll
            for (int m = 0; m < 4; ++m)
#pragma unroll
                for (int bj = 0; bj < 2; ++bj)
#pragma unroll
                    for (int n = 0; n < 2; ++n) bs[m][bj][n] = *(const f32x4*)(base + (size_t)(row0 + ai * HALF + m * 16) * 1024 + col0 + bj * HALF + n * 16);
            asm volatile("" ::: "memory");
#pragma unroll
            for (int m = 0; m < 4; ++m) { const int row = row0 + ai * HALF + m * 16; float ss = 0.f;
#pragma unroll
                for (int bj = 0; bj < 2; ++bj)
#pragma unroll
                    for (int n = 0; n < 2; ++n) { const f32x4 o = bs[m][bj][n] + gv[bj][n] * acc[ai][bj][m][n]; *(f32x4*)(out + (size_t)row * 1024 + col0 + bj * HALF + n * 16) = o;
                        ss += (o[0] * o[0] + o[1] * o[1]) + (o[2] * o[2] + o[3] * o[3]); }
                ss += __shfl_xor(ss, 16); ss += __shfl_xor(ss, 32);
                if (fq == 0) RSS[(size_t)row * 16 + u.pn * 4 + wc] = ss; }
            asm volatile("" ::: "memory");
        }
    }
};
struct EpiSwiGLU {
    static constexpr bool PERM = true, AFTER_DRAIN = false, I8 = false;
    bf16_t* HID;
    __device__ __forceinline__ void operator()(const f32x4 (&acc)[2][2][4][2], const Unit& u, int wr, int wc, int fr, int fq) const {
        const int row0 = u.pm * BM + wr * 64 + fr, col0 = (u.pn & 3) * HALF + wc * 32 + 8 * fq;
#pragma unroll
        for (int ai = 0; ai < 2; ++ai)
#pragma unroll
            for (int m = 0; m < 4; ++m) {
                const f32x4 g0 = acc[ai][0][m][0], g1 = acc[ai][0][m][1], u0 = acc[ai][1][m][0], u1 = acc[ai][1][m][1];
                u32x4 w;
                w.x = cvt_pk_bf16(silu1(g0[0]) * u0[0], silu1(g0[1]) * u0[1]); w.y = cvt_pk_bf16(silu1(g0[2]) * u0[2], silu1(g0[3]) * u0[3]);
                w.z = cvt_pk_bf16(silu1(g1[0]) * u1[0], silu1(g1[1]) * u1[1]); w.w = cvt_pk_bf16(silu1(g1[2]) * u1[2], silu1(g1[3]) * u1[3]);
                *(u32x4*)(HID + (size_t)(row0 + ai * HALF + m * 16) * 512 + col0) = w;
            }
    }
};
struct EpiSwiGLU8 {
    static constexpr bool PERM = true, AFTER_DRAIN = false, I8 = true;
    bf16_t* HID; const float* RSC; const float* CSC;
    __device__ __forceinline__ void operator()(const i32x4 (&acc)[2][2][4][2], const Unit& u, int wr, int wc, int fr, int fq) const {
        const int row0 = u.pm * BM + wr * 64 + fr, ct = u.pn & 3, col0 = ct * HALF + wc * 32 + 8 * fq;
        const float* cs = CSC + (size_t)(u.pn >> 2) * 1024 + ct * BM + wc * 32 + 8 * fq;
        const f32x4 cg0 = *(const f32x4*)(cs), cg1 = *(const f32x4*)(cs + 4), cu0 = *(const f32x4*)(cs + HALF), cu1 = *(const f32x4*)(cs + HALF + 4);
#pragma unroll
        for (int ai = 0; ai < 2; ++ai)
#pragma unroll
            for (int m = 0; m < 4; ++m) { const int row = row0 + ai * HALF + m * 16; const float rs = RSC[row];
                const f32x4 g0 = __builtin_convertvector(acc[ai][0][m][0], f32x4) * cg0 * rs, g1 = __builtin_convertvector(acc[ai][0][m][1], f32x4) * cg1 * rs;
                const f32x4 u0 = __builtin_convertvector(acc[ai][1][m][0], f32x4) * cu0 * rs, u1 = __builtin_convertvector(acc[ai][1][m][1], f32x4) * cu1 * rs;
                u32x4 w;
                w.x = cvt_pk_bf16(silu1(g0[0]) * u0[0], silu1(g0[1]) * u0[1]); w.y = cvt_pk_bf16(silu1(g0[2]) * u0[2], silu1(g0[3]) * u0[3]);
                w.z = cvt_pk_bf16(silu1(g1[0]) * u1[0], silu1(g1[1]) * u1[1]); w.w = cvt_pk_bf16(silu1(g1[2]) * u1[2], silu1(g1[3]) * u1[3]);
                *(u32x4*)(HID + (size_t)row * 512 + col0) = w;
            }
    }
};
struct EpiDown {
    static constexpr bool PERM = true, AFTER_DRAIN = false, I8 = false;
    bf16_t* Y;
    __device__ __forceinline__ void operator()(const f32x4 (&acc)[2][2][4][2], const Unit& u, int wr, int wc, int fr, int fq) const {
        const int row0 = u.pm * BM + wr * 64 + fr, col0 = (u.pn & 3) * BM + wc * 32 + 8 * fq;
#pragma unroll
        for (int ai = 0; ai < 2; ++ai)
#pragma unroll
            for (int m = 0; m < 4; ++m) { bf16_t* rowp = Y + (size_t)(row0 + ai * HALF + m * 16) * 1024 + col0;
#pragma unroll
                for (int bj = 0; bj < 2; ++bj) { const f32x4 v0 = acc[ai][bj][m][0], v1 = acc[ai][bj][m][1];
                    u32x4 w; w.x = cvt_pk_bf16(v0[0], v0[1]); w.y = cvt_pk_bf16(v0[2], v0[3]); w.z = cvt_pk_bf16(v1[0], v1[1]); w.w = cvt_pk_bf16(v1[2], v1[3]);
                    *(u32x4*)(rowp + bj * HALF) = w; } }
    }
};
struct EpiInO {
    static constexpr bool PERM = true, AFTER_DRAIN = false, I8 = false;
    bf16_t* BG; bf16_t* Y;
    __device__ __forceinline__ void operator()(const f32x4 (&acc)[2][2][4][2], const Unit& u, int wr, int wc, int fr, int fq) const {
        const int row0 = u.pm * BM + wr * 64 + fr;
        if (u.pn < 8) {
            const int col0 = u.pn * HALF + wc * 32 + 8 * fq;
#pragma unroll
            for (int ai = 0; ai < 2; ++ai)
#pragma unroll
                for (int m = 0; m < 4; ++m) { const f32x4 v0 = acc[ai][0][m][0] * acc[ai][1][m][0], v1 = acc[ai][0][m][1] * acc[ai][1][m][1];
                    u32x4 w; w.x = cvt_pk_bf16(v0[0], v0[1]); w.y = cvt_pk_bf16(v0[2], v0[3]); w.z = cvt_pk_bf16(v1[0], v1[1]); w.w = cvt_pk_bf16(v1[2], v1[3]);
                    *(u32x4*)(Y + (size_t)(row0 + ai * HALF + m * 16) * 1024 + col0) = w; }
        } else {
            const int col0 = (u.pn - 8) * BM + wc * 32 + 8 * fq;
#pragma unroll
            for (int ai = 0; ai < 2; ++ai)
#pragma unroll
                for (int m = 0; m < 4; ++m) { bf16_t* rowp = BG + (size_t)(row0 + ai * HALF + m * 16) * 1024 + col0;
#pragma unroll
                    for (int bj = 0; bj < 2; ++bj) { const f32x4 v0 = acc[ai][bj][m][0], v1 = acc[ai][bj][m][1];
                        u32x4 w; w.x = cvt_pk_bf16(v0[0], v0[1]); w.y = cvt_pk_bf16(v0[2], v0[3]); w.z = cvt_pk_bf16(v1[0], v1[1]); w.w = cvt_pk_bf16(v1[2], v1[3]);
                        *(u32x4*)(rowp + bj * HALF) = w; } }
        }
    }
};
struct EpiInO8 {
    static constexpr bool PERM = true, AFTER_DRAIN = false, I8 = true;
    bf16_t* BG; bf16_t* Y; const float* RSC; const float* CSC;
    __device__ __forceinline__ void operator()(const i32x4 (&acc)[2][2][4][2], const Unit& u, int wr, int wc, int fr, int fq) const {
        const int row0 = u.pm * BM + wr * 64 + fr;
        const float* cs = CSC + u.pn * BM + wc * 32 + 8 * fq;
        const f32x4 c00 = *(const f32x4*)(cs), c01 = *(const f32x4*)(cs + 4), c10 = *(const f32x4*)(cs + HALF), c11 = *(const f32x4*)(cs + HALF + 4);
        if (u.pn < 8) {
            const int col0 = u.pn * HALF + wc * 32 + 8 * fq;
#pragma unroll
            for (int ai = 0; ai < 2; ++ai)
#pragma unroll
                for (int m = 0; m < 4; ++m) { const int row = row0 + ai * HALF + m * 16; const float rs = RSC[row], rs2 = rs * rs;
                    const f32x4 v0 = __builtin_convertvector(acc[ai][0][m][0], f32x4) * __builtin_convertvector(acc[ai][1][m][0], f32x4) * (c00 * c10) * rs2;
                    const f32x4 v1 = __builtin_convertvector(acc[ai][0][m][1], f32x4) * __builtin_convertvector(acc[ai][1][m][1], f32x4) * (c01 * c11) * rs2;
                    u32x4 w; w.x = cvt_pk_bf16(v0[0], v0[1]); w.y = cvt_pk_bf16(v0[2], v0[3]); w.z = cvt_pk_bf16(v1[0], v1[1]); w.w = cvt_pk_bf16(v1[2], v1[3]);
                    *(u32x4*)(Y + (size_t)row * 1024 + col0) = w; }
        } else {
            const int col0 = (u.pn - 8) * BM + wc * 32 + 8 * fq;
#pragma unroll
            for (int ai = 0; ai < 2; ++ai)
#pragma unroll
                for (int m = 0; m < 4; ++m) { const int row = row0 + ai * HALF + m * 16; const float rs = RSC[row]; bf16_t* rowp = BG + (size_t)row * 1024 + col0;
#pragma unroll
                    for (int bj = 0; bj < 2; ++bj) { const f32x4 v0 = __builtin_convertvector(acc[ai][bj][m][0], f32x4) * (bj ? c10 : c00) * rs, v1 = __builtin_convertvector(acc[ai][bj][m][1], f32x4) * (bj ? c11 : c01) * rs;
                        u32x4 w; w.x = cvt_pk_bf16(v0[0], v0[1]); w.y = cvt_pk_bf16(v0[2], v0[3]); w.z = cvt_pk_bf16(v1[0], v1[1]); w.w = cvt_pk_bf16(v1[2], v1[3]);
                        *(u32x4*)(rowp + bj * HALF) = w; } }
        }
    }
};
struct EpiRes8 {
    static constexpr bool PERM = false, AFTER_DRAIN = false, I8 = true;
    const float* base; float* out; const float* gate; float* RSS; const float* RSC; const float* CSC;
    __device__ __forceinline__ void operator()(const i32x4 (&acc)[2][2][4][2], const Unit& u, int wr, int wc, int fr, int fq) const {
        const int row0 = u.pm * BM + wr * 64 + fr, col0 = u.pn * BM + wc * 32 + 4 * fq, b = u.pm >> 5;
        f32x4 gv[2][2];
#pragma unroll
        for (int bj = 0; bj < 2; ++bj)
#pragma unroll
            for (int n = 0; n < 2; ++n) gv[bj][n] = *(const f32x4*)(gate + (size_t)b * 6144 + col0 + bj * HALF + n * 16) * *(const f32x4*)(CSC + col0 + bj * HALF + n * 16);
#pragma unroll
        for (int ai = 0; ai < 2; ++ai) {
            f32x4 bs[4][2][2]; float rs[4];
#pragma unroll
            for (int m = 0; m < 4; ++m) { rs[m] = RSC[row0 + ai * HALF + m * 16];
#pragma unroll
                for (int bj = 0; bj < 2; ++bj)
#pragma unroll
                    for (int n = 0; n < 2; ++n) bs[m][bj][n] = *(const f32x4*)(base + (size_t)(row0 + ai * HALF + m * 16) * 1024 + col0 + bj * HALF + n * 16); }
            asm volatile("" ::: "memory");
#pragma unroll
            for (int m = 0; m < 4; ++m) { const int row = row0 + ai * HALF + m * 16; float ss = 0.f;
#pragma unroll
                for (int bj = 0; bj < 2; ++bj)
#pragma unroll
                    for (int n = 0; n < 2; ++n) { const f32x4 o = bs[m][bj][n] + gv[bj][n] * (__builtin_convertvector(acc[ai][bj][m][n], f32x4) * rs[m]); *(f32x4*)(out + (size_t)row * 1024 + col0 + bj * HALF + n * 16) = o;
                        ss += (o[0] * o[0] + o[1] * o[1]) + (o[2] * o[2] + o[3] * o[3]); }
                ss += __shfl_xor(ss, 16); ss += __shfl_xor(ss, 32);
                if (fq == 0) RSS[(size_t)row * 16 + u.pn * 4 + wc] = ss; }
            asm volatile("" ::: "memory");
        }
    }
};
struct InEOrder {
    StaticOrder so; int G, c;
    __device__ __forceinline__ bool next(int i, Unit& u) const {
        const long L = (long)i * G + c;
        if (L < 896) return so.next(i, u);
        if (L < 900) { u.pm = 128 + (int)(L - 896); u.pn = 2; return true; }
        return false;
    }
    __device__ __forceinline__ void a_ready(const Unit&) const {}
    __device__ __forceinline__ void done(const Unit&) const {}
};
struct MoeOrder {
    const PG8_LAS int* tile_e; int nunits, G, c;
    __device__ __forceinline__ bool next(int i, Unit& u) const {
        const long L = (long)i * G + c; if (L >= nunits) return false;
        const int t = (int)(L >> 2); u.pm = t; u.pn = tile_e[t] * 4 + (int)(L & 3); return true;
    }
    __device__ __forceinline__ void a_ready(const Unit&) const {}
    __device__ __forceinline__ void done(const Unit&) const {}
};
template <class Epi, class Sched, bool ALIGN_EPI = false, bool SP2 = false>
__device__ __forceinline__ void gemm_phase(PG8_LAS unsigned char* lds, const Gemm g, const Sched& S, const Epi& E, const int tid_in) {
    int tid_ = tid_in; asm volatile("" : "+v"(tid_));
    const int tid = tid_, wid = __builtin_amdgcn_readfirstlane(tid >> 6), lane = tid & 63, wr = wid >> 2, wc = wid & 3, fr = lane & 15, fq = lane >> 4;
    const int K = g.K, nt = K / BK;
    unsigned voffA[2], voffB[2];
#pragma unroll
    for (int i = 0; i < 2; ++i) { int R, C; stage_rc(tid * 16 + i * 8192, R, C); const int Rb = Epi::PERM ? ((R & ~31) + perm32(R & 31)) : R;
        voffA[i] = (unsigned)(R * K + C) * 2u; voffB[i] = (unsigned)(Rb * K + C) * 2u; }
    const size_t kstep = (size_t)(BK * 2);
    const size_t hstep = (size_t)HALF * K * 2;
    const size_t tstep = 2 * hstep;
    const unsigned ldsw = (unsigned)wid * 1024u;
    const int aoff = lds_byte(wr * 64 + fr, fq * 8), boff = lds_byte(wc * 32 + fr, fq * 8);
#define PG8_SA(b, h) (((b) * 2 + (h)) * HTB)
#define PG8_SB(b, h) ((4 + (b) * 2 + (h)) * HTB)
#define PG8_STAGE(bufoff, gbase, voff) do { _Pragma("unroll") for (int _i = 0; _i < 2; ++_i) \
        __builtin_amdgcn_global_load_lds((const unsigned*)((const char*)(gbase) + (voff)[_i]), (PG8_LAS unsigned*)(lds + (bufoff) + ldsw + _i * 8192), 16, 0, 0); } while (0)
#define PG8_LDA(dst, b, h) do { _Pragma("unroll") for (int m = 0; m < 4; ++m) _Pragma("unroll") for (int k = 0; k < 2; ++k) dst[m][k] = *(const PG8_LAS bf16x8*)(lds + PG8_SA(b, h) + aoff + m * 2048 + k * 1024); } while (0)
#define PG8_LDB(dst, b, h) do { _Pragma("unroll") for (int n = 0; n < 2; ++n) _Pragma("unroll") for (int k = 0; k < 2; ++k) dst[n][k] = *(const PG8_LAS bf16x8*)(lds + PG8_SB(b, h) + boff + n * 2048 + k * 1024); } while (0)
#define PG8_MMA(ai, bj, At, Bt) do { __builtin_amdgcn_s_setprio(1); _Pragma("unroll") for (int m = 0; m < 4; ++m) _Pragma("unroll") for (int n = 0; n < 2; ++n) _Pragma("unroll") for (int k = 0; k < 2; ++k) \
        acc[ai][bj][m][n] = mma16(Bt[n][k], At[m][k], acc[ai][bj][m][n]); __builtin_amdgcn_s_setprio(0); } while (0)
#define PG8_WAIT_V(n) asm volatile("s_waitcnt vmcnt(" #n ")" ::: "memory")
#define PG8_WAIT_L(n) asm volatile("s_waitcnt lgkmcnt(" #n ")" ::: "memory")
#define PG8_BAR __builtin_amdgcn_s_barrier()
#define PG8_SCHED __builtin_amdgcn_sched_barrier(0)
    Unit cur, nxt; int ui = 0;
    if (!S.next(0, cur)) return;
    typedef typename AccSel<Epi::I8>::t acc_t;
    acc_t acc[2][2][4][2];
#pragma unroll
    for (int a = 0; a < 2; ++a)
#pragma unroll
        for (int b = 0; b < 2; ++b)
#pragma unroll
            for (int m = 0; m < 4; ++m)
#pragma unroll
                for (int n = 0; n < 2; ++n) acc[a][b][m][n] = acc_t{};
    bf16x8 At[4][2], B0[2][2], B1[2][2];
    const char* cA = (const char*)g.A + (size_t)cur.pm * tstep; const char* cB = (const char*)g.Bt + (size_t)cur.pn * tstep;
    S.a_ready(cur);
    if constexpr (SP2) {
        PG8_STAGE(PG8_SB(0, 0), cB, voffB); PG8_STAGE(PG8_SB(0, 1), cB + hstep, voffB); PG8_STAGE(PG8_SA(0, 0), cA, voffA); PG8_STAGE(PG8_SA(0, 1), cA + hstep, voffA);
        if (wr == 1) PG8_BAR;
        PG8_WAIT_V(2); PG8_BAR;
        PG8_STAGE(PG8_SB(1, 0), cB + kstep, voffB); PG8_STAGE(PG8_SA(1, 0), cA + kstep, voffA); PG8_STAGE(PG8_SB(1, 1), cB + hstep + kstep, voffB);
        PG8_WAIT_V(6); PG8_BAR;
    } else {
        PG8_STAGE(PG8_SB(0, 0), cB, voffB); PG8_STAGE(PG8_SA(0, 0), cA, voffA); PG8_STAGE(PG8_SB(0, 1), cB + hstep, voffB); PG8_STAGE(PG8_SA(0, 1), cA + hstep, voffA);
        if (wr == 1) PG8_BAR;
        PG8_WAIT_V(4); PG8_BAR;
        PG8_STAGE(PG8_SB(1, 0), cB + kstep, voffB); PG8_STAGE(PG8_SA(1, 0), cA + kstep, voffA); PG8_STAGE(PG8_SB(1, 1), cB + hstep + kstep, voffB);
        PG8_WAIT_V(6); PG8_BAR;
    }
    for (;;) {
        const bool has_next = S.next(ui + 1, nxt);
        const char* nA = has_next ? (const char*)g.A + (size_t)nxt.pm * tstep : cA; const char* nB = has_next ? (const char*)g.Bt + (size_t)nxt.pn * tstep : cB;
        for (int t = 0; t < nt; t += 2) {
            const bool last = (t == nt - 2);
            const char* a1 = cA + (size_t)(t + 1) * kstep;
            const char* a2 = last ? nA : cA + (size_t)(t + 2) * kstep; const char* b2 = last ? nB : cB + (size_t)(t + 2) * kstep;
            const char* a3 = a2 + kstep; const char* b3 = b2 + kstep;
            if (last && has_next) S.a_ready(nxt);
            if constexpr (SP2) {
            PG8_LDB(B0, 0, 0); PG8_LDB(B1, 0, 1); PG8_SCHED; PG8_LDA(At, 0, 0); PG8_STAGE(PG8_SA(1, 1), a1 + hstep, voffA);
            PG8_WAIT_V(8); PG8_WAIT_L(0); PG8_BAR; PG8_MMA(0, 0, At, B0); PG8_MMA(0, 1, At, B1); PG8_BAR; PG8_SCHED;
            PG8_LDA(At, 0, 1); PG8_STAGE(PG8_SB(0, 0), b2, voffB); PG8_STAGE(PG8_SB(0, 1), b2 + hstep, voffB); PG8_STAGE(PG8_SA(0, 0), a2, voffA);
            PG8_WAIT_V(8); PG8_WAIT_L(0); PG8_BAR; PG8_MMA(1, 0, At, B0); PG8_MMA(1, 1, At, B1); PG8_BAR; PG8_SCHED;
            PG8_LDB(B0, 1, 0); PG8_LDB(B1, 1, 1); PG8_SCHED; PG8_LDA(At, 1, 0); PG8_STAGE(PG8_SA(0, 1), a2 + hstep, voffA);
            PG8_WAIT_V(8); PG8_WAIT_L(0); PG8_BAR; PG8_MMA(0, 0, At, B0); PG8_MMA(0, 1, At, B1); PG8_BAR; PG8_SCHED;
            PG8_LDA(At, 1, 1); PG8_STAGE(PG8_SB(1, 0), b3, voffB); PG8_STAGE(PG8_SB(1, 1), b3 + hstep, voffB); PG8_STAGE(PG8_SA(1, 0), a3, voffA);
            PG8_WAIT_V(8); PG8_WAIT_L(0); PG8_BAR; PG8_MMA(1, 0, At, B0); PG8_MMA(1, 1, At, B1); PG8_BAR; PG8_SCHED;
            } else {
            PG8_LDB(B0, 0, 0); PG8_SCHED; PG8_LDA(At, 0, 0); PG8_STAGE(PG8_SA(1, 1), a1 + hstep, voffA);
            PG8_WAIT_L(8); PG8_BAR; PG8_WAIT_L(0); PG8_MMA(0, 0, At, B0); PG8_BAR; PG8_SCHED;
            PG8_LDB(B1, 0, 1); PG8_STAGE(PG8_SB(0, 0), b2, voffB);
            PG8_BAR; PG8_WAIT_L(0); PG8_MMA(0, 1, At, B1); PG8_BAR;
            PG8_LDA(At, 0, 1); PG8_STAGE(PG8_SA(0, 0), a2, voffA);
            PG8_BAR; PG8_WAIT_L(0); PG8_MMA(1, 0, At, B0); PG8_BAR; PG8_SCHED;
            PG8_STAGE(PG8_SB(0, 1), b2 + hstep, voffB);
            PG8_WAIT_V(6); PG8_BAR; PG8_MMA(1, 1, At, B1); PG8_BAR;
            PG8_LDB(B0, 1, 0); PG8_SCHED; PG8_LDA(At, 1, 0); PG8_STAGE(PG8_SA(0, 1), a2 + hstep, voffA);
            PG8_WAIT_L(8); PG8_BAR; PG8_WAIT_L(0); PG8_MMA(0, 0, At, B0); PG8_BAR; PG8_SCHED;
            PG8_LDB(B1, 1, 1); PG8_STAGE(PG8_SB(1, 0), b3, voffB);
            PG8_BAR; PG8_WAIT_L(0); PG8_MMA(0, 1, At, B1); PG8_BAR;
            PG8_LDA(At, 1, 1); PG8_STAGE(PG8_SA(1, 0), a3, voffA);
            PG8_BAR; PG8_WAIT_L(0); PG8_MMA(1, 0, At, B0); PG8_BAR; PG8_SCHED;
            PG8_STAGE(PG8_SB(1, 1), b3 + hstep, voffB);
            PG8_WAIT_V(6); PG8_BAR; PG8_MMA(1, 1, At, B1); PG8_BAR;
            }
        }
        if constexpr (ALIGN_EPI) { if (wr == 0) PG8_BAR; }
        if constexpr (!Epi::AFTER_DRAIN) { E(acc, cur, wr, wc, fr, fq); S.done(cur); }
        if (!has_next) break;
#pragma unroll
        for (int a = 0; a < 2; ++a)
#pragma unroll
            for (int b = 0; b < 2; ++b)
#pragma unroll
                for (int m = 0; m < 4; ++m)
#pragma unroll
                    for (int n = 0; n < 2; ++n) acc[a][b][m][n] = acc_t{};
        cur = nxt; cA = nA; cB = nB; ++ui;
        if constexpr (ALIGN_EPI) { if (wr == 1) PG8_BAR; }
    }
    PG8_WAIT_V(0);
    if constexpr (!ALIGN_EPI) { if (wr == 0) PG8_BAR; }
    PG8_BAR;
    if constexpr (Epi::AFTER_DRAIN) { E.fused(acc, cur, wr, wc, fr, fq, lds, wid, lane); S.done(cur); }
#undef PG8_SA
#undef PG8_SB
#undef PG8_STAGE
#undef PG8_LDA
#undef PG8_LDB
#undef PG8_MMA
#undef PG8_WAIT_V
#undef PG8_WAIT_L
#undef PG8_BAR
#undef PG8_SCHED
}
}
constexpr int NWAVES = 8;
constexpr int BATCH = 4, SEQ = 8192, D = 1024, M = BATCH * SEQ, CTXL = 256, MC = BATCH * CTXL;
constexpr int NINE = 1792, NEXP = 32, EH = 512;
constexpr float EPS = 1e-6f;
constexpr int N_PHASES = 18;
#ifndef MK_ONE_LAUNCH
#define MK_ONE_LAUNCH 1
#endif
constexpr size_t MiB = 1u << 20;
constexpr size_t WS_CTL = 0, CTL_ZERO_BYTES = 1 * MiB;
constexpr size_t WS_MOD = 1 * MiB;
constexpr size_t WS_MODC = WS_MOD + 2 * 4 * 6144 * 4;
constexpr size_t WS_MODP = 1 * MiB + 768 * 1024;
static_assert(WS_MODC + 6144 * 4 <= 1 * MiB + 256 * 1024, "MOD/MODC overlap the rope tables");
constexpr size_t WS_ROPE = 1 * MiB + 256 * 1024;
constexpr size_t WS_WSP = 1 * MiB + 512 * 1024;
constexpr size_t WS_TOKE = 2 * MiB;
constexpr size_t WS_TOKP = 2 * MiB + 256 * 1024;
constexpr size_t WS_TOKW = 2 * MiB + 512 * 1024;
constexpr size_t WS_TOKS = 2 * MiB + 768 * 1024;
constexpr size_t WS_KC = 3 * MiB;
constexpr size_t WS_VCT = 3 * MiB + 256 * 1024;
constexpr size_t WS_VT = 4 * MiB;
constexpr size_t WS_WINE = 12 * MiB, WS_WOUTE = 16 * MiB, WS_WINO = 18 * MiB, WS_WOUTO = 24 * MiB;
constexpr size_t WS_WGU = 26 * MiB;
constexpr size_t WS_WD = 154 * MiB;
constexpr size_t WS_H = 218 * MiB;
constexpr size_t WS_A = 284 * MiB;
constexpr size_t WS_B = 428 * MiB;
constexpr size_t WS_RSS = 500 * MiB;
constexpr size_t WS_CSC = 502 * MiB;
constexpr size_t WS_CSC2 = 502 * MiB + 256 * 1024;
constexpr size_t WS_RSC = 502 * MiB + 512 * 1024;
constexpr size_t WS_END = 503 * MiB;
constexpr int CW_TMO = 0, CW_CODE = 1, CW_BAR = 4096, CW_GCNT = 8192;

constexpr int RING_BYTES = 131072;
constexpr int LDS_BYTES = 155648;
constexpr int MISC_OFF = LDS_BYTES - 256;
constexpr int MOE_TAB_OFF = RING_BYTES;
constexpr int RW_STRIDE = 2064;
constexpr int RT_WH = 0, RT_WL = 36 * RW_STRIDE, RT_CNT = 72 * RW_STRIDE, RT_BASE = RT_CNT + 128, RT_INFO = RT_CNT + 256;
static_assert(RT_INFO + 128 * 6 * 4 <= MISC_OFF, "LDS map");

#define GAS __attribute__((address_space(1)))
#define LAS __attribute__((address_space(3)))
typedef unsigned short bf16;
typedef unsigned v4u __attribute__((ext_vector_type(4)));
typedef unsigned v2u __attribute__((ext_vector_type(2)));
typedef float f32x4 __attribute__((ext_vector_type(4)));
typedef float f32x16 __attribute__((ext_vector_type(16)));
typedef short bf16x8 __attribute__((ext_vector_type(8)));
typedef GAS unsigned gu32;
#define RLX_AGENT __ATOMIC_RELAXED, __HIP_MEMORY_SCOPE_AGENT
#define LDS_WAIT() asm volatile("s_waitcnt lgkmcnt(0)" ::: "memory")
__device__ __forceinline__ unsigned f2bf(float f) { unsigned u = __builtin_bit_cast(unsigned, f); return (u + 0x7fffu + ((u >> 16) & 1u)) >> 16; }
__device__ __forceinline__ unsigned pk2(float lo, float hi) { return f2bf(lo) | (f2bf(hi) << 16); }
__device__ __forceinline__ float bflo(unsigned w) { return __builtin_bit_cast(float, w << 16); }
__device__ __forceinline__ float bfhi(unsigned w) { return __builtin_bit_cast(float, w & 0xffff0000u); }
__device__ __forceinline__ float wave_sum(float v) {
#pragma unroll
    for (int o = 1; o < 64; o <<= 1) v += __shfl_xor(v, o);
    return v;
}
#define XB_TMO      128
#define XB_XCNT(j)  (256  + 64 * (j))
#define XB_XSUB(j)  (1280 + 64 * (j))
#define XB_XGEN(j)  (2304 + 64 * (j))
#define XB_TOP      3328
#define XB_TOPGEN   3392
#define XCD_BAR_WORDS 3456
#define XB_SPIN_CAP (1u << 18)

__device__ __forceinline__ unsigned xb_ld(unsigned* p)              { return __hip_atomic_load(p, __ATOMIC_RELAXED, __HIP_MEMORY_SCOPE_AGENT); }
__device__ __forceinline__ unsigned xb_add(unsigned* p, unsigned v) { return __hip_atomic_fetch_add(p, v, __ATOMIC_RELAXED, __HIP_MEMORY_SCOPE_AGENT); }
__device__ __forceinline__ unsigned xb_xcc_id() { return (unsigned)__builtin_amdgcn_s_getreg((3 << 11) | 20) & 0xFu; }
#define XB_SPIN(cond, bar) do { unsigned _sp = 0; while (cond) { __builtin_amdgcn_s_sleep(1); \
    if ((++_sp & 255u) == 0u) { if (xb_ld(&(bar)[XB_TMO])) break; if (_sp > XB_SPIN_CAP) { atomicAdd(&(bar)[XB_TMO], 1u); break; } } } } while (0)

struct XcdBarrier {
    unsigned* bar; unsigned x;
    volatile LAS unsigned* st;
};

__device__ __forceinline__ XcdBarrier xcd_barrier_post(unsigned* bar, volatile LAS unsigned* st) {
    XcdBarrier b; b.bar = bar; b.x = xb_xcc_id(); b.st = st;
    if (threadIdx.x == 0) (void)xb_add(&bar[XB_XCNT(b.x)], 1u);
    return b;
}
__device__ __forceinline__ void xcd_barrier_complete(unsigned* bar, unsigned x, unsigned& nloc, unsigned& nx) {
    const unsigned G = gridDim.x * gridDim.y * gridDim.z;
    unsigned sum, cnt, mine, sp = 0u;
    for (;;) {
        sum = 0u; cnt = 0u; mine = 0u;
#pragma unroll
        for (unsigned j = 0; j < 16; ++j) { const unsigned c = xb_ld(&bar[XB_XCNT(j)]); sum += c; cnt += (c > 0u) ? 1u : 0u; mine = (j == x) ? c : mine; }
        if (sum == G) break;
        __builtin_amdgcn_s_sleep(1);
        if ((++sp & 255u) == 0u) { if (xb_ld(&bar[XB_TMO])) break; if (sp > XB_SPIN_CAP) { atomicAdd(&bar[XB_TMO], 1u); break; } }
    }
    nloc = mine > 0u ? mine : 1u; nx = cnt > 0u ? cnt : 1u;
}

__device__ __forceinline__ void xcd_barrier(const XcdBarrier& b, const int xb_tid) {
    asm volatile("s_waitcnt vmcnt(0)" ::: "memory");
    __syncthreads();
    if (xb_tid == 0) {
        unsigned* bar = b.bar;
        __builtin_amdgcn_s_waitcnt(0);
        unsigned nloc = b.st[0], nx = b.st[1];
        if (nloc == 0u) { xcd_barrier_complete(bar, b.x, nloc, nx); b.st[0] = nloc; b.st[1] = nx; }
        const unsigned old = xb_add(&bar[XB_XSUB(b.x)], 1u);
        const unsigned gen = old / nloc;
        if (old + 1u == (gen + 1u) * nloc) {
            __builtin_amdgcn_fence(__ATOMIC_RELEASE, "agent");
            asm volatile("s_waitcnt vmcnt(0)" ::: "memory");
            const unsigned og = xb_add(&bar[XB_TOP], 1u);
            const unsigned tg = og / nx;
            if (og + 1u == (tg + 1u) * nx) xb_add(&bar[XB_TOPGEN], 1u);
            else XB_SPIN(xb_ld(&bar[XB_TOPGEN]) == tg, bar);
            __builtin_amdgcn_fence(__ATOMIC_ACQUIRE, "agent");
            xb_add(&bar[XB_XGEN(b.x)], 1u);
            asm volatile("s_waitcnt vmcnt(0)" ::: "memory");
        } else {
            XB_SPIN(xb_ld(&bar[XB_XGEN(b.x)]) == gen, bar);
            __builtin_amdgcn_fence(__ATOMIC_ACQUIRE, "agent");
            asm volatile("s_waitcnt vmcnt(0)" ::: "memory");
        }
    }
    __syncthreads();
}

struct Args { const float* in[25]; float* out; unsigned char* ws; int ph_lo, ph_hi; };
struct Ctx {
    LAS unsigned char* lds; unsigned ldsaddr;
    int tid, lane, wave, G, bid;
    float* out; unsigned char* ws; gu32* ctl;
};
__device__ __forceinline__ const float* kin(int k) {
    const __attribute__((address_space(4))) Args* ka = (const __attribute__((address_space(4))) Args*)__builtin_amdgcn_kernarg_segment_ptr();
    return (const float*)(const GAS float*)ka->in[k];
}
__device__ const float ROPE_INV[16] = {1.000000000e+00f, 5.623413324e-01f, 3.162277639e-01f, 1.778279394e-01f, 1.000000015e-01f, 5.623413250e-02f, 3.162277490e-02f, 1.778279431e-02f,
                                       9.999999776e-03f, 5.623413250e-03f, 3.162277630e-03f, 1.778279431e-03f, 1.000000047e-03f, 5.623413017e-04f, 3.162277571e-04f, 1.778279402e-04f};

__device__ __forceinline__ void transpose_item(const float* W, int K, int N, bf16* WT, int k0, int n0, int drow0, LAS float* scr, int lane) {
#pragma unroll 8
    for (int i = 0; i < 32; ++i) { const int kk = 2 * i + (lane >> 5); scr[kk * 33 + (lane & 31)] = W[(size_t)(k0 + kk) * N + n0 + (lane & 31)]; }
    LDS_WAIT(); asm volatile("" ::: "memory");
    const int c = lane & 7;
#pragma unroll
    for (int j = 0; j < 4; ++j) { const int n = (lane >> 3) + 8 * j; const LAS float* s = scr + (8 * c) * 33 + n;
        v4u o; o.x = pk2(s[0 * 33], s[1 * 33]); o.y = pk2(s[2 * 33], s[3 * 33]); o.z = pk2(s[4 * 33], s[5 * 33]); o.w = pk2(s[6 * 33], s[7 * 33]);
        *(GAS v4u*)(WT + (size_t)(drow0 + n) * K + k0 + 8 * c) = o; }
    LDS_WAIT(); asm volatile("" ::: "memory");
}
__device__ __forceinline__ void sincos_acc(float a, float& s, float& c) {
    const double x = (double)a, kf = __builtin_rint(x * 0.63661977236758134308), r = x - kf * 1.57079632679489661923, r2 = r * r;
    const double sp = r * (1.0 + r2 * (-1.0 / 6 + r2 * (1.0 / 120 + r2 * (-1.0 / 5040 + r2 * (1.0 / 362880 + r2 * (-1.0 / 39916800 + r2 * (1.0 / 6227020800.0)))))));
    const double cp = 1.0 + r2 * (-0.5 + r2 * (1.0 / 24 + r2 * (-1.0 / 720 + r2 * (1.0 / 40320 + r2 * (-1.0 / 3628800 + r2 * (1.0 / 479001600 + r2 * (-1.0 / 87178291200.0)))))));
    const int k = (int)kf & 3;
    s = (float)((k == 0) ? sp : (k == 1) ? cp : (k == 2) ? -sp : -cp);
    c = (float)((k == 0) ? cp : (k == 1) ? -sp : (k == 2) ? -cp : sp);
}
__device__ __forceinline__ void adaln_unit(const Ctx& C, int u) {
    const int l = u / 96, col = (u % 96) * 64 + C.lane;
    LAS float* sil = (LAS float*)C.lds; LAS float* red = (LAS float*)(C.lds + 5 * 1024 * 4);
    for (int idx = C.tid; idx < 5120; idx += NWAVES * 64) { const float v = (idx < 4096) ? kin(1)[idx] : kin(3)[idx - 4096]; sil[idx] = v / (1.0f + __expf(-v)); }
    __syncthreads();
    float acc[5] = {0.f, 0.f, 0.f, 0.f, 0.f};
    const int k0 = C.wave * 128; const float* wp = kin(4) + (size_t)l * 1024 * 6144 + (size_t)k0 * 6144 + col;
#pragma unroll 8
    for (int kk = 0; kk < 128; ++kk) { const float w = wp[(size_t)kk * 6144];
#pragma unroll
        for (int v = 0; v < 5; ++v) acc[v] += sil[v * 1024 + k0 + kk] * w; }
#pragma unroll
    for (int v = 0; v < 5; ++v) red[(C.wave * 5 + v) * 64 + C.lane] = acc[v];
    __syncthreads();
    if (C.wave == 0) {
        float* MOD = (float*)(C.ws + WS_MOD); float* MODC = (float*)(C.ws + WS_MODC); float* MODP = (float*)(C.ws + WS_MODP); const float bias = kin(5)[l * 6144 + col];
#pragma unroll
        for (int v = 0; v < 5; ++v) { float s = 0.f;
#pragma unroll
            for (int w = 0; w < NWAVES; ++w) s += red[(w * 5 + v) * 64 + C.lane];
            s += bias;
            if (v < 4) { MOD[(size_t)(l * 4 + v) * 6144 + col] = s;
                const int ch = col >> 10;
                if (ch == 1 || ch == 4) { const int w2 = (ch == 4) ? 1 : 0; MODP[(size_t)((l * 4 + v) * 2 + w2) * 1024 + (col & 1023)] = ((w2 ? kin(7) : kin(6))[l * 1024 + (col & 1023)]) * (1.0f + s); }
            } else if (l == 0) MODC[col] = s; }
    }
    __syncthreads();
}
struct StripDesc { const float* W; int N, n0, drow0; unsigned char* W8; float* CSC; };
constexpr int N_STRIPS = 2048 + 96 + 32;
__device__ __forceinline__ StripDesc strip_desc(const Ctx& C, int st) {
    StripDesc d;
    if (st < 2048) { const int me = st >> 5, which = (st >> 4) & 1, j0 = 32 * (st & 15);
        d.W = (which ? kin(23) : kin(22)) + (size_t)me * 1024 * 512; d.N = 512; d.n0 = j0; d.W8 = (unsigned char*)(C.ws + WS_WGU) + (size_t)me * 1024 * 1024; d.CSC = (float*)(C.ws + WS_CSC) + (size_t)me * 1024;
        d.drow0 = 256 * (j0 >> 7) + (j0 & 127) + 128 * which;
    } else if (st < 2048 + 96) { const int n0 = 32 * (st - 2048), j = n0 & 1023;
        d.W = kin(15); d.N = 3072; d.n0 = n0; d.W8 = (unsigned char*)(C.ws + WS_WINO); d.CSC = (float*)(C.ws + WS_CSC2); d.drow0 = (n0 < 1024) ? 2048 + n0 : 256 * (j >> 7) + (j & 127) + ((n0 >= 2048) ? 128 : 0);
    } else { const int n0 = 32 * (st - 2048 - 96);
        d.W = kin(17); d.N = 1024; d.n0 = n0; d.W8 = (unsigned char*)(C.ws + WS_WOUTO); d.CSC = (float*)(C.ws + WS_CSC2) + 3072; d.drow0 = n0; }
    return d;
}
#define QS_LOAD(v, d) do { const float* p_ = (d).W + (size_t)(16 * kr) * (d).N + (d).n0 + 4 * c4; _Pragma("unroll") for (int i = 0; i < 16; ++i) v[i] = *(const f32x4*)(p_ + (size_t)i * (d).N); } while (0)
__device__ __forceinline__ void quant_strip_regs(const Ctx& C, const f32x4 (&v)[16], const StripDesc& d, int par) {
    const int c4 = C.tid & 7, kr = C.tid >> 3;
    LAS float* part = (LAS float*)(C.lds + par * 8448); LAS float* cmax = part + 2048;
    f32x4 mx = (f32x4){0.f, 0.f, 0.f, 0.f};
#pragma unroll
    for (int i = 0; i < 16; ++i) mx = __builtin_elementwise_max(mx, __builtin_elementwise_abs(v[i]));
#pragma unroll
    for (int j = 0; j < 4; ++j) part[kr * 32 + 4 * c4 + j] = mx[j];
    __syncthreads();
    if (C.tid < 32) { float m = 0.f;
        for (int g = 0; g < 64; ++g) m = fmaxf(m, part[g * 32 + C.tid]);
        cmax[C.tid] = m; d.CSC[d.drow0 + C.tid] = m > 0.f ? m * (1.0f / 127.0f) : 1.0f; }
    __syncthreads();
#pragma unroll
    for (int j = 0; j < 4; ++j) { const float am = cmax[4 * c4 + j], inv = am > 0.f ? 127.0f / am : 0.f; unsigned w[4];
#pragma unroll
        for (int g = 0; g < 4; ++g) { unsigned acc = 0u;
#pragma unroll
            for (int e = 0; e < 4; ++e) acc |= ((unsigned)(int)__builtin_rintf(v[4 * g + e][j] * inv) & 0xffu) << (8 * e);
            w[g] = acc; }
        *(v4u*)(d.W8 + (size_t)(d.drow0 + 4 * c4 + j) * 1024 + 16 * kr) = (v4u){w[0], w[1], w[2], w[3]}; }
}
__device__ __forceinline__ void quant_strips(const Ctx& C) {
    const int c4 = C.tid & 7, kr = C.tid >> 3;
    f32x4 va[16], vb[16];
    int st = C.bid; if (st >= N_STRIPS) return;
    StripDesc da = strip_desc(C, st), db = da; QS_LOAD(va, da);
#pragma unroll 1
    for (;;) {
        const bool hb = st + C.G < N_STRIPS; if (hb) { db = strip_desc(C, st + C.G); QS_LOAD(vb, db); }
        quant_strip_regs(C, va, da, 0);
        if (!hb) break;
        st += 2 * C.G; const bool ha = st < N_STRIPS; if (ha) { da = strip_desc(C, st); QS_LOAD(va, da); }
        quant_strip_regs(C, vb, db, 1);
        if (!ha) break;
    }
    __syncthreads();
}
#undef QS_LOAD
__device__ __forceinline__ void p0_prologue(const Ctx& C) {
    for (int u = C.bid; u < 192; u += C.G) adaln_unit(C, u);
    quant_strips(C);
    LAS float* scr = (LAS float*)(C.lds + C.wave * 16384);
    const int gw = C.bid * NWAVES + C.wave, NGW = C.G * NWAVES;
    constexpr int NDENSE = 896 + 512, NITEMS = NDENSE + 64 * 256;
    for (int it = gw; it < NITEMS; it += NGW) {
        int r = it;
        if (r < 896) { transpose_item(kin(9), 1024, 1792, (bf16*)(C.ws + WS_WINE), 64 * (r / 56), 32 * (r % 56), 32 * (r % 56), scr, C.lane); continue; } r -= 896;
        if (r < 512) { transpose_item(kin(14), 1024, 1024, (bf16*)(C.ws + WS_WOUTE), 64 * (r / 32), 32 * (r % 32), 32 * (r % 32), scr, C.lane); continue; } r -= 512;
        const int me = r >> 8, s = r & 255;
        transpose_item(kin(24) + (size_t)me * 512 * 1024, 512, 1024, (bf16*)(C.ws + WS_WD) + (size_t)me * 1024 * 512, 64 * (s >> 5), 32 * (s & 31), 32 * (s & 31), scr, C.lane);
    }
    for (int it = gw; it < 256; it += NGW) {
        const f32x4* src = (const f32x4*)(kin(12) + (size_t)it * 512) + 2 * C.lane; const f32x4 a = src[0], b = src[1];
        v4u o; o.x = pk2(a.x, a.y); o.y = pk2(a.z, a.w); o.z = pk2(b.x, b.y); o.w = pk2(b.z, b.w);
        *(v4u*)((bf16*)(C.ws + WS_WSP) + (size_t)it * 512 + 8 * C.lane) = o;
    }
    { const int gt = gw * 64 + C.lane;
        if (gt < 2048) { float s, c; sincos_acc((float)(gt >> 4) * ROPE_INV[gt & 15], s, c); ((float*)(C.ws + WS_ROPE))[gt] = c; ((float*)(C.ws + WS_ROPE))[2048 + gt] = s; } }
}

__device__ __forceinline__ void unpack8(const v4u w, float (&f)[8]) { f[0] = bflo(w.x); f[1] = bfhi(w.x); f[2] = bflo(w.y); f[3] = bfhi(w.y); f[4] = bflo(w.z); f[5] = bfhi(w.z); f[6] = bflo(w.w); f[7] = bfhi(w.w); }
__device__ __forceinline__ void load_mod(const float* gam, const float* shp, const float* scp, int lane, f32x4 (&sc)[4], f32x4 (&sh)[4]) {
#pragma unroll
    for (int j = 0; j < 4; ++j) { const int idx = lane + 64 * j; const f32x4 g = ((const f32x4*)gam)[idx], s = ((const f32x4*)scp)[idx]; sc[j] = g * (1.0f + s); sh[j] = ((const f32x4*)shp)[idx]; }
}
__device__ __forceinline__ float row_rinv(const f32x4 (&v)[4]) {
    float ss = 0.f;
#pragma unroll
    for (int j = 0; j < 4; ++j) ss += (v[j].x * v[j].x + v[j].y * v[j].y) + (v[j].z * v[j].z + v[j].w * v[j].w);
    return rsqrtf(wave_sum(ss) * (1.0f / 1024.0f) + EPS);
}
__device__ __forceinline__ void mod_store(const f32x4 (&v)[4], float rinv, const f32x4 (&sc)[4], const f32x4 (&sh)[4], bf16* orow, int lane) {
#pragma unroll
    for (int j = 0; j < 4; ++j) { const f32x4 o = v[j] * rinv * sc[j] + sh[j]; v2u w; w.x = pk2(o.x, o.y); w.y = pk2(o.z, o.w); ((v2u*)orow)[lane + 64 * j] = w; }
}
__device__ __forceinline__ void mod_store8(const f32x4 (&v)[4], float rinv, const f32x4 (&sc)[4], const f32x4 (&sh)[4], unsigned char* orow8, float* rsc, int lane) {
    f32x4 o[4]; float am = 0.f;
#pragma unroll
    for (int j = 0; j < 4; ++j) { o[j] = v[j] * rinv * sc[j] + sh[j]; am = fmaxf(am, fmaxf(fmaxf(fabsf(o[j].x), fabsf(o[j].y)), fmaxf(fabsf(o[j].z), fabsf(o[j].w)))); }
#pragma unroll
    for (int s = 1; s < 64; s <<= 1) am = fmaxf(am, __shfl_xor(am, s));
    const float inv = am > 0.f ? 127.0f / am : 0.f;
#pragma unroll
    for (int j = 0; j < 4; ++j) { const unsigned w = ((unsigned)(int)__builtin_rintf(o[j].x * inv) & 0xffu) | (((unsigned)(int)__builtin_rintf(o[j].y * inv) & 0xffu) << 8) | (((unsigned)(int)__builtin_rintf(o[j].z * inv) & 0xffu) << 16) | (((unsigned)(int)__builtin_rintf(o[j].w * inv) & 0xffu) << 24);
        ((unsigned*)orow8)[lane + 64 * j] = w; }
    if (lane == 0) *rsc = am > 0.f ? am * (1.0f / 127.0f) : 1.0f;
}
__device__ __forceinline__ void phase_norm1_l0(const Ctx& C) {
    const int gw = C.bid * NWAVES + C.wave, NGW = C.G * NWAVES;
    const float* MOD = (const float*)(C.ws + WS_MOD); const float* MODC = (const float*)(C.ws + WS_MODC); bf16* H = (bf16*)(C.ws + WS_H);
    for (int grp = gw; grp < (M + MC) / 16; grp += NGW) {
        f32x4 sc[4], sh[4]; const float* src;
        if (grp < M / 16) { const float* mod = MOD + (size_t)(grp >> 9) * 6144; load_mod(kin(6), mod, mod + 1024, C.lane, sc, sh); src = kin(0) + (size_t)grp * 16 * D; }
        else { load_mod(kin(6), MODC, MODC + 1024, C.lane, sc, sh); src = kin(2) + (size_t)(grp - M / 16) * 16 * D; }
        bf16* dst = H + (size_t)grp * 16 * D;
        f32x4 va[4][4], vb[4][4];
#define N1_LOAD(buf, r0) do { _Pragma("unroll") for (int r = 0; r < 4; ++r) _Pragma("unroll") for (int j = 0; j < 4; ++j) buf[r][j] = ((const f32x4*)(src + (size_t)((r0) + r) * D))[C.lane + 64 * j]; } while (0)
#define N1_PROC(buf, r0) do { _Pragma("unroll") for (int r = 0; r < 4; ++r) mod_store(buf[r], row_rinv(buf[r]), sc, sh, dst + (size_t)((r0) + r) * D, C.lane); } while (0)
        N1_LOAD(va, 0);
#pragma unroll 1
        for (int it = 0; it < 2; ++it) { const int r0 = 8 * it;
            N1_LOAD(vb, r0 + 4); N1_PROC(va, r0);
            if (it < 1) N1_LOAD(va, r0 + 8);
            N1_PROC(vb, r0 + 4); }
#undef N1_LOAD
#undef N1_PROC
    }
}
__device__ __forceinline__ void phase_router(const Ctx& C, int l) {
    LAS unsigned char* WH = C.lds + RT_WH; LAS unsigned char* WL = C.lds + RT_WL;
    LAS int* cnt = (LAS int*)(C.lds + RT_CNT); LAS int* base = (LAS int*)(C.lds + RT_BASE); LAS int* info = (LAS int*)(C.lds + RT_INFO);
    const float* wrg = kin(18) + l * 4096; const float* wre = kin(20) + l * 32768; const float* brg = kin(19) + l * 4; const float* bre = kin(21) + l * 32;
    for (int idx = C.tid; idx < 9216; idx += NWAVES * 64) { const int k = idx / 9, q9 = idx - 9 * k;
        const f32x4 v = (q9 == 0) ? *(const f32x4*)(wrg + 4 * k) : *(const f32x4*)(wre + 32 * k + 4 * (q9 - 1));
        const int row0 = (q9 == 0) ? 32 : 16 * ((q9 - 1) & 1) + 4 * ((q9 - 1) >> 1);
#pragma unroll
        for (int i = 0; i < 4; ++i) { const unsigned hi = f2bf(v[i]), lo = f2bf(v[i] - bflo(hi));
            *(LAS bf16*)(WH + (row0 + i) * RW_STRIDE + 2 * k) = (bf16)hi; *(LAS bf16*)(WL + (row0 + i) * RW_STRIDE + 2 * k) = (bf16)lo; } }
    if (C.tid < 32) cnt[C.tid] = 0;
    __syncthreads();
    const float* MOD = (const float*)(C.ws + WS_MOD); const float* MODP = (const float*)(C.ws + WS_MODP); const float* RSS = (const float*)(C.ws + WS_RSS); bf16* H = (bf16*)(C.ws + WS_H);
    gu32* gcnt = C.ctl + CW_GCNT + l * 32;
    int* TOKE = (int*)(C.ws + WS_TOKE); int* TOKP = (int*)(C.ws + WS_TOKP); float* TOKW = (float*)(C.ws + WS_TOKW);
    const int r = C.lane & 15, q = C.lane >> 4;
    for (int rb = C.bid; rb < M / 128; rb += C.G) {
        const int bq = rb >> 6; const size_t row = (size_t)rb * 128 + C.wave * 16 + r;
        float rinv; { const f32x4* rp = (const f32x4*)(RSS + row * 16); const f32x4 a = rp[0], b = rp[1], c = rp[2], d = rp[3];
            const f32x4 t = (a + b) + (c + d); rinv = rsqrtf(((t.x + t.y) + (t.z + t.w)) * (1.0f / 1024.0f) + EPS); }
        const f32x4* xr = (const f32x4*)(C.out + row * D + 8 * q);
        const f32x4* sp = (const f32x4*)(MODP + (size_t)((l * 4 + bq) * 2 + 1) * 1024 + 8 * q); const f32x4* hp = (const f32x4*)(MOD + (size_t)(l * 4 + bq) * 6144 + 3 * 1024 + 8 * q);
        bf16* hrow = H + row * D + 8 * q;
        const LAS unsigned char* a0 = WH + (C.lane & 15) * RW_STRIDE + 16 * q; const LAS unsigned char* a2 = WH + (32 + (C.lane & 3)) * RW_STRIDE + 16 * q;
        pg8::f32x4 acc[3];
#pragma unroll
        for (int t = 0; t < 3; ++t) acc[t] = (pg8::f32x4){0.f, 0.f, 0.f, 0.f};
        f32x4 xc[8], xn[8];
#pragma unroll
        for (int s = 0; s < 4; ++s) { xc[2 * s] = xr[8 * s]; xc[2 * s + 1] = xr[8 * s + 1]; }
        for (int kb = 0; kb < 8; ++kb) {
            if (kb < 7) {
#pragma unroll
                for (int s = 0; s < 4; ++s) { xn[2 * s] = xr[8 * (4 * (kb + 1) + s)]; xn[2 * s + 1] = xr[8 * (4 * (kb + 1) + s) + 1]; } }
            f32x4 sv[8], hv[8];
#pragma unroll
            for (int s = 0; s < 4; ++s) { sv[2 * s] = sp[8 * (4 * kb + s)]; sv[2 * s + 1] = sp[8 * (4 * kb + s) + 1]; hv[2 * s] = hp[8 * (4 * kb + s)]; hv[2 * s + 1] = hp[8 * (4 * kb + s) + 1]; }
#pragma unroll
            for (int s = 0; s < 4; ++s) { const int kk = 4 * kb + s;
                const f32x4 h0 = xc[2 * s] * rinv * sv[2 * s] + hv[2 * s], h1 = xc[2 * s + 1] * rinv * sv[2 * s + 1] + hv[2 * s + 1];
                v4u hi; hi.x = pg8::cvt_pk_bf16(h0.x, h0.y); hi.y = pg8::cvt_pk_bf16(h0.z, h0.w); hi.z = pg8::cvt_pk_bf16(h1.x, h1.y); hi.w = pg8::cvt_pk_bf16(h1.z, h1.w);
                v4u lo; lo.x = pg8::cvt_pk_bf16(h0.x - bflo(hi.x), h0.y - bfhi(hi.x)); lo.y = pg8::cvt_pk_bf16(h0.z - bflo(hi.y), h0.w - bfhi(hi.y));
                lo.z = pg8::cvt_pk_bf16(h1.x - bflo(hi.z), h1.y - bfhi(hi.z)); lo.w = pg8::cvt_pk_bf16(h1.z - bflo(hi.w), h1.w - bfhi(hi.w));
                *(v4u*)(hrow + 32 * kk) = hi;
                const bf16x8 bh = __builtin_bit_cast(bf16x8, hi), bl = __builtin_bit_cast(bf16x8, lo);
#pragma unroll
                for (int t = 0; t < 3; ++t) { const LAS unsigned char* ap = ((t == 2) ? a2 : a0 + 16 * t * RW_STRIDE) + 64 * kk;
                    const bf16x8 ah = *(const LAS bf16x8*)ap, al = *(const LAS bf16x8*)(ap + RT_WL);
                    acc[t] = __builtin_amdgcn_mfma_f32_16x16x32_bf16(ah, bh, acc[t], 0, 0, 0);
                    acc[t] = __builtin_amdgcn_mfma_f32_16x16x32_bf16(al, bh, acc[t], 0, 0, 0);
                    acc[t] = __builtin_amdgcn_mfma_f32_16x16x32_bf16(ah, bl, acc[t], 0, 0, 0); } }
            if (kb < 7) {
#pragma unroll
                for (int s = 0; s < 8; ++s) xc[s] = xn[s]; }
        }
        float gl[4];
#pragma unroll
        for (int gi = 0; gi < 4; ++gi) gl[gi] = acc[2][gi] + brg[gi];
        int gidx = 0; float gmax = gl[0];
#pragma unroll
        for (int gi = 1; gi < 4; ++gi) if (gl[gi] > gmax) { gmax = gl[gi]; gidx = gi; }
        if (q == gidx) {
            float den = 0.f;
#pragma unroll
            for (int gi = 0; gi < 4; ++gi) den += __expf(gl[gi] - gmax);
            const float gwt = 1.0f / den;
            float ev[8];
#pragma unroll
            for (int j = 0; j < 8; ++j) ev[j] = acc[j >> 2][j & 3] + bre[8 * q + j];
            int i0 = 0; float v0 = ev[0];
#pragma unroll
            for (int j = 1; j < 8; ++j) if (ev[j] > v0) { v0 = ev[j]; i0 = j; }
            int i1 = (i0 == 0) ? 1 : 0; float v1 = (i0 == 0) ? ev[1] : ev[0];
#pragma unroll
            for (int j = 1; j < 8; ++j) if (j != i0 && ev[j] > v1) { v1 = ev[j]; i1 = j; }
            const float t = __expf(v1 - v0), p0 = 1.0f / (1.0f + t), p1 = t * p0;
            const int rr = C.wave * 16 + r, e0 = gidx * 8 + i0, e1 = gidx * 8 + i1;
            const int pl0 = __hip_atomic_fetch_add(cnt + e0, 1, __ATOMIC_RELAXED, __HIP_MEMORY_SCOPE_WORKGROUP), pl1 = __hip_atomic_fetch_add(cnt + e1, 1, __ATOMIC_RELAXED, __HIP_MEMORY_SCOPE_WORKGROUP);
            info[rr * 6 + 0] = e0; info[rr * 6 + 1] = e1; info[rr * 6 + 2] = pl0; info[rr * 6 + 3] = pl1;
            info[rr * 6 + 4] = __builtin_bit_cast(int, gwt * p0); info[rr * 6 + 5] = __builtin_bit_cast(int, gwt * p1);
        }
        __syncthreads();
        if (C.tid < 32) base[C.tid] = (int)__hip_atomic_fetch_add(gcnt + C.tid, (unsigned)cnt[C.tid], RLX_AGENT);
        __syncthreads();
        if (C.tid < 128) { const size_t orow = (size_t)rb * 128 + C.tid; const int e0 = info[C.tid * 6], e1 = info[C.tid * 6 + 1];
            TOKE[orow] = e0 | (e1 << 8); TOKP[orow * 2] = base[e0] + info[C.tid * 6 + 2]; TOKP[orow * 2 + 1] = base[e1] + info[C.tid * 6 + 3];
            TOKW[orow * 2] = __builtin_bit_cast(float, info[C.tid * 6 + 4]); TOKW[orow * 2 + 1] = __builtin_bit_cast(float, info[C.tid * 6 + 5]); }
        __syncthreads();
        if (C.tid < 32) cnt[C.tid] = 0;
        __syncthreads();
    }
}
__device__ __forceinline__ int moe_tables(const Ctx& C, int l) {
    LAS int* tile_e = (LAS int*)(C.lds + MOE_TAB_OFF); LAS int* seg = (LAS int*)(C.lds + MOE_TAB_OFF + 1280); LAS int* lc = (LAS int*)(C.lds + MOE_TAB_OFF + 1280 + 160);
    if (C.tid < 32) lc[C.tid] = (int)__hip_atomic_load(C.ctl + CW_GCNT + l * 32 + C.tid, RLX_AGENT);
    __syncthreads();
    if (C.tid == 0) { int t = 0;
        for (int e = 0; e < 32; ++e) { seg[e] = t * 256; const int n = (lc[e] + 255) >> 8; for (int k = 0; k < n; ++k) tile_e[t + k] = e; t += n; }
        seg[32] = t * 256; }
    __syncthreads();
    return seg[32] >> 8;
}
__device__ __forceinline__ void phase_scatter(const Ctx& C, int l) {
    (void)moe_tables(C, l);
    const LAS int* seg = (const LAS int*)(C.lds + MOE_TAB_OFF + 1280);
    const int gw = C.bid * NWAVES + C.wave, NGW = C.G * NWAVES;
    const int* TOKE = (const int*)(C.ws + WS_TOKE); const int* TOKP = (const int*)(C.ws + WS_TOKP); int* TOKS = (int*)(C.ws + WS_TOKS);
    const bf16* H = (const bf16*)(C.ws + WS_H); unsigned char* XS = (unsigned char*)(C.ws + WS_A); float* RSC = (float*)(C.ws + WS_RSC);
    for (int grp = gw; grp < M / 16; grp += NGW) {
        const int tev = TOKE[(size_t)grp * 16 + (C.lane & 15)], tpv = TOKP[(size_t)grp * 32 + (C.lane & 31)];
        v4u ha[4][2];
#define SC_LOAD(r0) do { _Pragma("unroll") for (int r = 0; r < 4; ++r) { ha[r][0] = ((const v4u*)(H + ((size_t)grp * 16 + (r0) + r) * D))[C.lane]; ha[r][1] = ((const v4u*)(H + ((size_t)grp * 16 + (r0) + r) * D))[C.lane + 64]; } } while (0)
#pragma unroll 1
        for (int r0 = 0; r0 < 16; r0 += 4) {
            SC_LOAD(r0);
#pragma unroll
            for (int r = 0; r < 4; ++r) { const size_t row = (size_t)grp * 16 + r0 + r; const int ee = __builtin_amdgcn_readlane(tev, r0 + r);
                const int s0 = seg[ee & 255] + __builtin_amdgcn_readlane(tpv, 2 * (r0 + r)), s1 = seg[ee >> 8] + __builtin_amdgcn_readlane(tpv, 2 * (r0 + r) + 1);
                float f[2][8]; unpack8(ha[r][0], f[0]); unpack8(ha[r][1], f[1]);
                float am = 0.f;
#pragma unroll
                for (int j = 0; j < 2; ++j)
#pragma unroll
                    for (int e = 0; e < 8; ++e) am = fmaxf(am, fabsf(f[j][e]));
#pragma unroll
                for (int o = 1; o < 64; o <<= 1) am = fmaxf(am, __shfl_xor(am, o));
                const float inv = am > 0.f ? 127.0f / am : 0.f;
                v2u q[2];
#pragma unroll
                for (int j = 0; j < 2; ++j) { unsigned w0 = 0u, w1 = 0u;
#pragma unroll
                    for (int e = 0; e < 4; ++e) { w0 |= ((unsigned)(int)__builtin_rintf(f[j][e] * inv) & 0xffu) << (8 * e); w1 |= ((unsigned)(int)__builtin_rintf(f[j][4 + e] * inv) & 0xffu) << (8 * e); }
                    q[j] = (v2u){w0, w1}; }
                ((v2u*)(XS + (size_t)s0 * 1024))[C.lane] = q[0]; ((v2u*)(XS + (size_t)s0 * 1024))[C.lane + 64] = q[1];
                ((v2u*)(XS + (size_t)s1 * 1024))[C.lane] = q[0]; ((v2u*)(XS + (size_t)s1 * 1024))[C.lane + 64] = q[1];
                if (C.lane == 0) { const float sc = am > 0.f ? am * (1.0f / 127.0f) : 1.0f; TOKS[row * 2] = s0; TOKS[row * 2 + 1] = s1; RSC[s0] = sc; RSC[s1] = sc; } }
        }
#undef SC_LOAD
    }
}
template <bool FINAL> __device__ __forceinline__ void phase_combine(const Ctx& C, int lp) {
    const int gw = C.bid * NWAVES + C.wave, NGW = C.G * NWAVES;
    const float* MOD = (const float*)(C.ws + WS_MOD); bf16* H = (bf16*)(C.ws + WS_H); const bf16* YB = (const bf16*)(C.ws + WS_A);
    const int* TOKS = (const int*)(C.ws + WS_TOKS); const float* TOKW = (const float*)(C.ws + WS_TOKW);
    for (int grp = gw; grp < M / 16; grp += NGW) {
        const int b = grp >> 9; f32x4 g2[4], sc[4], sh[4];
#pragma unroll
        for (int j = 0; j < 4; ++j) g2[j] = ((const f32x4*)(MOD + (size_t)(lp * 4 + b) * 6144 + 5 * 1024))[C.lane + 64 * j];
        if (FINAL) {
#pragma unroll
            for (int j = 0; j < 4; ++j) { sc[j] = ((const f32x4*)kin(8))[C.lane + 64 * j]; sh[j] = (f32x4){0.f, 0.f, 0.f, 0.f}; }
        } else { const float* mod = MOD + (size_t)(4 + b) * 6144; load_mod(kin(6) + 1024, mod, mod + 1024, C.lane, sc, sh); }
        const int tsv = TOKS[(size_t)grp * 32 + (C.lane & 31)], twv = __builtin_bit_cast(int, TOKW[(size_t)grp * 32 + (C.lane & 31)]);
        f32x4 xv[2][4]; v2u ya[2][4], yc[2][4]; float w0[2], w1[2];
#define CB_LOAD(buf, r0) do { const size_t row_ = (size_t)grp * 16 + (r0); \
            const int s0_ = __builtin_amdgcn_readlane(tsv, 2 * (r0)), s1_ = __builtin_amdgcn_readlane(tsv, 2 * (r0) + 1); \
            w0[buf] = __builtin_bit_cast(float, __builtin_amdgcn_readlane(twv, 2 * (r0))); w1[buf] = __builtin_bit_cast(float, __builtin_amdgcn_readlane(twv, 2 * (r0) + 1)); \
            _Pragma("unroll") for (int j = 0; j < 4; ++j) { xv[buf][j] = ((const f32x4*)(C.out + row_ * D))[C.lane + 64 * j]; \
                ya[buf][j] = ((const v2u*)(YB + (size_t)s0_ * D))[C.lane + 64 * j]; yc[buf][j] = ((const v2u*)(YB + (size_t)s1_ * D))[C.lane + 64 * j]; } } while (0)
#define CB_PROC(buf, r0) do { const size_t row = (size_t)grp * 16 + (r0); f32x4 v[4]; \
            _Pragma("unroll") for (int j = 0; j < 4; ++j) { const v2u a = ya[buf][j], c = yc[buf][j]; \
                const f32x4 y0 = (f32x4){bflo(a.x), bfhi(a.x), bflo(a.y), bfhi(a.y)}, y1 = (f32x4){bflo(c.x), bfhi(c.x), bflo(c.y), bfhi(c.y)}; \
                v[j] = xv[buf][j] + g2[j] * (y0 * w0[buf] + y1 * w1[buf]); } \
            const float rinv = row_rinv(v); \
            if (FINAL) { _Pragma("unroll") for (int j = 0; j < 4; ++j) ((f32x4*)(C.out + row * D))[C.lane + 64 * j] = v[j] * rinv * sc[j]; } \
            else { _Pragma("unroll") for (int j = 0; j < 4; ++j) ((f32x4*)(C.out + row * D))[C.lane + 64 * j] = v[j]; mod_store8(v, rinv, sc, sh, (unsigned char*)H + row * D, (float*)(C.ws + WS_RSC) + row, C.lane); } } while (0)
        CB_LOAD(0, 0);
#pragma unroll 1
        for (int it = 0; it < 8; ++it) { const int r0 = 2 * it;
            CB_LOAD(1, r0 + 1); CB_PROC(0, r0);
            if (it < 7) CB_LOAD(0, r0 + 2);
            CB_PROC(1, r0 + 1); }
#undef CB_PROC
#undef CB_LOAD
    }
}
__device__ __forceinline__ void phase_conv(const Ctx& C) {
    const int gw = C.bid * NWAVES + C.wave, NGW = C.G * NWAVES;
    const bf16* BG = (const bf16*)(C.ws + WS_A); const bf16* Y = BG + (size_t)M * D; unsigned char* MIX8 = (unsigned char*)(C.ws + WS_B); float* RSC = (float*)(C.ws + WS_RSC);
    float cw[3][2][8];
#pragma unroll
    for (int t = 0; t < 3; ++t)
#pragma unroll
        for (int j = 0; j < 2; ++j) { const f32x4 a = *(const f32x4*)(kin(16) + t * 1024 + j * 512 + 8 * C.lane), b = *(const f32x4*)(kin(16) + t * 1024 + j * 512 + 8 * C.lane + 4);
            cw[t][j][0] = a.x; cw[t][j][1] = a.y; cw[t][j][2] = a.z; cw[t][j][3] = a.w; cw[t][j][4] = b.x; cw[t][j][5] = b.y; cw[t][j][6] = b.z; cw[t][j][7] = b.w; }
    const v4u zero4 = (v4u){0u, 0u, 0u, 0u};
    for (int grp = gw; grp < M / 16; grp += NGW) {
        const size_t t0 = (size_t)grp * 16; v4u prev[2], cur[2];
        v4u yn[2][2], bgv[2][2];
#define CV_LOAD(buf, r0) do { const size_t row_ = t0 + (r0); const bool last_ = (row_ & 8191) == 8191; \
            _Pragma("unroll") for (int j = 0; j < 2; ++j) { yn[buf][j] = last_ ? zero4 : ((const v4u*)(Y + (row_ + 1) * D))[C.lane + 64 * j]; bgv[buf][j] = ((const v4u*)(BG + row_ * D))[C.lane + 64 * j]; } } while (0)
#pragma unroll
        for (int j = 0; j < 2; ++j) { prev[j] = ((t0 & 8191) == 0) ? zero4 : ((const v4u*)(Y + (t0 - 1) * D))[C.lane + 64 * j]; cur[j] = ((const v4u*)(Y + t0 * D))[C.lane + 64 * j]; }
#define CV_PROC(buf, r0) do { const size_t row = t0 + (r0); float ov[2][8]; float am = 0.f; \
            _Pragma("unroll") for (int j = 0; j < 2; ++j) { const v4u nx = yn[buf][j]; \
                float fp[8], fc[8], fn[8], fb[8]; unpack8(prev[j], fp); unpack8(cur[j], fc); unpack8(nx, fn); unpack8(bgv[buf][j], fb); \
                _Pragma("unroll") for (int e = 0; e < 8; ++e) { ov[j][e] = fb[e] * (fp[e] * cw[0][j][e] + fc[e] * cw[1][j][e] + fn[e] * cw[2][j][e]); am = fmaxf(am, fabsf(ov[j][e])); } \
                prev[j] = cur[j]; cur[j] = nx; } \
            _Pragma("unroll") for (int s_ = 1; s_ < 64; s_ <<= 1) am = fmaxf(am, __shfl_xor(am, s_)); \
            const float inv = am > 0.f ? 127.0f / am : 0.f; \
            _Pragma("unroll") for (int j = 0; j < 2; ++j) { unsigned w0 = 0u, w1 = 0u; \
                _Pragma("unroll") for (int e = 0; e < 4; ++e) { w0 |= ((unsigned)(int)__builtin_rintf(ov[j][e] * inv) & 0xffu) << (8 * e); w1 |= ((unsigned)(int)__builtin_rintf(ov[j][4 + e] * inv) & 0xffu) << (8 * e); } \
                ((v2u*)(MIX8 + row * D))[C.lane + 64 * j] = (v2u){w0, w1}; } \
            if (C.lane == 0) RSC[row] = am > 0.f ? am * (1.0f / 127.0f) : 1.0f; } while (0)
        CV_LOAD(0, 0);
#pragma unroll 1
        for (int it = 0; it < 8; ++it) { const int r0 = 2 * it;
            CV_LOAD(1, r0 + 1); CV_PROC(0, r0);
            if (it < 7) CV_LOAD(0, r0 + 2);
            CV_PROC(1, r0 + 1); }
#undef CV_PROC
#undef CV_LOAD
    }
}
constexpr float LOG2E = 1.4426950408889634f;
constexpr float QSCALE = 0.125f * LOG2E;
constexpr int AT_K = 0, AT_V = 16384, AT_WS = 32768, AT_ST = 34816;
__device__ __forceinline__ int crow(int r, int hi) { return (r & 3) + 8 * (r >> 2) + 4 * hi; }
__device__ __forceinline__ bf16x8 pack8(float a0, float a1, float a2, float a3, float a4, float a5, float a6, float a7) {
    v4u w; w.x = pg8::cvt_pk_bf16(a0, a1); w.y = pg8::cvt_pk_bf16(a2, a3); w.z = pg8::cvt_pk_bf16(a4, a5); w.w = pg8::cvt_pk_bf16(a6, a7); return __builtin_bit_cast(bf16x8, w);
}
__device__ __forceinline__ void attn_unit(const Ctx& C, int au) {
    const int qblk = au & 127, kvh = (au >> 7) & 1, b = au >> 8;
    const int ph = C.wave & 1, head = kvh * 4 + (C.wave >> 1), q32 = C.lane & 31, hi = C.lane >> 5;
    const bf16* QK = (const bf16*)(C.ws + WS_A); const bf16* VT = (const bf16*)(C.ws + WS_VT); const bf16* KC = (const bf16*)(C.ws + WS_KC); const bf16* VCT = (const bf16*)(C.ws + WS_VCT);
    bf16* MIX = (bf16*)(C.ws + WS_B);
    const size_t qrow = (size_t)b * SEQ + 64 * qblk + 32 * ph + q32;
    bf16x8 qf[4];
#pragma unroll
    for (int ds = 0; ds < 4; ++ds) qf[ds] = *(const bf16x8*)(QK + qrow * NINE + head * 64 + 16 * ds + 8 * hi);
    float m = kin(10)[head] * LOG2E, l = (hi == 0) ? 1.0f : 0.0f;
    f32x16 o0, o1;
#pragma unroll
    for (int r = 0; r < 16; ++r) { o0[r] = 0.f; o1[r] = 0.f; }
    const int jlo = (qblk < 2) ? 2 - qblk : 0, jhi = (qblk > 125) ? 129 - qblk : 4, NT = 4 + jhi - jlo + 1;
    const int prow = C.tid >> 3, pch = C.tid & 7;
    LAS float* wsf = (LAS float*)(C.lds + AT_WS) + C.wave * 64;
    v4u kr0, vr0, kr1, vr1;
#define AT_LOAD(t, kreg, vreg) do { if ((t) < 4) { kreg = *(const v4u*)(KC + ((size_t)(b * 256 + 64 * (t) + prow) * 128 + kvh * 64 + 8 * pch)); \
            vreg = *(const v4u*)(VCT + ((size_t)((b * 2 + kvh) * 64 + prow) * 256 + 64 * (t) + 8 * pch)); } \
        else { const int kblk_ = qblk - 2 + jlo + (t) - 4; kreg = *(const v4u*)(QK + ((size_t)(b * SEQ + 64 * kblk_ + prow) * NINE + 512 + kvh * 64 + 8 * pch)); \
            vreg = *(const v4u*)(VT + ((size_t)((b * 2 + kvh) * 64 + prow) * SEQ + 64 * kblk_ + 8 * pch)); } } while (0)
#define AT_WRITE(bufi, kreg, vreg) do { *(LAS v4u*)(C.lds + AT_K + (bufi) * 8192 + pch * 1024 + prow * 16) = kreg; *(LAS v4u*)(C.lds + AT_V + (bufi) * 8192 + pch * 1024 + prow * 16) = vreg; } while (0)
    AT_LOAD(0, kr0, vr0); AT_LOAD(1, kr1, vr1);
    AT_WRITE(0, kr0, vr0); AT_LOAD(2, kr0, vr0);
    __syncthreads();
    for (int t = 0; t < NT; ++t) {
        const int buf = t & 1;
        if (t + 1 < NT) {
            if (buf == 0) { AT_WRITE(1, kr1, vr1); if (t + 3 < NT) AT_LOAD(t + 3, kr1, vr1); }
            else { AT_WRITE(0, kr0, vr0); if (t + 3 < NT) AT_LOAD(t + 3, kr0, vr0); }
        }
        const LAS unsigned char* kb = C.lds + AT_K + buf * 8192; const LAS unsigned char* vb = C.lds + AT_V + buf * 8192;
        f32x16 p0, p1;
#pragma unroll
        for (int r = 0; r < 16; ++r) { p0[r] = 0.f; p1[r] = 0.f; }
#pragma unroll
        for (int ds = 0; ds < 4; ++ds) {
            const bf16x8 a0 = *(const LAS bf16x8*)(kb + (2 * ds + hi) * 1024 + q32 * 16), a1 = *(const LAS bf16x8*)(kb + (2 * ds + hi) * 1024 + (q32 + 32) * 16);
            p0 = __builtin_amdgcn_mfma_f32_32x32x16_bf16(a0, qf[ds], p0, 0, 0, 0); p1 = __builtin_amdgcn_mfma_f32_32x32x16_bf16(a1, qf[ds], p1, 0, 0, 0);
        }
        const int j = (t < 4) ? -1 : jlo + t - 4;
        if (j == 0 || j == 4) {
            int qq = 32 * ph + q32; asm volatile("" : "+v"(qq));
#pragma unroll
            for (int r = 0; r < 16; ++r) { const int kv = crow(r, hi);
                const bool d0 = (j == 0) ? (kv < qq) : (kv > qq), d1 = (j == 0) ? (kv + 32 < qq) : (kv + 32 > qq);
                if (d0) p0[r] = -__builtin_inff(); if (d1) p1[r] = -__builtin_inff(); }
        }
        float rm = fmaxf(p0[0], p1[0]);
#pragma unroll
        for (int r = 1; r < 16; ++r) rm = fmaxf(rm, fmaxf(p0[r], p1[r]));
        rm = fmaxf(rm, __shfl_xor(rm, 32));
        if (__any(rm > m)) {
            const float mn = fmaxf(m, rm), al = __builtin_amdgcn_exp2f(m - mn); m = mn; l *= al;
            if (hi == 0) wsf[q32] = al;
#pragma unroll
            for (int r = 0; r < 16; ++r) { const float f = wsf[crow(r, hi)]; o0[r] *= f; o1[r] *= f; }
        }
        float ls = 0.f;
#pragma unroll
        for (int r = 0; r < 16; ++r) { p0[r] = __builtin_amdgcn_exp2f(p0[r] - m); p1[r] = __builtin_amdgcn_exp2f(p1[r] - m); ls += p0[r] + p1[r]; }
        l += ls;
#pragma unroll
        for (int s = 0; s < 2; ++s) {
            const bf16x8 pa = pack8(p0[8 * s], p0[8 * s + 1], p0[8 * s + 2], p0[8 * s + 3], p0[8 * s + 4], p0[8 * s + 5], p0[8 * s + 6], p0[8 * s + 7]);
            const bf16x8 pb = pack8(p1[8 * s], p1[8 * s + 1], p1[8 * s + 2], p1[8 * s + 3], p1[8 * s + 4], p1[8 * s + 5], p1[8 * s + 6], p1[8 * s + 7]);
            const bf16x8 va0 = *(const LAS bf16x8*)(vb + (2 * s + hi) * 1024 + q32 * 16), va1 = *(const LAS bf16x8*)(vb + (2 * s + hi) * 1024 + (q32 + 32) * 16);
            const bf16x8 vb0 = *(const LAS bf16x8*)(vb + (4 + 2 * s + hi) * 1024 + q32 * 16), vb1 = *(const LAS bf16x8*)(vb + (4 + 2 * s + hi) * 1024 + (q32 + 32) * 16);
            o0 = __builtin_amdgcn_mfma_f32_32x32x16_bf16(pa, va0, o0, 0, 0, 0); o1 = __builtin_amdgcn_mfma_f32_32x32x16_bf16(pa, va1, o1, 0, 0, 0);
            o0 = __builtin_amdgcn_mfma_f32_32x32x16_bf16(pb, vb0, o0, 0, 0, 0); o1 = __builtin_amdgcn_mfma_f32_32x32x16_bf16(pb, vb1, o1, 0, 0, 0);
        }
        __syncthreads();
    }
#undef AT_LOAD
#undef AT_WRITE
    l += __shfl_xor(l, 32);
    if (hi == 0) wsf[32 + q32] = l;
    LAS bf16* stg = (LAS bf16*)(C.lds + AT_ST) + C.wave * 2048;
#pragma unroll
    for (int r = 0; r < 16; ++r) { const int orow = crow(r, hi); const float rl = 1.0f / wsf[32 + orow];
        stg[orow * 64 + q32] = (bf16)f2bf(o0[r] * rl); stg[orow * 64 + 32 + q32] = (bf16)f2bf(o1[r] * rl); }
    bf16* Ow = MIX + ((size_t)b * SEQ + 64 * qblk + 32 * ph) * D + head * 64;
#pragma unroll
    for (int i = 0; i < 4; ++i) { const int pc = i * 64 + C.lane, row = pc >> 3, ch = pc & 7; const v4u v = *(const LAS v4u*)(stg + row * 64 + ch * 8); *(v4u*)(Ow + (size_t)row * D + ch * 8) = v; }
    __syncthreads();
}
constexpr int ZS = 1040;
__device__ __forceinline__ v2u tr_read(unsigned addr) { v2u r; asm volatile("ds_read_b64_tr_b16 %0, %1\n\ts_waitcnt lgkmcnt(0)" : "=&v"(r) : "v"(addr) : "memory"); return r; }
__device__ __forceinline__ void sgu_unit(const Ctx& C, int su) {
    const size_t R0 = (size_t)su * 128;
    const bf16* QK = (const bf16*)(C.ws + WS_A); bf16* MIX = (bf16*)(C.ws + WS_B); const bf16* WSP = (const bf16*)(C.ws + WS_WSP);
    { float gs[8]; const f32x4 a = *(const f32x4*)(kin(11) + 8 * C.lane), c = *(const f32x4*)(kin(11) + 8 * C.lane + 4);
        gs[0] = a.x; gs[1] = a.y; gs[2] = a.z; gs[3] = a.w; gs[4] = c.x; gs[5] = c.y; gs[6] = c.z; gs[7] = c.w;
#pragma unroll 4
        for (int rr = 0; rr < 16; ++rr) { const int j = C.wave * 16 + rr;
            const v4u zw = *(const v4u*)(QK + (R0 + j) * NINE + 1280 + 8 * C.lane); float x[8]; unpack8(zw, x);
            float s = 0.f;
#pragma unroll
            for (int e = 0; e < 8; ++e) s += x[e];
            const float mean = wave_sum(s) * (1.0f / 512.0f); float q = 0.f;
#pragma unroll
            for (int e = 0; e < 8; ++e) { x[e] -= mean; q += x[e] * x[e]; }
            const float rstd = rsqrtf(wave_sum(q) * (1.0f / 512.0f) + EPS);
            v4u w; w.x = pk2(x[0] * rstd * gs[0], x[1] * rstd * gs[1]); w.y = pk2(x[2] * rstd * gs[2], x[3] * rstd * gs[3]);
            w.z = pk2(x[4] * rstd * gs[4], x[5] * rstd * gs[5]); w.w = pk2(x[6] * rstd * gs[6], x[7] * rstd * gs[7]);
            *(LAS v4u*)(C.lds + j * ZS + 16 * C.lane) = w; }
    }
    __syncthreads();
    const int h = C.wave, l31 = C.lane & 31, hi = C.lane >> 5, g16 = (C.lane >> 4) & 1, q4 = (C.lane & 15) >> 2, p4 = C.lane & 3;
    f32x16 acc[2][4];
#pragma unroll
    for (int cb = 0; cb < 2; ++cb)
#pragma unroll
        for (int ib = 0; ib < 4; ++ib)
#pragma unroll
            for (int r = 0; r < 16; ++r) acc[cb][ib][r] = 0.f;
#pragma unroll 2
    for (int ks = 0; ks < 8; ++ks) {
        bf16x8 bw[4];
#pragma unroll
        for (int ib = 0; ib < 4; ++ib) bw[ib] = *(const bf16x8*)(WSP + ((size_t)h * 128 + 32 * ib + l31) * 128 + 16 * ks + 8 * hi);
        bf16x8 az[2];
#pragma unroll
        for (int cb = 0; cb < 2; ++cb) {
            const unsigned a0 = C.ldsaddr + (unsigned)((16 * ks + 8 * hi + q4) * ZS + (64 * h + 32 * cb + 16 * g16 + 4 * p4) * 2);
            const v2u lo = tr_read(a0), hi2 = tr_read(a0 + 4 * ZS);
            az[cb] = __builtin_bit_cast(bf16x8, (v4u){lo.x, lo.y, hi2.x, hi2.y});
        }
#pragma unroll
        for (int cb = 0; cb < 2; ++cb)
#pragma unroll
            for (int ib = 0; ib < 4; ++ib) acc[cb][ib] = __builtin_amdgcn_mfma_f32_32x32x16_bf16(az[cb], bw[ib], acc[cb][ib], 0, 0, 0);
    }
#pragma unroll
    for (int ib = 0; ib < 4; ++ib) {
        const int i = 32 * ib + l31; const float bias = kin(13)[h * 128 + i]; const size_t row = R0 + i;
#pragma unroll
        for (int cb = 0; cb < 2; ++cb)
#pragma unroll
            for (int rg = 0; rg < 4; ++rg) { const int c = 64 * h + 32 * cb + 8 * rg + 4 * hi;
                const v2u uw = *(const v2u*)(QK + row * NINE + 768 + c);
                const float o0 = bflo(uw.x) * (acc[cb][ib][4 * rg] + bias), o1 = bfhi(uw.x) * (acc[cb][ib][4 * rg + 1] + bias), o2 = bflo(uw.y) * (acc[cb][ib][4 * rg + 2] + bias), o3 = bfhi(uw.y) * (acc[cb][ib][4 * rg + 3] + bias);
                v2u w; w.x = pk2(o0, o1); w.y = pk2(o2, o3); *(v2u*)(MIX + row * D + 512 + c) = w; }
    }
    __syncthreads();
}
__device__ __forceinline__ void phase_attn_sgu(const Ctx& C) {
    for (int au = C.bid; au < BATCH * 2 * 128; au += C.G) attn_unit(C, au);
    for (int su = C.bid; su < M / 128; su += C.G) sgu_unit(C, su);
}
__global__ void __launch_bounds__(NWAVES * 64, 2) mk_fwd(Args args) {
    extern __shared__ __attribute__((aligned(16))) unsigned char lds_raw[];
    Ctx C;
    C.lds = (LAS unsigned char*)lds_raw; C.ldsaddr = (unsigned)(uintptr_t)C.lds;
    C.tid = threadIdx.x; C.lane = C.tid & 63; C.wave = __builtin_amdgcn_readfirstlane(C.tid >> 6);
    C.G = gridDim.x; C.bid = blockIdx.x;
    C.out = args.out; C.ws = args.ws; C.ctl = (gu32*)(args.ws + WS_CTL);
    volatile LAS unsigned* MISC = (volatile LAS unsigned*)(C.lds + MISC_OFF);
    if (C.tid < 64) MISC[C.tid] = 0u;
    __syncthreads();
#define FRESH_IDS(Cx) do { int z_ = 0; asm volatile("" : "+s"(z_)); Cx.lane = (int)__builtin_amdgcn_mbcnt_hi(~0u, __builtin_amdgcn_mbcnt_lo(~0u, (unsigned)z_)); Cx.tid = Cx.wave * 64 + Cx.lane; } while (0)
    const int lo = args.ph_lo, hi = args.ph_hi;
    const bool one = (hi - lo) > 1;
    XcdBarrier bar; bar.bar = (unsigned*)(C.ctl + CW_BAR); bar.x = 0; bar.st = nullptr;
    if (one) bar = xcd_barrier_post((unsigned*)(C.ctl + CW_BAR), MISC + 8);
#ifndef PHMASK
#define PHMASK 0x3ffff
#endif
#define IN(k) (((PHMASK >> (k)) & 1) && lo <= (k) && (k) < hi)
#define SEAM(k) do { if (IN(k) && IN((k) + 1)) { Ctx Cb = C; FRESH_IDS(Cb); xcd_barrier(bar, Cb.tid); } } while (0)
#ifndef DUPMASK
#define DUPMASK 0
#endif
#define DUP(k) DUP_##k
#if (DUPMASK >> 0) & 1
#define DUP_0 _Pragma("unroll") for (int rep_ = 0; rep_ < 2; ++rep_)
#else
#define DUP_0
#endif
#if (DUPMASK >> 1) & 1
#define DUP_1 _Pragma("unroll") for (int rep_ = 0; rep_ < 2; ++rep_)
#else
#define DUP_1
#endif
#if (DUPMASK >> 2) & 1
#define DUP_2 _Pragma("unroll") for (int rep_ = 0; rep_ < 2; ++rep_)
#else
#define DUP_2
#endif
#if (DUPMASK >> 3) & 1
#define DUP_3 _Pragma("unroll") for (int rep_ = 0; rep_ < 2; ++rep_)
#else
#define DUP_3
#endif
#if (DUPMASK >> 4) & 1
#define DUP_4 _Pragma("unroll") for (int rep_ = 0; rep_ < 2; ++rep_)
#else
#define DUP_4
#endif
#if (DUPMASK >> 5) & 1
#define DUP_5 _Pragma("unroll") for (int rep_ = 0; rep_ < 2; ++rep_)
#else
#define DUP_5
#endif
#if (DUPMASK >> 6) & 1
#define DUP_6 _Pragma("unroll") for (int rep_ = 0; rep_ < 2; ++rep_)
#else
#define DUP_6
#endif
#if (DUPMASK >> 7) & 1
#define DUP_7 _Pragma("unroll") for (int rep_ = 0; rep_ < 2; ++rep_)
#else
#define DUP_7
#endif
#if (DUPMASK >> 8) & 1
#define DUP_8 _Pragma("unroll") for (int rep_ = 0; rep_ < 2; ++rep_)
#else
#define DUP_8
#endif
#if (DUPMASK >> 9) & 1
#define DUP_9 _Pragma("unroll") for (int rep_ = 0; rep_ < 2; ++rep_)
#else
#define DUP_9
#endif
#if (DUPMASK >> 10) & 1
#define DUP_10 _Pragma("unroll") for (int rep_ = 0; rep_ < 2; ++rep_)
#else
#define DUP_10
#endif
#if (DUPMASK >> 11) & 1
#define DUP_11 _Pragma("unroll") for (int rep_ = 0; rep_ < 2; ++rep_)
#else
#define DUP_11
#endif
#if (DUPMASK >> 12) & 1
#define DUP_12 _Pragma("unroll") for (int rep_ = 0; rep_ < 2; ++rep_)
#else
#define DUP_12
#endif
#if (DUPMASK >> 13) & 1
#define DUP_13 _Pragma("unroll") for (int rep_ = 0; rep_ < 2; ++rep_)
#else
#define DUP_13
#endif
#if (DUPMASK >> 14) & 1
#define DUP_14 _Pragma("unroll") for (int rep_ = 0; rep_ < 2; ++rep_)
#else
#define DUP_14
#endif
#if (DUPMASK >> 15) & 1
#define DUP_15 _Pragma("unroll") for (int rep_ = 0; rep_ < 2; ++rep_)
#else
#define DUP_15
#endif
#if (DUPMASK >> 16) & 1
#define DUP_16 _Pragma("unroll") for (int rep_ = 0; rep_ < 2; ++rep_)
#else
#define DUP_16
#endif
#if (DUPMASK >> 17) & 1
#define DUP_17 _Pragma("unroll") for (int rep_ = 0; rep_ < 2; ++rep_)
#else
#define DUP_17
#endif
    bf16* const H = (bf16*)(C.ws + WS_H); bf16* const RA = (bf16*)(C.ws + WS_A); bf16* const RB = (bf16*)(C.ws + WS_B);
    const float* const MOD = (const float*)(C.ws + WS_MOD);

    DUP(0) { if (IN(0)) { Ctx Cp = C; FRESH_IDS(Cp); p0_prologue(Cp); } SEAM(0); }
    DUP(1) { if (IN(1)) { Ctx Cp = C; FRESH_IDS(Cp); phase_norm1_l0(Cp); } SEAM(1); }
    DUP(2) { if (IN(2)) { Ctx Cp = C; FRESH_IDS(Cp);
        pg8::Gemm g{H, (const bf16*)(Cp.ws + WS_WINE), M, NINE, D}; pg8::InEOrder S; S.so.init(M, NINE, Cp.G, Cp.bid); S.G = Cp.G; S.c = Cp.bid;
        pg8::EpiInE E{RA, (bf16*)(Cp.ws + WS_VT), (bf16*)(Cp.ws + WS_KC), (bf16*)(Cp.ws + WS_VCT), (const float*)(Cp.ws + WS_ROPE), (const float*)(Cp.ws + WS_ROPE) + 2048, QSCALE};
        pg8::gemm_phase<pg8::EpiInE, pg8::InEOrder, true, true>(Cp.lds, g, S, E, Cp.tid);
    } SEAM(2); }
    DUP(3) { if (IN(3)) { Ctx Cp = C; FRESH_IDS(Cp); phase_attn_sgu(Cp); } SEAM(3); }
    DUP(4) { if (IN(4)) { Ctx Cp = C; FRESH_IDS(Cp);
        pg8::Gemm g{RB, (const bf16*)(Cp.ws + WS_WOUTE), M, D, D}; pg8::StaticOrder S; S.init(M, D, Cp.G, Cp.bid);
        pg8::EpiRes E{kin(0), Cp.out, MOD + 2 * 1024, (float*)(Cp.ws + WS_RSS)};
        pg8::gemm_phase<pg8::EpiRes, pg8::StaticOrder, true, true>(Cp.lds, g, S, E, Cp.tid);
    } SEAM(4); }
    DUP(5) { if (IN(5)) { Ctx Cp = C; FRESH_IDS(Cp); phase_router(Cp, 0); } SEAM(5); }
    DUP(6) { if (IN(6)) { Ctx Cp = C; FRESH_IDS(Cp); phase_scatter(Cp, 0); } SEAM(6); }
    DUP(7) { if (IN(7)) { Ctx Cp = C; FRESH_IDS(Cp);
        const int nt = moe_tables(Cp, 0);
        pg8::Gemm g{RA, (const bf16*)(Cp.ws + WS_WGU), nt * 256, NEXP * 1024, D / 2}; pg8::MoeOrder S{(const LAS int*)(Cp.lds + MOE_TAB_OFF), nt * 4, Cp.G, Cp.bid};
        pg8::EpiSwiGLU8 E{RB, (const float*)(Cp.ws + WS_RSC), (const float*)(Cp.ws + WS_CSC)};
        pg8::gemm_phase<pg8::EpiSwiGLU8, pg8::MoeOrder, true, true>(Cp.lds, g, S, E, Cp.tid);
    } SEAM(7); }
    DUP(8) { if (IN(8)) { Ctx Cp = C; FRESH_IDS(Cp);
        const int nt = moe_tables(Cp, 0);
        pg8::Gemm g{RB, (const bf16*)(Cp.ws + WS_WD), nt * 256, NEXP * 1024, EH}; pg8::MoeOrder S{(const LAS int*)(Cp.lds + MOE_TAB_OFF), nt * 4, Cp.G, Cp.bid};
        pg8::EpiDown E{RA};
        pg8::gemm_phase<pg8::EpiDown, pg8::MoeOrder, true, true>(Cp.lds, g, S, E, Cp.tid);
    } SEAM(8); }
    DUP(9) { if (IN(9)) { Ctx Cp = C; FRESH_IDS(Cp); phase_combine<false>(Cp, 0); } SEAM(9); }
    DUP(10) { if (IN(10)) { Ctx Cp = C; FRESH_IDS(Cp);
        pg8::Gemm g{H, (const bf16*)(Cp.ws + WS_WINO), M, 3072, D / 2}; pg8::StaticOrder S; S.init(M, 3072, Cp.G, Cp.bid);
        pg8::EpiInO8 E{RA, RA + (size_t)M * D, (const float*)(Cp.ws + WS_RSC), (const float*)(Cp.ws + WS_CSC2)};
        pg8::gemm_phase<pg8::EpiInO8, pg8::StaticOrder, true, true>(Cp.lds, g, S, E, Cp.tid);
    } SEAM(10); }
    DUP(11) { if (IN(11)) { Ctx Cp = C; FRESH_IDS(Cp); phase_conv(Cp); } SEAM(11); }
    DUP(12) { if (IN(12)) { Ctx Cp = C; FRESH_IDS(Cp);
        pg8::Gemm g{RB, (const bf16*)(Cp.ws + WS_WOUTO), M, D, D / 2}; pg8::StaticOrder S; S.init(M, D, Cp.G, Cp.bid);
        pg8::EpiRes8 E{Cp.out, Cp.out, MOD + (size_t)4 * 6144 + 2 * 1024, (float*)(Cp.ws + WS_RSS), (const float*)(Cp.ws + WS_RSC), (const float*)(Cp.ws + WS_CSC2) + 3072};
        pg8::gemm_phase<pg8::EpiRes8, pg8::StaticOrder, true, true>(Cp.lds, g, S, E, Cp.tid);
    } SEAM(12); }
    DUP(13) { if (IN(13)) { Ctx Cp = C; FRESH_IDS(Cp); phase_router(Cp, 1); } SEAM(13); }
    DUP(14) { if (IN(14)) { Ctx Cp = C; FRESH_IDS(Cp); phase_scatter(Cp, 1); } SEAM(14); }
    DUP(15) { if (IN(15)) { Ctx Cp = C; FRESH_IDS(Cp);
        const int nt = moe_tables(Cp, 1);
        pg8::Gemm g{RA, (const bf16*)(Cp.ws + WS_WGU + (size_t)NEXP * 1024 * 1024), nt * 256, NEXP * 1024, D / 2}; pg8::MoeOrder S{(const LAS int*)(Cp.lds + MOE_TAB_OFF), nt * 4, Cp.G, Cp.bid};
        pg8::EpiSwiGLU8 E{RB, (const float*)(Cp.ws + WS_RSC), (const float*)(Cp.ws + WS_CSC) + (size_t)NEXP * 1024};
        pg8::gemm_phase<pg8::EpiSwiGLU8, pg8::MoeOrder, true, true>(Cp.lds, g, S, E, Cp.tid);
    } SEAM(15); }
    DUP(16) { if (IN(16)) { Ctx Cp = C; FRESH_IDS(Cp);
        const int nt = moe_tables(Cp, 1);
        pg8::Gemm g{RB, (const bf16*)(Cp.ws + WS_WD) + (size_t)NEXP * 1024 * 512, nt * 256, NEXP * 1024, EH}; pg8::MoeOrder S{(const LAS int*)(Cp.lds + MOE_TAB_OFF), nt * 4, Cp.G, Cp.bid};
        pg8::EpiDown E{RA};
        pg8::gemm_phase<pg8::EpiDown, pg8::MoeOrder, true, true>(Cp.lds, g, S, E, Cp.tid);
    } SEAM(16); }
    DUP(17) { if (IN(17)) { Ctx Cp = C; FRESH_IDS(Cp); phase_combine<true>(Cp, 1); } }
#undef IN
#undef SEAM
}

extern "C" void kernel_launch(void* const* d_in, const int* in_sizes, int n_in, void* d_out, int out_size, void* d_ws, size_t ws_size, hipStream_t stream) {
    static int grid = 0;
    if (grid == 0) {
        if (n_in != 25 || in_sizes[0] != M * D || out_size != M * D || ws_size < WS_END) { fprintf(stderr, "kernel_launch: unexpected shapes (n_in %d, in0 %d, out %d, ws %zu)\n", n_in, n_in > 0 ? in_sizes[0] : -1, out_size, ws_size); grid = -1; return; }
        int dev = 0, cus = 0, per_cu = 0;
        if (hipGetDevice(&dev) != hipSuccess || hipDeviceGetAttribute(&cus, hipDeviceAttributeMultiprocessorCount, dev) != hipSuccess) { grid = -1; return; }
        if (hipFuncSetAttribute((const void*)mk_fwd, hipFuncAttributeMaxDynamicSharedMemorySize, LDS_BYTES) != hipSuccess) { fprintf(stderr, "kernel_launch: hipFuncSetAttribute failed\n"); grid = -1; return; }
        if (hipOccupancyMaxActiveBlocksPerMultiprocessor(&per_cu, (const void*)mk_fwd, NWAVES * 64, LDS_BYTES) != hipSuccess || per_cu < 1) { fprintf(stderr, "kernel_launch: occupancy query says %d\n", per_cu); }
        (void)hipGetLastError();
        grid = cus;
    }
    if (grid < 0) return;
    if (hipMemsetAsync((char*)d_ws + WS_CTL, 0, CTL_ZERO_BYTES, stream) != hipSuccess) return;
    Args a{};
    for (int i = 0; i < 25; ++i) a.in[i] = (const float*)d_in[i];
    a.out = (float*)d_out; a.ws = (unsigned char*)d_ws;
#if defined(PROBE_K)
    a.ph_lo = 0; a.ph_hi = PROBE_K + 1; hipLaunchKernelGGL(mk_fwd, dim3(grid), dim3(NWAVES * 64), LDS_BYTES, stream, a);
    (void)hipMemsetAsync((char*)d_ws + WS_CTL, 0, (PROBE_K == 5 || PROBE_K == 13) ? CTL_ZERO_BYTES : (size_t)4 * CW_GCNT, stream);
    a.ph_lo = PROBE_K; a.ph_hi = PROBE_K + 1; hipLaunchKernelGGL(mk_fwd, dim3(grid), dim3(NWAVES * 64), LDS_BYTES, stream, a);
    (void)hipMemsetAsync((char*)d_ws + WS_CTL, 0, 4 * CW_GCNT, stream);
    if (PROBE_K + 1 < N_PHASES) { a.ph_lo = PROBE_K + 1; a.ph_hi = N_PHASES; hipLaunchKernelGGL(mk_fwd, dim3(grid), dim3(NWAVES * 64), LDS_BYTES, stream, a); }
#elif MK_ONE_LAUNCH
    a.ph_lo = 0; a.ph_hi = N_PHASES;
    hipLaunchKernelGGL(mk_fwd, dim3(grid), dim3(NWAVES * 64), LDS_BYTES, stream, a);
#else
    for (int p = 0; p < N_PHASES; ++p) { a.ph_lo = p; a.ph_hi = p + 1; hipLaunchKernelGGL(mk_fwd, dim3(grid), dim3(NWAVES * 64), LDS_BYTES, stream, a); }
#endif
}
```

```cpp
#include <hip/hip_runtime.h>
#include <cstdio>
#include <cstdint>
namespace pg8 {
#define PG8_LAS __attribute__((address_space(3)))
typedef unsigned short bf16_t;
typedef short bf16x8 __attribute__((ext_vector_type(8)));
typedef float f32x4 __attribute__((ext_vector_type(4)));
typedef unsigned u32x4 __attribute__((ext_vector_type(4)));
constexpr int BM = 256, BK = 64, HALF = 128, HTB = HALF * BK * 2  , STAGE_BYTES = 8 * HTB, NXCD = 8, WGM = 8;

__host__ __device__ __forceinline__ int lds_byte(int r, int c) { const int st = (r >> 4) * 2 + (c >> 5), rr = r & 15, cc = c & 31, ob = rr * 64 + cc * 2; return st * 1024 + (ob ^ (((ob >> 9) & 1) << 5)); }
__host__ __device__ __forceinline__ void stage_rc(int b, int& R, int& C) { const int st = b / 1024, sb = b % 1024, swz = sb ^ (((sb >> 9) & 1) << 5); R = (st >> 1) * 16 + swz / 64; C = (st & 1) * 32 + (swz % 64) / 2; }
__host__ __device__ __forceinline__ int perm32(int rho) { const int n = rho >> 4, i = rho & 15; return 8 * (i >> 2) + 4 * n + (i & 3); }

struct Unit { int pm, pn; };
struct Gemm { const bf16_t* A; const bf16_t* Bt; int M, N, K; };

struct StaticOrder {
    int nM, nN, nwg, G, c;
    __host__ __device__ void init(int M, int N, int G_, int c_) { nM = M / BM; nN = N / BM; nwg = nM * nN; G = G_; c = c_; }
    __host__ __device__ bool next(int i, Unit& u) const {
        const long L = (long)i * G + c; if (L >= nwg) return false;
        int wgid = (int)L; { const int q = nwg / NXCD, r = nwg % NXCD, xcd = wgid % NXCD, off = wgid / NXCD; wgid = (xcd < r ? xcd * (q + 1) : r * (q + 1) + (xcd - r) * q) + off; }
        const int nig = WGM * nN, gid = wgid / nig, fm = gid * WGM, gsz = (nM - fm) < WGM ? (nM - fm) : WGM;
        u.pm = fm + ((wgid % nig) % gsz); u.pn = (wgid % nig) / gsz; return true;
    }
    __device__ __forceinline__ void a_ready(const Unit&) const {}
    __device__ __forceinline__ void done(const Unit&) const {}
};

__device__ __forceinline__ unsigned cvt_pk_bf16(float lo, float hi) { unsigned r; asm volatile("v_cvt_pk_bf16_f32 %0, %1, %2" : "=v"(r) : "v"(lo), "v"(hi)); return r; }
typedef float f32x2 __attribute__((ext_vector_type(2)));
__device__ __forceinline__ f32x2 gelu_pk(f32x2 v) {
    const f32x2 av = __builtin_elementwise_abs(v), d = av * 0.2316418882f + 1.0f;
    f32x2 t; t.x = __builtin_amdgcn_rcpf(d.x); t.y = __builtin_amdgcn_rcpf(d.y);
    f32x2 q = t * 0.5307027145f + (-0.7265760135f); q = q * t + 0.7107068705f; q = q * t + (-0.142248368f); q = q * t + 0.127414796f; q = q * t;
    const f32x2 s = (v * v) * (-0.72134752044f);
    f32x2 e; e.x = __builtin_amdgcn_exp2f(s.x); e.y = __builtin_amdgcn_exp2f(s.y);
    const f32x2 m = v * (q * e), r = v - m;
    f32x2 o; o.x = v.x < 0.f ? m.x : r.x; o.y = v.y < 0.f ? m.y : r.y; return o;
}

typedef int i32x4 __attribute__((ext_vector_type(4)));
template <bool I8> struct AccSel { typedef f32x4 t; };
template <> struct AccSel<true> { typedef i32x4 t; };
__device__ __forceinline__ f32x4 mma16(bf16x8 a, bf16x8 b, f32x4 c) { return __builtin_amdgcn_mfma_f32_16x16x32_bf16(a, b, c, 0, 0, 0); }
__device__ __forceinline__ i32x4 mma16(bf16x8 a, bf16x8 b, i32x4 c) { return __builtin_amdgcn_mfma_i32_16x16x64_i8(__builtin_bit_cast(i32x4, a), __builtin_bit_cast(i32x4, b), c, 0, 0, 0); }
typedef unsigned u32x2 __attribute__((ext_vector_type(2)));
__device__ __forceinline__ int perm16(int x) { return (x & 3) | ((x & 4) << 1) | ((x & 8) >> 1); }
__device__ __forceinline__ bf16_t bf1(float v) { return (bf16_t)(cvt_pk_bf16(v, 0.f) & 0xffffu); }
__device__ __forceinline__ u32x2 pk4(f32x4 v) { u32x2 w; w.x = cvt_pk_bf16(v[0], v[1]); w.y = cvt_pk_bf16(v[2], v[3]); return w; }
__device__ __forceinline__ f32x4 gelu4(f32x4 v) { const f32x2 a = gelu_pk((f32x2){v[0], v[1]}), b = gelu_pk((f32x2){v[2], v[3]}); return (f32x4){a.x, a.y, b.x, b.y}; }
__device__ __forceinline__ float silu1(float g) { return g * __builtin_amdgcn_rcpf(1.0f + __builtin_amdgcn_exp2f(-1.4426950408889634f * g)); }

struct EpiInE {
    static constexpr bool PERM = false, AFTER_DRAIN = false, I8 = false;
    bf16_t* QK; bf16_t* VT; bf16_t* KC; bf16_t* VCT; const float* rc; const float* rs; float qscale;
    __device__ __forceinline__ void operator()(const f32x4 (&acc)[2][2][4][2], const Unit& u, int wr, int wc, int fr, int fq) const {
        const int row0 = u.pm * BM + wr * 64 + fr;
        if (u.pm >= 128) {
#pragma unroll
            for (int ai = 0; ai < 2; ++ai)
#pragma unroll
                for (int m = 0; m < 4; ++m) {
                    const int row = row0 + ai * HALF + m * 16 - 32768, b = row >> 8, j = row & 255, jp = (j & ~15) | perm16(j & 15);
#pragma unroll
                    for (int n = 0; n < 2; ++n) {
                        *(u32x2*)(KC + (size_t)row * 128 + wc * 32 + n * 16 + 4 * fq) = pk4(acc[ai][0][m][n]);
#pragma unroll
                        for (int i = 0; i < 4; ++i) { const int cv = wc * 32 + n * 16 + 4 * fq + i; VCT[((size_t)(b * 2 + (cv >> 6)) * 64 + (cv & 63)) * 256 + jp] = bf1(acc[ai][1][m][n][i]); }
                    }
                }
            return;
        }
        if (u.pn <= 2) {
            const float sc = (u.pn < 2) ? qscale : 1.0f;
#pragma unroll
            for (int ai = 0; ai < 2; ++ai)
#pragma unroll
                for (int m = 0; m < 4; ++m) {
                    const int row = row0 + ai * HALF + m * 16, pos = row & 8191, pidx = (wc & 1) ? (pos & 63) : (pos >> 6);
                    const f32x4 c4 = *(const f32x4*)(rc + pidx * 16 + 4 * fq) * sc, s4 = *(const f32x4*)(rs + pidx * 16 + 4 * fq) * sc;
                    bf16_t* rowp = QK + (size_t)row * 1792 + u.pn * BM + wc * 32 + 4 * fq;
#pragma unroll
                    for (int bj = 0; bj < 2; ++bj) {
                        if (u.pn == 2 && bj == 1) break;
                        const f32x4 v0 = acc[ai][bj][m][0], v1 = acc[ai][bj][m][1];
                        *(u32x2*)(rowp + bj * HALF) = pk4(v0 * c4 - v1 * s4);
                        *(u32x2*)(rowp + bj * HALF + 16) = pk4(v1 * c4 + v0 * s4);
                    }
                    if (u.pn == 2) {
                        const int b = row >> 13, pp = (pos & ~15) | perm16(pos & 15);
#pragma unroll
                        for (int n = 0; n < 2; ++n)
#pragma unroll
                            for (int i = 0; i < 4; ++i) { const int cv = wc * 32 + n * 16 + 4 * fq + i; VT[((size_t)(b * 2 + (cv >> 6)) * 64 + (cv & 63)) * 8192 + pp] = bf1(acc[ai][1][m][n][i]); }
                    }
                }
            return;
        }
#pragma unroll
        for (int ai = 0; ai < 2; ++ai)
#pragma unroll
            for (int m = 0; m < 4; ++m) {
                bf16_t* rowp = QK + (size_t)(row0 + ai * HALF + m * 16) * 1792 + u.pn * BM + wc * 32 + 4 * fq;
#pragma unroll
                for (int bj = 0; bj < 2; ++bj)
#pragma unroll
                    for (int n = 0; n < 2; ++n) *(u32x2*)(rowp + bj * HALF + n * 16) = pk4(gelu4(acc[ai][bj][m][n]));
            }
    }
};
struct EpiRes {
    static constexpr bool PERM = false, AFTER_DRAIN = false, I8 = false;
    const float* base; bf16_t* out; const float* gate; float* RSS;
    __device__ __forceinline__ void operator()(const f32x4 (&acc)[2][2][4][2], const Unit& u, int wr, int wc, int fr, int fq) const {
        const int row0 = u.pm * BM + wr * 64 + fr, col0 = u.pn * BM + wc * 32 + 4 * fq, b = u.pm >> 5;
        f32x4 gv[2][2];
#pragma unroll
        for (int bj = 0; bj < 2; ++bj)
#pragma unroll
            for (int n = 0; n < 2; ++n) gv[bj][n] = *(const f32x4*)(gate + (size_t)b * 6144 + col0 + bj * HALF + n * 16);
#pragma unroll
        for (int ai = 0; ai < 2; ++ai) {
            f32x4 bs[4][2][2];
#pragma unroll
            for (int m = 0; m < 4; ++m)
#pragma unroll
                for (int bj = 0; bj < 2; ++bj)
#pragma unroll
                    for (int n = 0; n < 2; ++n) bs[m][bj][n] = *(const f32x4*)(base + (size_t)(row0 + ai * HALF + m * 16) * 1024 + col0 + bj * HALF + n * 16);
#pragma unroll
            for (int m = 0; m < 4; ++m) { const int row = row0 + ai * HALF + m * 16; float ss = 0.f;
#pragma unroll
                for (int bj = 0; bj < 2; ++bj)
#pragma unroll
                    for (int n = 0; n < 2; ++n) { const f32x4 o = bs[m][bj][n] + gv[bj][n] * acc[ai][bj][m][n]; const u32x2 w = pk4(o); *(u32x2*)(out + (size_t)row * 1024 + col0 + bj * HALF + n * 16) = w;
                        const float r0 = __builtin_bit_cast(float, w.x << 16), r1 = __builtin_bit_cast(float, w.x & 0xffff0000u), r2 = __builtin_bit_cast(float, w.y << 16), r3 = __builtin_bit_cast(float, w.y & 0xffff0000u);
                        ss += (r0 * r0 + r1 * r1) + (r2 * r2 + r3 * r3); }
                ss += __shfl_xor(ss, 16); ss += __shfl_xor(ss, 32);
                if (fq == 0) RSS[(size_t)row * 16 + u.pn * 4 + wc] = ss; }
        }
    }
};
struct EpiSwiGLU {
    static constexpr bool PERM = true, AFTER_DRAIN = false, I8 = false;
    bf16_t* HID;
    __device__ __forceinline__ void operator()(const f32x4 (&acc)[2][2][4][2], const Unit& u, int wr, int wc, int fr, int fq) const {
        const int row0 = u.pm * BM + wr * 64 + fr, col0 = (u.pn & 3) * HALF + wc * 32 + 8 * fq;
#pragma unroll
        for (int ai = 0; ai < 2; ++ai)
#pragma unroll
            for (int m = 0; m < 4; ++m) {
                const f32x4 g0 = acc[ai][0][m][0], g1 = acc[ai][0][m][1], u0 = acc[ai][1][m][0], u1 = acc[ai][1][m][1];
                u32x4 w;
                w.x = cvt_pk_bf16(silu1(g0[0]) * u0[0], silu1(g0[1]) * u0[1]); w.y = cvt_pk_bf16(silu1(g0[2]) * u0[2], silu1(g0[3]) * u0[3]);
                w.z = cvt_pk_bf16(silu1(g1[0]) * u1[0], silu1(g1[1]) * u1[1]); w.w = cvt_pk_bf16(silu1(g1[2]) * u1[2], silu1(g1[3]) * u1[3]);
                *(u32x4*)(HID + (size_t)(row0 + ai * HALF + m * 16) * 512 + col0) = w;
            }
    }
};
struct EpiSwiGLU8 {
    static constexpr bool PERM = true, AFTER_DRAIN = false, I8 = true;
    bf16_t* HID; const float* RSC; const float* CSC;
    __device__ __forceinline__ void operator()(const i32x4 (&acc)[2][2][4][2], const Unit& u, int wr, int wc, int fr, int fq) const {
        const int row0 = u.pm * BM + wr * 64 + fr, ct = u.pn & 3, col0 = ct * HALF + wc * 32 + 8 * fq;
        const float* cs = CSC + (size_t)(u.pn >> 2) * 1024 + ct * BM + wc * 32 + 8 * fq;
        const f32x4 cg0 = *(const f32x4*)(cs), cg1 = *(const f32x4*)(cs + 4), cu0 = *(const f32x4*)(cs + HALF), cu1 = *(const f32x4*)(cs + HALF + 4);
#pragma unroll
        for (int ai = 0; ai < 2; ++ai)
#pragma unroll
            for (int m = 0; m < 4; ++m) { const int row = row0 + ai * HALF + m * 16; const float rs = RSC[row];
                const f32x4 g0 = __builtin_convertvector(acc[ai][0][m][0], f32x4) * cg0 * rs, g1 = __builtin_convertvector(acc[ai][0][m][1], f32x4) * cg1 * rs;
                const f32x4 u0 = __builtin_convertvector(acc[ai][1][m][0], f32x4) * cu0 * rs, u1 = __builtin_convertvector(acc[ai][1][m][1], f32x4) * cu1 * rs;
                u32x4 w;
                w.x = cvt_pk_bf16(silu1(g0[0]) * u0[0], silu1(g0[1]) * u0[1]); w.y = cvt_pk_bf16(silu1(g0[2]) * u0[2], silu1(g0[3]) * u0[3]);
                w.z = cvt_pk_bf16(silu1(g1[0]) * u1[0], silu1(g1[1]) * u1[1]); w.w = cvt_pk_bf16(silu1(g1[2]) * u1[2], silu1(g1[3]) * u1[3]);
                *(u32x4*)(HID + (size_t)row * 512 + col0) = w;
            }
    }
};
struct EpiDown {
    static constexpr bool PERM = true, AFTER_DRAIN = false, I8 = false;
    bf16_t* Y;
    __device__ __forceinline__ void operator()(const f32x4 (&acc)[2][2][4][2], const Unit& u, int wr, int wc, int fr, int fq) const {
        const int row0 = u.pm * BM + wr * 64 + fr, col0 = (u.pn & 3) * BM + wc * 32 + 8 * fq;
#pragma unroll
        for (int ai = 0; ai < 2; ++ai)
#pragma unroll
            for (int m = 0; m < 4; ++m) { bf16_t* rowp = Y + (size_t)(row0 + ai * HALF + m * 16) * 1024 + col0;
#pragma unroll
                for (int bj = 0; bj < 2; ++bj) { const f32x4 v0 = acc[ai][bj][m][0], v1 = acc[ai][bj][m][1];
                    u32x4 w; w.x = cvt_pk_bf16(v0[0], v0[1]); w.y = cvt_pk_bf16(v0[2], v0[3]); w.z = cvt_pk_bf16(v1[0], v1[1]); w.w = cvt_pk_bf16(v1[2], v1[3]);
                    *(u32x4*)(rowp + bj * HALF) = w; } }
    }
};
struct EpiInO {
    static constexpr bool PERM = true, AFTER_DRAIN = false, I8 = false;
    bf16_t* BG; bf16_t* Y;
    __device__ __forceinline__ void operator()(const f32x4 (&acc)[2][2][4][2], const Unit& u, int wr, int wc, int fr, int fq) const {
        const int row0 = u.pm * BM + wr * 64 + fr;
        if (u.pn < 8) {
            const int col0 = u.pn * HALF + wc * 32 + 8 * fq;
#pragma unroll
            for (int ai = 0; ai < 2; ++ai)
#pragma unroll
                for (int m = 0; m < 4; ++m) { const f32x4 v0 = acc[ai][0][m][0] * acc[ai][1][m][0], v1 = acc[ai][0][m][1] * acc[ai][1][m][1];
                    u32x4 w; w.x = cvt_pk_bf16(v0[0], v0[1]); w.y = cvt_pk_bf16(v0[2], v0[3]); w.z = cvt_pk_bf16(v1[0], v1[1]); w.w = cvt_pk_bf16(v1[2], v1[3]);
                    *(u32x4*)(Y + (size_t)(row0 + ai * HALF + m * 16) * 1024 + col0) = w; }
        } else {
            const int col0 = (u.pn - 8) * BM + wc * 32 + 8 * fq;
#pragma unroll
            for (int ai = 0; ai < 2; ++ai)
#pragma unroll
                for (int m = 0; m < 4; ++m) { bf16_t* rowp = BG + (size_t)(row0 + ai * HALF + m * 16) * 1024 + col0;
#pragma unroll
                    for (int bj = 0; bj < 2; ++bj) { const f32x4 v0 = acc[ai][bj][m][0], v1 = acc[ai][bj][m][1];
                        u32x4 w; w.x = cvt_pk_bf16(v0[0], v0[1]); w.y = cvt_pk_bf16(v0[2], v0[3]); w.z = cvt_pk_bf16(v1[0], v1[1]); w.w = cvt_pk_bf16(v1[2], v1[3]);
                        *(u32x4*)(rowp + bj * HALF) = w; } }
        }
    }
};
struct EpiInO8 {
    static constexpr bool PERM = true, AFTER_DRAIN = false, I8 = true;
    bf16_t* BG; bf16_t* Y; const float* RSC; const float* CSC;
    __device__ __forceinline__ void operator()(const i32x4 (&acc)[2][2][4][2], const Unit& u, int wr, int wc, int fr, int fq) const {
        const int row0 = u.pm * BM + wr * 64 + fr;
        const float* cs = CSC + u.pn * BM + wc * 32 + 8 * fq;
        const f32x4 c00 = *(const f32x4*)(cs), c01 = *(const f32x4*)(cs + 4), c10 = *(const f32x4*)(cs + HALF), c11 = *(const f32x4*)(cs + HALF + 4);
        if (u.pn < 8) {
            const int col0 = u.pn * HALF + wc * 32 + 8 * fq;
#pragma unroll
            for (int ai = 0; ai < 2; ++ai)
#pragma unroll
                for (int m = 0; m < 4; ++m) { const int row = row0 + ai * HALF + m * 16; const float rs = RSC[row], rs2 = rs * rs;
                    const f32x4 v0 = __builtin_convertvector(acc[ai][0][m][0], f32x4) * __builtin_convertvector(acc[ai][1][m][0], f32x4) * (c00 * c10) * rs2;
                    const f32x4 v1 = __builtin_convertvector(acc[ai][0][m][1], f32x4) * __builtin_convertvector(acc[ai][1][m][1], f32x4) * (c01 * c11) * rs2;
                    u32x4 w; w.x = cvt_pk_bf16(v0[0], v0[1]); w.y = cvt_pk_bf16(v0[2], v0[3]); w.z = cvt_pk_bf16(v1[0], v1[1]); w.w = cvt_pk_bf16(v1[2], v1[3]);
                    *(u32x4*)(Y + (size_t)row * 1024 + col0) = w; }
        } else {
            const int col0 = (u.pn - 8) * BM + wc * 32 + 8 * fq;
#pragma unroll
            for (int ai = 0; ai < 2; ++ai)
#pragma unroll
                for (int m = 0; m < 4; ++m) { const int row = row0 + ai * HALF + m * 16; const float rs = RSC[row]; bf16_t* rowp = BG + (size_t)row * 1024 + col0;
#pragma unroll
                    for (int bj = 0; bj < 2; ++bj) { const f32x4 v0 = __builtin_convertvector(acc[ai][bj][m][0], f32x4) * (bj ? c10 : c00) * rs, v1 = __builtin_convertvector(acc[ai][bj][m][1], f32x4) * (bj ? c11 : c01) * rs;
                        u32x4 w; w.x = cvt_pk_bf16(v0[0], v0[1]); w.y = cvt_pk_bf16(v0[2], v0[3]); w.z = cvt_pk_bf16(v1[0], v1[1]); w.w = cvt_pk_bf16(v1[2], v1[3]);
                        *(u32x4*)(rowp + bj * HALF) = w; } }
        }
    }
};
struct EpiRes8 {
    static constexpr bool PERM = false, AFTER_DRAIN = false, I8 = true;
    bf16_t* lat; const float* gate; float* RSS; const float* RSC; const float* CSC;
    __device__ __forceinline__ void operator()(const i32x4 (&acc)[2][2][4][2], const Unit& u, int wr, int wc, int fr, int fq) const {
        const int row0 = u.pm * BM + wr * 64 + fr, col0 = u.pn * BM + wc * 32 + 4 * fq, b = u.pm >> 5;
        f32x4 gv[2][2];
#pragma unroll
        for (int bj = 0; bj < 2; ++bj)
#pragma unroll
            for (int n = 0; n < 2; ++n) gv[bj][n] = *(const f32x4*)(gate + (size_t)b * 6144 + col0 + bj * HALF + n * 16) * *(const f32x4*)(CSC + col0 + bj * HALF + n * 16);
#pragma unroll
        for (int ai = 0; ai < 2; ++ai) {
            u32x2 bs[4][2][2]; float rs[4];
#pragma unroll
            for (int m = 0; m < 4; ++m) { rs[m] = RSC[row0 + ai * HALF + m * 16];
#pragma unroll
                for (int bj = 0; bj < 2; ++bj)
#pragma unroll
                    for (int n = 0; n < 2; ++n) bs[m][bj][n] = *(const u32x2*)(lat + (size_t)(row0 + ai * HALF + m * 16) * 1024 + col0 + bj * HALF + n * 16); }
            asm volatile("" ::: "memory");
#pragma unroll
            for (int m = 0; m < 4; ++m) { const int row = row0 + ai * HALF + m * 16; float ss = 0.f;
#pragma unroll
                for (int bj = 0; bj < 2; ++bj)
#pragma unroll
                    for (int n = 0; n < 2; ++n) { const u32x2 bw = bs[m][bj][n];
                        const f32x4 bf = (f32x4){__builtin_bit_cast(float, bw.x << 16), __builtin_bit_cast(float, bw.x & 0xffff0000u), __builtin_bit_cast(float, bw.y << 16), __builtin_bit_cast(float, bw.y & 0xffff0000u)};
                        const f32x4 o = bf + gv[bj][n] * (__builtin_convertvector(acc[ai][bj][m][n], f32x4) * rs[m]); const u32x2 w = pk4(o); *(u32x2*)(lat + (size_t)row * 1024 + col0 + bj * HALF + n * 16) = w;
                        const float r0 = __builtin_bit_cast(float, w.x << 16), r1 = __builtin_bit_cast(float, w.x & 0xffff0000u), r2 = __builtin_bit_cast(float, w.y << 16), r3 = __builtin_bit_cast(float, w.y & 0xffff0000u);
                        ss += (r0 * r0 + r1 * r1) + (r2 * r2 + r3 * r3); }
                ss += __shfl_xor(ss, 16); ss += __shfl_xor(ss, 32);
                if (fq == 0) RSS[(size_t)row * 16 + u.pn * 4 + wc] = ss; }
            asm volatile("" ::: "memory");
        }
    }
};
struct InEOrder {
    StaticOrder so; int G, c;
    __device__ __forceinline__ bool next(int i, Unit& u) const {
        const long L = (long)i * G + c;
        if (L < 896) return so.next(i, u);
        if (L < 900) { u.pm = 128 + (int)(L - 896); u.pn = 2; return true; }
        return false;
    }
    __device__ __forceinline__ void a_ready(const Unit&) const {}
    __device__ __forceinline__ void done(const Unit&) const {}
};
struct MoeOrder {
    const PG8_LAS int* tile_e; int nunits, G, c;
    __device__ __forceinline__ bool next(int i, Unit& u) const {
        const long L = (long)i * G + c; if (L >= nunits) return false;
        const int t = (int)(L >> 2); u.pm = t; u.pn = tile_e[t] * 4 + (int)(L & 3); return true;
    }
    __device__ __forceinline__ void a_ready(const Unit&) const {}
    __device__ __forceinline__ void done(const Unit&) const {}
};
template <class Epi, class Sched, bool ALIGN_EPI = false, bool SP2 = false>
__device__ __forceinline__ void gemm_phase(PG8_LAS unsigned char* lds, const Gemm g, const Sched& S, const Epi& E, const int tid_in) {
    int tid_ = tid_in; asm volatile("" : "+v"(tid_));
    const int tid = tid_, wid = __builtin_amdgcn_readfirstlane(tid >> 6), lane = tid & 63, wr = wid >> 2, wc = wid & 3, fr = lane & 15, fq = lane >> 4;
    const int K = g.K, nt = K / BK;
    unsigned voffA[2], voffB[2];
#pragma unroll
    for (int i = 0; i < 2; ++i) { int R, C; stage_rc(tid * 16 + i * 8192, R, C); const int Rb = Epi::PERM ? ((R & ~31) + perm32(R & 31)) : R;
        voffA[i] = (unsigned)(R * K + C) * 2u; voffB[i] = (unsigned)(Rb * K + C) * 2u; }
    const size_t kstep = (size_t)(BK * 2);
    const size_t hstep = (size_t)HALF * K * 2;
    const size_t tstep = 2 * hstep;
    const unsigned ldsw = (unsigned)wid * 1024u;
    const int aoff = lds_byte(wr * 64 + fr, fq * 8), boff = lds_byte(wc * 32 + fr, fq * 8);
#define PG8_SA(b, h) (((b) * 2 + (h)) * HTB)
#define PG8_SB(b, h) ((4 + (b) * 2 + (h)) * HTB)
#define PG8_STAGE(bufoff, gbase, voff) do { _Pragma("unroll") for (int _i = 0; _i < 2; ++_i) \
        __builtin_amdgcn_global_load_lds((const unsigned*)((const char*)(gbase) + (voff)[_i]), (PG8_LAS unsigned*)(lds + (bufoff) + ldsw + _i * 8192), 16, 0, 0); } while (0)
#define PG8_LDA(dst, b, h) do { _Pragma("unroll") for (int m = 0; m < 4; ++m) _Pragma("unroll") for (int k = 0; k < 2; ++k) dst[m][k] = *(const PG8_LAS bf16x8*)(lds + PG8_SA(b, h) + aoff + m * 2048 + k * 1024); } while (0)
#define PG8_LDB(dst, b, h) do { _Pragma("unroll") for (int n = 0; n < 2; ++n) _Pragma("unroll") for (int k = 0; k < 2; ++k) dst[n][k] = *(const PG8_LAS bf16x8*)(lds + PG8_SB(b, h) + boff + n * 2048 + k * 1024); } while (0)
#define PG8_MMA(ai, bj, At, Bt) do { __builtin_amdgcn_s_setprio(1); _Pragma("unroll") for (int m = 0; m < 4; ++m) _Pragma("unroll") for (int n = 0; n < 2; ++n) _Pragma("unroll") for (int k = 0; k < 2; ++k) \
        acc[ai][bj][m][n] = mma16(Bt[n][k], At[m][k], acc[ai][bj][m][n]); __builtin_amdgcn_s_setprio(0); } while (0)
#define PG8_WAIT_V(n) asm volatile("s_waitcnt vmcnt(" #n ")" ::: "memory")
#define PG8_WAIT_L(n) asm volatile("s_waitcnt lgkmcnt(" #n ")" ::: "memory")
#define PG8_BAR __builtin_amdgcn_s_barrier()
#define PG8_SCHED __builtin_amdgcn_sched_barrier(0)
    Unit cur, nxt; int ui = 0;
    if (!S.next(0, cur)) return;
    typedef typename AccSel<Epi::I8>::t acc_t;
    acc_t acc[2][2][4][2];
#pragma unroll
    for (int a = 0; a < 2; ++a)
#pragma unroll
        for (int b = 0; b < 2; ++b)
#pragma unroll
            for (int m = 0; m < 4; ++m)
#pragma unroll
                for (int n = 0; n < 2; ++n) acc[a][b][m][n] = acc_t{};
    bf16x8 At[4][2], B0[2][2], B1[2][2];
    const char* cA = (const char*)g.A + (size_t)cur.pm * tstep; const char* cB = (const char*)g.Bt + (size_t)cur.pn * tstep;
    S.a_ready(cur);
    if constexpr (SP2) {
        PG8_STAGE(PG8_SB(0, 0), cB, voffB); PG8_STAGE(PG8_SB(0, 1), cB + hstep, voffB); PG8_STAGE(PG8_SA(0, 0), cA, voffA); PG8_STAGE(PG8_SA(0, 1), cA + hstep, voffA);
        if (wr == 1) PG8_BAR;
        PG8_WAIT_V(2); PG8_BAR;
        PG8_STAGE(PG8_SB(1, 0), cB + kstep, voffB); PG8_STAGE(PG8_SA(1, 0), cA + kstep, voffA); PG8_STAGE(PG8_SB(1, 1), cB + hstep + kstep, voffB);
        PG8_WAIT_V(6); PG8_BAR;
    } else {
        PG8_STAGE(PG8_SB(0, 0), cB, voffB); PG8_STAGE(PG8_SA(0, 0), cA, voffA); PG8_STAGE(PG8_SB(0, 1), cB + hstep, voffB); PG8_STAGE(PG8_SA(0, 1), cA + hstep, voffA);
        if (wr == 1) PG8_BAR;
        PG8_WAIT_V(4); PG8_BAR;
        PG8_STAGE(PG8_SB(1, 0), cB + kstep, voffB); PG8_STAGE(PG8_SA(1, 0), cA + kstep, voffA); PG8_STAGE(PG8_SB(1, 1), cB + hstep + kstep, voffB);
        PG8_WAIT_V(6); PG8_BAR;
    }
    for (;;) {
        const bool has_next = S.next(ui + 1, nxt);
        const char* nA = has_next ? (const char*)g.A + (size_t)nxt.pm * tstep : cA; const char* nB = has_next ? (const char*)g.Bt + (size_t)nxt.pn * tstep : cB;
        for (int t = 0; t < nt; t += 2) {
            const bool last = (t == nt - 2);
            const char* a1 = cA + (size_t)(t + 1) * kstep;
            const char* a2 = last ? nA : cA + (size_t)(t + 2) * kstep; const char* b2 = last ? nB : cB + (size_t)(t + 2) * kstep;
            const char* a3 = a2 + kstep; const char* b3 = b2 + kstep;
            if (last && has_next) S.a_ready(nxt);
            if constexpr (SP2) {
            PG8_LDB(B0, 0, 0); PG8_LDB(B1, 0, 1); PG8_SCHED; PG8_LDA(At, 0, 0); PG8_STAGE(PG8_SA(1, 1), a1 + hstep, voffA);
            PG8_WAIT_V(8); PG8_WAIT_L(0); PG8_BAR; PG8_MMA(0, 0, At, B0); PG8_MMA(0, 1, At, B1); PG8_BAR; PG8_SCHED;
            PG8_LDA(At, 0, 1); PG8_STAGE(PG8_SB(0, 0), b2, voffB); PG8_STAGE(PG8_SB(0, 1), b2 + hstep, voffB); PG8_STAGE(PG8_SA(0, 0), a2, voffA);
            PG8_WAIT_V(8); PG8_WAIT_L(0); PG8_BAR; PG8_MMA(1, 0, At, B0); PG8_MMA(1, 1, At, B1); PG8_BAR; PG8_SCHED;
            PG8_LDB(B0, 1, 0); PG8_LDB(B1, 1, 1); PG8_SCHED; PG8_LDA(At, 1, 0); PG8_STAGE(PG8_SA(0, 1), a2 + hstep, voffA);
            PG8_WAIT_V(8); PG8_WAIT_L(0); PG8_BAR; PG8_MMA(0, 0, At, B0); PG8_MMA(0, 1, At, B1); PG8_BAR; PG8_SCHED;
            PG8_LDA(At, 1, 1); PG8_STAGE(PG8_SB(1, 0), b3, voffB); PG8_STAGE(PG8_SB(1, 1), b3 + hstep, voffB); PG8_STAGE(PG8_SA(1, 0), a3, voffA);
            PG8_WAIT_V(8); PG8_WAIT_L(0); PG8_BAR; PG8_MMA(1, 0, At, B0); PG8_MMA(1, 1, At, B1); PG8_BAR; PG8_SCHED;
            } else {
            PG8_LDB(B0, 0, 0); PG8_SCHED; PG8_LDA(At, 0, 0); PG8_STAGE(PG8_SA(1, 1), a1 + hstep, voffA);
            PG8_WAIT_L(8); PG8_BAR; PG8_WAIT_L(0); PG8_MMA(0, 0, At, B0); PG8_BAR; PG8_SCHED;
            PG8_LDB(B1, 0, 1); PG8_STAGE(PG8_SB(0, 0), b2, voffB);
            PG8_BAR; PG8_WAIT_L(0); PG8_MMA(0, 1, At, B1); PG8_BAR;
            PG8_LDA(At, 0, 1); PG8_STAGE(PG8_SA(0, 0), a2, voffA);
            PG8_BAR; PG8_WAIT_L(0); PG8_MMA(1, 0, At, B0); PG8_BAR; PG8_SCHED;
            PG8_STAGE(PG8_SB(0, 1), b2 + hstep, voffB);
            PG8_WAIT_V(6); PG8_BAR; PG8_MMA(1, 1, At, B1); PG8_BAR;
            PG8_LDB(B0, 1, 0); PG8_SCHED; PG8_LDA(At, 1, 0); PG8_STAGE(PG8_SA(0, 1), a2 + hstep, voffA);
            PG8_WAIT_L(8); PG8_BAR; PG8_WAIT_L(0); PG8_MMA(0, 0, At, B0); PG8_BAR; PG8_SCHED;
            PG8_LDB(B1, 1, 1); PG8_STAGE(PG8_SB(1, 0), b3, voffB);
            PG8_BAR; PG8_WAIT_L(0); PG8_MMA(0, 1, At, B1); PG8_BAR;
            PG8_LDA(At, 1, 1); PG8_STAGE(PG8_SA(1, 0), a3, voffA);
            PG8_BAR; PG8_WAIT_L(0); PG8_MMA(1, 0, At, B0); PG8_BAR; PG8_SCHED;
            PG8_STAGE(PG8_SB(1, 1), b3 + hstep, voffB);
            PG8_WAIT_V(6); PG8_BAR; PG8_MMA(1, 1, At, B1); PG8_BAR;
            }
        }
        if constexpr (ALIGN_EPI) { if (wr == 0) PG8_BAR; }
        if constexpr (!Epi::AFTER_DRAIN) { E(acc, cur, wr, wc, fr, fq); S.done(cur); }
        if (!has_next) break;
#pragma unroll
        for (int a = 0; a < 2; ++a)
#pragma unroll
            for (int b = 0; b < 2; ++b)
#pragma unroll
                for (int m = 0; m < 4; ++m)
#pragma unroll
                    for (int n = 0; n < 2; ++n) acc[a][b][m][n] = acc_t{};
        cur = nxt; cA = nA; cB = nB; ++ui;
        if constexpr (ALIGN_EPI) { if (wr == 1) PG8_BAR; }
    }
    PG8_WAIT_V(0);
    if constexpr (!ALIGN_EPI) { if (wr == 0) PG8_BAR; }
    PG8_BAR;
    if constexpr (Epi::AFTER_DRAIN) { E.fused(acc, cur, wr, wc, fr, fq, lds, wid, lane); S.done(cur); }
#undef PG8_SA
#undef PG8_SB
#undef PG8_STAGE
#undef PG8_LDA
#undef PG8_LDB
#undef PG8_MMA
#undef PG8_WAIT_V
#undef PG8_WAIT_L
#undef PG8_BAR
#undef PG8_SCHED
}
}
constexpr int NWAVES = 8;
constexpr int BATCH = 4, SEQ = 8192, D = 1024, M = BATCH * SEQ, CTXL = 256, MC = BATCH * CTXL;
constexpr int NINE = 1792, NEXP = 32, EH = 512;
constexpr float EPS = 1e-6f;
constexpr int N_PHASES = 18;
#ifndef MK_ONE_LAUNCH
#define MK_ONE_LAUNCH 1
#endif
constexpr size_t MiB = 1u << 20;
constexpr size_t WS_CTL = 0, CTL_ZERO_BYTES = 1 * MiB;
constexpr size_t WS_MOD = 1 * MiB;
constexpr size_t WS_MODC = WS_MOD + 2 * 4 * 6144 * 4;
constexpr size_t WS_MODP = 1 * MiB + 768 * 1024;
static_assert(WS_MODC + 6144 * 4 <= 1 * MiB + 256 * 1024, "MOD/MODC overlap the rope tables");
constexpr size_t WS_ROPE = 1 * MiB + 256 * 1024;
constexpr size_t WS_WSP = 1 * MiB + 512 * 1024;
constexpr size_t WS_TOKE = 2 * MiB;
constexpr size_t WS_TOKP = 2 * MiB + 256 * 1024;
constexpr size_t WS_TOKW = 2 * MiB + 512 * 1024;
constexpr size_t WS_TOKS = 2 * MiB + 768 * 1024;
constexpr size_t WS_KC = 3 * MiB;
constexpr size_t WS_VCT = 3 * MiB + 256 * 1024;
constexpr size_t WS_VT = 4 * MiB;
constexpr size_t WS_WINE = 12 * MiB, WS_WOUTE = 16 * MiB, WS_WINO = 18 * MiB, WS_WOUTO = 24 * MiB;
constexpr size_t WS_WGU = 26 * MiB;
constexpr size_t WS_WD = 154 * MiB;
constexpr size_t WS_H = 218 * MiB;
constexpr size_t WS_A = 284 * MiB;
constexpr size_t WS_B = 428 * MiB;
constexpr size_t WS_RSS = 500 * MiB;
constexpr size_t WS_CSC = 502 * MiB;
constexpr size_t WS_CSC2 = 502 * MiB + 256 * 1024;
constexpr size_t WS_RSC = 502 * MiB + 512 * 1024;
constexpr size_t WS_LAT = 503 * MiB;
constexpr size_t WS_END = 567 * MiB;
constexpr int CW_TMO = 0, CW_CODE = 1, CW_BAR = 4096, CW_GCNT = 8192;

constexpr int RING_BYTES = 131072;
constexpr int LDS_BYTES = 155648;
constexpr int MISC_OFF = LDS_BYTES - 256;
constexpr int MOE_TAB_OFF = RING_BYTES;
constexpr int RW_STRIDE = 2064;
constexpr int RT_WH = 0, RT_WL = 36 * RW_STRIDE, RT_CNT = 72 * RW_STRIDE, RT_BASE = RT_CNT + 128, RT_INFO = RT_CNT + 256;
static_assert(RT_INFO + 128 * 6 * 4 <= MISC_OFF, "LDS map");

#define GAS __attribute__((address_space(1)))
#define LAS __attribute__((address_space(3)))
typedef unsigned short bf16;
typedef unsigned v4u __attribute__((ext_vector_type(4)));
typedef unsigned v2u __attribute__((ext_vector_type(2)));
typedef float f32x4 __attribute__((ext_vector_type(4)));
typedef float f32x16 __attribute__((ext_vector_type(16)));
typedef short bf16x8 __attribute__((ext_vector_type(8)));
typedef GAS unsigned gu32;
#define RLX_AGENT __ATOMIC_RELAXED, __HIP_MEMORY_SCOPE_AGENT
#define LDS_WAIT() asm volatile("s_waitcnt lgkmcnt(0)" ::: "memory")
__device__ __forceinline__ unsigned f2bf(float f) { unsigned u = __builtin_bit_cast(unsigned, f); return (u + 0x7fffu + ((u >> 16) & 1u)) >> 16; }
__device__ __forceinline__ unsigned pk2(float lo, float hi) { return f2bf(lo) | (f2bf(hi) << 16); }
__device__ __forceinline__ float bflo(unsigned w) { return __builtin_bit_cast(float, w << 16); }
__device__ __forceinline__ float bfhi(unsigned w) { return __builtin_bit_cast(float, w & 0xffff0000u); }
__device__ __forceinline__ float wave_sum(float v) {
#pragma unroll
    for (int o = 1; o < 64; o <<= 1) v += __shfl_xor(v, o);
    return v;
}
#define XB_TMO      128
#define XB_XCNT(j)  (256  + 64 * (j))
#define XB_XSUB(j)  (1280 + 64 * (j))
#define XB_XGEN(j)  (2304 + 64 * (j))
#define XB_TOP      3328
#define XB_TOPGEN   3392
#define XCD_BAR_WORDS 3456
#define XB_SPIN_CAP (1u << 18)

__device__ __forceinline__ unsigned xb_ld(unsigned* p)              { return __hip_atomic_load(p, __ATOMIC_RELAXED, __HIP_MEMORY_SCOPE_AGENT); }
__device__ __forceinline__ unsigned xb_add(unsigned* p, unsigned v) { return __hip_atomic_fetch_add(p, v, __ATOMIC_RELAXED, __HIP_MEMORY_SCOPE_AGENT); }
__device__ __forceinline__ unsigned xb_xcc_id() { return (unsigned)__builtin_amdgcn_s_getreg((3 << 11) | 20) & 0xFu; }
#define XB_SPIN(cond, bar) do { unsigned _sp = 0; while (cond) { __builtin_amdgcn_s_sleep(1); \
    if ((++_sp & 255u) == 0u) { if (xb_ld(&(bar)[XB_TMO])) break; if (_sp > XB_SPIN_CAP) { atomicAdd(&(bar)[XB_TMO], 1u); break; } } } } while (0)

struct XcdBarrier {
    unsigned* bar; unsigned x;
    volatile LAS unsigned* st;
};

__device__ __forceinline__ XcdBarrier xcd_barrier_post(unsigned* bar, volatile LAS unsigned* st) {
    XcdBarrier b; b.bar = bar; b.x = xb_xcc_id(); b.st = st;
    if (threadIdx.x == 0) (void)xb_add(&bar[XB_XCNT(b.x)], 1u);
    return b;
}
__device__ __forceinline__ void xcd_barrier_complete(unsigned* bar, unsigned x, unsigned& nloc, unsigned& nx) {
    const unsigned G = gridDim.x * gridDim.y * gridDim.z;
    unsigned sum, cnt, mine, sp = 0u;
    for (;;) {
        sum = 0u; cnt = 0u; mine = 0u;
#pragma unroll
        for (unsigned j = 0; j < 16; ++j) { const unsigned c = xb_ld(&bar[XB_XCNT(j)]); sum += c; cnt += (c > 0u) ? 1u : 0u; mine = (j == x) ? c : mine; }
        if (sum == G) break;
        __builtin_amdgcn_s_sleep(1);
        if ((++sp & 255u) == 0u) { if (xb_ld(&bar[XB_TMO])) break; if (sp > XB_SPIN_CAP) { atomicAdd(&bar[XB_TMO], 1u); break; } }
    }
    nloc = mine > 0u ? mine : 1u; nx = cnt > 0u ? cnt : 1u;
}

__device__ __forceinline__ void xcd_barrier(const XcdBarrier& b, const int xb_tid) {
    asm volatile("s_waitcnt vmcnt(0)" ::: "memory");
    __syncthreads();
    if (xb_tid == 0) {
        unsigned* bar = b.bar;
        __builtin_amdgcn_s_waitcnt(0);
        unsigned nloc = b.st[0], nx = b.st[1];
        if (nloc == 0u) { xcd_barrier_complete(bar, b.x, nloc, nx); b.st[0] = nloc; b.st[1] = nx; }
        const unsigned old = xb_add(&bar[XB_XSUB(b.x)], 1u);
        const unsigned gen = old / nloc;
        if (old + 1u == (gen + 1u) * nloc) {
            __builtin_amdgcn_fence(__ATOMIC_RELEASE, "agent");
            asm volatile("s_waitcnt vmcnt(0)" ::: "memory");
            const unsigned og = xb_add(&bar[XB_TOP], 1u);
            const unsigned tg = og / nx;
            if (og + 1u == (tg + 1u) * nx) xb_add(&bar[XB_TOPGEN], 1u);
            else XB_SPIN(xb_ld(&bar[XB_TOPGEN]) == tg, bar);
            __builtin_amdgcn_fence(__ATOMIC_ACQUIRE, "agent");
            xb_add(&bar[XB_XGEN(b.x)], 1u);
            asm volatile("s_waitcnt vmcnt(0)" ::: "memory");
        } else {
            XB_SPIN(xb_ld(&bar[XB_XGEN(b.x)]) == gen, bar);
            __builtin_amdgcn_fence(__ATOMIC_ACQUIRE, "agent");
            asm volatile("s_waitcnt vmcnt(0)" ::: "memory");
        }
    }
    __syncthreads();
}

struct Args { const float* in[25]; float* out; unsigned char* ws; int ph_lo, ph_hi; };
struct Ctx {
    LAS unsigned char* lds; unsigned ldsaddr;
    int tid, lane, wave, G, bid;
    float* out; unsigned char* ws; gu32* ctl;
};
__device__ __forceinline__ const float* kin(int k) {
    const __attribute__((address_space(4))) Args* ka = (const __attribute__((address_space(4))) Args*)__builtin_amdgcn_kernarg_segment_ptr();
    return (const float*)(const GAS float*)ka->in[k];
}
__device__ const float ROPE_INV[16] = {1.000000000e+00f, 5.623413324e-01f, 3.162277639e-01f, 1.778279394e-01f, 1.000000015e-01f, 5.623413250e-02f, 3.162277490e-02f, 1.778279431e-02f,
                                       9.999999776e-03f, 5.623413250e-03f, 3.162277630e-03f, 1.778279431e-03f, 1.000000047e-03f, 5.623413017e-04f, 3.162277571e-04f, 1.778279402e-04f};

__device__ __forceinline__ void transpose_item(const float* W, int K, int N, bf16* WT, int k0, int n0, int drow0, LAS float* scr, int lane) {
#pragma unroll 8
    for (int i = 0; i < 32; ++i) { const int kk = 2 * i + (lane >> 5); scr[kk * 33 + (lane & 31)] = W[(size_t)(k0 + kk) * N + n0 + (lane & 31)]; }
    LDS_WAIT(); asm volatile("" ::: "memory");
    const int c = lane & 7;
#pragma unroll
    for (int j = 0; j < 4; ++j) { const int n = (lane >> 3) + 8 * j; const LAS float* s = scr + (8 * c) * 33 + n;
        v4u o; o.x = pk2(s[0 * 33], s[1 * 33]); o.y = pk2(s[2 * 33], s[3 * 33]); o.z = pk2(s[4 * 33], s[5 * 33]); o.w = pk2(s[6 * 33], s[7 * 33]);
        *(GAS v4u*)(WT + (size_t)(drow0 + n) * K + k0 + 8 * c) = o; }
    LDS_WAIT(); asm volatile("" ::: "memory");
}
__device__ __forceinline__ void sincos_acc(float a, float& s, float& c) {
    const double x = (double)a, kf = __builtin_rint(x * 0.63661977236758134308), r = x - kf * 1.57079632679489661923, r2 = r * r;
    const double sp = r * (1.0 + r2 * (-1.0 / 6 + r2 * (1.0 / 120 + r2 * (-1.0 / 5040 + r2 * (1.0 / 362880 + r2 * (-1.0 / 39916800 + r2 * (1.0 / 6227020800.0)))))));
    const double cp = 1.0 + r2 * (-0.5 + r2 * (1.0 / 24 + r2 * (-1.0 / 720 + r2 * (1.0 / 40320 + r2 * (-1.0 / 3628800 + r2 * (1.0 / 479001600 + r2 * (-1.0 / 87178291200.0)))))));
    const int k = (int)kf & 3;
    s = (float)((k == 0) ? sp : (k == 1) ? cp : (k == 2) ? -sp : -cp);
    c = (float)((k == 0) ? cp : (k == 1) ? -sp : (k == 2) ? -cp : sp);
}
__device__ __forceinline__ void adaln_unit(const Ctx& C, int u) {
    const int l = u / 96, col = (u % 96) * 64 + C.lane;
    LAS float* sil = (LAS float*)C.lds; LAS float* red = (LAS float*)(C.lds + 5 * 1024 * 4);
    for (int idx = C.tid; idx < 5120; idx += NWAVES * 64) { const float v = (idx < 4096) ? kin(1)[idx] : kin(3)[idx - 4096]; sil[idx] = v / (1.0f + __expf(-v)); }
    __syncthreads();
    float acc[5] = {0.f, 0.f, 0.f, 0.f, 0.f};
    const int k0 = C.wave * 128; const float* wp = kin(4) + (size_t)l * 1024 * 6144 + (size_t)k0 * 6144 + col;
#pragma unroll 8
    for (int kk = 0; kk < 128; ++kk) { const float w = wp[(size_t)kk * 6144];
#pragma unroll
        for (int v = 0; v < 5; ++v) acc[v] += sil[v * 1024 + k0 + kk] * w; }
#pragma unroll
    for (int v = 0; v < 5; ++v) red[(C.wave * 5 + v) * 64 + C.lane] = acc[v];
    __syncthreads();
    if (C.wave == 0) {
        float* MOD = (float*)(C.ws + WS_MOD); float* MODC = (float*)(C.ws + WS_MODC); float* MODP = (float*)(C.ws + WS_MODP); const float bias = kin(5)[l * 6144 + col];
#pragma unroll
        for (int v = 0; v < 5; ++v) { float s = 0.f;
#pragma unroll
            for (int w = 0; w < NWAVES; ++w) s += red[(w * 5 + v) * 64 + C.lane];
            s += bias;
            if (v < 4) { MOD[(size_t)(l * 4 + v) * 6144 + col] = s;
                const int ch = col >> 10;
                if (ch == 1 || ch == 4) { const int w2 = (ch == 4) ? 1 : 0; MODP[(size_t)((l * 4 + v) * 2 + w2) * 1024 + (col & 1023)] = ((w2 ? kin(7) : kin(6))[l * 1024 + (col & 1023)]) * (1.0f + s); }
            } else if (l == 0) MODC[col] = s; }
    }
    __syncthreads();
}
struct StripDesc { const float* W; int N, n0, drow0; unsigned char* W8; float* CSC; };
constexpr int N_STRIPS = 2048 + 96 + 32;
__device__ __forceinline__ StripDesc strip_desc(const Ctx& C, int st) {
    StripDesc d;
    if (st < 2048) { const int me = st >> 5, which = (st >> 4) & 1, j0 = 32 * (st & 15);
        d.W = (which ? kin(23) : kin(22)) + (size_t)me * 1024 * 512; d.N = 512; d.n0 = j0; d.W8 = (unsigned char*)(C.ws + WS_WGU) + (size_t)me * 1024 * 1024; d.CSC = (float*)(C.ws + WS_CSC) + (size_t)me * 1024;
        d.drow0 = 256 * (j0 >> 7) + (j0 & 127) + 128 * which;
    } else if (st < 2048 + 96) { const int n0 = 32 * (st - 2048), j = n0 & 1023;
        d.W = kin(15); d.N = 3072; d.n0 = n0; d.W8 = (unsigned char*)(C.ws + WS_WINO); d.CSC = (float*)(C.ws + WS_CSC2); d.drow0 = (n0 < 1024) ? 2048 + n0 : 256 * (j >> 7) + (j & 127) + ((n0 >= 2048) ? 128 : 0);
    } else { const int n0 = 32 * (st - 2048 - 96);
        d.W = kin(17); d.N = 1024; d.n0 = n0; d.W8 = (unsigned char*)(C.ws + WS_WOUTO); d.CSC = (float*)(C.ws + WS_CSC2) + 3072; d.drow0 = n0; }
    return d;
}
#define QS_LOAD(v, d) do { const float* p_ = (d).W + (size_t)(16 * kr) * (d).N + (d).n0 + 4 * c4; _Pragma("unroll") for (int i = 0; i < 16; ++i) v[i] = *(const f32x4*)(p_ + (size_t)i * (d).N); } while (0)
__device__ __forceinline__ void quant_strip_regs(const Ctx& C, const f32x4 (&v)[16], const StripDesc& d, int par) {
    const int c4 = C.tid & 7, kr = C.tid >> 3;
    LAS float* part = (LAS float*)(C.lds + par * 8448); LAS float* cmax = part + 2048;
    f32x4 mx = (f32x4){0.f, 0.f, 0.f, 0.f};
#pragma unroll
    for (int i = 0; i < 16; ++i) mx = __builtin_elementwise_max(mx, __builtin_elementwise_abs(v[i]));
#pragma unroll
    for (int j = 0; j < 4; ++j) part[kr * 32 + 4 * c4 + j] = mx[j];
    __syncthreads();
    if (C.tid < 32) { float m = 0.f;
        for (int g = 0; g < 64; ++g) m = fmaxf(m, part[g * 32 + C.tid]);
        cmax[C.tid] = m; d.CSC[d.drow0 + C.tid] = m > 0.f ? m * (1.0f / 127.0f) : 1.0f; }
    __syncthreads();
#pragma unroll
    for (int j = 0; j < 4; ++j) { const float am = cmax[4 * c4 + j], inv = am > 0.f ? 127.0f / am : 0.f; unsigned w[4];
#pragma unroll
        for (int g = 0; g < 4; ++g) { unsigned acc = 0u;
#pragma unroll
            for (int e = 0; e < 4; ++e) acc |= ((unsigned)(int)__builtin_rintf(v[4 * g + e][j] * inv) & 0xffu) << (8 * e);
            w[g] = acc; }
        *(v4u*)(d.W8 + (size_t)(d.drow0 + 4 * c4 + j) * 1024 + 16 * kr) = (v4u){w[0], w[1], w[2], w[3]}; }
}
__device__ __forceinline__ void quant_strips(const Ctx& C) {
    const int c4 = C.tid & 7, kr = C.tid >> 3;
    f32x4 va[16], vb[16];
    int st = C.bid; if (st >= N_STRIPS) return;
    StripDesc da = strip_desc(C, st), db = da; QS_LOAD(va, da);
#pragma unroll 1
    for (;;) {
        const bool hb = st + C.G < N_STRIPS; if (hb) { db = strip_desc(C, st + C.G); QS_LOAD(vb, db); }
        quant_strip_regs(C, va, da, 0);
        if (!hb) break;
        st += 2 * C.G; const bool ha = st < N_STRIPS; if (ha) { da = strip_desc(C, st); QS_LOAD(va, da); }
        quant_strip_regs(C, vb, db, 1);
        if (!ha) break;
    }
    __syncthreads();
}
#undef QS_LOAD
__device__ __forceinline__ void p0_prologue(const Ctx& C) {
    for (int u = C.bid; u < 192; u += C.G) adaln_unit(C, u);
    quant_strips(C);
    LAS float* scr = (LAS float*)(C.lds + C.wave * 16384);
    const int gw = C.bid * NWAVES + C.wave, NGW = C.G * NWAVES;
    constexpr int NDENSE = 896 + 512, NITEMS = NDENSE + 64 * 256;
    for (int it = gw; it < NITEMS; it += NGW) {
        int r = it;
        if (r < 896) { transpose_item(kin(9), 1024, 1792, (bf16*)(C.ws + WS_WINE), 64 * (r / 56), 32 * (r % 56), 32 * (r % 56), scr, C.lane); continue; } r -= 896;
        if (r < 512) { transpose_item(kin(14), 1024, 1024, (bf16*)(C.ws + WS_WOUTE), 64 * (r / 32), 32 * (r % 32), 32 * (r % 32), scr, C.lane); continue; } r -= 512;
        const int me = r >> 8, s = r & 255;
        transpose_item(kin(24) + (size_t)me * 512 * 1024, 512, 1024, (bf16*)(C.ws + WS_WD) + (size_t)me * 1024 * 512, 64 * (s >> 5), 32 * (s & 31), 32 * (s & 31), scr, C.lane);
    }
    for (int it = gw; it < 256; it += NGW) {
        const f32x4* src = (const f32x4*)(kin(12) + (size_t)it * 512) + 2 * C.lane; const f32x4 a = src[0], b = src[1];
        v4u o; o.x = pk2(a.x, a.y); o.y = pk2(a.z, a.w); o.z = pk2(b.x, b.y); o.w = pk2(b.z, b.w);
        *(v4u*)((bf16*)(C.ws + WS_WSP) + (size_t)it * 512 + 8 * C.lane) = o;
    }
    { const int gt = gw * 64 + C.lane;
        if (gt < 2048) { float s, c; sincos_acc((float)(gt >> 4) * ROPE_INV[gt & 15], s, c); ((float*)(C.ws + WS_ROPE))[gt] = c; ((float*)(C.ws + WS_ROPE))[2048 + gt] = s; } }
}

__device__ __forceinline__ void unpack8(const v4u w, float (&f)[8]) { f[0] = bflo(w.x); f[1] = bfhi(w.x); f[2] = bflo(w.y); f[3] = bfhi(w.y); f[4] = bflo(w.z); f[5] = bfhi(w.z); f[6] = bflo(w.w); f[7] = bfhi(w.w); }
__device__ __forceinline__ void load_mod(const float* gam, const float* shp, const float* scp, int lane, f32x4 (&sc)[4], f32x4 (&sh)[4]) {
#pragma unroll
    for (int j = 0; j < 4; ++j) { const int idx = lane + 64 * j; const f32x4 g = ((const f32x4*)gam)[idx], s = ((const f32x4*)scp)[idx]; sc[j] = g * (1.0f + s); sh[j] = ((const f32x4*)shp)[idx]; }
}
__device__ __forceinline__ float row_rinv(const f32x4 (&v)[4]) {
    float ss = 0.f;
#pragma unroll
    for (int j = 0; j < 4; ++j) ss += (v[j].x * v[j].x + v[j].y * v[j].y) + (v[j].z * v[j].z + v[j].w * v[j].w);
    return rsqrtf(wave_sum(ss) * (1.0f / 1024.0f) + EPS);
}
__device__ __forceinline__ void mod_store(const f32x4 (&v)[4], float rinv, const f32x4 (&sc)[4], const f32x4 (&sh)[4], bf16* orow, int lane) {
#pragma unroll
    for (int j = 0; j < 4; ++j) { const f32x4 o = v[j] * rinv * sc[j] + sh[j]; v2u w; w.x = pk2(o.x, o.y); w.y = pk2(o.z, o.w); ((v2u*)orow)[lane + 64 * j] = w; }
}
__device__ __forceinline__ void mod_store8(const f32x4 (&v)[4], float rinv, const f32x4 (&sc)[4], const f32x4 (&sh)[4], unsigned char* orow8, float* rsc, int lane) {
    f32x4 o[4]; float am = 0.f;
#pragma unroll
    for (int j = 0; j < 4; ++j) { o[j] = v[j] * rinv * sc[j] + sh[j]; am = fmaxf(am, fmaxf(fmaxf(fabsf(o[j].x), fabsf(o[j].y)), fmaxf(fabsf(o[j].z), fabsf(o[j].w)))); }
#pragma unroll
    for (int s = 1; s < 64; s <<= 1) am = fmaxf(am, __shfl_xor(am, s));
    const float inv = am > 0.f ? 127.0f / am : 0.f;
#pragma unroll
    for (int j = 0; j < 4; ++j) { const unsigned w = ((unsigned)(int)__builtin_rintf(o[j].x * inv) & 0xffu) | (((unsigned)(int)__builtin_rintf(o[j].y * inv) & 0xffu) << 8) | (((unsigned)(int)__builtin_rintf(o[j].z * inv) & 0xffu) << 16) | (((unsigned)(int)__builtin_rintf(o[j].w * inv) & 0xffu) << 24);
        ((unsigned*)orow8)[lane + 64 * j] = w; }
    if (lane == 0) *rsc = am > 0.f ? am * (1.0f / 127.0f) : 1.0f;
}
__device__ __forceinline__ void phase_norm1_l0(const Ctx& C) {
    const int gw = C.bid * NWAVES + C.wave, NGW = C.G * NWAVES;
    const float* MOD = (const float*)(C.ws + WS_MOD); const float* MODC = (const float*)(C.ws + WS_MODC); bf16* H = (bf16*)(C.ws + WS_H);
    for (int grp = gw; grp < (M + MC) / 16; grp += NGW) {
        f32x4 sc[4], sh[4]; const float* src;
        if (grp < M / 16) { const float* mod = MOD + (size_t)(grp >> 9) * 6144; load_mod(kin(6), mod, mod + 1024, C.lane, sc, sh); src = kin(0) + (size_t)grp * 16 * D; }
        else { load_mod(kin(6), MODC, MODC + 1024, C.lane, sc, sh); src = kin(2) + (size_t)(grp - M / 16) * 16 * D; }
        bf16* dst = H + (size_t)grp * 16 * D;
        f32x4 va[4][4], vb[4][4];
#define N1_LOAD(buf, r0) do { _Pragma("unroll") for (int r = 0; r < 4; ++r) _Pragma("unroll") for (int j = 0; j < 4; ++j) buf[r][j] = ((const f32x4*)(src + (size_t)((r0) + r) * D))[C.lane + 64 * j]; } while (0)
#define N1_PROC(buf, r0) do { _Pragma("unroll") for (int r = 0; r < 4; ++r) mod_store(buf[r], row_rinv(buf[r]), sc, sh, dst + (size_t)((r0) + r) * D, C.lane); } while (0)
        N1_LOAD(va, 0);
#pragma unroll 1
        for (int it = 0; it < 2; ++it) { const int r0 = 8 * it;
            N1_LOAD(vb, r0 + 4); N1_PROC(va, r0);
            if (it < 1) N1_LOAD(va, r0 + 8);
            N1_PROC(vb, r0 + 4); }
#undef N1_LOAD
#undef N1_PROC
    }
}
__device__ __forceinline__ void phase_router(const Ctx& C, int l) {
    LAS unsigned char* WH = C.lds + RT_WH; LAS unsigned char* WL = C.lds + RT_WL;
    LAS int* cnt = (LAS int*)(C.lds + RT_CNT); LAS int* base = (LAS int*)(C.lds + RT_BASE); LAS int* info = (LAS int*)(C.lds + RT_INFO);
    const float* wrg = kin(18) + l * 4096; const float* wre = kin(20) + l * 32768; const float* brg = kin(19) + l * 4; const float* bre = kin(21) + l * 32;
    for (int idx = C.tid; idx < 9216; idx += NWAVES * 64) { const int k = idx / 9, q9 = idx - 9 * k;
        const f32x4 v = (q9 == 0) ? *(const f32x4*)(wrg + 4 * k) : *(const f32x4*)(wre + 32 * k + 4 * (q9 - 1));
        const int row0 = (q9 == 0) ? 32 : 16 * ((q9 - 1) & 1) + 4 * ((q9 - 1) >> 1);
#pragma unroll
        for (int i = 0; i < 4; ++i) { const unsigned hi = f2bf(v[i]), lo = f2bf(v[i] - bflo(hi));
            *(LAS bf16*)(WH + (row0 + i) * RW_STRIDE + 2 * k) = (bf16)hi; *(LAS bf16*)(WL + (row0 + i) * RW_STRIDE + 2 * k) = (bf16)lo; } }
    if (C.tid < 32) cnt[C.tid] = 0;
    __syncthreads();
    const float* MOD = (const float*)(C.ws + WS_MOD); const float* MODP = (const float*)(C.ws + WS_MODP); const float* RSS = (const float*)(C.ws + WS_RSS); bf16* H = (bf16*)(C.ws + WS_H);
    gu32* gcnt = C.ctl + CW_GCNT + l * 32;
    int* TOKE = (int*)(C.ws + WS_TOKE); int* TOKP = (int*)(C.ws + WS_TOKP); float* TOKW = (float*)(C.ws + WS_TOKW);
    const int r = C.lane & 15, q = C.lane >> 4;
    for (int rb = C.bid; rb < M / 128; rb += C.G) {
        const int bq = rb >> 6; const size_t row = (size_t)rb * 128 + C.wave * 16 + r;
        float rinv; { const f32x4* rp = (const f32x4*)(RSS + row * 16); const f32x4 a = rp[0], b = rp[1], c = rp[2], d = rp[3];
            const f32x4 t = (a + b) + (c + d); rinv = rsqrtf(((t.x + t.y) + (t.z + t.w)) * (1.0f / 1024.0f) + EPS); }
        const v4u* xr = (const v4u*)((const bf16*)(C.ws + WS_LAT) + row * D + 8 * q);
        const f32x4* sp = (const f32x4*)(MODP + (size_t)((l * 4 + bq) * 2 + 1) * 1024 + 8 * q); const f32x4* hp = (const f32x4*)(MOD + (size_t)(l * 4 + bq) * 6144 + 3 * 1024 + 8 * q);
        bf16* hrow = H + row * D + 8 * q;
        const LAS unsigned char* a0 = WH + (C.lane & 15) * RW_STRIDE + 16 * q; const LAS unsigned char* a2 = WH + (32 + (C.lane & 3)) * RW_STRIDE + 16 * q;
        pg8::f32x4 acc[3];
#pragma unroll
        for (int t = 0; t < 3; ++t) acc[t] = (pg8::f32x4){0.f, 0.f, 0.f, 0.f};
        v4u xc[4], xn[4];
#pragma unroll
        for (int s = 0; s < 4; ++s) xc[s] = xr[4 * s];
        for (int kb = 0; kb < 8; ++kb) {
            if (kb < 7) {
#pragma unroll
                for (int s = 0; s < 4; ++s) xn[s] = xr[4 * (4 * (kb + 1) + s)]; }
            f32x4 sv[8], hv[8];
#pragma unroll
            for (int s = 0; s < 4; ++s) { sv[2 * s] = sp[8 * (4 * kb + s)]; sv[2 * s + 1] = sp[8 * (4 * kb + s) + 1]; hv[2 * s] = hp[8 * (4 * kb + s)]; hv[2 * s + 1] = hp[8 * (4 * kb + s) + 1]; }
#pragma unroll
            for (int s = 0; s < 4; ++s) { const int kk = 4 * kb + s;
                const f32x4 x0 = (f32x4){bflo(xc[s].x), bfhi(xc[s].x), bflo(xc[s].y), bfhi(xc[s].y)}, x1 = (f32x4){bflo(xc[s].z), bfhi(xc[s].z), bflo(xc[s].w), bfhi(xc[s].w)};
                const f32x4 h0 = x0 * rinv * sv[2 * s] + hv[2 * s], h1 = x1 * rinv * sv[2 * s + 1] + hv[2 * s + 1];
                v4u hi; hi.x = pg8::cvt_pk_bf16(h0.x, h0.y); hi.y = pg8::cvt_pk_bf16(h0.z, h0.w); hi.z = pg8::cvt_pk_bf16(h1.x, h1.y); hi.w = pg8::cvt_pk_bf16(h1.z, h1.w);
                v4u lo; lo.x = pg8::cvt_pk_bf16(h0.x - bflo(hi.x), h0.y - bfhi(hi.x)); lo.y = pg8::cvt_pk_bf16(h0.z - bflo(hi.y), h0.w - bfhi(hi.y));
                lo.z = pg8::cvt_pk_bf16(h1.x - bflo(hi.z), h1.y - bfhi(hi.z)); lo.w = pg8::cvt_pk_bf16(h1.z - bflo(hi.w), h1.w - bfhi(hi.w));
                *(v4u*)(hrow + 32 * kk) = hi;
                const bf16x8 bh = __builtin_bit_cast(bf16x8, hi), bl = __builtin_bit_cast(bf16x8, lo);
#pragma unroll
                for (int t = 0; t < 3; ++t) { const LAS unsigned char* ap = ((t == 2) ? a2 : a0 + 16 * t * RW_STRIDE) + 64 * kk;
                    const bf16x8 ah = *(const LAS bf16x8*)ap, al = *(const LAS bf16x8*)(ap + RT_WL);
                    acc[t] = __builtin_amdgcn_mfma_f32_16x16x32_bf16(ah, bh, acc[t], 0, 0, 0);
                    acc[t] = __builtin_amdgcn_mfma_f32_16x16x32_bf16(al, bh, acc[t], 0, 0, 0);
                    acc[t] = __builtin_amdgcn_mfma_f32_16x16x32_bf16(ah, bl, acc[t], 0, 0, 0); } }
            if (kb < 7) {
#pragma unroll
                for (int s = 0; s < 4; ++s) xc[s] = xn[s]; }
        }
        float gl[4];
#pragma unroll
        for (int gi = 0; gi < 4; ++gi) gl[gi] = acc[2][gi] + brg[gi];
        int gidx = 0; float gmax = gl[0];
#pragma unroll
        for (int gi = 1; gi < 4; ++gi) if (gl[gi] > gmax) { gmax = gl[gi]; gidx = gi; }
        if (q == gidx) {
            float den = 0.f;
#pragma unroll
            for (int gi = 0; gi < 4; ++gi) den += __expf(gl[gi] - gmax);
            const float gwt = 1.0f / den;
            float ev[8];
#pragma unroll
            for (int j = 0; j < 8; ++j) ev[j] = acc[j >> 2][j & 3] + bre[8 * q + j];
            int i0 = 0; float v0 = ev[0];
#pragma unroll
            for (int j = 1; j < 8; ++j) if (ev[j] > v0) { v0 = ev[j]; i0 = j; }
            int i1 = (i0 == 0) ? 1 : 0; float v1 = (i0 == 0) ? ev[1] : ev[0];
#pragma unroll
            for (int j = 1; j < 8; ++j) if (j != i0 && ev[j] > v1) { v1 = ev[j]; i1 = j; }
            const float t = __expf(v1 - v0), p0 = 1.0f / (1.0f + t), p1 = t * p0;
            const int rr = C.wave * 16 + r, e0 = gidx * 8 + i0, e1 = gidx * 8 + i1;
            const int pl0 = __hip_atomic_fetch_add(cnt + e0, 1, __ATOMIC_RELAXED, __HIP_MEMORY_SCOPE_WORKGROUP), pl1 = __hip_atomic_fetch_add(cnt + e1, 1, __ATOMIC_RELAXED, __HIP_MEMORY_SCOPE_WORKGROUP);
            info[rr * 6 + 0] = e0; info[rr * 6 + 1] = e1; info[rr * 6 + 2] = pl0; info[rr * 6 + 3] = pl1;
            info[rr * 6 + 4] = __builtin_bit_cast(int, gwt * p0); info[rr * 6 + 5] = __builtin_bit_cast(int, gwt * p1);
        }
        __syncthreads();
        if (C.tid < 32) base[C.tid] = (int)__hip_atomic_fetch_add(gcnt + C.tid, (unsigned)cnt[C.tid], RLX_AGENT);
        __syncthreads();
        if (C.tid < 128) { const size_t orow = (size_t)rb * 128 + C.tid; const int e0 = info[C.tid * 6], e1 = info[C.tid * 6 + 1];
            TOKE[orow] = e0 | (e1 << 8); TOKP[orow * 2] = base[e0] + info[C.tid * 6 + 2]; TOKP[orow * 2 + 1] = base[e1] + info[C.tid * 6 + 3];
            TOKW[orow * 2] = __builtin_bit_cast(float, info[C.tid * 6 + 4]); TOKW[orow * 2 + 1] = __builtin_bit_cast(float, info[C.tid * 6 + 5]); }
        __syncthreads();
        if (C.tid < 32) cnt[C.tid] = 0;
        __syncthreads();
    }
}
__device__ __forceinline__ int moe_tables(const Ctx& C, int l) {
    LAS int* tile_e = (LAS int*)(C.lds + MOE_TAB_OFF); LAS int* seg = (LAS int*)(C.lds + MOE_TAB_OFF + 1280); LAS int* lc = (LAS int*)(C.lds + MOE_TAB_OFF + 1280 + 160);
    if (C.tid < 32) lc[C.tid] = (int)__hip_atomic_load(C.ctl + CW_GCNT + l * 32 + C.tid, RLX_AGENT);
    __syncthreads();
    if (C.tid == 0) { int t = 0;
        for (int e = 0; e < 32; ++e) { seg[e] = t * 256; const int n = (lc[e] + 255) >> 8; for (int k = 0; k < n; ++k) tile_e[t + k] = e; t += n; }
        seg[32] = t * 256; }
    __syncthreads();
    return seg[32] >> 8;
}
__device__ __forceinline__ void phase_scatter(const Ctx& C, int l) {
    (void)moe_tables(C, l);
    const LAS int* seg = (const LAS int*)(C.lds + MOE_TAB_OFF + 1280);
    const int gw = C.bid * NWAVES + C.wave, NGW = C.G * NWAVES;
    const int* TOKE = (const int*)(C.ws + WS_TOKE); const int* TOKP = (const int*)(C.ws + WS_TOKP); int* TOKS = (int*)(C.ws + WS_TOKS);
    const bf16* H = (const bf16*)(C.ws + WS_H); unsigned char* XS = (unsigned char*)(C.ws + WS_A); float* RSC = (float*)(C.ws + WS_RSC);
    for (int grp = gw; grp < M / 16; grp += NGW) {
        const int tev = TOKE[(size_t)grp * 16 + (C.lane & 15)], tpv = TOKP[(size_t)grp * 32 + (C.lane & 31)];
        v4u ha[4][2];
#define SC_LOAD(r0) do { _Pragma("unroll") for (int r = 0; r < 4; ++r) { ha[r][0] = ((const v4u*)(H + ((size_t)grp * 16 + (r0) + r) * D))[C.lane]; ha[r][1] = ((const v4u*)(H + ((size_t)grp * 16 + (r0) + r) * D))[C.lane + 64]; } } while (0)
#pragma unroll 1
        for (int r0 = 0; r0 < 16; r0 += 4) {
            SC_LOAD(r0);
#pragma unroll
            for (int r = 0; r < 4; ++r) { const size_t row = (size_t)grp * 16 + r0 + r; const int ee = __builtin_amdgcn_readlane(tev, r0 + r);
                const int s0 = seg[ee & 255] + __builtin_amdgcn_readlane(tpv, 2 * (r0 + r)), s1 = seg[ee >> 8] + __builtin_amdgcn_readlane(tpv, 2 * (r0 + r) + 1);
                float f[2][8]; unpack8(ha[r][0], f[0]); unpack8(ha[r][1], f[1]);
                float am = 0.f;
#pragma unroll
                for (int j = 0; j < 2; ++j)
#pragma unroll
                    for (int e = 0; e < 8; ++e) am = fmaxf(am, fabsf(f[j][e]));
#pragma unroll
                for (int o = 1; o < 64; o <<= 1) am = fmaxf(am, __shfl_xor(am, o));
                const float inv = am > 0.f ? 127.0f / am : 0.f;
                v2u q[2];
#pragma unroll
                for (int j = 0; j < 2; ++j) { unsigned w0 = 0u, w1 = 0u;
#pragma unroll
                    for (int e = 0; e < 4; ++e) { w0 |= ((unsigned)(int)__builtin_rintf(f[j][e] * inv) & 0xffu) << (8 * e); w1 |= ((unsigned)(int)__builtin_rintf(f[j][4 + e] * inv) & 0xffu) << (8 * e); }
                    q[j] = (v2u){w0, w1}; }
                ((v2u*)(XS + (size_t)s0 * 1024))[C.lane] = q[0]; ((v2u*)(XS + (size_t)s0 * 1024))[C.lane + 64] = q[1];
                ((v2u*)(XS + (size_t)s1 * 1024))[C.lane] = q[0]; ((v2u*)(XS + (size_t)s1 * 1024))[C.lane + 64] = q[1];
                if (C.lane == 0) { const float sc = am > 0.f ? am * (1.0f / 127.0f) : 1.0f; TOKS[row * 2] = s0; TOKS[row * 2 + 1] = s1; RSC[s0] = sc; RSC[s1] = sc; } }
        }
#undef SC_LOAD
    }
}
template <bool FINAL> __device__ __forceinline__ void phase_combine(const Ctx& C, int lp) {
    const int gw = C.bid * NWAVES + C.wave, NGW = C.G * NWAVES;
    const float* MOD = (const float*)(C.ws + WS_MOD); bf16* H = (bf16*)(C.ws + WS_H); const bf16* YB = (const bf16*)(C.ws + WS_A); bf16* LAT = (bf16*)(C.ws + WS_LAT);
    const int* TOKS = (const int*)(C.ws + WS_TOKS); const float* TOKW = (const float*)(C.ws + WS_TOKW);
    for (int grp = gw; grp < M / 16; grp += NGW) {
        const int b = grp >> 9; f32x4 g2[4], sc[4], sh[4];
#pragma unroll
        for (int j = 0; j < 4; ++j) g2[j] = ((const f32x4*)(MOD + (size_t)(lp * 4 + b) * 6144 + 5 * 1024))[C.lane + 64 * j];
        if (FINAL) {
#pragma unroll
            for (int j = 0; j < 4; ++j) { sc[j] = ((const f32x4*)kin(8))[C.lane + 64 * j]; sh[j] = (f32x4){0.f, 0.f, 0.f, 0.f}; }
        } else { const float* mod = MOD + (size_t)(4 + b) * 6144; load_mod(kin(6) + 1024, mod, mod + 1024, C.lane, sc, sh); }
        const int tsv = TOKS[(size_t)grp * 32 + (C.lane & 31)], twv = __builtin_bit_cast(int, TOKW[(size_t)grp * 32 + (C.lane & 31)]);
        v2u xv[2][4]; v2u ya[2][4], yc[2][4]; float w0[2], w1[2];
#define CB_LOAD(buf, r0) do { const size_t row_ = (size_t)grp * 16 + (r0); \
            const int s0_ = __builtin_amdgcn_readlane(tsv, 2 * (r0)), s1_ = __builtin_amdgcn_readlane(tsv, 2 * (r0) + 1); \
            w0[buf] = __builtin_bit_cast(float, __builtin_amdgcn_readlane(twv, 2 * (r0))); w1[buf] = __builtin_bit_cast(float, __builtin_amdgcn_readlane(twv, 2 * (r0) + 1)); \
            _Pragma("unroll") for (int j = 0; j < 4; ++j) { xv[buf][j] = ((const v2u*)(LAT + row_ * D))[C.lane + 64 * j]; \
                ya[buf][j] = ((const v2u*)(YB + (size_t)s0_ * D))[C.lane + 64 * j]; yc[buf][j] = ((const v2u*)(YB + (size_t)s1_ * D))[C.lane + 64 * j]; } } while (0)
#define CB_PROC(buf, r0) do { const size_t row = (size_t)grp * 16 + (r0); f32x4 v[4]; \
            _Pragma("unroll") for (int j = 0; j < 4; ++j) { const v2u a = ya[buf][j], c = yc[buf][j]; \
                const f32x4 y0 = (f32x4){bflo(a.x), bfhi(a.x), bflo(a.y), bfhi(a.y)}, y1 = (f32x4){bflo(c.x), bfhi(c.x), bflo(c.y), bfhi(c.y)}; \
                const v2u xw = xv[buf][j]; v[j] = (f32x4){bflo(xw.x), bfhi(xw.x), bflo(xw.y), bfhi(xw.y)} + g2[j] * (y0 * w0[buf] + y1 * w1[buf]); } \
            if (FINAL) { const float rinv = row_rinv(v); _Pragma("unroll") for (int j = 0; j < 4; ++j) ((f32x4*)(C.out + row * D))[C.lane + 64 * j] = v[j] * rinv * sc[j]; } \
            else { _Pragma("unroll") for (int j = 0; j < 4; ++j) { v2u w_; w_.x = pk2(v[j].x, v[j].y); w_.y = pk2(v[j].z, v[j].w); ((v2u*)(LAT + row * D))[C.lane + 64 * j] = w_; \
                    v[j] = (f32x4){bflo(w_.x), bfhi(w_.x), bflo(w_.y), bfhi(w_.y)}; } const float rinv = row_rinv(v); mod_store8(v, rinv, sc, sh, (unsigned char*)H + row * D, (float*)(C.ws + WS_RSC) + row, C.lane); } } while (0)
        CB_LOAD(0, 0);
#pragma unroll 1
        for (int it = 0; it < 8; ++it) { const int r0 = 2 * it;
            CB_LOAD(1, r0 + 1); CB_PROC(0, r0);
            if (it < 7) CB_LOAD(0, r0 + 2);
            CB_PROC(1, r0 + 1); }
#undef CB_PROC
#undef CB_LOAD
    }
}
__device__ __forceinline__ void phase_conv(const Ctx& C) {
    const int gw = C.bid * NWAVES + C.wave, NGW = C.G * NWAVES;
    const bf16* BG = (const bf16*)(C.ws + WS_A); const bf16* Y = BG + (size_t)M * D; unsigned char* MIX8 = (unsigned char*)(C.ws + WS_B); float* RSC = (float*)(C.ws + WS_RSC);
    float cw[3][2][8];
#pragma unroll
    for (int t = 0; t < 3; ++t)
#pragma unroll
        for (int j = 0; j < 2; ++j) { const f32x4 a = *(const f32x4*)(kin(16) + t * 1024 + j * 512 + 8 * C.lane), b = *(const f32x4*)(kin(16) + t * 1024 + j * 512 + 8 * C.lane + 4);
            cw[t][j][0] = a.x; cw[t][j][1] = a.y; cw[t][j][2] = a.z; cw[t][j][3] = a.w; cw[t][j][4] = b.x; cw[t][j][5] = b.y; cw[t][j][6] = b.z; cw[t][j][7] = b.w; }
    const v4u zero4 = (v4u){0u, 0u, 0u, 0u};
    for (int grp = gw; grp < M / 16; grp += NGW) {
        const size_t t0 = (size_t)grp * 16; v4u prev[2], cur[2];
        v4u yn[2][2], bgv[2][2];
#define CV_LOAD(buf, r0) do { const size_t row_ = t0 + (r0); const bool last_ = (row_ & 8191) == 8191; \
            _Pragma("unroll") for (int j = 0; j < 2; ++j) { yn[buf][j] = last_ ? zero4 : ((const v4u*)(Y + (row_ + 1) * D))[C.lane + 64 * j]; bgv[buf][j] = ((const v4u*)(BG + row_ * D))[C.lane + 64 * j]; } } while (0)
#pragma unroll
        for (int j = 0; j < 2; ++j) { prev[j] = ((t0 & 8191) == 0) ? zero4 : ((const v4u*)(Y + (t0 - 1) * D))[C.lane + 64 * j]; cur[j] = ((const v4u*)(Y + t0 * D))[C.lane + 64 * j]; }
#define CV_PROC(buf, r0) do { const size_t row = t0 + (r0); float ov[2][8]; float am = 0.f; \
            _Pragma("unroll") for (int j = 0; j < 2; ++j) { const v4u nx = yn[buf][j]; \
                float fp[8], fc[8], fn[8], fb[8]; unpack8(prev[j], fp); unpack8(cur[j], fc); unpack8(nx, fn); unpack8(bgv[buf][j], fb); \
                _Pragma("unroll") for (int e = 0; e < 8; ++e) { ov[j][e] = fb[e] * (fp[e] * cw[0][j][e] + fc[e] * cw[1][j][e] + fn[e] * cw[2][j][e]); am = fmaxf(am, fabsf(ov[j][e])); } \
                prev[j] = cur[j]; cur[j] = nx; } \
            _Pragma("unroll") for (int s_ = 1; s_ < 64; s_ <<= 1) am = fmaxf(am, __shfl_xor(am, s_)); \
            const float inv = am > 0.f ? 127.0f / am : 0.f; \
            _Pragma("unroll") for (int j = 0; j < 2; ++j) { unsigned w0 = 0u, w1 = 0u; \
                _Pragma("unroll") for (int e = 0; e < 4; ++e) { w0 |= ((unsigned)(int)__builtin_rintf(ov[j][e] * inv) & 0xffu) << (8 * e); w1 |= ((unsigned)(int)__builtin_rintf(ov[j][4 + e] * inv) & 0xffu) << (8 * e); } \
                ((v2u*)(MIX8 + row * D))[C.lane + 64 * j] = (v2u){w0, w1}; } \
            if (C.lane == 0) RSC[row] = am > 0.f ? am * (1.0f / 127.0f) : 1.0f; } while (0)
        CV_LOAD(0, 0);
#pragma unroll 1
        for (int it = 0; it < 8; ++it) { const int r0 = 2 * it;
            CV_LOAD(1, r0 + 1); CV_PROC(0, r0);
            if (it < 7) CV_LOAD(0, r0 + 2);
            CV_PROC(1, r0 + 1); }
#undef CV_PROC
#undef CV_LOAD
    }
}
constexpr float LOG2E = 1.4426950408889634f;
constexpr float QSCALE = 0.125f * LOG2E;
constexpr int AT_K = 0, AT_V = 16384, AT_WS = 32768, AT_ST = 34816;
__device__ __forceinline__ int crow(int r, int hi) { return (r & 3) + 8 * (r >> 2) + 4 * hi; }
__device__ __forceinline__ bf16x8 pack8(float a0, float a1, float a2, float a3, float a4, float a5, float a6, float a7) {
    v4u w; w.x = pg8::cvt_pk_bf16(a0, a1); w.y = pg8::cvt_pk_bf16(a2, a3); w.z = pg8::cvt_pk_bf16(a4, a5); w.w = pg8::cvt_pk_bf16(a6, a7); return __builtin_bit_cast(bf16x8, w);
}
__device__ __forceinline__ void attn_unit(const Ctx& C, int au) {
    const int qblk = au & 127, kvh = (au >> 7) & 1, b = au >> 8;
    const int ph = C.wave & 1, head = kvh * 4 + (C.wave >> 1), q32 = C.lane & 31, hi = C.lane >> 5;
    const bf16* QK = (const bf16*)(C.ws + WS_A); const bf16* VT = (const bf16*)(C.ws + WS_VT); const bf16* KC = (const bf16*)(C.ws + WS_KC); const bf16* VCT = (const bf16*)(C.ws + WS_VCT);
    bf16* MIX = (bf16*)(C.ws + WS_B);
    const size_t qrow = (size_t)b * SEQ + 64 * qblk + 32 * ph + q32;
    bf16x8 qf[4];
#pragma unroll
    for (int ds = 0; ds < 4; ++ds) qf[ds] = *(const bf16x8*)(QK + qrow * NINE + head * 64 + 16 * ds + 8 * hi);
    float m = kin(10)[head] * LOG2E, l = (hi == 0) ? 1.0f : 0.0f;
    f32x16 o0, o1;
#pragma unroll
    for (int r = 0; r < 16; ++r) { o0[r] = 0.f; o1[r] = 0.f; }
    const int jlo = (qblk < 2) ? 2 - qblk : 0, jhi = (qblk > 125) ? 129 - qblk : 4, NT = 4 + jhi - jlo + 1;
    const int prow = C.tid >> 3, pch = C.tid & 7;
    LAS float* wsf = (LAS float*)(C.lds + AT_WS) + C.wave * 64;
    v4u kr0, vr0, kr1, vr1;
#define AT_LOAD(t, kreg, vreg) do { if ((t) < 4) { kreg = *(const v4u*)(KC + ((size_t)(b * 256 + 64 * (t) + prow) * 128 + kvh * 64 + 8 * pch)); \
            vreg = *(const v4u*)(VCT + ((size_t)((b * 2 + kvh) * 64 + prow) * 256 + 64 * (t) + 8 * pch)); } \
        else { const int kblk_ = qblk - 2 + jlo + (t) - 4; kreg = *(const v4u*)(QK + ((size_t)(b * SEQ + 64 * kblk_ + prow) * NINE + 512 + kvh * 64 + 8 * pch)); \
            vreg = *(const v4u*)(VT + ((size_t)((b * 2 + kvh) * 64 + prow) * SEQ + 64 * kblk_ + 8 * pch)); } } while (0)
#define AT_WRITE(bufi, kreg, vreg) do { *(LAS v4u*)(C.lds + AT_K + (bufi) * 8192 + pch * 1024 + prow * 16) = kreg; *(LAS v4u*)(C.lds + AT_V + (bufi) * 8192 + pch * 1024 + prow * 16) = vreg; } while (0)
    AT_LOAD(0, kr0, vr0); AT_LOAD(1, kr1, vr1);
    AT_WRITE(0, kr0, vr0); AT_LOAD(2, kr0, vr0);
    __syncthreads();
    for (int t = 0; t < NT; ++t) {
        const int buf = t & 1;
        if (t + 1 < NT) {
            if (buf == 0) { AT_WRITE(1, kr1, vr1); if (t + 3 < NT) AT_LOAD(t + 3, kr1, vr1); }
            else { AT_WRITE(0, kr0, vr0); if (t + 3 < NT) AT_LOAD(t + 3, kr0, vr0); }
        }
        const LAS unsigned char* kb = C.lds + AT_K + buf * 8192; const LAS unsigned char* vb = C.lds + AT_V + buf * 8192;
        f32x16 p0, p1;
#pragma unroll
        for (int r = 0; r < 16; ++r) { p0[r] = 0.f; p1[r] = 0.f; }
#pragma unroll
        for (int ds = 0; ds < 4; ++ds) {
            const bf16x8 a0 = *(const LAS bf16x8*)(kb + (2 * ds + hi) * 1024 + q32 * 16), a1 = *(const LAS bf16x8*)(kb + (2 * ds + hi) * 1024 + (q32 + 32) * 16);
            p0 = __builtin_amdgcn_mfma_f32_32x32x16_bf16(a0, qf[ds], p0, 0, 0, 0); p1 = __builtin_amdgcn_mfma_f32_32x32x16_bf16(a1, qf[ds], p1, 0, 0, 0);
        }
        const int j = (t < 4) ? -1 : jlo + t - 4;
        if (j == 0 || j == 4) {
            int qq = 32 * ph + q32; asm volatile("" : "+v"(qq));
#pragma unroll
            for (int r = 0; r < 16; ++r) { const int kv = crow(r, hi);
                const bool d0 = (j == 0) ? (kv < qq) : (kv > qq), d1 = (j == 0) ? (kv + 32 < qq) : (kv + 32 > qq);
                if (d0) p0[r] = -__builtin_inff(); if (d1) p1[r] = -__builtin_inff(); }
        }
        float rm = fmaxf(p0[0], p1[0]);
#pragma unroll
        for (int r = 1; r < 16; ++r) rm = fmaxf(rm, fmaxf(p0[r], p1[r]));
        rm = fmaxf(rm, __shfl_xor(rm, 32));
        if (__any(rm > m)) {
            const float mn = fmaxf(m, rm), al = __builtin_amdgcn_exp2f(m - mn); m = mn; l *= al;
            if (hi == 0) wsf[q32] = al;
#pragma unroll
            for (int r = 0; r < 16; ++r) { const float f = wsf[crow(r, hi)]; o0[r] *= f; o1[r] *= f; }
        }
        float ls = 0.f;
#pragma unroll
        for (int r = 0; r < 16; ++r) { p0[r] = __builtin_amdgcn_exp2f(p0[r] - m); p1[r] = __builtin_amdgcn_exp2f(p1[r] - m); ls += p0[r] + p1[r]; }
        l += ls;
#pragma unroll
        for (int s = 0; s < 2; ++s) {
            const bf16x8 pa = pack8(p0[8 * s], p0[8 * s + 1], p0[8 * s + 2], p0[8 * s + 3], p0[8 * s + 4], p0[8 * s + 5], p0[8 * s + 6], p0[8 * s + 7]);
            const bf16x8 pb = pack8(p1[8 * s], p1[8 * s + 1], p1[8 * s + 2], p1[8 * s + 3], p1[8 * s + 4], p1[8 * s + 5], p1[8 * s + 6], p1[8 * s + 7]);
            const bf16x8 va0 = *(const LAS bf16x8*)(vb + (2 * s + hi) * 1024 + q32 * 16), va1 = *(const LAS bf16x8*)(vb + (2 * s + hi) * 1024 + (q32 + 32) * 16);
            const bf16x8 vb0 = *(const LAS bf16x8*)(vb + (4 + 2 * s + hi) * 1024 + q32 * 16), vb1 = *(const LAS bf16x8*)(vb + (4 + 2 * s + hi) * 1024 + (q32 + 32) * 16);
            o0 = __builtin_amdgcn_mfma_f32_32x32x16_bf16(pa, va0, o0, 0, 0, 0); o1 = __builtin_amdgcn_mfma_f32_32x32x16_bf16(pa, va1, o1, 0, 0, 0);
            o0 = __builtin_amdgcn_mfma_f32_32x32x16_bf16(pb, vb0, o0, 0, 0, 0); o1 = __builtin_amdgcn_mfma_f32_32x32x16_bf16(pb, vb1, o1, 0, 0, 0);
        }
        __syncthreads();
    }
#undef AT_LOAD
#undef AT_WRITE
    l += __shfl_xor(l, 32);
    if (hi == 0) wsf[32 + q32] = l;
    LAS bf16* stg = (LAS bf16*)(C.lds + AT_ST) + C.wave * 2048;
#pragma unroll
    for (int r = 0; r < 16; ++r) { const int orow = crow(r, hi); const float rl = 1.0f / wsf[32 + orow];
        stg[orow * 64 + q32] = (bf16)f2bf(o0[r] * rl); stg[orow * 64 + 32 + q32] = (bf16)f2bf(o1[r] * rl); }
    bf16* Ow = MIX + ((size_t)b * SEQ + 64 * qblk + 32 * ph) * D + head * 64;
#pragma unroll
    for (int i = 0; i < 4; ++i) { const int pc = i * 64 + C.lane, row = pc >> 3, ch = pc & 7; const v4u v = *(const LAS v4u*)(stg + row * 64 + ch * 8); *(v4u*)(Ow + (size_t)row * D + ch * 8) = v; }
    __syncthreads();
}
constexpr int ZS = 1040;
__device__ __forceinline__ v2u tr_read(unsigned addr) { v2u r; asm volatile("ds_read_b64_tr_b16 %0, %1\n\ts_waitcnt lgkmcnt(0)" : "=&v"(r) : "v"(addr) : "memory"); return r; }
__device__ __forceinline__ void sgu_unit(const Ctx& C, int su) {
    const size_t R0 = (size_t)su * 128;
    const bf16* QK = (const bf16*)(C.ws + WS_A); bf16* MIX = (bf16*)(C.ws + WS_B); const bf16* WSP = (const bf16*)(C.ws + WS_WSP);
    { float gs[8]; const f32x4 a = *(const f32x4*)(kin(11) + 8 * C.lane), c = *(const f32x4*)(kin(11) + 8 * C.lane + 4);
        gs[0] = a.x; gs[1] = a.y; gs[2] = a.z; gs[3] = a.w; gs[4] = c.x; gs[5] = c.y; gs[6] = c.z; gs[7] = c.w;
#pragma unroll 4
        for (int rr = 0; rr < 16; ++rr) { const int j = C.wave * 16 + rr;
            const v4u zw = *(const v4u*)(QK + (R0 + j) * NINE + 1280 + 8 * C.lane); float x[8]; unpack8(zw, x);
            float s = 0.f;
#pragma unroll
            for (int e = 0; e < 8; ++e) s += x[e];
            const float mean = wave_sum(s) * (1.0f / 512.0f); float q = 0.f;
#pragma unroll
            for (int e = 0; e < 8; ++e) { x[e] -= mean; q += x[e] * x[e]; }
            const float rstd = rsqrtf(wave_sum(q) * (1.0f / 512.0f) + EPS);
            v4u w; w.x = pk2(x[0] * rstd * gs[0], x[1] * rstd * gs[1]); w.y = pk2(x[2] * rstd * gs[2], x[3] * rstd * gs[3]);
            w.z = pk2(x[4] * rstd * gs[4], x[5] * rstd * gs[5]); w.w = pk2(x[6] * rstd * gs[6], x[7] * rstd * gs[7]);
            *(LAS v4u*)(C.lds + j * ZS + 16 * C.lane) = w; }
    }
    __syncthreads();
    const int h = C.wave, l31 = C.lane & 31, hi = C.lane >> 5, g16 = (C.lane >> 4) & 1, q4 = (C.lane & 15) >> 2, p4 = C.lane & 3;
    f32x16 acc[2][4];
#pragma unroll
    for (int cb = 0; cb < 2; ++cb)
#pragma unroll
        for (int ib = 0; ib < 4; ++ib)
#pragma unroll
            for (int r = 0; r < 16; ++r) acc[cb][ib][r] = 0.f;
#pragma unroll 2
    for (int ks = 0; ks < 8; ++ks) {
        bf16x8 bw[4];
#pragma unroll
        for (int ib = 0; ib < 4; ++ib) bw[ib] = *(const bf16x8*)(WSP + ((size_t)h * 128 + 32 * ib + l31) * 128 + 16 * ks + 8 * hi);
        bf16x8 az[2];
#pragma unroll
        for (int cb = 0; cb < 2; ++cb) {
            const unsigned a0 = C.ldsaddr + (unsigned)((16 * ks + 8 * hi + q4) * ZS + (64 * h + 32 * cb + 16 * g16 + 4 * p4) * 2);
            const v2u lo = tr_read(a0), hi2 = tr_read(a0 + 4 * ZS);
            az[cb] = __builtin_bit_cast(bf16x8, (v4u){lo.x, lo.y, hi2.x, hi2.y});
        }
#pragma unroll
        for (int cb = 0; cb < 2; ++cb)
#pragma unroll
            for (int ib = 0; ib < 4; ++ib) acc[cb][ib] = __builtin_amdgcn_mfma_f32_32x32x16_bf16(az[cb], bw[ib], acc[cb][ib], 0, 0, 0);
    }
#pragma unroll
    for (int ib = 0; ib < 4; ++ib) {
        const int i = 32 * ib + l31; const float bias = kin(13)[h * 128 + i]; const size_t row = R0 + i;
#pragma unroll
        for (int cb = 0; cb < 2; ++cb)
#pragma unroll
            for (int rg = 0; rg < 4; ++rg) { const int c = 64 * h + 32 * cb + 8 * rg + 4 * hi;
                const v2u uw = *(const v2u*)(QK + row * NINE + 768 + c);
                const float o0 = bflo(uw.x) * (acc[cb][ib][4 * rg] + bias), o1 = bfhi(uw.x) * (acc[cb][ib][4 * rg + 1] + bias), o2 = bflo(uw.y) * (acc[cb][ib][4 * rg + 2] + bias), o3 = bfhi(uw.y) * (acc[cb][ib][4 * rg + 3] + bias);
                v2u w; w.x = pk2(o0, o1); w.y = pk2(o2, o3); *(v2u*)(MIX + row * D + 512 + c) = w; }
    }
    __syncthreads();
}
__device__ __forceinline__ void phase_attn_sgu(const Ctx& C) {
    for (int au = C.bid; au < BATCH * 2 * 128; au += C.G) attn_unit(C, au);
    for (int su = C.bid; su < M / 128; su += C.G) sgu_unit(C, su);
}
__global__ void __launch_bounds__(NWAVES * 64, 2) mk_fwd(Args args) {
    extern __shared__ __attribute__((aligned(16))) unsigned char lds_raw[];
    Ctx C;
    C.lds = (LAS unsigned char*)lds_raw; C.ldsaddr = (unsigned)(uintptr_t)C.lds;
    C.tid = threadIdx.x; C.lane = C.tid & 63; C.wave = __builtin_amdgcn_readfirstlane(C.tid >> 6);
    C.G = gridDim.x; C.bid = blockIdx.x;
    C.out = args.out; C.ws = args.ws; C.ctl = (gu32*)(args.ws + WS_CTL);
    volatile LAS unsigned* MISC = (volatile LAS unsigned*)(C.lds + MISC_OFF);
    if (C.tid < 64) MISC[C.tid] = 0u;
    __syncthreads();
#define FRESH_IDS(Cx) do { int z_ = 0; asm volatile("" : "+s"(z_)); Cx.lane = (int)__builtin_amdgcn_mbcnt_hi(~0u, __builtin_amdgcn_mbcnt_lo(~0u, (unsigned)z_)); Cx.tid = Cx.wave * 64 + Cx.lane; } while (0)
    const int lo = args.ph_lo, hi = args.ph_hi;
    const bool one = (hi - lo) > 1;
    XcdBarrier bar; bar.bar = (unsigned*)(C.ctl + CW_BAR); bar.x = 0; bar.st = nullptr;
    if (one) bar = xcd_barrier_post((unsigned*)(C.ctl + CW_BAR), MISC + 8);
#ifndef PHMASK
#define PHMASK 0x3ffff
#endif
#define IN(k) (((PHMASK >> (k)) & 1) && lo <= (k) && (k) < hi)
#define SEAM(k) do { if (IN(k) && IN((k) + 1)) { Ctx Cb = C; FRESH_IDS(Cb); xcd_barrier(bar, Cb.tid); } } while (0)
#ifndef DUPMASK
#define DUPMASK 0
#endif
#define DUP(k) DUP_##k
#if (DUPMASK >> 0) & 1
#define DUP_0 _Pragma("unroll") for (int rep_ = 0; rep_ < 2; ++rep_)
#else
#define DUP_0
#endif
#if (DUPMASK >> 1) & 1
#define DUP_1 _Pragma("unroll") for (int rep_ = 0; rep_ < 2; ++rep_)
#else
#define DUP_1
#endif
#if (DUPMASK >> 2) & 1
#define DUP_2 _Pragma("unroll") for (int rep_ = 0; rep_ < 2; ++rep_)
#else
#define DUP_2
#endif
#if (DUPMASK >> 3) & 1
#define DUP_3 _Pragma("unroll") for (int rep_ = 0; rep_ < 2; ++rep_)
#else
#define DUP_3
#endif
#if (DUPMASK >> 4) & 1
#define DUP_4 _Pragma("unroll") for (int rep_ = 0; rep_ < 2; ++rep_)
#else
#define DUP_4
#endif
#if (DUPMASK >> 5) & 1
#define DUP_5 _Pragma("unroll") for (int rep_ = 0; rep_ < 2; ++rep_)
#else
#define DUP_5
#endif
#if (DUPMASK >> 6) & 1
#define DUP_6 _Pragma("unroll") for (int rep_ = 0; rep_ < 2; ++rep_)
#else
#define DUP_6
#endif
#if (DUPMASK >> 7) & 1
#define DUP_7 _Pragma("unroll") for (int rep_ = 0; rep_ < 2; ++rep_)
#else
#define DUP_7
#endif
#if (DUPMASK >> 8) & 1
#define DUP_8 _Pragma("unroll") for (int rep_ = 0; rep_ < 2; ++rep_)
#else
#define DUP_8
#endif
#if (DUPMASK >> 9) & 1
#define DUP_9 _Pragma("unroll") for (int rep_ = 0; rep_ < 2; ++rep_)
#else
#define DUP_9
#endif
#if (DUPMASK >> 10) & 1
#define DUP_10 _Pragma("unroll") for (int rep_ = 0; rep_ < 2; ++rep_)
#else
#define DUP_10
#endif
#if (DUPMASK >> 11) & 1
#define DUP_11 _Pragma("unroll") for (int rep_ = 0; rep_ < 2; ++rep_)
#else
#define DUP_11
#endif
#if (DUPMASK >> 12) & 1
#define DUP_12 _Pragma("unroll") for (int rep_ = 0; rep_ < 2; ++rep_)
#else
#define DUP_12
#endif
#if (DUPMASK >> 13) & 1
#define DUP_13 _Pragma("unroll") for (int rep_ = 0; rep_ < 2; ++rep_)
#else
#define DUP_13
#endif
#if (DUPMASK >> 14) & 1
#define DUP_14 _Pragma("unroll") for (int rep_ = 0; rep_ < 2; ++rep_)
#else
#define DUP_14
#endif
#if (DUPMASK >> 15) & 1
#define DUP_15 _Pragma("unroll") for (int rep_ = 0; rep_ < 2; ++rep_)
#else
#define DUP_15
#endif
#if (DUPMASK >> 16) & 1
#define DUP_16 _Pragma("unroll") for (int rep_ = 0; rep_ < 2; ++rep_)
#else
#define DUP_16
#endif
#if (DUPMASK >> 17) & 1
#define DUP_17 _Pragma("unroll") for (int rep_ = 0; rep_ < 2; ++rep_)
#else
#define DUP_17
#endif
    bf16* const H = (bf16*)(C.ws + WS_H); bf16* const RA = (bf16*)(C.ws + WS_A); bf16* const RB = (bf16*)(C.ws + WS_B);
    const float* const MOD = (const float*)(C.ws + WS_MOD);

    DUP(0) { if (IN(0)) { Ctx Cp = C; FRESH_IDS(Cp); p0_prologue(Cp); } SEAM(0); }
    DUP(1) { if (IN(1)) { Ctx Cp = C; FRESH_IDS(Cp); phase_norm1_l0(Cp); } SEAM(1); }
    DUP(2) { if (IN(2)) { Ctx Cp = C; FRESH_IDS(Cp);
        pg8::Gemm g{H, (const bf16*)(Cp.ws + WS_WINE), M, NINE, D}; pg8::InEOrder S; S.so.init(M, NINE, Cp.G, Cp.bid); S.G = Cp.G; S.c = Cp.bid;
        pg8::EpiInE E{RA, (bf16*)(Cp.ws + WS_VT), (bf16*)(Cp.ws + WS_KC), (bf16*)(Cp.ws + WS_VCT), (const float*)(Cp.ws + WS_ROPE), (const float*)(Cp.ws + WS_ROPE) + 2048, QSCALE};
        pg8::gemm_phase<pg8::EpiInE, pg8::InEOrder, true, true>(Cp.lds, g, S, E, Cp.tid);
    } SEAM(2); }
    DUP(3) { if (IN(3)) { Ctx Cp = C; FRESH_IDS(Cp); phase_attn_sgu(Cp); } SEAM(3); }
    DUP(4) { if (IN(4)) { Ctx Cp = C; FRESH_IDS(Cp);
        pg8::Gemm g{RB, (const bf16*)(Cp.ws + WS_WOUTE), M, D, D}; pg8::StaticOrder S; S.init(M, D, Cp.G, Cp.bid);
        pg8::EpiRes E{kin(0), (bf16*)(Cp.ws + WS_LAT), MOD + 2 * 1024, (float*)(Cp.ws + WS_RSS)};
        pg8::gemm_phase<pg8::EpiRes, pg8::StaticOrder, true, true>(Cp.lds, g, S, E, Cp.tid);
    } SEAM(4); }
    DUP(5) { if (IN(5)) { Ctx Cp = C; FRESH_IDS(Cp); phase_router(Cp, 0); } SEAM(5); }
    DUP(6) { if (IN(6)) { Ctx Cp = C; FRESH_IDS(Cp); phase_scatter(Cp, 0); } SEAM(6); }
    DUP(7) { if (IN(7)) { Ctx Cp = C; FRESH_IDS(Cp);
        const int nt = moe_tables(Cp, 0);
        pg8::Gemm g{RA, (const bf16*)(Cp.ws + WS_WGU), nt * 256, NEXP * 1024, D / 2}; pg8::MoeOrder S{(const LAS int*)(Cp.lds + MOE_TAB_OFF), nt * 4, Cp.G, Cp.bid};
        pg8::EpiSwiGLU8 E{RB, (const float*)(Cp.ws + WS_RSC), (const float*)(Cp.ws + WS_CSC)};
        pg8::gemm_phase<pg8::EpiSwiGLU8, pg8::MoeOrder, true, true>(Cp.lds, g, S, E, Cp.tid);
    } SEAM(7); }
    DUP(8) { if (IN(8)) { Ctx Cp = C; FRESH_IDS(Cp);
        const int nt = moe_tables(Cp, 0);
        pg8::Gemm g{RB, (const bf16*)(Cp.ws + WS_WD), nt * 256, NEXP * 1024, EH}; pg8::MoeOrder S{(const LAS int*)(Cp.lds + MOE_TAB_OFF), nt * 4, Cp.G, Cp.bid};
        pg8::EpiDown E{RA};
        pg8::gemm_phase<pg8::EpiDown, pg8::MoeOrder, true, true>(Cp.lds, g, S, E, Cp.tid);
    } SEAM(8); }
    DUP(9) { if (IN(9)) { Ctx Cp = C; FRESH_IDS(Cp); phase_combine<false>(Cp, 0); } SEAM(9); }
    DUP(10) { if (IN(10)) { Ctx Cp = C; FRESH_IDS(Cp);
        pg8::Gemm g{H, (const bf16*)(Cp.ws + WS_WINO), M, 3072, D / 2}; pg8::StaticOrder S; S.init(M, 3072, Cp.G, Cp.bid);
        pg8::EpiInO8 E{RA, RA + (size_t)M * D, (const float*)(Cp.ws + WS_RSC), (const float*)(Cp.ws + WS_CSC2)};
        pg8::gemm_phase<pg8::EpiInO8, pg8::StaticOrder, true, true>(Cp.lds, g, S, E, Cp.tid);
    } SEAM(10); }
    DUP(11) { if (IN(11)) { Ctx Cp = C; FRESH_IDS(Cp); phase_conv(Cp); } SEAM(11); }
    DUP(12) { if (IN(12)) { Ctx Cp = C; FRESH_IDS(Cp);
        pg8::Gemm g{RB, (const bf16*)(Cp.ws + WS_WOUTO), M, D, D / 2}; pg8::StaticOrder S; S.init(M, D, Cp.G, Cp.bid);
        pg8::EpiRes8 E{(bf16*)(Cp.ws + WS_LAT), MOD + (size_t)4 * 6144 + 2 * 1024, (float*)(Cp.ws + WS_RSS), (const float*)(Cp.ws + WS_RSC), (const float*)(Cp.ws + WS_CSC2) + 3072};
        pg8::gemm_phase<pg8::EpiRes8, pg8::StaticOrder, true, true>(Cp.lds, g, S, E, Cp.tid);
    } SEAM(12); }
    DUP(13) { if (IN(13)) { Ctx Cp = C; FRESH_IDS(Cp); phase_router(Cp, 1); } SEAM(13); }
    DUP(14) { if (IN(14)) { Ctx Cp = C; FRESH_IDS(Cp); phase_scatter(Cp, 1); } SEAM(14); }
    DUP(15) { if (IN(15)) { Ctx Cp = C; FRESH_IDS(Cp);
        const int nt = moe_tables(Cp, 1);
        pg8::Gemm g{RA, (const bf16*)(Cp.ws + WS_WGU + (size_t)NEXP * 1024 * 1024), nt * 256, NEXP * 1024, D / 2}; pg8::MoeOrder S{(const LAS int*)(Cp.lds + MOE_TAB_OFF), nt * 4, Cp.G, Cp.bid};
        pg8::EpiSwiGLU8 E{RB, (const float*)(Cp.ws + WS_RSC), (const float*)(Cp.ws + WS_CSC) + (size_t)NEXP * 1024};
        pg8::gemm_phase<pg8::EpiSwiGLU8, pg8::MoeOrder, true, true>(Cp.lds, g, S, E, Cp.tid);
    } SEAM(15); }
    DUP(16) { if (IN(16)) { Ctx Cp = C; FRESH_IDS(Cp);
        const int nt = moe_tables(Cp, 1);
        pg8::Gemm g{RB, (const bf16*)(Cp.ws + WS_WD) + (size_t)NEXP * 1024 * 512, nt * 256, NEXP * 1024, EH}; pg8::MoeOrder S{(const LAS int*)(Cp.lds + MOE_TAB_OFF), nt * 4, Cp.G, Cp.bid};
        pg8::EpiDown E{RA};
        pg8::gemm_phase<pg8::EpiDown, pg8::MoeOrder, true, true>(Cp.lds, g, S, E, Cp.tid);
    } SEAM(16); }
    DUP(17) { if (IN(17)) { Ctx Cp = C; FRESH_IDS(Cp); phase_combine<true>(Cp, 1); } }
#undef IN
#undef SEAM
}

extern "C" void kernel_launch(void* const* d_in, const int* in_sizes, int n_in, void* d_out, int out_size, void* d_ws, size_t ws_size, hipStream_t stream) {
    static int grid = 0;
    if (grid == 0) {
        if (n_in != 25 || in_sizes[0] != M * D || out_size != M * D || ws_size < WS_END) { fprintf(stderr, "kernel_launch: unexpected shapes (n_in %d, in0 %d, out %d, ws %zu)\n", n_in, n_in > 0 ? in_sizes[0] : -1, out_size, ws_size); grid = -1; return; }
        int dev = 0, cus = 0, per_cu = 0;
        if (hipGetDevice(&dev) != hipSuccess || hipDeviceGetAttribute(&cus, hipDeviceAttributeMultiprocessorCount, dev) != hipSuccess) { grid = -1; return; }
        if (hipFuncSetAttribute((const void*)mk_fwd, hipFuncAttributeMaxDynamicSharedMemorySize, LDS_BYTES) != hipSuccess) { fprintf(stderr, "kernel_launch: hipFuncSetAttribute failed\n"); grid = -1; return; }
        if (hipOccupancyMaxActiveBlocksPerMultiprocessor(&per_cu, (const void*)mk_fwd, NWAVES * 64, LDS_BYTES) != hipSuccess || per_cu < 1) { fprintf(stderr, "kernel_launch: occupancy query says %d\n", per_cu); }
        (void)hipGetLastError();
        grid = cus;
    }
    if (grid < 0) return;
    if (hipMemsetAsync((char*)d_ws + WS_CTL, 0, CTL_ZERO_BYTES, stream) != hipSuccess) return;
    Args a{};
    for (int i = 0; i < 25; ++i) a.in[i] = (const float*)d_in[i];
    a.out = (float*)d_out; a.ws = (unsigned char*)d_ws;
#if defined(PROBE_K)
    a.ph_lo = 0; a.ph_hi = PROBE_K + 1; hipLaunchKernelGGL(mk_fwd, dim3(grid), dim3(NWAVES * 64), LDS_BYTES, stream, a);
    (void)hipMemsetAsync((char*)d_ws + WS_CTL, 0, (PROBE_K == 5 || PROBE_K == 13) ? CTL_ZERO_BYTES : (size_t)4 * CW_GCNT, stream);
    a.ph_lo = PROBE_K; a.ph_hi = PROBE_K + 1; hipLaunchKernelGGL(mk_fwd, dim3(grid), dim3(NWAVES * 64), LDS_BYTES, stream, a);
    (void)hipMemsetAsync((char*)d_ws + WS_CTL, 0, 4 * CW_GCNT, stream);
    if (PROBE_K + 1 < N_PHASES) { a.ph_lo = PROBE_K + 1; a.ph_hi = N_PHASES; hipLaunchKernelGGL(mk_fwd, dim3(grid), dim3(NWAVES * 64), LDS_BYTES, stream, a); }
#elif MK_ONE_LAUNCH
    a.ph_lo = 0; a.ph_hi = N_PHASES;
    hipLaunchKernelGGL(mk_fwd, dim3(grid), dim3(NWAVES * 64), LDS_BYTES, stream, a);
#else
    for (int p = 0; p < N_PHASES; ++p) { a.ph_lo = p; a.ph_hi = p + 1; hipLaunchKernelGGL(mk_fwd, dim3(grid), dim3(NWAVES * 64), LDS_BYTES, stream, a); }
#endif
}
```

```cpp
#include <hip/hip_runtime.h>
#include <cstdio>
#include <cstdint>
namespace pg8 {
#define PG8_LAS __attribute__((address_space(3)))
typedef unsigned short bf16_t;
typedef short bf16x8 __attribute__((ext_vector_type(8)));
typedef float f32x4 __attribute__((ext_vector_type(4)));
typedef unsigned u32x4 __attribute__((ext_vector_type(4)));
constexpr int BM = 256, BK = 64, HALF = 128, HTB = HALF * BK * 2  , STAGE_BYTES = 8 * HTB, NXCD = 8, WGM = 8;

__host__ __device__ __forceinline__ int lds_byte(int r, int c) { const int st = (r >> 4) * 2 + (c >> 5), rr = r & 15, cc = c & 31, ob = rr * 64 + cc * 2; return st * 1024 + (ob ^ (((ob >> 9) & 1) << 5)); }
__host__ __device__ __forceinline__ void stage_rc(int b, int& R, int& C) { const int st = b / 1024, sb = b % 1024, swz = sb ^ (((sb >> 9) & 1) << 5); R = (st >> 1) * 16 + swz / 64; C = (st & 1) * 32 + (swz % 64) / 2; }
__host__ __device__ __forceinline__ int perm32(int rho) { const int n = rho >> 4, i = rho & 15; return 8 * (i >> 2) + 4 * n + (i & 3); }

struct Unit { int pm, pn, li; };
struct Gemm { const bf16_t* A; const bf16_t* Bt; int M, N, K; };

struct StaticOrder {
    static constexpr bool GATHER = false;
    int nM, nN, nwg, G, c;
    __host__ __device__ void init(int M, int N, int G_, int c_) { nM = M / BM; nN = N / BM; nwg = nM * nN; G = G_; c = c_; }
    __host__ __device__ bool next(int i, Unit& u) const {
        const long L = (long)i * G + c; if (L >= nwg) return false;
        int wgid = (int)L; { const int q = nwg / NXCD, r = nwg % NXCD, xcd = wgid % NXCD, off = wgid / NXCD; wgid = (xcd < r ? xcd * (q + 1) : r * (q + 1) + (xcd - r) * q) + off; }
        const int nig = WGM * nN, gid = wgid / nig, fm = gid * WGM, gsz = (nM - fm) < WGM ? (nM - fm) : WGM;
        u.pm = fm + ((wgid % nig) % gsz); u.pn = (wgid % nig) / gsz; return true;
    }
    __device__ __forceinline__ unsigned goff(const Unit&, int) const { return 0u; }
    __device__ __forceinline__ void a_ready(const Unit&) const {}
    __device__ __forceinline__ void done(const Unit&) const {}
};

__device__ __forceinline__ unsigned cvt_pk_bf16(float lo, float hi) { unsigned r; asm volatile("v_cvt_pk_bf16_f32 %0, %1, %2" : "=v"(r) : "v"(lo), "v"(hi)); return r; }
typedef float f32x2 __attribute__((ext_vector_type(2)));
__device__ __forceinline__ f32x2 gelu_pk(f32x2 v) {
    const f32x2 av = __builtin_elementwise_abs(v), d = av * 0.2316418882f + 1.0f;
    f32x2 t; t.x = __builtin_amdgcn_rcpf(d.x); t.y = __builtin_amdgcn_rcpf(d.y);
    f32x2 q = t * 0.5307027145f + (-0.7265760135f); q = q * t + 0.7107068705f; q = q * t + (-0.142248368f); q = q * t + 0.127414796f; q = q * t;
    const f32x2 s = (v * v) * (-0.72134752044f);
    f32x2 e; e.x = __builtin_amdgcn_exp2f(s.x); e.y = __builtin_amdgcn_exp2f(s.y);
    const f32x2 m = v * (q * e), r = v - m;
    f32x2 o; o.x = v.x < 0.f ? m.x : r.x; o.y = v.y < 0.f ? m.y : r.y; return o;
}

typedef int i32x4 __attribute__((ext_vector_type(4)));
typedef long i64x2 __attribute__((ext_vector_type(2)));
template <bool I8> struct AccSel { typedef f32x4 t; };
template <> struct AccSel<true> { typedef i32x4 t; };
template <int MODE> __device__ __forceinline__ f32x4 mma16(bf16x8 a, bf16x8 b, f32x4 c) {
    if constexpr (MODE == 2) { const i64x2 a2 = __builtin_bit_cast(i64x2, a), b2 = __builtin_bit_cast(i64x2, b);
        c = __builtin_amdgcn_mfma_f32_16x16x32_fp8_fp8(a2[0], b2[0], c, 0, 0, 0); return __builtin_amdgcn_mfma_f32_16x16x32_fp8_fp8(a2[1], b2[1], c, 0, 0, 0); }
    else return __builtin_amdgcn_mfma_f32_16x16x32_bf16(a, b, c, 0, 0, 0);
}
template <int MODE> __device__ __forceinline__ i32x4 mma16(bf16x8 a, bf16x8 b, i32x4 c) { return __builtin_amdgcn_mfma_i32_16x16x64_i8(__builtin_bit_cast(i32x4, a), __builtin_bit_cast(i32x4, b), c, 0, 0, 0); }
typedef unsigned u32x2 __attribute__((ext_vector_type(2)));
constexpr int M_ROWS = 32768;
__device__ __forceinline__ int perm16(int x) { return (x & 3) | ((x & 4) << 1) | ((x & 8) >> 1); }
__device__ __forceinline__ bf16_t bf1(float v) { return (bf16_t)(cvt_pk_bf16(v, 0.f) & 0xffffu); }
__device__ __forceinline__ u32x2 pk4(f32x4 v) { u32x2 w; w.x = cvt_pk_bf16(v[0], v[1]); w.y = cvt_pk_bf16(v[2], v[3]); return w; }
__device__ __forceinline__ f32x4 gelu4(f32x4 v) { const f32x2 a = gelu_pk((f32x2){v[0], v[1]}), b = gelu_pk((f32x2){v[2], v[3]}); return (f32x4){a.x, a.y, b.x, b.y}; }
__device__ __forceinline__ float silu1(float g) { return g * __builtin_amdgcn_rcpf(1.0f + __builtin_amdgcn_exp2f(-1.4426950408889634f * g)); }

struct EpiInE {
    static constexpr bool PERM = false, AFTER_DRAIN = false, MODE = 0;
    bf16_t* QK; bf16_t* VT; bf16_t* KC; bf16_t* VCT; const float* rc; const float* rs; float qscale;
    __device__ __forceinline__ void operator()(const f32x4 (&acc)[2][2][4][2], const Unit& u, int wr, int wc, int fr, int fq) const {
        const int row0 = u.pm * BM + wr * 64 + fr;
        if (u.pm >= 128) {
#pragma unroll
            for (int ai = 0; ai < 2; ++ai)
#pragma unroll
                for (int m = 0; m < 4; ++m) {
                    const int row = row0 + ai * HALF + m * 16 - 32768, b = row >> 8, j = row & 255, jp = (j & ~15) | perm16(j & 15);
#pragma unroll
                    for (int n = 0; n < 2; ++n) {
                        *(u32x2*)(KC + (size_t)row * 128 + wc * 32 + n * 16 + 4 * fq) = pk4(acc[ai][0][m][n]);
#pragma unroll
                        for (int i = 0; i < 4; ++i) { const int cv = wc * 32 + n * 16 + 4 * fq + i; VCT[((size_t)(b * 2 + (cv >> 6)) * 64 + (cv & 63)) * 256 + jp] = bf1(acc[ai][1][m][n][i]); }
                    }
                }
            return;
        }
        if (u.pn <= 2) {
            const float sc = (u.pn < 2) ? qscale : 1.0f;
#pragma unroll
            for (int ai = 0; ai < 2; ++ai)
#pragma unroll
                for (int m = 0; m < 4; ++m) {
                    const int row = row0 + ai * HALF + m * 16, pos = row & 8191, pidx = (wc & 1) ? (pos & 63) : (pos >> 6);
                    const f32x4 c4 = *(const f32x4*)(rc + pidx * 16 + 4 * fq) * sc, s4 = *(const f32x4*)(rs + pidx * 16 + 4 * fq) * sc;
                    bf16_t* rowp = QK + (size_t)row * 1792 + u.pn * BM + wc * 32 + 4 * fq;
#pragma unroll
                    for (int bj = 0; bj < 2; ++bj) {
                        if (u.pn == 2 && bj == 1) break;
                        const f32x4 v0 = acc[ai][bj][m][0], v1 = acc[ai][bj][m][1];
                        *(u32x2*)(rowp + bj * HALF) = pk4(v0 * c4 - v1 * s4);
                        *(u32x2*)(rowp + bj * HALF + 16) = pk4(v1 * c4 + v0 * s4);
                    }
                    if (u.pn == 2) {
                        const int b = row >> 13, pp = (pos & ~15) | perm16(pos & 15);
#pragma unroll
                        for (int n = 0; n < 2; ++n)
#pragma unroll
                            for (int i = 0; i < 4; ++i) { const int cv = wc * 32 + n * 16 + 4 * fq + i; VT[((size_t)(b * 2 + (cv >> 6)) * 64 + (cv & 63)) * 8192 + pp] = bf1(acc[ai][1][m][n][i]); }
                    }
                }
            return;
        }
#pragma unroll
        for (int ai = 0; ai < 2; ++ai)
#pragma unroll
            for (int m = 0; m < 4; ++m) {
                bf16_t* rowp = QK + (size_t)(row0 + ai * HALF + m * 16) * 1792 + u.pn * BM + wc * 32 + 4 * fq;
#pragma unroll
                for (int bj = 0; bj < 2; ++bj)
#pragma unroll
                    for (int n = 0; n < 2; ++n) *(u32x2*)(rowp + bj * HALF + n * 16) = pk4(gelu4(acc[ai][bj][m][n]));
            }
    }
};
struct EpiInE8 {
    static constexpr bool PERM = false, AFTER_DRAIN = false, MODE = 1;
    bf16_t* QK; bf16_t* VT; bf16_t* KC; bf16_t* VCT; const float* rc; const float* rs; float qscale; const float* RSC; const float* CSC;
    __device__ __forceinline__ void operator()(const i32x4 (&acci)[2][2][4][2], const Unit& u, int wr, int wc, int fr, int fq) const {
        asm volatile("" ::: "memory");
        const int row0 = u.pm * BM + wr * 64 + fr;
        f32x4 acc[2][2][4][2];
        { f32x4 cs[2][2];
#pragma unroll
            for (int bj = 0; bj < 2; ++bj)
#pragma unroll
                for (int n = 0; n < 2; ++n) cs[bj][n] = *(const f32x4*)(CSC + u.pn * BM + bj * HALF + wc * 32 + n * 16 + 4 * fq);
#pragma unroll
            for (int ai = 0; ai < 2; ++ai)
#pragma unroll
                for (int m = 0; m < 4; ++m) { const float rsv = RSC[row0 + ai * HALF + m * 16];
#pragma unroll
                    for (int bj = 0; bj < 2; ++bj)
#pragma unroll
                        for (int n = 0; n < 2; ++n) acc[ai][bj][m][n] = __builtin_convertvector(acci[ai][bj][m][n], f32x4) * cs[bj][n] * rsv; } }
        if (u.pm >= 128) {
#pragma unroll
            for (int ai = 0; ai < 2; ++ai)
#pragma unroll
                for (int m = 0; m < 4; ++m) {
                    const int row = row0 + ai * HALF + m * 16 - 32768, b = row >> 8, j = row & 255, jp = (j & ~15) | perm16(j & 15);
#pragma unroll
                    for (int n = 0; n < 2; ++n) {
                        *(u32x2*)(KC + (size_t)row * 128 + wc * 32 + n * 16 + 4 * fq) = pk4(acc[ai][0][m][n]);
#pragma unroll
                        for (int i = 0; i < 4; ++i) { const int cv = wc * 32 + n * 16 + 4 * fq + i; VCT[((size_t)(b * 2 + (cv >> 6)) * 64 + (cv & 63)) * 256 + jp] = bf1(acc[ai][1][m][n][i]); }
                    }
                }
            return;
        }
        if (u.pn <= 2) {
            const float sc = (u.pn < 2) ? qscale : 1.0f;
#pragma unroll
            for (int ai = 0; ai < 2; ++ai)
#pragma unroll
                for (int m = 0; m < 4; ++m) {
                    const int row = row0 + ai * HALF + m * 16, pos = row & 8191, pidx = (wc & 1) ? (pos & 63) : (pos >> 6);
                    const f32x4 c4 = *(const f32x4*)(rc + pidx * 16 + 4 * fq) * sc, s4 = *(const f32x4*)(rs + pidx * 16 + 4 * fq) * sc;
                    bf16_t* rowp = QK + (size_t)row * 1792 + u.pn * BM + wc * 32 + 4 * fq;
#pragma unroll
                    for (int bj = 0; bj < 2; ++bj) {
                        if (u.pn == 2 && bj == 1) break;
                        const f32x4 v0 = acc[ai][bj][m][0], v1 = acc[ai][bj][m][1];
                        *(u32x2*)(rowp + bj * HALF) = pk4(v0 * c4 - v1 * s4);
                        *(u32x2*)(rowp + bj * HALF + 16) = pk4(v1 * c4 + v0 * s4);
                    }
                    if (u.pn == 2) {
                        const int b = row >> 13, pp = (pos & ~15) | perm16(pos & 15);
#pragma unroll
                        for (int n = 0; n < 2; ++n)
#pragma unroll
                            for (int i = 0; i < 4; ++i) { const int cv = wc * 32 + n * 16 + 4 * fq + i; VT[((size_t)(b * 2 + (cv >> 6)) * 64 + (cv & 63)) * 8192 + pp] = bf1(acc[ai][1][m][n][i]); }
                    }
                }
            return;
        }
#pragma unroll
        for (int ai = 0; ai < 2; ++ai)
#pragma unroll
            for (int m = 0; m < 4; ++m) {
                bf16_t* rowp = QK + (size_t)(row0 + ai * HALF + m * 16) * 1792 + u.pn * BM + wc * 32 + 4 * fq;
#pragma unroll
                for (int bj = 0; bj < 2; ++bj)
#pragma unroll
                    for (int n = 0; n < 2; ++n) *(u32x2*)(rowp + bj * HALF + n * 16) = pk4(gelu4(acc[ai][bj][m][n]));
            }
    }
};
struct EpiRes {
    static constexpr bool PERM = false, AFTER_DRAIN = false, MODE = 0;
    const float* base; bf16_t* out; const float* gate; float* RSS;
    __device__ __forceinline__ void operator()(const f32x4 (&acc)[2][2][4][2], const Unit& u, int wr, int wc, int fr, int fq) const {
        const int row0 = u.pm * BM + wr * 64 + fr, col0 = u.pn * BM + wc * 32 + 4 * fq, b = u.pm >> 5;
        f32x4 gv[2][2];
#pragma unroll
        for (int bj = 0; bj < 2; ++bj)
#pragma unroll
            for (int n = 0; n < 2; ++n) gv[bj][n] = *(const f32x4*)(gate + (size_t)b * 6144 + col0 + bj * HALF + n * 16);
#pragma unroll
        for (int ai = 0; ai < 2; ++ai) {
            f32x4 bs[4][2][2];
#pragma unroll
            for (int m = 0; m < 4; ++m)
#pragma unroll
                for (int bj = 0; bj < 2; ++bj)
#pragma unroll
                    for (int n = 0; n < 2; ++n) bs[m][bj][n] = *(const f32x4*)(base + (size_t)(row0 + ai * HALF + m * 16) * 1024 + col0 + bj * HALF + n * 16);
#pragma unroll
            for (int m = 0; m < 4; ++m) { const int row = row0 + ai * HALF + m * 16; float ss = 0.f, am = 0.f;
#pragma unroll
                for (int bj = 0; bj < 2; ++bj)
#pragma unroll
                    for (int n = 0; n < 2; ++n) { const f32x4 o = bs[m][bj][n] + gv[bj][n] * acc[ai][bj][m][n]; const u32x2 w = pk4(o); *(u32x2*)(out + (size_t)row * 1024 + col0 + bj * HALF + n * 16) = w;
                        const float r0 = __builtin_bit_cast(float, w.x << 16), r1 = __builtin_bit_cast(float, w.x & 0xffff0000u), r2 = __builtin_bit_cast(float, w.y << 16), r3 = __builtin_bit_cast(float, w.y & 0xffff0000u);
                        ss += (r0 * r0 + r1 * r1) + (r2 * r2 + r3 * r3); am = fmaxf(fmaxf(am, fmaxf(fabsf(r0), fabsf(r1))), fmaxf(fabsf(r2), fabsf(r3))); }
                ss += __shfl_xor(ss, 16); ss += __shfl_xor(ss, 32); am = fmaxf(am, __shfl_xor(am, 16)); am = fmaxf(am, __shfl_xor(am, 32));
                if (fq == 0) { RSS[(size_t)row * 16 + u.pn * 4 + wc] = ss; RSS[(size_t)M_ROWS * 16 + (size_t)row * 16 + u.pn * 4 + wc] = am; } }
        }
    }
};
struct EpiSwiGLU {
    static constexpr bool PERM = true, AFTER_DRAIN = false, MODE = 0;
    bf16_t* HID;
    __device__ __forceinline__ void operator()(const f32x4 (&acc)[2][2][4][2], const Unit& u, int wr, int wc, int fr, int fq) const {
        const int row0 = u.pm * BM + wr * 64 + fr, col0 = (u.pn & 3) * HALF + wc * 32 + 8 * fq;
#pragma unroll
        for (int ai = 0; ai < 2; ++ai)
#pragma unroll
            for (int m = 0; m < 4; ++m) {
                const f32x4 g0 = acc[ai][0][m][0], g1 = acc[ai][0][m][1], u0 = acc[ai][1][m][0], u1 = acc[ai][1][m][1];
                u32x4 w;
                w.x = cvt_pk_bf16(silu1(g0[0]) * u0[0], silu1(g0[1]) * u0[1]); w.y = cvt_pk_bf16(silu1(g0[2]) * u0[2], silu1(g0[3]) * u0[3]);
                w.z = cvt_pk_bf16(silu1(g1[0]) * u1[0], silu1(g1[1]) * u1[1]); w.w = cvt_pk_bf16(silu1(g1[2]) * u1[2], silu1(g1[3]) * u1[3]);
                *(u32x4*)(HID + (size_t)(row0 + ai * HALF + m * 16) * 512 + col0) = w;
            }
    }
};
struct EpiSwiGLU8 {
    static constexpr bool PERM = true, AFTER_DRAIN = false, MODE = 1;
    unsigned char* HID; const PG8_LAS float* rtab; const float* CSC;
    __device__ __forceinline__ void operator()(const i32x4 (&acc)[2][2][4][2], const Unit& u, int wr, int wc, int fr, int fq) const {
        const int row0 = u.pm * BM + wr * 64 + fr, ct = u.pn & 3, col0 = ct * HALF + wc * 32 + 8 * fq;
        const float* cs = CSC + (size_t)(u.pn >> 2) * 1024 + ct * BM + wc * 32 + 8 * fq;
        const f32x4 cg0 = *(const f32x4*)(cs), cg1 = *(const f32x4*)(cs + 4), cu0 = *(const f32x4*)(cs + HALF), cu1 = *(const f32x4*)(cs + HALF + 4);
#pragma unroll
        for (int ai = 0; ai < 2; ++ai)
#pragma unroll
            for (int m = 0; m < 4; ++m) { const int row = row0 + ai * HALF + m * 16; const float rs = rtab[u.li * 256 + (row - u.pm * BM)];
                const f32x4 g0 = __builtin_convertvector(acc[ai][0][m][0], f32x4) * cg0 * rs, g1 = __builtin_convertvector(acc[ai][0][m][1], f32x4) * cg1 * rs;
                const f32x4 u0 = __builtin_convertvector(acc[ai][1][m][0], f32x4) * cu0 * rs, u1 = __builtin_convertvector(acc[ai][1][m][1], f32x4) * cu1 * rs;
                int w0 = __builtin_amdgcn_cvt_pk_fp8_f32(silu1(g0[0]) * u0[0], silu1(g0[1]) * u0[1], 0, false); w0 = __builtin_amdgcn_cvt_pk_fp8_f32(silu1(g0[2]) * u0[2], silu1(g0[3]) * u0[3], w0, true);
                int w1 = __builtin_amdgcn_cvt_pk_fp8_f32(silu1(g1[0]) * u1[0], silu1(g1[1]) * u1[1], 0, false); w1 = __builtin_amdgcn_cvt_pk_fp8_f32(silu1(g1[2]) * u1[2], silu1(g1[3]) * u1[3], w1, true);
                *(u32x2*)(HID + (size_t)row * 512 + col0) = (u32x2){(unsigned)w0, (unsigned)w1};
            }
    }
};
struct EpiDown {
    static constexpr bool PERM = true, AFTER_DRAIN = false; static constexpr int MODE = 2;
    unsigned char* Y; const float* CSD;
    __device__ __forceinline__ void operator()(const f32x4 (&acc)[2][2][4][2], const Unit& u, int wr, int wc, int fr, int fq) const {
        const int row0 = u.pm * BM + wr * 64 + fr, col0 = (u.pn & 3) * BM + wc * 32 + 8 * fq;
        f32x4 cs[2][2];
#pragma unroll
        for (int bj = 0; bj < 2; ++bj) { cs[bj][0] = *(const f32x4*)(CSD + (size_t)(u.pn >> 2) * 1024 + col0 + bj * HALF); cs[bj][1] = *(const f32x4*)(CSD + (size_t)(u.pn >> 2) * 1024 + col0 + bj * HALF + 4); }
#pragma unroll
        for (int ai = 0; ai < 2; ++ai)
#pragma unroll
            for (int m = 0; m < 4; ++m) { unsigned char* rowp = Y + (size_t)(row0 + ai * HALF + m * 16) * 1024 + col0;
#pragma unroll
                for (int bj = 0; bj < 2; ++bj) { const f32x4 v0 = acc[ai][bj][m][0] * cs[bj][0], v1 = acc[ai][bj][m][1] * cs[bj][1];
                    int w0 = __builtin_amdgcn_cvt_pk_fp8_f32(v0[0], v0[1], 0, false); w0 = __builtin_amdgcn_cvt_pk_fp8_f32(v0[2], v0[3], w0, true);
                    int w1 = __builtin_amdgcn_cvt_pk_fp8_f32(v1[0], v1[1], 0, false); w1 = __builtin_amdgcn_cvt_pk_fp8_f32(v1[2], v1[3], w1, true);
                    *(u32x2*)(rowp + bj * HALF) = (u32x2){(unsigned)w0, (unsigned)w1}; } }
    }
};
struct EpiInO {
    static constexpr bool PERM = true, AFTER_DRAIN = false, MODE = 0;
    bf16_t* BG; bf16_t* Y;
    __device__ __forceinline__ void operator()(const f32x4 (&acc)[2][2][4][2], const Unit& u, int wr, int wc, int fr, int fq) const {
        const int row0 = u.pm * BM + wr * 64 + fr;
        if (u.pn < 8) {
            const int col0 = u.pn * HALF + wc * 32 + 8 * fq;
#pragma unroll
            for (int ai = 0; ai < 2; ++ai)
#pragma unroll
                for (int m = 0; m < 4; ++m) { const f32x4 v0 = acc[ai][0][m][0] * acc[ai][1][m][0], v1 = acc[ai][0][m][1] * acc[ai][1][m][1];
                    u32x4 w; w.x = cvt_pk_bf16(v0[0], v0[1]); w.y = cvt_pk_bf16(v0[2], v0[3]); w.z = cvt_pk_bf16(v1[0], v1[1]); w.w = cvt_pk_bf16(v1[2], v1[3]);
                    *(u32x4*)(Y + (size_t)(row0 + ai * HALF + m * 16) * 1024 + col0) = w; }
        } else {
            const int col0 = (u.pn - 8) * BM + wc * 32 + 8 * fq;
#pragma unroll
            for (int ai = 0; ai < 2; ++ai)
#pragma unroll
                for (int m = 0; m < 4; ++m) { bf16_t* rowp = BG + (size_t)(row0 + ai * HALF + m * 16) * 1024 + col0;
#pragma unroll
                    for (int bj = 0; bj < 2; ++bj) { const f32x4 v0 = acc[ai][bj][m][0], v1 = acc[ai][bj][m][1];
                        u32x4 w; w.x = cvt_pk_bf16(v0[0], v0[1]); w.y = cvt_pk_bf16(v0[2], v0[3]); w.z = cvt_pk_bf16(v1[0], v1[1]); w.w = cvt_pk_bf16(v1[2], v1[3]);
                        *(u32x4*)(rowp + bj * HALF) = w; } }
        }
    }
};
struct EpiInO8 {
    static constexpr bool PERM = true, AFTER_DRAIN = false, MODE = 1;
    bf16_t* BG; bf16_t* Y; const float* RSC; const float* CSC;
    __device__ __forceinline__ void operator()(const i32x4 (&acc)[2][2][4][2], const Unit& u, int wr, int wc, int fr, int fq) const {
        asm volatile("" ::: "memory");
        const int row0 = u.pm * BM + wr * 64 + fr;
        const float* cs = CSC + u.pn * BM + wc * 32 + 8 * fq;
        const f32x4 c00 = *(const f32x4*)(cs), c01 = *(const f32x4*)(cs + 4), c10 = *(const f32x4*)(cs + HALF), c11 = *(const f32x4*)(cs + HALF + 4);
        if (u.pn < 8) {
            const int col0 = u.pn * HALF + wc * 32 + 8 * fq;
#pragma unroll
            for (int ai = 0; ai < 2; ++ai)
#pragma unroll
                for (int m = 0; m < 4; ++m) { const int row = row0 + ai * HALF + m * 16; const float rs = RSC[row], rs2 = rs * rs;
                    const f32x4 v0 = __builtin_convertvector(acc[ai][0][m][0], f32x4) * __builtin_convertvector(acc[ai][1][m][0], f32x4) * (c00 * c10) * rs2;
                    const f32x4 v1 = __builtin_convertvector(acc[ai][0][m][1], f32x4) * __builtin_convertvector(acc[ai][1][m][1], f32x4) * (c01 * c11) * rs2;
                    u32x4 w; w.x = cvt_pk_bf16(v0[0], v0[1]); w.y = cvt_pk_bf16(v0[2], v0[3]); w.z = cvt_pk_bf16(v1[0], v1[1]); w.w = cvt_pk_bf16(v1[2], v1[3]);
                    *(u32x4*)(Y + (size_t)row * 1024 + col0) = w; }
        } else {
            const int col0 = (u.pn - 8) * BM + wc * 32 + 8 * fq;
#pragma unroll
            for (int ai = 0; ai < 2; ++ai)
#pragma unroll
                for (int m = 0; m < 4; ++m) { const int row = row0 + ai * HALF + m * 16; const float rs = RSC[row]; bf16_t* rowp = BG + (size_t)row * 1024 + col0;
#pragma unroll
                    for (int bj = 0; bj < 2; ++bj) { const f32x4 v0 = __builtin_convertvector(acc[ai][bj][m][0], f32x4) * (bj ? c10 : c00) * rs, v1 = __builtin_convertvector(acc[ai][bj][m][1], f32x4) * (bj ? c11 : c01) * rs;
                        u32x4 w; w.x = cvt_pk_bf16(v0[0], v0[1]); w.y = cvt_pk_bf16(v0[2], v0[3]); w.z = cvt_pk_bf16(v1[0], v1[1]); w.w = cvt_pk_bf16(v1[2], v1[3]);
                        *(u32x4*)(rowp + bj * HALF) = w; } }
        }
    }
};
struct EpiRes8 {
    static constexpr bool PERM = false, AFTER_DRAIN = false, MODE = 1;
    bf16_t* lat; const float* gate; float* RSS; const float* RSC; const float* CSC;
    __device__ __forceinline__ void operator()(const i32x4 (&acc)[2][2][4][2], const Unit& u, int wr, int wc, int fr, int fq) const {
        const int row0 = u.pm * BM + wr * 64 + fr, col0 = u.pn * BM + wc * 32 + 4 * fq, b = u.pm >> 5;
        f32x4 gv[2][2];
#pragma unroll
        for (int bj = 0; bj < 2; ++bj)
#pragma unroll
            for (int n = 0; n < 2; ++n) gv[bj][n] = *(const f32x4*)(gate + (size_t)b * 6144 + col0 + bj * HALF + n * 16) * *(const f32x4*)(CSC + col0 + bj * HALF + n * 16);
#pragma unroll
        for (int ai = 0; ai < 2; ++ai) {
            u32x2 bs[4][2][2]; float rs[4];
#pragma unroll
            for (int m = 0; m < 4; ++m) { rs[m] = RSC[row0 + ai * HALF + m * 16];
#pragma unroll
                for (int bj = 0; bj < 2; ++bj)
#pragma unroll
                    for (int n = 0; n < 2; ++n) bs[m][bj][n] = *(const u32x2*)(lat + (size_t)(row0 + ai * HALF + m * 16) * 1024 + col0 + bj * HALF + n * 16); }
            asm volatile("" ::: "memory");
#pragma unroll
            for (int m = 0; m < 4; ++m) { const int row = row0 + ai * HALF + m * 16; float ss = 0.f, am = 0.f;
#pragma unroll
                for (int bj = 0; bj < 2; ++bj)
#pragma unroll
                    for (int n = 0; n < 2; ++n) { const u32x2 bw = bs[m][bj][n];
                        const f32x4 bf = (f32x4){__builtin_bit_cast(float, bw.x << 16), __builtin_bit_cast(float, bw.x & 0xffff0000u), __builtin_bit_cast(float, bw.y << 16), __builtin_bit_cast(float, bw.y & 0xffff0000u)};
                        const f32x4 o = bf + gv[bj][n] * (__builtin_convertvector(acc[ai][bj][m][n], f32x4) * rs[m]); const u32x2 w = pk4(o); *(u32x2*)(lat + (size_t)row * 1024 + col0 + bj * HALF + n * 16) = w;
                        const float r0 = __builtin_bit_cast(float, w.x << 16), r1 = __builtin_bit_cast(float, w.x & 0xffff0000u), r2 = __builtin_bit_cast(float, w.y << 16), r3 = __builtin_bit_cast(float, w.y & 0xffff0000u);
                        ss += (r0 * r0 + r1 * r1) + (r2 * r2 + r3 * r3); am = fmaxf(fmaxf(am, fmaxf(fabsf(r0), fabsf(r1))), fmaxf(fabsf(r2), fabsf(r3))); }
                ss += __shfl_xor(ss, 16); ss += __shfl_xor(ss, 32); am = fmaxf(am, __shfl_xor(am, 16)); am = fmaxf(am, __shfl_xor(am, 32));
                if (fq == 0) { RSS[(size_t)row * 16 + u.pn * 4 + wc] = ss; RSS[(size_t)M_ROWS * 16 + (size_t)row * 16 + u.pn * 4 + wc] = am; } }
            asm volatile("" ::: "memory");
        }
    }
};
struct InEOrder {
    static constexpr bool GATHER = false;
    StaticOrder so; int G, c;
    __device__ __forceinline__ unsigned goff(const Unit&, int) const { return 0u; }
    __device__ __forceinline__ bool next(int i, Unit& u) const {
        const long L = (long)i * G + c;
        if (L < 896) return so.next(i, u);
        if (L < 900) { u.pm = 128 + (int)(L - 896); u.pn = 2; return true; }
        return false;
    }
    __device__ __forceinline__ void a_ready(const Unit&) const {}
    __device__ __forceinline__ void done(const Unit&) const {}
};
template <bool GATH> struct MoeOrderT {
    static constexpr bool GATHER = GATH;
    const PG8_LAS int* tile_e; int nt, G, c; const PG8_LAS unsigned* gtab;
    __device__ __forceinline__ bool next(int i, Unit& u) const {
        const int nx = (G % NXCD == 0) ? NXCD : 1, x = c % nx, k = c / nx, per = G / nx, chunk = (nt + nx - 1) / nx;
        const int j = k + i * per, t = x * chunk + (j >> 2), tend = (x + 1) * chunk < nt ? (x + 1) * chunk : nt;
        if (t >= tend) return false;
        u.pm = t; u.pn = tile_e[t] * 4 + (j & 3); u.li = i; return true;
    }
    __device__ __forceinline__ unsigned goff(const Unit& u, int r) const { return gtab[u.li * 256 + r]; }
    __device__ __forceinline__ void a_ready(const Unit&) const {}
    __device__ __forceinline__ void done(const Unit&) const {}
};
typedef MoeOrderT<false> MoeOrder;
typedef MoeOrderT<true> MoeGatherOrder;
template <class Epi, class Sched, bool ALIGN_EPI = false, bool SP2 = false>
__device__ __forceinline__ void gemm_phase(PG8_LAS unsigned char* lds, const Gemm g, const Sched& S, const Epi& E, const int tid_in) {
    int tid_ = tid_in; asm volatile("" : "+v"(tid_));
    const int tid = tid_, wid = __builtin_amdgcn_readfirstlane(tid >> 6), lane = tid & 63, wr = wid >> 2, wc = wid & 3, fr = lane & 15, fq = lane >> 4;
    const int K = g.K, nt = K / BK;
    unsigned voffA[2], voffB[2];
#pragma unroll
    for (int i = 0; i < 2; ++i) { int R, C; stage_rc(tid * 16 + i * 8192, R, C); const int Rb = Epi::PERM ? ((R & ~31) + perm32(R & 31)) : R;
        voffA[i] = (unsigned)(R * K + C) * 2u; voffB[i] = (unsigned)(Rb * K + C) * 2u; }
    constexpr bool GATHER = Sched::GATHER;
    static_assert(!GATHER || SP2, "the gathered A path is written for the SP2 loop");
    unsigned gofC[2][2], gofN[2][2], go2[2][2]; int stR[2], stC2[2];
#pragma unroll
    for (int i = 0; i < 2; ++i) { int R, C; stage_rc(tid * 16 + i * 8192, R, C); stR[i] = R; stC2[i] = C * 2; gofC[0][i] = gofC[1][i] = gofN[0][i] = gofN[1][i] = go2[0][i] = go2[1][i] = 0u; }
#define PG8_GLOAD(dst, unit) do { if constexpr (GATHER) { _Pragma("unroll") for (int h_ = 0; h_ < 2; ++h_) _Pragma("unroll") for (int i_ = 0; i_ < 2; ++i_) dst[h_][i_] = S.goff(unit, h_ * HALF + stR[i_]) + (unsigned)stC2[i_]; } } while (0)
#define PG8_STA(bufoff, ptr, h, OFFS) do { if constexpr (GATHER) { PG8_STAGE(bufoff, ptr, OFFS[h]); } else { PG8_STAGE(bufoff, (ptr) + (h) * hstep, voffA); } } while (0)
    const size_t kstep = (size_t)(BK * 2);
    const size_t hstep = (size_t)HALF * K * 2;
    const size_t tstep = 2 * hstep;
    const unsigned ldsw = (unsigned)wid * 1024u;
    const int aoff = lds_byte(wr * 64 + fr, fq * 8), boff = lds_byte(wc * 32 + fr, fq * 8);
#define PG8_SA(b, h) (((b) * 2 + (h)) * HTB)
#define PG8_SB(b, h) ((4 + (b) * 2 + (h)) * HTB)
#define PG8_STAGE(bufoff, gbase, voff) do { _Pragma("unroll") for (int _i = 0; _i < 2; ++_i) \
        __builtin_amdgcn_global_load_lds((const unsigned*)((const char*)(gbase) + (voff)[_i]), (PG8_LAS unsigned*)(lds + (bufoff) + ldsw + _i * 8192), 16, 0, 0); } while (0)
#define PG8_LDA(dst, b, h) do { _Pragma("unroll") for (int m = 0; m < 4; ++m) _Pragma("unroll") for (int k = 0; k < 2; ++k) dst[m][k] = *(const PG8_LAS bf16x8*)(lds + PG8_SA(b, h) + aoff + m * 2048 + k * 1024); } while (0)
#define PG8_LDB(dst, b, h) do { _Pragma("unroll") for (int n = 0; n < 2; ++n) _Pragma("unroll") for (int k = 0; k < 2; ++k) dst[n][k] = *(const PG8_LAS bf16x8*)(lds + PG8_SB(b, h) + boff + n * 2048 + k * 1024); } while (0)
#define PG8_MMA(ai, bj, At, Bt) do { __builtin_amdgcn_s_setprio(1); _Pragma("unroll") for (int m = 0; m < 4; ++m) _Pragma("unroll") for (int n = 0; n < 2; ++n) _Pragma("unroll") for (int k = 0; k < 2; ++k) \
        acc[ai][bj][m][n] = mma16<Epi::MODE>(Bt[n][k], At[m][k], acc[ai][bj][m][n]); __builtin_amdgcn_s_setprio(0); } while (0)
#define PG8_WAIT_V(n) asm volatile("s_waitcnt vmcnt(" #n ")" ::: "memory")
#define PG8_WAIT_L(n) asm volatile("s_waitcnt lgkmcnt(" #n ")" ::: "memory")
#define PG8_BAR __builtin_amdgcn_s_barrier()
#define PG8_SCHED __builtin_amdgcn_sched_barrier(0)
    Unit cur, nxt; int ui = 0;
    if (!S.next(0, cur)) return;
    typedef typename AccSel<Epi::MODE == 1>::t acc_t;
    acc_t acc[2][2][4][2];
#pragma unroll
    for (int a = 0; a < 2; ++a)
#pragma unroll
        for (int b = 0; b < 2; ++b)
#pragma unroll
            for (int m = 0; m < 4; ++m)
#pragma unroll
                for (int n = 0; n < 2; ++n) acc[a][b][m][n] = acc_t{};
    bf16x8 At[4][2], B0[2][2], B1[2][2];
    const char* cA = (const char*)g.A + (GATHER ? (size_t)0 : (size_t)cur.pm * tstep); const char* cB = (const char*)g.Bt + (size_t)cur.pn * tstep;
    PG8_GLOAD(gofC, cur);
    S.a_ready(cur);
    if constexpr (SP2) {
        PG8_STAGE(PG8_SB(0, 0), cB, voffB); PG8_STAGE(PG8_SB(0, 1), cB + hstep, voffB); PG8_STA(PG8_SA(0, 0), cA, 0, gofC); PG8_STA(PG8_SA(0, 1), cA, 1, gofC);
        if (wr == 1) PG8_BAR;
        PG8_WAIT_V(2); PG8_BAR;
        PG8_STAGE(PG8_SB(1, 0), cB + kstep, voffB); PG8_STA(PG8_SA(1, 0), cA + kstep, 0, gofC); PG8_STAGE(PG8_SB(1, 1), cB + hstep + kstep, voffB);
        PG8_WAIT_V(6); PG8_BAR;
    } else {
        PG8_STAGE(PG8_SB(0, 0), cB, voffB); PG8_STAGE(PG8_SA(0, 0), cA, voffA); PG8_STAGE(PG8_SB(0, 1), cB + hstep, voffB); PG8_STAGE(PG8_SA(0, 1), cA + hstep, voffA);
        if (wr == 1) PG8_BAR;
        PG8_WAIT_V(4); PG8_BAR;
        PG8_STAGE(PG8_SB(1, 0), cB + kstep, voffB); PG8_STAGE(PG8_SA(1, 0), cA + kstep, voffA); PG8_STAGE(PG8_SB(1, 1), cB + hstep + kstep, voffB);
        PG8_WAIT_V(6); PG8_BAR;
    }
    for (;;) {
        const bool has_next = S.next(ui + 1, nxt);
        if (has_next) PG8_GLOAD(gofN, nxt);
        const char* nA = has_next ? (const char*)g.A + (GATHER ? (size_t)0 : (size_t)nxt.pm * tstep) : cA; const char* nB = has_next ? (const char*)g.Bt + (size_t)nxt.pn * tstep : cB;
        for (int t = 0; t < nt; t += 2) {
            const bool last = (t == nt - 2);
            const char* a1 = cA + (size_t)(t + 1) * kstep;
            const char* a2 = last ? nA : cA + (size_t)(t + 2) * kstep; const char* b2 = last ? nB : cB + (size_t)(t + 2) * kstep;
            const char* a3 = a2 + kstep; const char* b3 = b2 + kstep;
            if constexpr (GATHER) { const bool usen = last && has_next;
#pragma unroll
                for (int h_ = 0; h_ < 2; ++h_)
#pragma unroll
                    for (int i_ = 0; i_ < 2; ++i_) go2[h_][i_] = usen ? gofN[h_][i_] : gofC[h_][i_]; }
            if (last && has_next) S.a_ready(nxt);
            if constexpr (SP2) {
            PG8_LDB(B0, 0, 0); PG8_LDB(B1, 0, 1); PG8_SCHED; PG8_LDA(At, 0, 0); PG8_STA(PG8_SA(1, 1), a1, 1, gofC);
            PG8_WAIT_V(8); PG8_WAIT_L(0); PG8_BAR; PG8_MMA(0, 0, At, B0); PG8_MMA(0, 1, At, B1); PG8_BAR; PG8_SCHED;
            PG8_LDA(At, 0, 1); PG8_STAGE(PG8_SB(0, 0), b2, voffB); PG8_STAGE(PG8_SB(0, 1), b2 + hstep, voffB); PG8_STA(PG8_SA(0, 0), a2, 0, go2);
            PG8_WAIT_V(8); PG8_WAIT_L(0); PG8_BAR; PG8_MMA(1, 0, At, B0); PG8_MMA(1, 1, At, B1); PG8_BAR; PG8_SCHED;
            PG8_LDB(B0, 1, 0); PG8_LDB(B1, 1, 1); PG8_SCHED; PG8_LDA(At, 1, 0); PG8_STA(PG8_SA(0, 1), a2, 1, go2);
            PG8_WAIT_V(8); PG8_WAIT_L(0); PG8_BAR; PG8_MMA(0, 0, At, B0); PG8_MMA(0, 1, At, B1); PG8_BAR; PG8_SCHED;
            PG8_LDA(At, 1, 1); PG8_STAGE(PG8_SB(1, 0), b3, voffB); PG8_STAGE(PG8_SB(1, 1), b3 + hstep, voffB); PG8_STA(PG8_SA(1, 0), a3, 0, go2);
            PG8_WAIT_V(8); PG8_WAIT_L(0); PG8_BAR; PG8_MMA(1, 0, At, B0); PG8_MMA(1, 1, At, B1); PG8_BAR; PG8_SCHED;
            } else {
            PG8_LDB(B0, 0, 0); PG8_SCHED; PG8_LDA(At, 0, 0); PG8_STAGE(PG8_SA(1, 1), a1 + hstep, voffA);
            PG8_WAIT_L(8); PG8_BAR; PG8_WAIT_L(0); PG8_MMA(0, 0, At, B0); PG8_BAR; PG8_SCHED;
            PG8_LDB(B1, 0, 1); PG8_STAGE(PG8_SB(0, 0), b2, voffB);
            PG8_BAR; PG8_WAIT_L(0); PG8_MMA(0, 1, At, B1); PG8_BAR;
            PG8_LDA(At, 0, 1); PG8_STAGE(PG8_SA(0, 0), a2, voffA);
            PG8_BAR; PG8_WAIT_L(0); PG8_MMA(1, 0, At, B0); PG8_BAR; PG8_SCHED;
            PG8_STAGE(PG8_SB(0, 1), b2 + hstep, voffB);
            PG8_WAIT_V(6); PG8_BAR; PG8_MMA(1, 1, At, B1); PG8_BAR;
            PG8_LDB(B0, 1, 0); PG8_SCHED; PG8_LDA(At, 1, 0); PG8_STAGE(PG8_SA(0, 1), a2 + hstep, voffA);
            PG8_WAIT_L(8); PG8_BAR; PG8_WAIT_L(0); PG8_MMA(0, 0, At, B0); PG8_BAR; PG8_SCHED;
            PG8_LDB(B1, 1, 1); PG8_STAGE(PG8_SB(1, 0), b3, voffB);
            PG8_BAR; PG8_WAIT_L(0); PG8_MMA(0, 1, At, B1); PG8_BAR;
            PG8_LDA(At, 1, 1); PG8_STAGE(PG8_SA(1, 0), a3, voffA);
            PG8_BAR; PG8_WAIT_L(0); PG8_MMA(1, 0, At, B0); PG8_BAR; PG8_SCHED;
            PG8_STAGE(PG8_SB(1, 1), b3 + hstep, voffB);
            PG8_WAIT_V(6); PG8_BAR; PG8_MMA(1, 1, At, B1); PG8_BAR;
            }
        }
        if constexpr (ALIGN_EPI) { if (wr == 0) PG8_BAR; }
        if constexpr (!Epi::AFTER_DRAIN) { E(acc, cur, wr, wc, fr, fq); S.done(cur); }
        if (!has_next) break;
#pragma unroll
        for (int a = 0; a < 2; ++a)
#pragma unroll
            for (int b = 0; b < 2; ++b)
#pragma unroll
                for (int m = 0; m < 4; ++m)
#pragma unroll
                    for (int n = 0; n < 2; ++n) acc[a][b][m][n] = acc_t{};
        cur = nxt; cA = nA; cB = nB; ++ui;
        if constexpr (GATHER) {
#pragma unroll
            for (int h_ = 0; h_ < 2; ++h_)
#pragma unroll
                for (int i_ = 0; i_ < 2; ++i_) gofC[h_][i_] = gofN[h_][i_]; }
        if constexpr (ALIGN_EPI) { if (wr == 1) PG8_BAR; }
    }
    PG8_WAIT_V(0);
    if constexpr (!ALIGN_EPI) { if (wr == 0) PG8_BAR; }
    PG8_BAR;
    if constexpr (Epi::AFTER_DRAIN) { E.fused(acc, cur, wr, wc, fr, fq, lds, wid, lane); S.done(cur); }
#undef PG8_GLOAD
#undef PG8_STA
#undef PG8_SA
#undef PG8_SB
#undef PG8_STAGE
#undef PG8_LDA
#undef PG8_LDB
#undef PG8_MMA
#undef PG8_WAIT_V
#undef PG8_WAIT_L
#undef PG8_BAR
#undef PG8_SCHED
}
}
constexpr int NWAVES = 8;
constexpr int BATCH = 4, SEQ = 8192, D = 1024, M = BATCH * SEQ, CTXL = 256, MC = BATCH * CTXL;
constexpr int NINE = 1792, NEXP = 32, EH = 512;
constexpr float EPS = 1e-6f;
constexpr int N_PHASES = 18;
#ifndef MK_ONE_LAUNCH
#define MK_ONE_LAUNCH 1
#endif
constexpr size_t MiB = 1u << 20;
constexpr size_t WS_CTL = 0, CTL_ZERO_BYTES = 1 * MiB;
constexpr size_t WS_MOD = 1 * MiB;
constexpr size_t WS_MODC = WS_MOD + 2 * 4 * 6144 * 4;
constexpr size_t WS_MODP = 1 * MiB + 768 * 1024;
static_assert(WS_MODC + 6144 * 4 <= 1 * MiB + 256 * 1024, "MOD/MODC overlap the rope tables");
constexpr size_t WS_ROPE = 1 * MiB + 256 * 1024;
constexpr size_t WS_WSP = 1 * MiB + 512 * 1024;
constexpr size_t WS_TOKE = 2 * MiB;
constexpr size_t WS_TOKP = 2 * MiB + 256 * 1024;
constexpr size_t WS_TOKW = 2 * MiB + 512 * 1024;
constexpr size_t WS_TOKS = 2 * MiB + 768 * 1024;
constexpr size_t WS_KC = 3 * MiB;
constexpr size_t WS_VCT = 3 * MiB + 256 * 1024;
constexpr size_t WS_VT = 4 * MiB;
constexpr size_t WS_WINE = 12 * MiB, WS_WOUTE = 16 * MiB, WS_WINO = 18 * MiB, WS_WOUTO = 24 * MiB;
constexpr size_t WS_WGU = 26 * MiB;
constexpr size_t WS_WD = 154 * MiB;
constexpr size_t WS_H = 218 * MiB;
constexpr size_t WS_A = 284 * MiB;
constexpr size_t WS_B = 428 * MiB;
constexpr size_t WS_RSS = 574 * MiB;
constexpr size_t WS_CSC = 502 * MiB;
constexpr size_t WS_CSC2 = 502 * MiB + 256 * 1024;
constexpr size_t WS_RSC = 502 * MiB + 512 * 1024;
constexpr size_t WS_LAT = 503 * MiB;
constexpr size_t WS_LIST = 567 * MiB;
constexpr size_t WS_TOKSC = 571 * MiB;
constexpr size_t WS_CSD = 578 * MiB;
constexpr size_t WS_END = 579 * MiB;
constexpr int CW_TMO = 0, CW_CODE = 1, CW_Q0 = 512, CW_Q1 = 576, CW_BAR = 4096, CW_GCNT = 8192;

constexpr int RING_BYTES = 131072;
constexpr int LDS_BYTES = 155648;
constexpr int MISC_OFF = LDS_BYTES - 256;
constexpr int MOE_TAB_OFF = RING_BYTES;
constexpr int MOE_GTAB_OFF = RING_BYTES + 2048, MOE_RTAB_OFF = MOE_GTAB_OFF + 8 * 1024, MOE_MAXU = 8;
static_assert(MOE_RTAB_OFF + 8 * 1024 <= LDS_BYTES - 256, "LDS map");
constexpr int RW_STRIDE = 2064;
constexpr int RT_WH = 0, RT_WL = 36 * RW_STRIDE, RT_CNT = 72 * RW_STRIDE, RT_BASE = RT_CNT + 128, RT_INFO = RT_CNT + 256, RT_RED = RT_INFO + 128 * 8 * 4;
static_assert(RT_RED + 64 <= MISC_OFF, "LDS map");

#define GAS __attribute__((address_space(1)))
#define LAS __attribute__((address_space(3)))
typedef unsigned short bf16;
typedef unsigned v4u __attribute__((ext_vector_type(4)));
typedef unsigned v2u __attribute__((ext_vector_type(2)));
typedef float f32x4 __attribute__((ext_vector_type(4)));
typedef float f32x16 __attribute__((ext_vector_type(16)));
typedef short bf16x8 __attribute__((ext_vector_type(8)));
typedef GAS unsigned gu32;
#define RLX_AGENT __ATOMIC_RELAXED, __HIP_MEMORY_SCOPE_AGENT
#define LDS_WAIT() asm volatile("s_waitcnt lgkmcnt(0)" ::: "memory")
__device__ __forceinline__ unsigned f2bf(float f) { unsigned u = __builtin_bit_cast(unsigned, f); return (u + 0x7fffu + ((u >> 16) & 1u)) >> 16; }
__device__ __forceinline__ unsigned pk2(float lo, float hi) { return f2bf(lo) | (f2bf(hi) << 16); }
__device__ __forceinline__ float bflo(unsigned w) { return __builtin_bit_cast(float, w << 16); }
__device__ __forceinline__ float bfhi(unsigned w) { return __builtin_bit_cast(float, w & 0xffff0000u); }
__device__ __forceinline__ float wave_sum(float v) {
#pragma unroll
    for (int o = 1; o < 64; o <<= 1) v += __shfl_xor(v, o);
    return v;
}
__device__ __forceinline__ void lds_barrier() { asm volatile("s_waitcnt lgkmcnt(0)\n\ts_barrier" ::: "memory"); }
#define XB_TMO      128
#define XB_XCNT(j)  (256  + 64 * (j))
#define XB_XSUB(j)  (1280 + 64 * (j))
#define XB_XGEN(j)  (2304 + 64 * (j))
#define XB_TOP      3328
#define XB_TOPGEN   3392
#define XCD_BAR_WORDS 3456
#define XB_SPIN_CAP (1u << 18)

__device__ __forceinline__ unsigned xb_ld(unsigned* p)              { return __hip_atomic_load(p, __ATOMIC_RELAXED, __HIP_MEMORY_SCOPE_AGENT); }
__device__ __forceinline__ unsigned xb_add(unsigned* p, unsigned v) { return __hip_atomic_fetch_add(p, v, __ATOMIC_RELAXED, __HIP_MEMORY_SCOPE_AGENT); }
__device__ __forceinline__ unsigned xb_xcc_id() { return (unsigned)__builtin_amdgcn_s_getreg((3 << 11) | 20) & 0xFu; }
#define XB_SPIN(cond, bar) do { unsigned _sp = 0; while (cond) { __builtin_amdgcn_s_sleep(1); \
    if ((++_sp & 255u) == 0u) { if (xb_ld(&(bar)[XB_TMO])) break; if (_sp > XB_SPIN_CAP) { atomicAdd(&(bar)[XB_TMO], 1u); break; } } } } while (0)

struct XcdBarrier {
    unsigned* bar; unsigned x;
    volatile LAS unsigned* st;
};

__device__ __forceinline__ XcdBarrier xcd_barrier_post(unsigned* bar, volatile LAS unsigned* st) {
    XcdBarrier b; b.bar = bar; b.x = xb_xcc_id(); b.st = st;
    if (threadIdx.x == 0) (void)xb_add(&bar[XB_XCNT(b.x)], 1u);
    return b;
}
__device__ __forceinline__ void xcd_barrier_complete(unsigned* bar, unsigned x, unsigned& nloc, unsigned& nx) {
    const unsigned G = gridDim.x * gridDim.y * gridDim.z;
    unsigned sum, cnt, mine, sp = 0u;
    for (;;) {
        sum = 0u; cnt = 0u; mine = 0u;
#pragma unroll
        for (unsigned j = 0; j < 16; ++j) { const unsigned c = xb_ld(&bar[XB_XCNT(j)]); sum += c; cnt += (c > 0u) ? 1u : 0u; mine = (j == x) ? c : mine; }
        if (sum == G) break;
        __builtin_amdgcn_s_sleep(1);
        if ((++sp & 255u) == 0u) { if (xb_ld(&bar[XB_TMO])) break; if (sp > XB_SPIN_CAP) { atomicAdd(&bar[XB_TMO], 1u); break; } }
    }
    nloc = mine > 0u ? mine : 1u; nx = cnt > 0u ? cnt : 1u;
}

__device__ __forceinline__ void xcd_barrier(const XcdBarrier& b, const int xb_tid) {
    asm volatile("s_waitcnt vmcnt(0)" ::: "memory");
    __syncthreads();
    if (xb_tid == 0) {
        unsigned* bar = b.bar;
        __builtin_amdgcn_s_waitcnt(0);
        unsigned nloc = b.st[0], nx = b.st[1];
        if (nloc == 0u) { xcd_barrier_complete(bar, b.x, nloc, nx); b.st[0] = nloc; b.st[1] = nx; }
        const unsigned old = xb_add(&bar[XB_XSUB(b.x)], 1u);
        const unsigned gen = old / nloc;
        if (old + 1u == (gen + 1u) * nloc) {
            __builtin_amdgcn_fence(__ATOMIC_RELEASE, "agent");
            asm volatile("s_waitcnt vmcnt(0)" ::: "memory");
            const unsigned og = xb_add(&bar[XB_TOP], 1u);
            const unsigned tg = og / nx;
            if (og + 1u == (tg + 1u) * nx) xb_add(&bar[XB_TOPGEN], 1u);
            else XB_SPIN(xb_ld(&bar[XB_TOPGEN]) == tg, bar);
            __builtin_amdgcn_fence(__ATOMIC_ACQUIRE, "agent");
            xb_add(&bar[XB_XGEN(b.x)], 1u);
            asm volatile("s_waitcnt vmcnt(0)" ::: "memory");
        } else {
            XB_SPIN(xb_ld(&bar[XB_XGEN(b.x)]) == gen, bar);
            __builtin_amdgcn_fence(__ATOMIC_ACQUIRE, "agent");
            asm volatile("s_waitcnt vmcnt(0)" ::: "memory");
        }
    }
    __syncthreads();
}

struct Args { const float* in[25]; float* out; unsigned char* ws; int ph_lo, ph_hi; };
struct Ctx {
    LAS unsigned char* lds; unsigned ldsaddr;
    int tid, lane, wave, G, bid;
    float* out; unsigned char* ws; gu32* ctl;
};
__device__ __forceinline__ const float* kin(int k) {
    const __attribute__((address_space(4))) Args* ka = (const __attribute__((address_space(4))) Args*)__builtin_amdgcn_kernarg_segment_ptr();
    return (const float*)(const GAS float*)ka->in[k];
}
__device__ const float ROPE_INV[16] = {1.000000000e+00f, 5.623413324e-01f, 3.162277639e-01f, 1.778279394e-01f, 1.000000015e-01f, 5.623413250e-02f, 3.162277490e-02f, 1.778279431e-02f,
                                       9.999999776e-03f, 5.623413250e-03f, 3.162277630e-03f, 1.778279431e-03f, 1.000000047e-03f, 5.623413017e-04f, 3.162277571e-04f, 1.778279402e-04f};

__device__ __forceinline__ void transpose_item(const float* W, int K, int N, bf16* WT, int k0, int n0, int drow0, LAS float* scr, int lane) {
    float tv[32];
#pragma unroll
    for (int i = 0; i < 32; ++i) tv[i] = W[(size_t)(k0 + 2 * i + (lane >> 5)) * N + n0 + (lane & 31)];
#pragma unroll
    for (int i = 0; i < 32; ++i) scr[(2 * i + (lane >> 5)) * 33 + (lane & 31)] = tv[i];
    LDS_WAIT(); asm volatile("" ::: "memory");
    const int c = lane & 7;
#pragma unroll
    for (int j = 0; j < 4; ++j) { const int n = (lane >> 3) + 8 * j; const LAS float* s = scr + (8 * c) * 33 + n;
        v4u o; o.x = pk2(s[0 * 33], s[1 * 33]); o.y = pk2(s[2 * 33], s[3 * 33]); o.z = pk2(s[4 * 33], s[5 * 33]); o.w = pk2(s[6 * 33], s[7 * 33]);
        *(GAS v4u*)(WT + (size_t)(drow0 + n) * K + k0 + 8 * c) = o; }
    LDS_WAIT(); asm volatile("" ::: "memory");
}
__device__ __forceinline__ void sincos_acc(float a, float& s, float& c) {
    const double x = (double)a, kf = __builtin_rint(x * 0.63661977236758134308), r = x - kf * 1.57079632679489661923, r2 = r * r;
    const double sp = r * (1.0 + r2 * (-1.0 / 6 + r2 * (1.0 / 120 + r2 * (-1.0 / 5040 + r2 * (1.0 / 362880 + r2 * (-1.0 / 39916800 + r2 * (1.0 / 6227020800.0)))))));
    const double cp = 1.0 + r2 * (-0.5 + r2 * (1.0 / 24 + r2 * (-1.0 / 720 + r2 * (1.0 / 40320 + r2 * (-1.0 / 3628800 + r2 * (1.0 / 479001600 + r2 * (-1.0 / 87178291200.0)))))));
    const int k = (int)kf & 3;
    s = (float)((k == 0) ? sp : (k == 1) ? cp : (k == 2) ? -sp : -cp);
    c = (float)((k == 0) ? cp : (k == 1) ? -sp : (k == 2) ? -cp : sp);
}
__device__ __forceinline__ void adaln_unit(const Ctx& C, int u) {
    const int l = u / 96, col = (u % 96) * 64 + C.lane;
    LAS float* sil = (LAS float*)C.lds; LAS float* red = (LAS float*)(C.lds + 5 * 1024 * 4);
    for (int idx = C.tid; idx < 5120; idx += NWAVES * 64) { const float v = (idx < 4096) ? kin(1)[idx] : kin(3)[idx - 4096]; sil[idx] = v / (1.0f + __expf(-v)); }
    __syncthreads();
    float acc[5] = {0.f, 0.f, 0.f, 0.f, 0.f};
    const int k0 = C.wave * 128; const float* wp = kin(4) + (size_t)l * 1024 * 6144 + (size_t)k0 * 6144 + col;
#pragma unroll 1
    for (int kq = 0; kq < 128; kq += 32) { float wv[32];
#pragma unroll
        for (int kk = 0; kk < 32; ++kk) wv[kk] = wp[(size_t)(kq + kk) * 6144];
#pragma unroll
        for (int kk = 0; kk < 32; ++kk)
#pragma unroll
            for (int v = 0; v < 5; ++v) acc[v] += sil[v * 1024 + k0 + kq + kk] * wv[kk]; }
#pragma unroll
    for (int v = 0; v < 5; ++v) red[(C.wave * 5 + v) * 64 + C.lane] = acc[v];
    __syncthreads();
    if (C.wave == 0) {
        float* MOD = (float*)(C.ws + WS_MOD); float* MODC = (float*)(C.ws + WS_MODC); float* MODP = (float*)(C.ws + WS_MODP); const float bias = kin(5)[l * 6144 + col];
#pragma unroll
        for (int v = 0; v < 5; ++v) { float s = 0.f;
#pragma unroll
            for (int w = 0; w < NWAVES; ++w) s += red[(w * 5 + v) * 64 + C.lane];
            s += bias;
            if (v < 4) { MOD[(size_t)(l * 4 + v) * 6144 + col] = s;
                const int ch = col >> 10;
                if (ch == 1 || ch == 4) { const int w2 = (ch == 4) ? 1 : 0; MODP[(size_t)((l * 4 + v) * 2 + w2) * 1024 + (col & 1023)] = ((w2 ? kin(7) : kin(6))[l * 1024 + (col & 1023)]) * (1.0f + s); }
            } else if (l == 0) MODC[col] = s; }
    }
    __syncthreads();
}
struct StripDesc { const float* W; int N, n0, drow0; unsigned char* W8; float* CSC; };
constexpr int N_STRIPS = 2048 + 96 + 32 + 56;
__device__ __forceinline__ StripDesc strip_desc(const Ctx& C, int st) {
    StripDesc d;
    if (st < 2048) { const int me = st >> 5, which = (st >> 4) & 1, j0 = 32 * (st & 15);
        d.W = (which ? kin(23) : kin(22)) + (size_t)me * 1024 * 512; d.N = 512; d.n0 = j0; d.W8 = (unsigned char*)(C.ws + WS_WGU) + (size_t)me * 1024 * 1024; d.CSC = (float*)(C.ws + WS_CSC) + (size_t)me * 1024;
        d.drow0 = 256 * (j0 >> 7) + (j0 & 127) + 128 * which;
    } else if (st < 2048 + 96) { const int n0 = 32 * (st - 2048), j = n0 & 1023;
        d.W = kin(15); d.N = 3072; d.n0 = n0; d.W8 = (unsigned char*)(C.ws + WS_WINO); d.CSC = (float*)(C.ws + WS_CSC2); d.drow0 = (n0 < 1024) ? 2048 + n0 : 256 * (j >> 7) + (j & 127) + ((n0 >= 2048) ? 128 : 0);
    } else if (st < 2048 + 96 + 32) { const int n0 = 32 * (st - 2048 - 96);
        d.W = kin(17); d.N = 1024; d.n0 = n0; d.W8 = (unsigned char*)(C.ws + WS_WOUTO); d.CSC = (float*)(C.ws + WS_CSC2) + 3072; d.drow0 = n0;
    } else { const int n0 = 32 * (st - 2048 - 96 - 32);
        d.W = kin(9); d.N = 1792; d.n0 = n0; d.W8 = (unsigned char*)(C.ws + WS_WINE); d.CSC = (float*)(C.ws + WS_CSC2) + 4096; d.drow0 = n0; }
    return d;
}
#define QS_LOAD(v, d) do { const float* p_ = (d).W + (size_t)(16 * kr) * (d).N + (d).n0 + 4 * c4; _Pragma("unroll") for (int i = 0; i < 16; ++i) v[i] = *(const f32x4*)(p_ + (size_t)i * (d).N); } while (0)
__device__ __forceinline__ void quant_strip_regs(const Ctx& C, const f32x4 (&v)[16], const StripDesc& d, int par) {
    const int c4 = C.tid & 7, kr = C.tid >> 3;
    LAS float* part = (LAS float*)(C.lds + par * 2048); LAS float* cmax = part + 256;
    f32x4 mx = (f32x4){0.f, 0.f, 0.f, 0.f};
#pragma unroll
    for (int i = 0; i < 16; ++i) mx = __builtin_elementwise_max(mx, __builtin_elementwise_abs(v[i]));
#pragma unroll
    for (int j = 0; j < 4; ++j) { float m = mx[j]; m = fmaxf(m, __shfl_xor(m, 8)); m = fmaxf(m, __shfl_xor(m, 16)); m = fmaxf(m, __shfl_xor(m, 32)); mx[j] = m; }
    if ((C.lane >> 3) == 0) {
#pragma unroll
        for (int j = 0; j < 4; ++j) part[C.wave * 32 + 4 * c4 + j] = mx[j]; }
    lds_barrier();
    if (C.tid < 32) { float m = part[C.tid];
#pragma unroll
        for (int g = 1; g < 8; ++g) m = fmaxf(m, part[g * 32 + C.tid]);
        cmax[C.tid] = m; d.CSC[d.drow0 + C.tid] = m > 0.f ? m * (1.0f / 127.0f) : 1.0f; }
    lds_barrier();
#pragma unroll
    for (int j = 0; j < 4; ++j) { const float am = cmax[4 * c4 + j], inv = am > 0.f ? 127.0f / am : 0.f; unsigned w[4];
#pragma unroll
        for (int g = 0; g < 4; ++g) { unsigned acc = 0u;
#pragma unroll
            for (int e = 0; e < 4; ++e) acc |= ((unsigned)(int)__builtin_rintf(v[4 * g + e][j] * inv) & 0xffu) << (8 * e);
            w[g] = acc; }
        *(v4u*)(d.W8 + (size_t)(d.drow0 + 4 * c4 + j) * 1024 + 16 * kr) = (v4u){w[0], w[1], w[2], w[3]}; }
    (void)kr;
}
constexpr int N_PSTRIPS = 1024 + (N_STRIPS - 2176);
__device__ __forceinline__ int strip_of(const Ctx& C, int i) {
    int p;
    if (C.G != 256) { p = C.bid + i * C.G; }
    else if (C.bid < 192) { if (i >= 4) return -1; p = C.bid + 192 * i; }
    else p = 768 + (C.bid - 192) + 64 * i;
    if (p >= N_PSTRIPS) return -1;
    return p < 1024 ? p : p + 1152;
}
__device__ __forceinline__ void quant_strips(const Ctx& C) {
    const int c4 = C.tid & 7, kr = C.tid >> 3;
    f32x4 va[16], vb[16];
    int i = 0, sta = strip_of(C, 0);
    if (sta >= 0) {
        StripDesc da = strip_desc(C, sta), db = da; QS_LOAD(va, da);
#pragma unroll 1
        for (;;) {
            const int stb = strip_of(C, i + 1); if (stb >= 0) { db = strip_desc(C, stb); QS_LOAD(vb, db); }
            quant_strip_regs(C, va, da, 0);
            if (stb < 0) break;
            i += 2; sta = strip_of(C, i); if (sta >= 0) { da = strip_desc(C, sta); QS_LOAD(va, da); }
            quant_strip_regs(C, vb, db, 1);
            if (sta < 0) break;
        }
    }
    __syncthreads();
}
__device__ __forceinline__ void quant_strips_q(const Ctx& C, gu32* qhead, int nq1, int base1, int nq2, int base2) {
    const int nq = nq1 + nq2;
#define QS_MAP(q) ((q) < nq1 ? base1 + (q) : base2 + (q) - nq1)
    const int c4 = C.tid & 7, kr = C.tid >> 3;
    volatile LAS int* qi = (volatile LAS int*)(C.lds + 4096);
    __syncthreads();
    if (C.tid == 0) { qi[0] = (int)__hip_atomic_fetch_add(qhead, 1u, RLX_AGENT); qi[1] = (int)__hip_atomic_fetch_add(qhead, 1u, RLX_AGENT); }
    __syncthreads();
    int sta = qi[0], stb = qi[1];
    f32x4 va[16], vb[16];
    if (sta < nq) {
        StripDesc da = strip_desc(C, QS_MAP(sta)), db = da; QS_LOAD(va, da);
#pragma unroll 1
        for (;;) {
            const bool hb = stb < nq; if (hb) { db = strip_desc(C, QS_MAP(stb)); QS_LOAD(vb, db); }
            if (C.tid == 0) qi[0] = (int)__hip_atomic_fetch_add(qhead, 1u, RLX_AGENT);
            quant_strip_regs(C, va, da, 0);
            sta = qi[0];
            if (!hb) break;
            const bool ha = sta < nq; if (ha) { da = strip_desc(C, QS_MAP(sta)); QS_LOAD(va, da); }
            if (C.tid == 0) qi[1] = (int)__hip_atomic_fetch_add(qhead, 1u, RLX_AGENT);
            quant_strip_regs(C, vb, db, 1);
            stb = qi[1];
            if (!ha) break;
        }
    }
    __syncthreads();
}
#undef QS_MAP
#undef QS_LOAD
#define WD_LOAD(v, sd) do { const float* p_ = kin(24) + (size_t)((sd) >> 5) * 512 * 1024 + (size_t)(8 * kr) * 1024 + 32 * ((sd) & 31) + 4 * c4; _Pragma("unroll") for (int i = 0; i < 8; ++i) v[i] = *(const f32x4*)(p_ + (size_t)i * 1024); } while (0)
__device__ __forceinline__ void wd_strip_regs(const Ctx& C, const f32x4 (&v)[8], int sd, int par) {
    const int c4 = C.tid & 7, kr = C.tid >> 3, me = sd >> 5, n0 = 32 * (sd & 31);
    LAS float* part = (LAS float*)(C.lds + par * 2048); LAS float* cmax = part + 256;
    f32x4 mx = (f32x4){0.f, 0.f, 0.f, 0.f};
#pragma unroll
    for (int i = 0; i < 8; ++i) mx = __builtin_elementwise_max(mx, __builtin_elementwise_abs(v[i]));
#pragma unroll
    for (int j = 0; j < 4; ++j) { float m = mx[j]; m = fmaxf(m, __shfl_xor(m, 8)); m = fmaxf(m, __shfl_xor(m, 16)); m = fmaxf(m, __shfl_xor(m, 32)); mx[j] = m; }
    if ((C.lane >> 3) == 0) {
#pragma unroll
        for (int j = 0; j < 4; ++j) part[C.wave * 32 + 4 * c4 + j] = mx[j]; }
    lds_barrier();
    if (C.tid < 32) { float m = part[C.tid];
#pragma unroll
        for (int g = 1; g < 8; ++g) m = fmaxf(m, part[g * 32 + C.tid]);
        cmax[C.tid] = m; ((float*)(C.ws + WS_CSD))[(size_t)me * 1024 + n0 + C.tid] = m > 0.f ? m * (1.0f / 240.0f) : 1.0f; }
    lds_barrier();
    unsigned char* W8 = (unsigned char*)(C.ws + WS_WD) + (size_t)me * 1024 * 512;
#pragma unroll
    for (int j = 0; j < 4; ++j) { const float am = cmax[4 * c4 + j], inv = am > 0.f ? 240.0f / am : 0.f;
        int w0 = __builtin_amdgcn_cvt_pk_fp8_f32(v[0][j] * inv, v[1][j] * inv, 0, false); w0 = __builtin_amdgcn_cvt_pk_fp8_f32(v[2][j] * inv, v[3][j] * inv, w0, true);
        int w1 = __builtin_amdgcn_cvt_pk_fp8_f32(v[4][j] * inv, v[5][j] * inv, 0, false); w1 = __builtin_amdgcn_cvt_pk_fp8_f32(v[6][j] * inv, v[7][j] * inv, w1, true);
        *(v2u*)(W8 + (size_t)(n0 + 4 * c4 + j) * 512 + 8 * kr) = (v2u){(unsigned)w0, (unsigned)w1}; }
}
__device__ __forceinline__ void wd_strips(const Ctx& C, int first, int stride, int end) {
    const int c4 = C.tid & 7, kr = C.tid >> 3;
    f32x4 va[8], vb[8];
    int sa = first;
    if (sa < end) { WD_LOAD(va, sa);
#pragma unroll 1
        for (;;) {
            const int sb = sa + stride; if (sb < end) WD_LOAD(vb, sb);
            wd_strip_regs(C, va, sa, 0);
            if (sb >= end) break;
            sa = sb + stride; if (sa < end) WD_LOAD(va, sa);
            wd_strip_regs(C, vb, sb, 1);
            if (sa >= end) break;
        }
    }
    __syncthreads();
}
#undef WD_LOAD
#if defined(TPROBE_P0)
#define P0_STAMP(i) do { if (C.tid == 0) { const unsigned long long n_ = __builtin_amdgcn_s_memrealtime(); volatile LAS unsigned long long* st_ = (volatile LAS unsigned long long*)(C.lds + MISC_OFF + 128); st_[i] = n_; \
        if ((i) == 3 && false) { const unsigned el_ = (unsigned)(n_ - st_[0]); __hip_atomic_fetch_max((unsigned*)(C.ctl + 200), el_, RLX_AGENT); __hip_atomic_fetch_max((unsigned*)(C.ctl + 203 + (C.bid >> 6)), el_, RLX_AGENT); } } } while (0)
#else
#define P0_STAMP(i) do { } while (0)
#endif
__device__ __forceinline__ void p0_prologue(const Ctx& C) {
    P0_STAMP(0);
    for (int u = C.bid; u < 192; u += C.G) adaln_unit(C, u);
    P0_STAMP(1);
    quant_strips(C);
    wd_strips(C, C.bid, C.G, 1024);
    wd_strips(C, 1664 + C.bid, C.G, 2048);
    P0_STAMP(2);
    LAS float* scr = (LAS float*)(C.lds + C.wave * 16384);
    const int gw = C.bid * NWAVES + C.wave, NGW = C.G * NWAVES;
    for (int it = gw; it < 512; it += NGW)
        transpose_item(kin(14), 1024, 1024, (bf16*)(C.ws + WS_WOUTE), 64 * (it / 32), 32 * (it % 32), 32 * (it % 32), scr, C.lane);
    for (int it = gw; it < 256; it += NGW) {
        const f32x4* src = (const f32x4*)(kin(12) + (size_t)it * 512) + 2 * C.lane; const f32x4 a = src[0], b = src[1];
        v4u o; o.x = pk2(a.x, a.y); o.y = pk2(a.z, a.w); o.z = pk2(b.x, b.y); o.w = pk2(b.z, b.w);
        *(v4u*)((bf16*)(C.ws + WS_WSP) + (size_t)it * 512 + 8 * C.lane) = o;
    }
    { const int gt = gw * 64 + C.lane;
        if (gt < 2048) { float s, c; sincos_acc((float)(gt >> 4) * ROPE_INV[gt & 15], s, c); ((float*)(C.ws + WS_ROPE))[gt] = c; ((float*)(C.ws + WS_ROPE))[2048 + gt] = s; } }
    P0_STAMP(3);
}
__device__ __forceinline__ void wd1_items(const Ctx& C, int hb, int nhb) { wd_strips(C, 1024 + hb, nhb, 1664); }

__device__ __forceinline__ void unpack8(const v4u w, float (&f)[8]) { f[0] = bflo(w.x); f[1] = bfhi(w.x); f[2] = bflo(w.y); f[3] = bfhi(w.y); f[4] = bflo(w.z); f[5] = bfhi(w.z); f[6] = bflo(w.w); f[7] = bfhi(w.w); }
__device__ __forceinline__ void load_mod(const float* gam, const float* shp, const float* scp, int lane, f32x4 (&sc)[4], f32x4 (&sh)[4]) {
#pragma unroll
    for (int j = 0; j < 4; ++j) { const int idx = lane + 64 * j; const f32x4 g = ((const f32x4*)gam)[idx], s = ((const f32x4*)scp)[idx]; sc[j] = g * (1.0f + s); sh[j] = ((const f32x4*)shp)[idx]; }
}
__device__ __forceinline__ float row_rinv(const f32x4 (&v)[4]) {
    float ss = 0.f;
#pragma unroll
    for (int j = 0; j < 4; ++j) ss += (v[j].x * v[j].x + v[j].y * v[j].y) + (v[j].z * v[j].z + v[j].w * v[j].w);
    return rsqrtf(wave_sum(ss) * (1.0f / 1024.0f) + EPS);
}
__device__ __forceinline__ void mod_store(const f32x4 (&v)[4], float rinv, const f32x4 (&sc)[4], const f32x4 (&sh)[4], bf16* orow, int lane) {
#pragma unroll
    for (int j = 0; j < 4; ++j) { const f32x4 o = v[j] * rinv * sc[j] + sh[j]; v2u w; w.x = pk2(o.x, o.y); w.y = pk2(o.z, o.w); ((v2u*)orow)[lane + 64 * j] = w; }
}
__device__ __forceinline__ void mod_store8(const f32x4 (&v)[4], float rinv, const f32x4 (&sc)[4], const f32x4 (&sh)[4], unsigned char* orow8, float* rsc, int lane) {
    f32x4 o[4]; float am = 0.f;
#pragma unroll
    for (int j = 0; j < 4; ++j) { o[j] = v[j] * rinv * sc[j] + sh[j]; am = fmaxf(am, fmaxf(fmaxf(fabsf(o[j].x), fabsf(o[j].y)), fmaxf(fabsf(o[j].z), fabsf(o[j].w)))); }
#pragma unroll
    for (int s = 1; s < 64; s <<= 1) am = fmaxf(am, __shfl_xor(am, s));
    const float inv = am > 0.f ? 127.0f / am : 0.f;
#pragma unroll
    for (int j = 0; j < 4; ++j) { const unsigned w = ((unsigned)(int)__builtin_rintf(o[j].x * inv) & 0xffu) | (((unsigned)(int)__builtin_rintf(o[j].y * inv) & 0xffu) << 8) | (((unsigned)(int)__builtin_rintf(o[j].z * inv) & 0xffu) << 16) | (((unsigned)(int)__builtin_rintf(o[j].w * inv) & 0xffu) << 24);
        ((unsigned*)orow8)[lane + 64 * j] = w; }
    if (lane == 0) *rsc = am > 0.f ? am * (1.0f / 127.0f) : 1.0f;
}
__device__ __forceinline__ void phase_norm1_l0(const Ctx& C) {
    const int gw = C.bid * NWAVES + C.wave, NGW = C.G * NWAVES;
    const float* MOD = (const float*)(C.ws + WS_MOD); const float* MODC = (const float*)(C.ws + WS_MODC); bf16* H = (bf16*)(C.ws + WS_H);
    const int nrow = (M + MC - gw + NGW - 1) / NGW;
    f32x4 sc[4], sh[4]; int curb = -1;
    f32x4 va[4][4], vb[4][4];
#define N1_SRC(row) (((row) < M) ? kin(0) + (size_t)(row) * D : kin(2) + (size_t)((row) - M) * D)
#define N1_LOAD(buf, i0) do { _Pragma("unroll") for (int r = 0; r < 4; ++r) { const int row_ = gw + ((i0) + r) * NGW; if ((i0) + r < nrow) { const float* s_ = N1_SRC(row_); \
            _Pragma("unroll") for (int j = 0; j < 4; ++j) buf[r][j] = ((const f32x4*)s_)[C.lane + 64 * j]; } } } while (0)
#define N1_PROC(buf, i0) do { _Pragma("unroll") for (int r = 0; r < 4; ++r) { const int row_ = gw + ((i0) + r) * NGW; if ((i0) + r < nrow) { const int b_ = (row_ < M) ? (row_ >> 13) : 4; \
            if (b_ != curb) { curb = b_; if (b_ < 4) { const float* mod = MOD + (size_t)b_ * 6144; load_mod(kin(6), mod, mod + 1024, C.lane, sc, sh); } else load_mod(kin(6), MODC, MODC + 1024, C.lane, sc, sh); } \
            mod_store8(buf[r], row_rinv(buf[r]), sc, sh, (unsigned char*)H + (size_t)row_ * D, (float*)(C.ws + WS_RSC) + row_, C.lane); } } } while (0)
    N1_LOAD(va, 0);
#pragma unroll 1
    for (int i0 = 0; i0 < nrow; i0 += 8) {
        N1_LOAD(vb, i0 + 4); N1_PROC(va, i0);
        N1_LOAD(va, i0 + 8); N1_PROC(vb, i0 + 4); }
#undef N1_LOAD
#undef N1_PROC
#undef N1_SRC
}
__device__ __forceinline__ void phase_router(const Ctx& C, int l) {
    LAS unsigned char* WH = C.lds + RT_WH; LAS unsigned char* WL = C.lds + RT_WL;
    LAS int* cnt = (LAS int*)(C.lds + RT_CNT); LAS int* base = (LAS int*)(C.lds + RT_BASE); LAS int* info = (LAS int*)(C.lds + RT_INFO);
    const float* wrg = kin(18) + l * 4096; const float* wre = kin(20) + l * 32768; const float* brg = kin(19) + l * 4; const float* bre = kin(21) + l * 32;
    for (int idx = C.tid; idx < 9216; idx += NWAVES * 64) { const int k = idx / 9, q9 = idx - 9 * k;
        const f32x4 v = (q9 == 0) ? *(const f32x4*)(wrg + 4 * k) : *(const f32x4*)(wre + 32 * k + 4 * (q9 - 1));
        const int row0 = (q9 == 0) ? 32 : 16 * ((q9 - 1) & 1) + 4 * ((q9 - 1) >> 1);
#pragma unroll
        for (int i = 0; i < 4; ++i) { const unsigned hi = f2bf(v[i]), lo = f2bf(v[i] - bflo(hi));
            *(LAS bf16*)(WH + (row0 + i) * RW_STRIDE + 2 * k) = (bf16)hi; *(LAS bf16*)(WL + (row0 + i) * RW_STRIDE + 2 * k) = (bf16)lo; } }
    if (C.tid < 32) cnt[C.tid] = 0;
    __syncthreads();
    const float* MOD = (const float*)(C.ws + WS_MOD); const float* MODP = (const float*)(C.ws + WS_MODP); const float* RSS = (const float*)(C.ws + WS_RSS); unsigned char* H8 = (unsigned char*)(C.ws + WS_H);
    int* LIST = (int*)(C.ws + WS_LIST); float* TOKSC = (float*)(C.ws + WS_TOKSC); LAS float* red = (LAS float*)(C.lds + RT_RED);
    gu32* gcnt = C.ctl + CW_GCNT + l * 32;
    int* TOKE = (int*)(C.ws + WS_TOKE); int* TOKP = (int*)(C.ws + WS_TOKP); float* TOKW = (float*)(C.ws + WS_TOKW);
    const int r = C.lane & 15, q = C.lane >> 4;
    for (int rb = C.bid; rb < M / 128; rb += C.G) {
        const int bq = rb >> 6; const size_t row = (size_t)rb * 128 + C.wave * 16 + r;
        { const float* sp_ = MODP + (size_t)((l * 4 + bq) * 2 + 1) * 1024; const float* hp_ = MOD + (size_t)(l * 4 + bq) * 6144 + 3 * 1024;
            float ms = fmaxf(fabsf(sp_[C.tid]), fabsf(sp_[C.tid + 512])), mh = fmaxf(fabsf(hp_[C.tid]), fabsf(hp_[C.tid + 512]));
#pragma unroll
            for (int o = 1; o < 64; o <<= 1) { ms = fmaxf(ms, __shfl_xor(ms, o)); mh = fmaxf(mh, __shfl_xor(mh, o)); }
            __syncthreads();
            if (C.lane == 0) { red[C.wave] = ms; red[8 + C.wave] = mh; }
            __syncthreads(); }
        float scmax = red[0], shmax = red[8];
#pragma unroll
        for (int w = 1; w < 8; ++w) { scmax = fmaxf(scmax, red[w]); shmax = fmaxf(shmax, red[8 + w]); }
        float rinv, qinv, qscale; { const f32x4* rp = (const f32x4*)(RSS + row * 16); const f32x4 a = rp[0], b = rp[1], c = rp[2], d = rp[3];
            const f32x4 t = (a + b) + (c + d); rinv = rsqrtf(((t.x + t.y) + (t.z + t.w)) * (1.0f / 1024.0f) + EPS);
            const f32x4* mp = (const f32x4*)(RSS + (size_t)M * 16 + row * 16); const f32x4 m4 = __builtin_elementwise_max(__builtin_elementwise_max(mp[0], mp[1]), __builtin_elementwise_max(mp[2], mp[3]));
            const float xmax = fmaxf(fmaxf(m4.x, m4.y), fmaxf(m4.z, m4.w)), bound = xmax * rinv * scmax + shmax;
            qinv = bound > 0.f ? 127.0f / bound : 0.f; qscale = bound > 0.f ? bound * (1.0f / 127.0f) : 1.0f; }
        const v4u* xr = (const v4u*)((const bf16*)(C.ws + WS_LAT) + row * D + 8 * q);
        const f32x4* sp = (const f32x4*)(MODP + (size_t)((l * 4 + bq) * 2 + 1) * 1024 + 8 * q); const f32x4* hp = (const f32x4*)(MOD + (size_t)(l * 4 + bq) * 6144 + 3 * 1024 + 8 * q);
        unsigned char* hrow = H8 + row * D + 8 * q;
        const LAS unsigned char* a0 = WH + (C.lane & 15) * RW_STRIDE + 16 * q; const LAS unsigned char* a2 = WH + (32 + (C.lane & 3)) * RW_STRIDE + 16 * q;
        pg8::f32x4 acc[3];
#pragma unroll
        for (int t = 0; t < 3; ++t) acc[t] = (pg8::f32x4){0.f, 0.f, 0.f, 0.f};
        v4u xc[8], xn[8];
#pragma unroll
        for (int s = 0; s < 8; ++s) xc[s] = xr[4 * s];
        for (int kb = 0; kb < 4; ++kb) {
            if (kb < 3) {
#pragma unroll
                for (int s = 0; s < 8; ++s) xn[s] = xr[4 * (8 * (kb + 1) + s)]; }
#pragma unroll
            for (int s = 0; s < 8; ++s) { const int kk = 8 * kb + s;
                const f32x4 sv0 = sp[8 * kk], sv1 = sp[8 * kk + 1], hv0 = hp[8 * kk], hv1 = hp[8 * kk + 1];
                const f32x4 x0 = (f32x4){bflo(xc[s].x), bfhi(xc[s].x), bflo(xc[s].y), bfhi(xc[s].y)}, x1 = (f32x4){bflo(xc[s].z), bfhi(xc[s].z), bflo(xc[s].w), bfhi(xc[s].w)};
                const f32x4 h0 = x0 * rinv * sv0 + hv0, h1 = x1 * rinv * sv1 + hv1;
                v4u hi; hi.x = pg8::cvt_pk_bf16(h0.x, h0.y); hi.y = pg8::cvt_pk_bf16(h0.z, h0.w); hi.z = pg8::cvt_pk_bf16(h1.x, h1.y); hi.w = pg8::cvt_pk_bf16(h1.z, h1.w);
                v4u lo; lo.x = pg8::cvt_pk_bf16(h0.x - bflo(hi.x), h0.y - bfhi(hi.x)); lo.y = pg8::cvt_pk_bf16(h0.z - bflo(hi.y), h0.w - bfhi(hi.y));
                lo.z = pg8::cvt_pk_bf16(h1.x - bflo(hi.z), h1.y - bfhi(hi.z)); lo.w = pg8::cvt_pk_bf16(h1.z - bflo(hi.w), h1.w - bfhi(hi.w));
                { unsigned w0 = 0u, w1 = 0u;
                    w0 = ((unsigned)(int)__builtin_rintf(h0.x * qinv) & 0xffu) | (((unsigned)(int)__builtin_rintf(h0.y * qinv) & 0xffu) << 8) | (((unsigned)(int)__builtin_rintf(h0.z * qinv) & 0xffu) << 16) | (((unsigned)(int)__builtin_rintf(h0.w * qinv) & 0xffu) << 24);
                    w1 = ((unsigned)(int)__builtin_rintf(h1.x * qinv) & 0xffu) | (((unsigned)(int)__builtin_rintf(h1.y * qinv) & 0xffu) << 8) | (((unsigned)(int)__builtin_rintf(h1.z * qinv) & 0xffu) << 16) | (((unsigned)(int)__builtin_rintf(h1.w * qinv) & 0xffu) << 24);
                    *(v2u*)(hrow + 32 * kk) = (v2u){w0, w1}; }
                const bf16x8 bh = __builtin_bit_cast(bf16x8, hi), bl = __builtin_bit_cast(bf16x8, lo);
#pragma unroll
                for (int t = 0; t < 3; ++t) { const LAS unsigned char* ap = ((t == 2) ? a2 : a0 + 16 * t * RW_STRIDE) + 64 * kk;
                    const bf16x8 ah = *(const LAS bf16x8*)ap, al = *(const LAS bf16x8*)(ap + RT_WL);
                    acc[t] = __builtin_amdgcn_mfma_f32_16x16x32_bf16(ah, bh, acc[t], 0, 0, 0);
                    acc[t] = __builtin_amdgcn_mfma_f32_16x16x32_bf16(al, bh, acc[t], 0, 0, 0);
                    acc[t] = __builtin_amdgcn_mfma_f32_16x16x32_bf16(ah, bl, acc[t], 0, 0, 0); } }
            if (kb < 3) {
#pragma unroll
                for (int s = 0; s < 8; ++s) xc[s] = xn[s]; }
        }
        float gl[4];
#pragma unroll
        for (int gi = 0; gi < 4; ++gi) gl[gi] = acc[2][gi] + brg[gi];
        int gidx = 0; float gmax = gl[0];
#pragma unroll
        for (int gi = 1; gi < 4; ++gi) if (gl[gi] > gmax) { gmax = gl[gi]; gidx = gi; }
        if (q == gidx) {
            float den = 0.f;
#pragma unroll
            for (int gi = 0; gi < 4; ++gi) den += __expf(gl[gi] - gmax);
            const float gwt = 1.0f / den;
            float ev[8];
#pragma unroll
            for (int j = 0; j < 8; ++j) ev[j] = acc[j >> 2][j & 3] + bre[8 * q + j];
            int i0 = 0; float v0 = ev[0];
#pragma unroll
            for (int j = 1; j < 8; ++j) if (ev[j] > v0) { v0 = ev[j]; i0 = j; }
            int i1 = (i0 == 0) ? 1 : 0; float v1 = (i0 == 0) ? ev[1] : ev[0];
#pragma unroll
            for (int j = 1; j < 8; ++j) if (j != i0 && ev[j] > v1) { v1 = ev[j]; i1 = j; }
            const float t = __expf(v1 - v0), p0 = 1.0f / (1.0f + t), p1 = t * p0;
            const int rr = C.wave * 16 + r, e0 = gidx * 8 + i0, e1 = gidx * 8 + i1;
            const int pl0 = __hip_atomic_fetch_add(cnt + e0, 1, __ATOMIC_RELAXED, __HIP_MEMORY_SCOPE_WORKGROUP), pl1 = __hip_atomic_fetch_add(cnt + e1, 1, __ATOMIC_RELAXED, __HIP_MEMORY_SCOPE_WORKGROUP);
            info[rr * 8 + 0] = e0; info[rr * 8 + 1] = e1; info[rr * 8 + 2] = pl0; info[rr * 8 + 3] = pl1;
            info[rr * 8 + 4] = __builtin_bit_cast(int, gwt * p0); info[rr * 8 + 5] = __builtin_bit_cast(int, gwt * p1); info[rr * 8 + 6] = __builtin_bit_cast(int, qscale);
        }
        __syncthreads();
        if (C.tid < 32) base[C.tid] = (int)__hip_atomic_fetch_add(gcnt + C.tid, (unsigned)cnt[C.tid], RLX_AGENT);
        __syncthreads();
        if (C.tid < 128) { const size_t orow = (size_t)rb * 128 + C.tid; const int e0 = info[C.tid * 8], e1 = info[C.tid * 8 + 1];
            const int p0 = base[e0] + info[C.tid * 8 + 2], p1 = base[e1] + info[C.tid * 8 + 3];
            TOKE[orow] = e0 | (e1 << 8); TOKP[orow * 2] = p0; TOKP[orow * 2 + 1] = p1; LIST[(size_t)e0 * 32768 + p0] = (int)orow; LIST[(size_t)e1 * 32768 + p1] = (int)orow;
            TOKW[orow * 2] = __builtin_bit_cast(float, info[C.tid * 8 + 4]); TOKW[orow * 2 + 1] = __builtin_bit_cast(float, info[C.tid * 8 + 5]); TOKSC[orow] = __builtin_bit_cast(float, info[C.tid * 8 + 6]); }
        __syncthreads();
        if (C.tid < 32) cnt[C.tid] = 0;
        __syncthreads();
    }
}
__device__ __forceinline__ int moe_tables(const Ctx& C, int l) {
    LAS int* tile_e = (LAS int*)(C.lds + MOE_TAB_OFF); LAS int* seg = (LAS int*)(C.lds + MOE_TAB_OFF + 1280); LAS int* lc = (LAS int*)(C.lds + MOE_TAB_OFF + 1280 + 160);
    if (C.tid < 32) lc[C.tid] = (int)__hip_atomic_load(C.ctl + CW_GCNT + l * 32 + C.tid, RLX_AGENT);
    __syncthreads();
    if (C.tid == 0) { int t = 0;
        for (int e = 0; e < 32; ++e) { seg[e] = t * 256; const int n = (lc[e] + 255) >> 8; for (int k = 0; k < n; ++k) tile_e[t + k] = e; t += n; }
        seg[32] = t * 256; }
    __syncthreads();
    return seg[32] >> 8;
}
template <class Sched> __device__ __forceinline__ void moe_gather_tables(const Ctx& C, const Sched& S) {
    const LAS int* tile_e = (const LAS int*)(C.lds + MOE_TAB_OFF); const LAS int* seg = (const LAS int*)(C.lds + MOE_TAB_OFF + 1280); const LAS int* lc = (const LAS int*)(C.lds + MOE_TAB_OFF + 1280 + 160);
    LAS unsigned* gtab = (LAS unsigned*)(C.lds + MOE_GTAB_OFF); LAS float* rtab = (LAS float*)(C.lds + MOE_RTAB_OFF);
    const int* LIST = (const int*)(C.ws + WS_LIST); const float* TOKSC = (const float*)(C.ws + WS_TOKSC);
    pg8::Unit u;
    for (int i = 0; i < MOE_MAXU && S.next(i, u); ++i) {
        if (C.tid < 256) { const int e = tile_e[u.pm], pos = u.pm * 256 - seg[e] + C.tid, tok = LIST[(size_t)e * 32768 + (pos < lc[e] ? pos : 0)];
            gtab[i * 256 + C.tid] = (unsigned)tok * 1024u; rtab[i * 256 + C.tid] = TOKSC[tok]; }
    }
    __syncthreads();
}
template <bool FINAL> __device__ __forceinline__ void phase_combine(const Ctx& C, int lp) {
    const int gw = C.bid * NWAVES + C.wave, NGW = C.G * NWAVES;
    const float* MOD = (const float*)(C.ws + WS_MOD); bf16* H = (bf16*)(C.ws + WS_H); const unsigned char* YB = (const unsigned char*)(C.ws + WS_A); bf16* LAT = (bf16*)(C.ws + WS_LAT);
    const int* TOKE = (const int*)(C.ws + WS_TOKE); const int* TOKP = (const int*)(C.ws + WS_TOKP); const float* TOKW = (const float*)(C.ws + WS_TOKW);
    (void)moe_tables(C, lp); const LAS int* seg = (const LAS int*)(C.lds + MOE_TAB_OFF + 1280);
    for (int grp = gw; grp < M / 16; grp += NGW) {
        const int b = grp >> 9; f32x4 g2[4], sc[4], sh[4];
#pragma unroll
        for (int j = 0; j < 4; ++j) g2[j] = ((const f32x4*)(MOD + (size_t)(lp * 4 + b) * 6144 + 5 * 1024))[C.lane + 64 * j];
        if (FINAL) {
#pragma unroll
            for (int j = 0; j < 4; ++j) { sc[j] = ((const f32x4*)kin(8))[C.lane + 64 * j]; sh[j] = (f32x4){0.f, 0.f, 0.f, 0.f}; }
        } else { const float* mod = MOD + (size_t)(4 + b) * 6144; load_mod(kin(6) + 1024, mod, mod + 1024, C.lane, sc, sh); }
        const int tev = TOKE[(size_t)grp * 16 + (C.lane & 15)], tsv = TOKP[(size_t)grp * 32 + (C.lane & 31)], twv = __builtin_bit_cast(int, TOKW[(size_t)grp * 32 + (C.lane & 31)]);
        v2u xv[4][4]; unsigned ya[4][4], yc[4][4]; float w0[4], w1[4];
#define CB_LOAD(buf, r0) do { const size_t row_ = (size_t)grp * 16 + (r0); \
            const int ee_ = __builtin_amdgcn_readlane(tev, (r0)); const int s0_ = seg[ee_ & 255] + __builtin_amdgcn_readlane(tsv, 2 * (r0)), s1_ = seg[ee_ >> 8] + __builtin_amdgcn_readlane(tsv, 2 * (r0) + 1); \
            w0[buf] = __builtin_bit_cast(float, __builtin_amdgcn_readlane(twv, 2 * (r0))); w1[buf] = __builtin_bit_cast(float, __builtin_amdgcn_readlane(twv, 2 * (r0) + 1)); \
            _Pragma("unroll") for (int j = 0; j < 4; ++j) { xv[buf][j] = ((const v2u*)(LAT + row_ * D))[C.lane + 64 * j]; \
                ya[buf][j] = ((const unsigned*)(YB + (size_t)s0_ * D))[C.lane + 64 * j]; yc[buf][j] = ((const unsigned*)(YB + (size_t)s1_ * D))[C.lane + 64 * j]; } } while (0)
#define CB_PROC(buf, r0) do { const size_t row = (size_t)grp * 16 + (r0); f32x4 v[4]; \
            _Pragma("unroll") for (int j = 0; j < 4; ++j) { const int a = (int)ya[buf][j], c = (int)yc[buf][j]; \
                const f32x4 y0 = (f32x4){__builtin_amdgcn_cvt_f32_fp8(a, 0), __builtin_amdgcn_cvt_f32_fp8(a, 1), __builtin_amdgcn_cvt_f32_fp8(a, 2), __builtin_amdgcn_cvt_f32_fp8(a, 3)}, \
                            y1 = (f32x4){__builtin_amdgcn_cvt_f32_fp8(c, 0), __builtin_amdgcn_cvt_f32_fp8(c, 1), __builtin_amdgcn_cvt_f32_fp8(c, 2), __builtin_amdgcn_cvt_f32_fp8(c, 3)}; \
                const v2u xw = xv[buf][j]; v[j] = (f32x4){bflo(xw.x), bfhi(xw.x), bflo(xw.y), bfhi(xw.y)} + g2[j] * (y0 * w0[buf] + y1 * w1[buf]); } \
            if (FINAL) { const float rinv = row_rinv(v); _Pragma("unroll") for (int j = 0; j < 4; ++j) ((f32x4*)(C.out + row * D))[C.lane + 64 * j] = v[j] * rinv * sc[j]; } \
            else { _Pragma("unroll") for (int j = 0; j < 4; ++j) { v2u w_; w_.x = pk2(v[j].x, v[j].y); w_.y = pk2(v[j].z, v[j].w); ((v2u*)(LAT + row * D))[C.lane + 64 * j] = w_; \
                    v[j] = (f32x4){bflo(w_.x), bfhi(w_.x), bflo(w_.y), bfhi(w_.y)}; } const float rinv = row_rinv(v); mod_store8(v, rinv, sc, sh, (unsigned char*)H + row * D, (float*)(C.ws + WS_RSC) + row, C.lane); } } while (0)
        CB_LOAD(0, 0); CB_LOAD(1, 1); CB_LOAD(2, 2);
#pragma unroll 1
        for (int it = 0; it < 4; ++it) { const int r0 = 4 * it;
            CB_LOAD(3, r0 + 3); CB_PROC(0, r0);
            if (it < 3) CB_LOAD(0, r0 + 4);
            CB_PROC(1, r0 + 1);
            if (it < 3) CB_LOAD(1, r0 + 5);
            CB_PROC(2, r0 + 2);
            if (it < 3) CB_LOAD(2, r0 + 6);
            CB_PROC(3, r0 + 3); }
#undef CB_PROC
#undef CB_LOAD
    }
}
__device__ __forceinline__ void phase_conv(const Ctx& C) {
    const int gw = C.bid * NWAVES + C.wave, NGW = C.G * NWAVES;
    const bf16* BG = (const bf16*)(C.ws + WS_A); const bf16* Y = BG + (size_t)M * D; unsigned char* MIX8 = (unsigned char*)(C.ws + WS_B); float* RSC = (float*)(C.ws + WS_RSC);
    float cw[3][2][8];
#pragma unroll
    for (int t = 0; t < 3; ++t)
#pragma unroll
        for (int j = 0; j < 2; ++j) { const f32x4 a = *(const f32x4*)(kin(16) + t * 1024 + j * 512 + 8 * C.lane), b = *(const f32x4*)(kin(16) + t * 1024 + j * 512 + 8 * C.lane + 4);
            cw[t][j][0] = a.x; cw[t][j][1] = a.y; cw[t][j][2] = a.z; cw[t][j][3] = a.w; cw[t][j][4] = b.x; cw[t][j][5] = b.y; cw[t][j][6] = b.z; cw[t][j][7] = b.w; }
    const v4u zero4 = (v4u){0u, 0u, 0u, 0u};
    for (int grp = gw; grp < M / 16; grp += NGW) {
        const size_t t0 = (size_t)grp * 16; v4u prev[2], cur[2];
        v4u yn[4][2], bgv[4][2];
#define CV_LOAD(buf, r0) do { const size_t row_ = t0 + (r0); const bool last_ = (row_ & 8191) == 8191; \
            _Pragma("unroll") for (int j = 0; j < 2; ++j) { yn[buf][j] = last_ ? zero4 : ((const v4u*)(Y + (row_ + 1) * D))[C.lane + 64 * j]; bgv[buf][j] = ((const v4u*)(BG + row_ * D))[C.lane + 64 * j]; } } while (0)
#pragma unroll
        for (int j = 0; j < 2; ++j) { prev[j] = ((t0 & 8191) == 0) ? zero4 : ((const v4u*)(Y + (t0 - 1) * D))[C.lane + 64 * j]; cur[j] = ((const v4u*)(Y + t0 * D))[C.lane + 64 * j]; }
#define CV_PROC(buf, r0) do { const size_t row = t0 + (r0); float ov[2][8]; float am = 0.f; \
            _Pragma("unroll") for (int j = 0; j < 2; ++j) { const v4u nx = yn[buf][j]; \
                float fp[8], fc[8], fn[8], fb[8]; unpack8(prev[j], fp); unpack8(cur[j], fc); unpack8(nx, fn); unpack8(bgv[buf][j], fb); \
                _Pragma("unroll") for (int e = 0; e < 8; ++e) { ov[j][e] = fb[e] * (fp[e] * cw[0][j][e] + fc[e] * cw[1][j][e] + fn[e] * cw[2][j][e]); am = fmaxf(am, fabsf(ov[j][e])); } \
                prev[j] = cur[j]; cur[j] = nx; } \
            _Pragma("unroll") for (int s_ = 1; s_ < 64; s_ <<= 1) am = fmaxf(am, __shfl_xor(am, s_)); \
            const float inv = am > 0.f ? 127.0f / am : 0.f; \
            _Pragma("unroll") for (int j = 0; j < 2; ++j) { unsigned w0 = 0u, w1 = 0u; \
                _Pragma("unroll") for (int e = 0; e < 4; ++e) { w0 |= ((unsigned)(int)__builtin_rintf(ov[j][e] * inv) & 0xffu) << (8 * e); w1 |= ((unsigned)(int)__builtin_rintf(ov[j][4 + e] * inv) & 0xffu) << (8 * e); } \
                ((v2u*)(MIX8 + row * D))[C.lane + 64 * j] = (v2u){w0, w1}; } \
            if (C.lane == 0) RSC[row] = am > 0.f ? am * (1.0f / 127.0f) : 1.0f; } while (0)
        CV_LOAD(0, 0); CV_LOAD(1, 1); CV_LOAD(2, 2);
#pragma unroll 1
        for (int it = 0; it < 4; ++it) { const int r0 = 4 * it;
            CV_LOAD(3, r0 + 3); CV_PROC(0, r0);
            if (it < 3) CV_LOAD(0, r0 + 4);
            CV_PROC(1, r0 + 1);
            if (it < 3) CV_LOAD(1, r0 + 5);
            CV_PROC(2, r0 + 2);
            if (it < 3) CV_LOAD(2, r0 + 6);
            CV_PROC(3, r0 + 3); }
#undef CV_PROC
#undef CV_LOAD
    }
}
constexpr float LOG2E = 1.4426950408889634f;
constexpr float QSCALE = 0.125f * LOG2E;
constexpr int AT_K = 0, AT_V = 16384, AT_WS = 32768, AT_ST = 34816;
__device__ __forceinline__ int crow(int r, int hi) { return (r & 3) + 8 * (r >> 2) + 4 * hi; }
__device__ __forceinline__ bf16x8 pack8(float a0, float a1, float a2, float a3, float a4, float a5, float a6, float a7) {
    v4u w; w.x = pg8::cvt_pk_bf16(a0, a1); w.y = pg8::cvt_pk_bf16(a2, a3); w.z = pg8::cvt_pk_bf16(a4, a5); w.w = pg8::cvt_pk_bf16(a6, a7); return __builtin_bit_cast(bf16x8, w);
}
__device__ __forceinline__ void attn_unit(const Ctx& C, int au) {
    const int qblk = au & 127, kvh = (au >> 7) & 1, b = au >> 8;
    const int ph = C.wave & 1, head = kvh * 4 + (C.wave >> 1), q32 = C.lane & 31, hi = C.lane >> 5;
    const bf16* QK = (const bf16*)(C.ws + WS_A); const bf16* VT = (const bf16*)(C.ws + WS_VT); const bf16* KC = (const bf16*)(C.ws + WS_KC); const bf16* VCT = (const bf16*)(C.ws + WS_VCT);
    bf16* MIX = (bf16*)(C.ws + WS_B);
    const size_t qrow = (size_t)b * SEQ + 64 * qblk + 32 * ph + q32;
    bf16x8 qf[4];
#pragma unroll
    for (int ds = 0; ds < 4; ++ds) qf[ds] = *(const bf16x8*)(QK + qrow * NINE + head * 64 + 16 * ds + 8 * hi);
    float m = kin(10)[head] * LOG2E, l = (hi == 0) ? 1.0f : 0.0f;
    f32x16 negm;
#pragma unroll
    for (int r = 0; r < 16; ++r) negm[r] = -m;
    f32x16 o0, o1;
#pragma unroll
    for (int r = 0; r < 16; ++r) { o0[r] = 0.f; o1[r] = 0.f; }
    const int jlo = (qblk < 2) ? 2 - qblk : 0, jhi = (qblk > 125) ? 129 - qblk : 4, NT = 4 + jhi - jlo + 1;
    const int prow = C.tid >> 3, pch = C.tid & 7;
    LAS float* wsf = (LAS float*)(C.lds + AT_WS) + C.wave * 64;
    unsigned fa[4];
#pragma unroll
    for (int v = 0; v < 4; ++v) fa[v] = hi * 1024 + (((q32 ^ hi) ^ (2 * v)) * 16) + 2 * v * 1024;
    v4u kr0, vr0, kr1, vr1;
#define AT_LOADK(t, kreg) do { if ((t) < 4) kreg = *(const v4u*)(KC + ((size_t)(b * 256 + 64 * (t) + prow) * 128 + kvh * 64 + 8 * pch)); \
        else { const int kblk_ = qblk - 2 + jlo + (t) - 4; kreg = *(const v4u*)(QK + ((size_t)(b * SEQ + 64 * kblk_ + prow) * NINE + 512 + kvh * 64 + 8 * pch)); } } while (0)
#define AT_LOADV(t, vreg) do { if ((t) < 4) vreg = *(const v4u*)(VCT + ((size_t)((b * 2 + kvh) * 64 + prow) * 256 + 64 * (t) + 8 * pch)); \
        else { const int kblk_ = qblk - 2 + jlo + (t) - 4; vreg = *(const v4u*)(VT + ((size_t)((b * 2 + kvh) * 64 + prow) * SEQ + 64 * kblk_ + 8 * pch)); } } while (0)
#define AT_WRITEK(bufi, kreg) do { *(LAS v4u*)(C.lds + AT_K + (bufi) * 8192 + pch * 1024 + ((prow ^ pch) * 16)) = kreg; } while (0)
#define AT_WRITEV(bufi, vreg) do { *(LAS v4u*)(C.lds + AT_V + (bufi) * 8192 + pch * 1024 + ((prow ^ pch) * 16)) = vreg; } while (0)
#define AT_CL(x) (((x) < NT) ? (x) : NT - 1)
    AT_LOADK(0, kr0); AT_LOADK(1, kr1); AT_LOADV(0, vr0); AT_LOADV(1, vr1);
    AT_WRITEK(0, kr0); AT_WRITEK(1, kr1); AT_WRITEV(0, vr0);
    AT_LOADK(2, kr0); AT_LOADV(2, vr0); AT_LOADK(3, kr1);
    lds_barrier();
    auto qk = [&](const int kbuf, f32x16& p0, f32x16& p1) __attribute__((always_inline)) {
        const LAS unsigned char* kb = C.lds + AT_K + kbuf * 8192;
#pragma unroll
        for (int ds = 0; ds < 4; ++ds) {
            const bf16x8 a0 = *(const LAS bf16x8*)(kb + fa[ds]), a1 = *(const LAS bf16x8*)(kb + fa[ds] + 512);
            if (ds == 0) { p0 = __builtin_amdgcn_mfma_f32_32x32x16_bf16(a0, qf[0], negm, 0, 0, 0); p1 = __builtin_amdgcn_mfma_f32_32x32x16_bf16(a1, qf[0], negm, 0, 0, 0); }
            else { p0 = __builtin_amdgcn_mfma_f32_32x32x16_bf16(a0, qf[ds], p0, 0, 0, 0); p1 = __builtin_amdgcn_mfma_f32_32x32x16_bf16(a1, qf[ds], p1, 0, 0, 0); }
        }
    };
    auto sm = [&](const int t, f32x16& p0, f32x16& p1, f32x16& n0, f32x16& n1) __attribute__((always_inline)) {
        const int j = (t < 4) ? -1 : jlo + t - 4;
        if (j == 0 || j == 4) {
            int dq = 32 * ph + q32 - 4 * hi; asm volatile("" : "+v"(dq));
            if (j == 0) {
#pragma unroll
                for (int r = 0; r < 16; ++r) { const int kc = (r & 3) + 8 * (r >> 2); if (kc < dq) p0[r] = -__builtin_inff(); if (kc + 32 < dq) p1[r] = -__builtin_inff(); }
            } else {
#pragma unroll
                for (int r = 0; r < 16; ++r) { const int kc = (r & 3) + 8 * (r >> 2); if (kc > dq) p0[r] = -__builtin_inff(); if (kc + 32 > dq) p1[r] = -__builtin_inff(); }
            }
        }
#define MX3(a, b, c) __builtin_fmaxf(__builtin_fmaxf((a), (b)), (c))
        float rm = MX3(p0[0], p0[1], p1[0]), rm2 = MX3(p0[2], p0[3], p1[1]); rm = MX3(rm, p1[2], p1[3]);
#pragma unroll
        for (int r = 4; r < 16; r += 4) { rm = MX3(rm, p0[r], p0[r + 1]); rm2 = MX3(rm2, p0[r + 2], p0[r + 3]); rm = MX3(rm, p1[r], p1[r + 1]); rm2 = MX3(rm2, p1[r + 2], p1[r + 3]); }
#undef MX3
        rm = fmaxf(fmaxf(rm, rm2), __shfl_xor(fmaxf(rm, rm2), 32));
        if (__any(rm > 6.0f)) {
            const float dl = fmaxf(rm, 0.f), al = __builtin_amdgcn_exp2f(-dl); m += dl; l *= al;
            if (hi == 0) wsf[q32] = al;
#pragma unroll
            for (int r = 0; r < 16; ++r) { const float f = wsf[crow(r, hi)]; o0[r] *= f; o1[r] *= f; p0[r] -= dl; p1[r] -= dl; n0[r] -= dl; n1[r] -= dl; negm[r] = -m; }
        }
        float ls = 0.f;
#pragma unroll
        for (int r = 0; r < 16; ++r) { p0[r] = __builtin_amdgcn_exp2f(p0[r]); p1[r] = __builtin_amdgcn_exp2f(p1[r]); ls += p0[r] + p1[r]; }
        l += ls;
    };
    auto pv = [&](const int vbuf, const f32x16& p0, const f32x16& p1) __attribute__((always_inline)) {
        const LAS unsigned char* vb = C.lds + AT_V + vbuf * 8192;
#pragma unroll
        for (int s = 0; s < 2; ++s) {
            const bf16x8 pa = pack8(p0[8 * s], p0[8 * s + 1], p0[8 * s + 2], p0[8 * s + 3], p0[8 * s + 4], p0[8 * s + 5], p0[8 * s + 6], p0[8 * s + 7]);
            const bf16x8 pb = pack8(p1[8 * s], p1[8 * s + 1], p1[8 * s + 2], p1[8 * s + 3], p1[8 * s + 4], p1[8 * s + 5], p1[8 * s + 6], p1[8 * s + 7]);
            const bf16x8 va0 = *(const LAS bf16x8*)(vb + fa[s]), va1 = *(const LAS bf16x8*)(vb + fa[s] + 512);
            const bf16x8 vb0 = *(const LAS bf16x8*)(vb + fa[2 + s]), vb1 = *(const LAS bf16x8*)(vb + fa[2 + s] + 512);
            o0 = __builtin_amdgcn_mfma_f32_32x32x16_bf16(pa, va0, o0, 0, 0, 0); o1 = __builtin_amdgcn_mfma_f32_32x32x16_bf16(pa, va1, o1, 0, 0, 0);
            o0 = __builtin_amdgcn_mfma_f32_32x32x16_bf16(pb, vb0, o0, 0, 0, 0); o1 = __builtin_amdgcn_mfma_f32_32x32x16_bf16(pb, vb1, o1, 0, 0, 0);
        }
    };
    f32x16 pa0, pa1, pb0, pb1;
    qk(0, pa0, pa1);
    lds_barrier();
    for (int t = 0; t < NT; t += 2) {
        AT_WRITEV(1, vr1); { const int tn = AT_CL(t + 3); AT_LOADV(tn, vr1); }
        AT_WRITEK(0, kr0); { const int tn = AT_CL(t + 4); AT_LOADK(tn, kr0); }
        if (t + 1 < NT) qk(1, pb0, pb1);
        sm(t, pa0, pa1, pb0, pb1);
        pv(0, pa0, pa1);
        lds_barrier();
        if (t + 1 >= NT) break;
        AT_WRITEV(0, vr0); { const int tn = AT_CL(t + 4); AT_LOADV(tn, vr0); }
        AT_WRITEK(1, kr1); { const int tn = AT_CL(t + 5); AT_LOADK(tn, kr1); }
        if (t + 2 < NT) qk(0, pa0, pa1);
        sm(t + 1, pb0, pb1, pa0, pa1);
        pv(1, pb0, pb1);
        lds_barrier();
    }
#undef AT_LOADK
#undef AT_LOADV
#undef AT_WRITEK
#undef AT_WRITEV
#undef AT_CL
    l += __shfl_xor(l, 32);
    if (hi == 0) wsf[32 + q32] = l;
    LAS bf16* stg = (LAS bf16*)(C.lds + AT_ST) + C.wave * 2048;
#pragma unroll
    for (int r = 0; r < 16; ++r) { const int orow = crow(r, hi); const float rl = 1.0f / wsf[32 + orow];
        stg[orow * 64 + q32] = (bf16)f2bf(o0[r] * rl); stg[orow * 64 + 32 + q32] = (bf16)f2bf(o1[r] * rl); }
    bf16* Ow = MIX + ((size_t)b * SEQ + 64 * qblk + 32 * ph) * D + head * 64;
#pragma unroll
    for (int i = 0; i < 4; ++i) { const int pc = i * 64 + C.lane, row = pc >> 3, ch = pc & 7; const v4u v = *(const LAS v4u*)(stg + row * 64 + ch * 8); *(v4u*)(Ow + (size_t)row * D + ch * 8) = v; }
    lds_barrier();
}
constexpr int ZS = 1040;
__device__ __forceinline__ v2u tr_read(unsigned addr) { v2u r; asm volatile("ds_read_b64_tr_b16 %0, %1\n\ts_waitcnt lgkmcnt(0)" : "=&v"(r) : "v"(addr) : "memory"); return r; }
template <int OFF> __device__ __forceinline__ v2u tr_read_o(unsigned addr) { v2u r; asm volatile("ds_read_b64_tr_b16 %0, %1 offset:%2\n\ts_waitcnt lgkmcnt(0)" : "=&v"(r) : "v"(addr), "i"(OFF) : "memory"); return r; }
__device__ __forceinline__ void sgu_unit(const Ctx& C, int su) {
    const size_t R0 = (size_t)su * 128;
    const bf16* QK = (const bf16*)(C.ws + WS_A); bf16* MIX = (bf16*)(C.ws + WS_B); const bf16* WSP = (const bf16*)(C.ws + WS_WSP);
    { float gs[8]; const f32x4 a = *(const f32x4*)(kin(11) + 8 * C.lane), c = *(const f32x4*)(kin(11) + 8 * C.lane + 4);
        gs[0] = a.x; gs[1] = a.y; gs[2] = a.z; gs[3] = a.w; gs[4] = c.x; gs[5] = c.y; gs[6] = c.z; gs[7] = c.w;
        v4u zr[16];
#pragma unroll
        for (int rr = 0; rr < 16; ++rr) zr[rr] = *(const v4u*)(QK + (R0 + C.wave * 16 + rr) * NINE + 1280 + 8 * C.lane);
        float s1[16], s2[16];
#pragma unroll
        for (int rr = 0; rr < 16; ++rr) { float x[8]; unpack8(zr[rr], x); float a = 0.f, q = 0.f;
#pragma unroll
            for (int e = 0; e < 8; ++e) { a += x[e]; q += x[e] * x[e]; }
            s1[rr] = a; s2[rr] = q; }
#pragma unroll
        for (int o = 1; o < 64; o <<= 1) {
#pragma unroll
            for (int rr = 0; rr < 16; ++rr) { s1[rr] += __shfl_xor(s1[rr], o); s2[rr] += __shfl_xor(s2[rr], o); } }
#pragma unroll
        for (int rr = 0; rr < 16; ++rr) { const int j = C.wave * 16 + rr;
            float x[8]; unpack8(zr[rr], x);
            const float mean = s1[rr] * (1.0f / 512.0f), var = fmaxf(s2[rr] * (1.0f / 512.0f) - mean * mean, 0.f), rstd = rsqrtf(var + EPS);
#pragma unroll
            for (int e = 0; e < 8; ++e) x[e] -= mean;
            v4u w; w.x = pk2(x[0] * rstd * gs[0], x[1] * rstd * gs[1]); w.y = pk2(x[2] * rstd * gs[2], x[3] * rstd * gs[3]);
            w.z = pk2(x[4] * rstd * gs[4], x[5] * rstd * gs[5]); w.w = pk2(x[6] * rstd * gs[6], x[7] * rstd * gs[7]);
            *(LAS v4u*)(C.lds + j * ZS + 16 * C.lane) = w; }
    }
    __syncthreads();
    int ln = C.lane; asm volatile("" : "+v"(ln));
    const int h = C.wave, l31 = ln & 31, hi = ln >> 5, g16 = (ln >> 4) & 1, q4 = (ln & 15) >> 2, p4 = ln & 3;
    f32x16 acc[2][4];
#pragma unroll
    for (int cb = 0; cb < 2; ++cb)
#pragma unroll
        for (int ib = 0; ib < 4; ++ib)
#pragma unroll
            for (int r = 0; r < 16; ++r) acc[cb][ib][r] = 0.f;
    const bf16* wb[4]; const bf16* ub[4]; bf16* ob[4];
#pragma unroll
    for (int ib = 0; ib < 4; ++ib) { wb[ib] = WSP + ((size_t)h * 128 + 32 * ib + l31) * 128 + 8 * hi; ub[ib] = QK + (R0 + 32 * ib + l31) * NINE + 768 + 64 * h + 4 * hi; ob[ib] = MIX + (R0 + 32 * ib + l31) * D + 512 + 64 * h + 4 * hi;
        asm volatile("" : "+v"(wb[ib]), "+v"(ub[ib]), "+v"(ob[ib])); }
    bf16x8 bwa[2][4], bwb[2][4];
#define SG_WLOAD(dst, ks0) do { _Pragma("unroll") for (int kk = 0; kk < 2; ++kk) _Pragma("unroll") for (int ib = 0; ib < 4; ++ib) dst[kk][ib] = *(const GAS bf16x8*)(wb[ib] + 16 * ((ks0) + kk)); } while (0)
    unsigned trb0 = C.ldsaddr + (unsigned)((8 * hi + q4) * ZS + (64 * h + 16 * g16 + 4 * p4) * 2), trb1 = trb0 + 64u * ZS;
    asm volatile("" : "+v"(trb0), "+v"(trb1));
#define SG_ONE(src, kk, ks) do { constexpr int ksl = ((ks) & 3); const unsigned tb = ((ks) < 4) ? trb0 : trb1; bf16x8 az[2]; \
        { const v2u lo = tr_read_o<16 * ksl * ZS>(tb), hi2 = tr_read_o<16 * ksl * ZS + 4 * ZS>(tb); az[0] = __builtin_bit_cast(bf16x8, (v4u){lo.x, lo.y, hi2.x, hi2.y}); } \
        { const v2u lo = tr_read_o<16 * ksl * ZS + 64>(tb), hi2 = tr_read_o<16 * ksl * ZS + 4 * ZS + 64>(tb); az[1] = __builtin_bit_cast(bf16x8, (v4u){lo.x, lo.y, hi2.x, hi2.y}); } \
        _Pragma("unroll") for (int cb = 0; cb < 2; ++cb) _Pragma("unroll") for (int ib = 0; ib < 4; ++ib) acc[cb][ib] = __builtin_amdgcn_mfma_f32_32x32x16_bf16(az[cb], src[kk][ib], acc[cb][ib], 0, 0, 0); } while (0)
#define SG_STEP(src, ks0) do { SG_ONE(src, 0, (ks0)); SG_ONE(src, 1, (ks0) + 1); } while (0)
    SG_WLOAD(bwa, 0);
    SG_WLOAD(bwb, 2); SG_STEP(bwa, 0);
    SG_WLOAD(bwa, 4); SG_STEP(bwb, 2);
    SG_WLOAD(bwb, 6); SG_STEP(bwa, 4);
    SG_STEP(bwb, 6);
#undef SG_WLOAD
#undef SG_STEP
#undef SG_ONE
    asm volatile("" ::: "memory");
    v2u uw[4][2][4]; float bias[4];
#pragma unroll
    for (int ib = 0; ib < 4; ++ib) { const int i = 32 * ib + l31; bias[ib] = kin(13)[h * 128 + i];
#pragma unroll
        for (int cb = 0; cb < 2; ++cb)
#pragma unroll
            for (int rg = 0; rg < 4; ++rg) uw[ib][cb][rg] = *(const GAS v2u*)(ub[ib] + 32 * cb + 8 * rg); }
#pragma unroll
    for (int ib = 0; ib < 4; ++ib) {
#pragma unroll
        for (int cb = 0; cb < 2; ++cb)
#pragma unroll
            for (int rg = 0; rg < 4; ++rg) { const v2u u2 = uw[ib][cb][rg];
                const float o0 = bflo(u2.x) * (acc[cb][ib][4 * rg] + bias[ib]), o1 = bfhi(u2.x) * (acc[cb][ib][4 * rg + 1] + bias[ib]), o2 = bflo(u2.y) * (acc[cb][ib][4 * rg + 2] + bias[ib]), o3 = bfhi(u2.y) * (acc[cb][ib][4 * rg + 3] + bias[ib]);
                v2u w; w.x = pk2(o0, o1); w.y = pk2(o2, o3); *(GAS v2u*)(ob[ib] + 32 * cb + 8 * rg) = w; }
    }
    lds_barrier();
}
__device__ __forceinline__ void phase_attn_sgu(const Ctx& C) {
    P0_STAMP(4);
    const int natt = (BATCH * 2 * 128 - C.bid + C.G - 1) / C.G, slot = (C.bid & 3) + 1 < natt ? (C.bid & 3) + 1 : natt;
    int ai = 0;
#pragma unroll 1
#define AT_FRESH(Cx) do { int z_ = 0; asm volatile("" : "+s"(z_)); Cx.lane = (int)__builtin_amdgcn_mbcnt_hi(~0u, __builtin_amdgcn_mbcnt_lo(~0u, (unsigned)z_)); Cx.tid = Cx.wave * 64 + Cx.lane; } while (0)
    for (; ai < slot; ++ai) { Ctx Ca = C; AT_FRESH(Ca); attn_unit(Ca, C.bid + ai * C.G); }
    for (int su = C.bid; su < M / 128; su += C.G) { Ctx Ca = C; AT_FRESH(Ca); sgu_unit(Ca, su); }
#pragma unroll 1
    for (; ai < natt; ++ai) { Ctx Ca = C; AT_FRESH(Ca); attn_unit(Ca, C.bid + ai * C.G); }
#undef AT_FRESH
    P0_STAMP(5);
    P0_STAMP(6);
}
__global__ void __launch_bounds__(NWAVES * 64, 2) mk_fwd(Args args) {
    extern __shared__ __attribute__((aligned(16))) unsigned char lds_raw[];
    Ctx C;
    C.lds = (LAS unsigned char*)lds_raw; C.ldsaddr = (unsigned)(uintptr_t)C.lds;
    C.tid = threadIdx.x; C.lane = C.tid & 63; C.wave = __builtin_amdgcn_readfirstlane(C.tid >> 6);
    C.G = gridDim.x; C.bid = blockIdx.x;
    C.out = args.out; C.ws = args.ws; C.ctl = (gu32*)(args.ws + WS_CTL);
    volatile LAS unsigned* MISC = (volatile LAS unsigned*)(C.lds + MISC_OFF);
    if (C.tid < 64) MISC[C.tid] = 0u;
    __syncthreads();
#define FRESH_IDS(Cx) do { int z_ = 0; asm volatile("" : "+s"(z_)); Cx.lane = (int)__builtin_amdgcn_mbcnt_hi(~0u, __builtin_amdgcn_mbcnt_lo(~0u, (unsigned)z_)); Cx.tid = Cx.wave * 64 + Cx.lane; } while (0)
    const int lo = args.ph_lo, hi = args.ph_hi;
    const bool one = (hi - lo) > 1;
    XcdBarrier bar; bar.bar = (unsigned*)(C.ctl + CW_BAR); bar.x = 0; bar.st = nullptr;
    if (one) bar = xcd_barrier_post((unsigned*)(C.ctl + CW_BAR), MISC + 8);
#ifndef PHMASK
#define PHMASK 0x3ffff
#endif
#define IN(k) (((PHMASK >> (k)) & 1) && lo <= (k) && (k) < hi)
#define SEAM(k) do { if (IN(k) && IN((k) + 1)) { Ctx Cb = C; FRESH_IDS(Cb); xcd_barrier(bar, Cb.tid); } } while (0)
#ifndef DUPMASK
#define DUPMASK 0
#endif
#define DUP(k) DUP_##k
#if (DUPMASK >> 0) & 1
#define DUP_0 _Pragma("unroll") for (int rep_ = 0; rep_ < 2; ++rep_)
#else
#define DUP_0
#endif
#if (DUPMASK >> 1) & 1
#define DUP_1 _Pragma("unroll") for (int rep_ = 0; rep_ < 2; ++rep_)
#else
#define DUP_1
#endif
#if (DUPMASK >> 2) & 1
#define DUP_2 _Pragma("unroll") for (int rep_ = 0; rep_ < 2; ++rep_)
#else
#define DUP_2
#endif
#if (DUPMASK >> 3) & 1
#define DUP_3 _Pragma("unroll") for (int rep_ = 0; rep_ < 2; ++rep_)
#else
#define DUP_3
#endif
#if (DUPMASK >> 4) & 1
#define DUP_4 _Pragma("unroll") for (int rep_ = 0; rep_ < 2; ++rep_)
#else
#define DUP_4
#endif
#if (DUPMASK >> 5) & 1
#define DUP_5 _Pragma("unroll") for (int rep_ = 0; rep_ < 2; ++rep_)
#else
#define DUP_5
#endif
#if (DUPMASK >> 6) & 1
#define DUP_6 _Pragma("unroll") for (int rep_ = 0; rep_ < 2; ++rep_)
#else
#define DUP_6
#endif
#if (DUPMASK >> 7) & 1
#define DUP_7 _Pragma("unroll") for (int rep_ = 0; rep_ < 2; ++rep_)
#else
#define DUP_7
#endif
#if (DUPMASK >> 8) & 1
#define DUP_8 _Pragma("unroll") for (int rep_ = 0; rep_ < 2; ++rep_)
#else
#define DUP_8
#endif
#if (DUPMASK >> 9) & 1
#define DUP_9 _Pragma("unroll") for (int rep_ = 0; rep_ < 2; ++rep_)
#else
#define DUP_9
#endif
#if (DUPMASK >> 10) & 1
#define DUP_10 _Pragma("unroll") for (int rep_ = 0; rep_ < 2; ++rep_)
#else
#define DUP_10
#endif
#if (DUPMASK >> 11) & 1
#define DUP_11 _Pragma("unroll") for (int rep_ = 0; rep_ < 2; ++rep_)
#else
#define DUP_11
#endif
#if (DUPMASK >> 12) & 1
#define DUP_12 _Pragma("unroll") for (int rep_ = 0; rep_ < 2; ++rep_)
#else
#define DUP_12
#endif
#if (DUPMASK >> 13) & 1
#define DUP_13 _Pragma("unroll") for (int rep_ = 0; rep_ < 2; ++rep_)
#else
#define DUP_13
#endif
#if (DUPMASK >> 14) & 1
#define DUP_14 _Pragma("unroll") for (int rep_ = 0; rep_ < 2; ++rep_)
#else
#define DUP_14
#endif
#if (DUPMASK >> 15) & 1
#define DUP_15 _Pragma("unroll") for (int rep_ = 0; rep_ < 2; ++rep_)
#else
#define DUP_15
#endif
#if (DUPMASK >> 16) & 1
#define DUP_16 _Pragma("unroll") for (int rep_ = 0; rep_ < 2; ++rep_)
#else
#define DUP_16
#endif
#if (DUPMASK >> 17) & 1
#define DUP_17 _Pragma("unroll") for (int rep_ = 0; rep_ < 2; ++rep_)
#else
#define DUP_17
#endif
    bf16* const H = (bf16*)(C.ws + WS_H); bf16* const RA = (bf16*)(C.ws + WS_A); bf16* const RB = (bf16*)(C.ws + WS_B);
    const float* const MOD = (const float*)(C.ws + WS_MOD);

#if defined(TPROBE)
    unsigned long long tp_t = 0ull, tp_acc = 0ull; const bool tp_on = (C.bid == 0 && C.wave == 0);
    constexpr int TW[18] = {TPROBE};
#define TSTART() do { if (tp_on) tp_t = __builtin_amdgcn_s_memrealtime(); } while (0)
#define TEND(k) do { if (tp_on) { const unsigned long long n_ = __builtin_amdgcn_s_memrealtime(); tp_acc += (unsigned long long)TW[k] * (n_ - tp_t); tp_t = n_; } } while (0)
#else
#define TSTART() do { } while (0)
#define TEND(k) do { } while (0)
#endif
    TSTART();
    DUP(0) { if (IN(0)) { Ctx Cp = C; FRESH_IDS(Cp); p0_prologue(Cp); } SEAM(0); TEND(0); }
    DUP(1) { if (IN(1)) { Ctx Cp = C; FRESH_IDS(Cp); phase_norm1_l0(Cp); } SEAM(1); TEND(1); }
    DUP(2) { if (IN(2)) { Ctx Cp = C; FRESH_IDS(Cp);
        pg8::Gemm g{H, (const bf16*)(Cp.ws + WS_WINE), M, NINE, D / 2}; pg8::InEOrder S; S.so.init(M, NINE, Cp.G, Cp.bid); S.G = Cp.G; S.c = Cp.bid;
        pg8::EpiInE8 E{RA, (bf16*)(Cp.ws + WS_VT), (bf16*)(Cp.ws + WS_KC), (bf16*)(Cp.ws + WS_VCT), (const float*)(Cp.ws + WS_ROPE), (const float*)(Cp.ws + WS_ROPE) + 2048, QSCALE, (const float*)(Cp.ws + WS_RSC), (const float*)(Cp.ws + WS_CSC2) + 4096};
        pg8::gemm_phase<pg8::EpiInE8, pg8::InEOrder, true, true>(Cp.lds, g, S, E, Cp.tid);
        { const int nmax = (900 + Cp.G - 1) / Cp.G, nfull = 900 - (nmax - 1) * Cp.G;
            if (nmax > 1 && Cp.bid >= nfull) wd1_items(Cp, Cp.bid - nfull, Cp.G - nfull);
            else if (nmax == 1 || nfull >= Cp.G) wd1_items(Cp, Cp.bid, Cp.G); }
    } SEAM(2); TEND(2); }
    DUP(3) { if (IN(3)) { Ctx Cp = C; FRESH_IDS(Cp); phase_attn_sgu(Cp); } SEAM(3); TEND(3); }
    DUP(4) { if (IN(4)) { Ctx Cp = C; FRESH_IDS(Cp);
        pg8::Gemm g{RB, (const bf16*)(Cp.ws + WS_WOUTE), M, D, D}; pg8::StaticOrder S; S.init(M, D, Cp.G, Cp.bid);
        pg8::EpiRes E{kin(0), (bf16*)(Cp.ws + WS_LAT), MOD + 2 * 1024, (float*)(Cp.ws + WS_RSS)};
        pg8::gemm_phase<pg8::EpiRes, pg8::StaticOrder, true, true>(Cp.lds, g, S, E, Cp.tid);
    } SEAM(4); TEND(4); }
    DUP(5) { if (IN(5)) { Ctx Cp = C; FRESH_IDS(Cp); phase_router(Cp, 0); } SEAM(5); TEND(5); }
    TEND(6);
    DUP(7) { if (IN(7)) { Ctx Cp = C; FRESH_IDS(Cp);
        const int nt = moe_tables(Cp, 0);
        pg8::Gemm g{H, (const bf16*)(Cp.ws + WS_WGU), nt * 256, NEXP * 1024, D / 2}; pg8::MoeGatherOrder S{(const LAS int*)(Cp.lds + MOE_TAB_OFF), nt, Cp.G, Cp.bid, (const LAS unsigned*)(Cp.lds + MOE_GTAB_OFF)};
        moe_gather_tables(Cp, S);
        pg8::EpiSwiGLU8 E{(unsigned char*)RB, (const LAS float*)(Cp.lds + MOE_RTAB_OFF), (const float*)(Cp.ws + WS_CSC)};
        pg8::gemm_phase<pg8::EpiSwiGLU8, pg8::MoeGatherOrder, true, true>(Cp.lds, g, S, E, Cp.tid);
        quant_strips_q(Cp, Cp.ctl + CW_Q0, 704, 1024, 128, 2048);
    } SEAM(7); TEND(7); }
    DUP(8) { if (IN(8)) { Ctx Cp = C; FRESH_IDS(Cp);
        const int nt = moe_tables(Cp, 0);
        pg8::Gemm g{RB, (const bf16*)(Cp.ws + WS_WD), nt * 256, NEXP * 1024, EH / 2}; pg8::MoeOrder S{(const LAS int*)(Cp.lds + MOE_TAB_OFF), nt, Cp.G, Cp.bid, nullptr};
        pg8::EpiDown E{(unsigned char*)RA, (const float*)(Cp.ws + WS_CSD)};
        pg8::gemm_phase<pg8::EpiDown, pg8::MoeOrder, true, true>(Cp.lds, g, S, E, Cp.tid);
        quant_strips_q(Cp, Cp.ctl + CW_Q1, 320, 1728, 0, 0);
    } SEAM(8); TEND(8); }
    DUP(9) { if (IN(9)) { Ctx Cp = C; FRESH_IDS(Cp); phase_combine<false>(Cp, 0); } SEAM(9); TEND(9); }
    DUP(10) { if (IN(10)) { Ctx Cp = C; FRESH_IDS(Cp);
        pg8::Gemm g{H, (const bf16*)(Cp.ws + WS_WINO), M, 3072, D / 2}; pg8::StaticOrder S; S.init(M, 3072, Cp.G, Cp.bid);
        pg8::EpiInO8 E{RA, RA + (size_t)M * D, (const float*)(Cp.ws + WS_RSC), (const float*)(Cp.ws + WS_CSC2)};
        pg8::gemm_phase<pg8::EpiInO8, pg8::StaticOrder, true, true>(Cp.lds, g, S, E, Cp.tid);
    } SEAM(10); TEND(10); }
    DUP(11) { if (IN(11)) { Ctx Cp = C; FRESH_IDS(Cp); phase_conv(Cp); } SEAM(11); TEND(11); }
    DUP(12) { if (IN(12)) { Ctx Cp = C; FRESH_IDS(Cp);
        pg8::Gemm g{RB, (const bf16*)(Cp.ws + WS_WOUTO), M, D, D / 2}; pg8::StaticOrder S; S.init(M, D, Cp.G, Cp.bid);
        pg8::EpiRes8 E{(bf16*)(Cp.ws + WS_LAT), MOD + (size_t)4 * 6144 + 2 * 1024, (float*)(Cp.ws + WS_RSS), (const float*)(Cp.ws + WS_RSC), (const float*)(Cp.ws + WS_CSC2) + 3072};
        pg8::gemm_phase<pg8::EpiRes8, pg8::StaticOrder, true, true>(Cp.lds, g, S, E, Cp.tid);
    } SEAM(12); TEND(12); }
    DUP(13) { if (IN(13)) { Ctx Cp = C; FRESH_IDS(Cp); phase_router(Cp, 1); } SEAM(13); TEND(13); }
    TEND(14);
    DUP(15) { if (IN(15)) { Ctx Cp = C; FRESH_IDS(Cp);
        const int nt = moe_tables(Cp, 1);
        pg8::Gemm g{H, (const bf16*)(Cp.ws + WS_WGU + (size_t)NEXP * 1024 * 1024), nt * 256, NEXP * 1024, D / 2}; pg8::MoeGatherOrder S{(const LAS int*)(Cp.lds + MOE_TAB_OFF), nt, Cp.G, Cp.bid, (const LAS unsigned*)(Cp.lds + MOE_GTAB_OFF)};
        moe_gather_tables(Cp, S);
        pg8::EpiSwiGLU8 E{(unsigned char*)RB, (const LAS float*)(Cp.lds + MOE_RTAB_OFF), (const float*)(Cp.ws + WS_CSC) + (size_t)NEXP * 1024};
        pg8::gemm_phase<pg8::EpiSwiGLU8, pg8::MoeGatherOrder, true, true>(Cp.lds, g, S, E, Cp.tid);
    } SEAM(15); TEND(15); }
    DUP(16) { if (IN(16)) { Ctx Cp = C; FRESH_IDS(Cp);
        const int nt = moe_tables(Cp, 1);
        pg8::Gemm g{RB, (const bf16*)(Cp.ws + WS_WD + (size_t)NEXP * 1024 * 512), nt * 256, NEXP * 1024, EH / 2}; pg8::MoeOrder S{(const LAS int*)(Cp.lds + MOE_TAB_OFF), nt, Cp.G, Cp.bid, nullptr};
        pg8::EpiDown E{(unsigned char*)RA, (const float*)(Cp.ws + WS_CSD) + (size_t)NEXP * 1024};
        pg8::gemm_phase<pg8::EpiDown, pg8::MoeOrder, true, true>(Cp.lds, g, S, E, Cp.tid);
    } SEAM(16); TEND(16); }
    DUP(17) { if (IN(17)) { Ctx Cp = C; FRESH_IDS(Cp); phase_combine<true>(Cp, 1); } TEND(17); }
#if defined(TPROBE_P0)
    if (tp_on) { constexpr int PW[5] = {TPROBE_P0}; volatile LAS unsigned long long* st_ = (volatile LAS unsigned long long*)(C.lds + MISC_OFF + 128);
        for (int i = 0; i < 3; ++i) tp_acc += (unsigned long long)PW[i] * (st_[i + 1] - st_[i]);
        tp_acc += (unsigned long long)PW[3] * (st_[5] - st_[4]) + (unsigned long long)PW[4] * (st_[6] - st_[5]);
#if defined(TPROBE_P0MAX)
        tp_acc += 4ull * (unsigned long long)__hip_atomic_load(C.ctl + TPROBE_P0MAX, RLX_AGENT);
#endif
    }
#endif
#if defined(TPROBE)
    if (tp_on) { const unsigned long long t0_ = __builtin_amdgcn_s_memrealtime(); while (__builtin_amdgcn_s_memrealtime() - t0_ < tp_acc) __builtin_amdgcn_s_sleep(8); }
#endif
#undef IN
#undef SEAM
}

extern "C" void kernel_launch(void* const* d_in, const int* in_sizes, int n_in, void* d_out, int out_size, void* d_ws, size_t ws_size, hipStream_t stream) {
    static int grid = 0;
    if (grid == 0) {
        if (n_in != 25 || in_sizes[0] != M * D || out_size != M * D || ws_size < WS_END) { fprintf(stderr, "kernel_launch: unexpected shapes (n_in %d, in0 %d, out %d, ws %zu)\n", n_in, n_in > 0 ? in_sizes[0] : -1, out_size, ws_size); grid = -1; return; }
        int dev = 0, cus = 0, per_cu = 0;
        if (hipGetDevice(&dev) != hipSuccess || hipDeviceGetAttribute(&cus, hipDeviceAttributeMultiprocessorCount, dev) != hipSuccess) { grid = -1; return; }
        if (hipFuncSetAttribute((const void*)mk_fwd, hipFuncAttributeMaxDynamicSharedMemorySize, LDS_BYTES) != hipSuccess) { fprintf(stderr, "kernel_launch: hipFuncSetAttribute failed\n"); grid = -1; return; }
        if (hipOccupancyMaxActiveBlocksPerMultiprocessor(&per_cu, (const void*)mk_fwd, NWAVES * 64, LDS_BYTES) != hipSuccess || per_cu < 1) { fprintf(stderr, "kernel_launch: occupancy query says %d\n", per_cu); }
        (void)hipGetLastError();
        grid = cus;
    }
    if (grid < 0) return;
    if (hipMemsetAsync((char*)d_ws + WS_CTL, 0, CTL_ZERO_BYTES, stream) != hipSuccess) return;
    Args a{};
    for (int i = 0; i < 25; ++i) a.in[i] = (const float*)d_in[i];
    a.out = (float*)d_out; a.ws = (unsigned char*)d_ws;
#if defined(PROBE_K)
    a.ph_lo = 0; a.ph_hi = PROBE_K + 1; hipLaunchKernelGGL(mk_fwd, dim3(grid), dim3(NWAVES * 64), LDS_BYTES, stream, a);
    (void)hipMemsetAsync((char*)d_ws + WS_CTL, 0, (PROBE_K == 5 || PROBE_K == 13) ? CTL_ZERO_BYTES : (size_t)4 * CW_GCNT, stream);
    a.ph_lo = PROBE_K; a.ph_hi = PROBE_K + 1; hipLaunchKernelGGL(mk_fwd, dim3(grid), dim3(NWAVES * 64), LDS_BYTES, stream, a);
    (void)hipMemsetAsync((char*)d_ws + WS_CTL, 0, 4 * CW_GCNT, stream);
    if (PROBE_K + 1 < N_PHASES) { a.ph_lo = PROBE_K + 1; a.ph_hi = N_PHASES; hipLaunchKernelGGL(mk_fwd, dim3(grid), dim3(NWAVES * 64), LDS_BYTES, stream, a); }
#elif MK_ONE_LAUNCH
    a.ph_lo = 0; a.ph_hi = N_PHASES;
    hipLaunchKernelGGL(mk_fwd, dim3(grid), dim3(NWAVES * 64), LDS_BYTES, stream, a);
#else
    for (int p = 0; p < N_PHASES; ++p) { a.ph_lo = p; a.ph_hi = p + 1; hipLaunchKernelGGL(mk_fwd, dim3(grid), dim3(NWAVES * 64), LDS_BYTES, stream, a); }
#endif
}
```

```cpp
#include <hip/hip_runtime.h>
#include <cstdio>
#include <cstdint>
namespace pg8 {
#define PG8_LAS __attribute__((address_space(3)))
typedef unsigned short bf16_t;
typedef short bf16x8 __attribute__((ext_vector_type(8)));
typedef float f32x4 __attribute__((ext_vector_type(4)));
typedef unsigned u32x4 __attribute__((ext_vector_type(4)));
constexpr int BM = 256, BK = 64, HALF = 128, HTB = HALF * BK * 2  , STAGE_BYTES = 8 * HTB, NXCD = 8, WGM = 8;

__host__ __device__ __forceinline__ int lds_byte(int r, int c) { const int st = (r >> 4) * 2 + (c >> 5), rr = r & 15, cc = c & 31, ob = rr * 64 + cc * 2; return st * 1024 + (ob ^ (((ob >> 9) & 1) << 5)); }
__host__ __device__ __forceinline__ void stage_rc(int b, int& R, int& C) { const int st = b / 1024, sb = b % 1024, swz = sb ^ (((sb >> 9) & 1) << 5); R = (st >> 1) * 16 + swz / 64; C = (st & 1) * 32 + (swz % 64) / 2; }
__host__ __device__ __forceinline__ int perm32(int rho) { const int n = rho >> 4, i = rho & 15; return 8 * (i >> 2) + 4 * n + (i & 3); }

struct Unit { int pm, pn, li; };
struct Gemm { const bf16_t* A; const bf16_t* Bt; int M, N, K; };

struct StaticOrder {
    static constexpr bool GATHER = false;
    int nM, nN, nwg, G, c;
    __host__ __device__ void init(int M, int N, int G_, int c_) { nM = M / BM; nN = N / BM; nwg = nM * nN; G = G_; c = c_; }
    __host__ __device__ bool next(int i, Unit& u) const {
        const long L = (long)i * G + c; if (L >= nwg) return false;
        int wgid = (int)L; { const int q = nwg / NXCD, r = nwg % NXCD, xcd = wgid % NXCD, off = wgid / NXCD; wgid = (xcd < r ? xcd * (q + 1) : r * (q + 1) + (xcd - r) * q) + off; }
        const int nig = WGM * nN, gid = wgid / nig, fm = gid * WGM, gsz = (nM - fm) < WGM ? (nM - fm) : WGM;
        u.pm = fm + ((wgid % nig) % gsz); u.pn = (wgid % nig) / gsz; return true;
    }
    __device__ __forceinline__ unsigned goff(const Unit&, int) const { return 0u; }
    __device__ __forceinline__ void a_ready(const Unit&) const {}
    __device__ __forceinline__ void done(const Unit&) const {}
};

__device__ __forceinline__ unsigned cvt_pk_bf16(float lo, float hi) { unsigned r; asm volatile("v_cvt_pk_bf16_f32 %0, %1, %2" : "=v"(r) : "v"(lo), "v"(hi)); return r; }
typedef float f32x2 __attribute__((ext_vector_type(2)));
__device__ __forceinline__ f32x2 gelu_pk(f32x2 v) {
    const f32x2 av = __builtin_elementwise_abs(v), d = av * 0.2316418882f + 1.0f;
    f32x2 t; t.x = __builtin_amdgcn_rcpf(d.x); t.y = __builtin_amdgcn_rcpf(d.y);
    f32x2 q = t * 0.5307027145f + (-0.7265760135f); q = q * t + 0.7107068705f; q = q * t + (-0.142248368f); q = q * t + 0.127414796f; q = q * t;
    const f32x2 s = (v * v) * (-0.72134752044f);
    f32x2 e; e.x = __builtin_amdgcn_exp2f(s.x); e.y = __builtin_amdgcn_exp2f(s.y);
    const f32x2 m = v * (q * e), r = v - m;
    f32x2 o; o.x = v.x < 0.f ? m.x : r.x; o.y = v.y < 0.f ? m.y : r.y; return o;
}

typedef int i32x4 __attribute__((ext_vector_type(4)));
typedef long i64x2 __attribute__((ext_vector_type(2)));
template <bool I8> struct AccSel { typedef f32x4 t; };
template <> struct AccSel<true> { typedef i32x4 t; };
template <int MODE> __device__ __forceinline__ f32x4 mma16(bf16x8 a, bf16x8 b, f32x4 c) {
    if constexpr (MODE == 2) { const i64x2 a2 = __builtin_bit_cast(i64x2, a), b2 = __builtin_bit_cast(i64x2, b);
        c = __builtin_amdgcn_mfma_f32_16x16x32_fp8_fp8(a2[0], b2[0], c, 0, 0, 0); return __builtin_amdgcn_mfma_f32_16x16x32_fp8_fp8(a2[1], b2[1], c, 0, 0, 0); }
    else return __builtin_amdgcn_mfma_f32_16x16x32_bf16(a, b, c, 0, 0, 0);
}
template <int MODE> __device__ __forceinline__ i32x4 mma16(bf16x8 a, bf16x8 b, i32x4 c) { return __builtin_amdgcn_mfma_i32_16x16x64_i8(__builtin_bit_cast(i32x4, a), __builtin_bit_cast(i32x4, b), c, 0, 0, 0); }
typedef unsigned u32x2 __attribute__((ext_vector_type(2)));
constexpr int M_ROWS = 32768;
__device__ __forceinline__ int perm16(int x) { return (x & 3) | ((x & 4) << 1) | ((x & 8) >> 1); }
__device__ __forceinline__ bf16_t bf1(float v) { return (bf16_t)(cvt_pk_bf16(v, 0.f) & 0xffffu); }
__device__ __forceinline__ u32x2 pk4(f32x4 v) { u32x2 w; w.x = cvt_pk_bf16(v[0], v[1]); w.y = cvt_pk_bf16(v[2], v[3]); return w; }
__device__ __forceinline__ f32x4 gelu4(f32x4 v) { const f32x2 a = gelu_pk((f32x2){v[0], v[1]}), b = gelu_pk((f32x2){v[2], v[3]}); return (f32x4){a.x, a.y, b.x, b.y}; }
__device__ __forceinline__ float silu1(float g) { return g * __builtin_amdgcn_rcpf(1.0f + __builtin_amdgcn_exp2f(-1.4426950408889634f * g)); }

struct EpiInE {
    static constexpr bool PERM = false, AFTER_DRAIN = false, MODE = 0;
    bf16_t* QK; bf16_t* VT; bf16_t* KC; bf16_t* VCT; const float* rc; const float* rs; float qscale;
    __device__ __forceinline__ void operator()(const f32x4 (&acc)[2][2][4][2], const Unit& u, int wr, int wc, int fr, int fq) const {
        const int row0 = u.pm * BM + wr * 64 + fr;
        if (u.pm >= 128) {
#pragma unroll
            for (int ai = 0; ai < 2; ++ai)
#pragma unroll
                for (int m = 0; m < 4; ++m) {
                    const int row = row0 + ai * HALF + m * 16 - 32768, b = row >> 8, j = row & 255, jp = (j & ~15) | perm16(j & 15);
#pragma unroll
                    for (int n = 0; n < 2; ++n) {
                        *(u32x2*)(KC + (size_t)row * 128 + wc * 32 + n * 16 + 4 * fq) = pk4(acc[ai][0][m][n]);
#pragma unroll
                        for (int i = 0; i < 4; ++i) { const int cv = wc * 32 + n * 16 + 4 * fq + i; VCT[((size_t)(b * 2 + (cv >> 6)) * 64 + (cv & 63)) * 256 + jp] = bf1(acc[ai][1][m][n][i]); }
                    }
                }
            return;
        }
        if (u.pn <= 2) {
            const float sc = (u.pn < 2) ? qscale : 1.0f;
#pragma unroll
            for (int ai = 0; ai < 2; ++ai)
#pragma unroll
                for (int m = 0; m < 4; ++m) {
                    const int row = row0 + ai * HALF + m * 16, pos = row & 8191, pidx = (wc & 1) ? (pos & 63) : (pos >> 6);
                    const f32x4 c4 = *(const f32x4*)(rc + pidx * 16 + 4 * fq) * sc, s4 = *(const f32x4*)(rs + pidx * 16 + 4 * fq) * sc;
                    bf16_t* rowp = QK + (size_t)row * 1792 + u.pn * BM + wc * 32 + 4 * fq;
#pragma unroll
                    for (int bj = 0; bj < 2; ++bj) {
                        if (u.pn == 2 && bj == 1) break;
                        const f32x4 v0 = acc[ai][bj][m][0], v1 = acc[ai][bj][m][1];
                        *(u32x2*)(rowp + bj * HALF) = pk4(v0 * c4 - v1 * s4);
                        *(u32x2*)(rowp + bj * HALF + 16) = pk4(v1 * c4 + v0 * s4);
                    }
                    if (u.pn == 2) {
                        const int b = row >> 13, pp = (pos & ~15) | perm16(pos & 15);
#pragma unroll
                        for (int n = 0; n < 2; ++n)
#pragma unroll
                            for (int i = 0; i < 4; ++i) { const int cv = wc * 32 + n * 16 + 4 * fq + i; VT[((size_t)(b * 2 + (cv >> 6)) * 64 + (cv & 63)) * 8192 + pp] = bf1(acc[ai][1][m][n][i]); }
                    }
                }
            return;
        }
#pragma unroll
        for (int ai = 0; ai < 2; ++ai)
#pragma unroll
            for (int m = 0; m < 4; ++m) {
                bf16_t* rowp = QK + (size_t)(row0 + ai * HALF + m * 16) * 1792 + u.pn * BM + wc * 32 + 4 * fq;
#pragma unroll
                for (int bj = 0; bj < 2; ++bj)
#pragma unroll
                    for (int n = 0; n < 2; ++n) *(u32x2*)(rowp + bj * HALF + n * 16) = pk4(gelu4(acc[ai][bj][m][n]));
            }
    }
};
struct EpiInE8 {
    static constexpr bool PERM = false, AFTER_DRAIN = false, MODE = 1;
    bf16_t* QK; bf16_t* VT; bf16_t* KC; bf16_t* VCT; const float* rc; const float* rs; float qscale; const float* RSC; const float* CSC;
    __device__ __forceinline__ void operator()(const i32x4 (&acci)[2][2][4][2], const Unit& u, int wr, int wc, int fr, int fq) const {
        asm volatile("" ::: "memory");
        const int row0 = u.pm * BM + wr * 64 + fr;
        f32x4 acc[2][2][4][2];
        { f32x4 cs[2][2];
#pragma unroll
            for (int bj = 0; bj < 2; ++bj)
#pragma unroll
                for (int n = 0; n < 2; ++n) cs[bj][n] = *(const f32x4*)(CSC + u.pn * BM + bj * HALF + wc * 32 + n * 16 + 4 * fq);
#pragma unroll
            for (int ai = 0; ai < 2; ++ai)
#pragma unroll
                for (int m = 0; m < 4; ++m) { const float rsv = RSC[row0 + ai * HALF + m * 16];
#pragma unroll
                    for (int bj = 0; bj < 2; ++bj)
#pragma unroll
                        for (int n = 0; n < 2; ++n) acc[ai][bj][m][n] = __builtin_convertvector(acci[ai][bj][m][n], f32x4) * cs[bj][n] * rsv; } }
        if (u.pm >= 128) {
#pragma unroll
            for (int ai = 0; ai < 2; ++ai)
#pragma unroll
                for (int m = 0; m < 4; ++m) {
                    const int row = row0 + ai * HALF + m * 16 - 32768, b = row >> 8, j = row & 255, jp = (j & ~15) | perm16(j & 15);
#pragma unroll
                    for (int n = 0; n < 2; ++n) {
                        *(u32x2*)(KC + (size_t)row * 128 + wc * 32 + n * 16 + 4 * fq) = pk4(acc[ai][0][m][n]);
#pragma unroll
                        for (int i = 0; i < 4; ++i) { const int cv = wc * 32 + n * 16 + 4 * fq + i; VCT[((size_t)(b * 2 + (cv >> 6)) * 64 + (cv & 63)) * 256 + jp] = bf1(acc[ai][1][m][n][i]); }
                    }
                }
            return;
        }
        if (u.pn <= 2) {
            const float sc = (u.pn < 2) ? qscale : 1.0f;
#pragma unroll
            for (int ai = 0; ai < 2; ++ai)
#pragma unroll
                for (int m = 0; m < 4; ++m) {
                    const int row = row0 + ai * HALF + m * 16, pos = row & 8191, pidx = (wc & 1) ? (pos & 63) : (pos >> 6);
                    const f32x4 c4 = *(const f32x4*)(rc + pidx * 16 + 4 * fq) * sc, s4 = *(const f32x4*)(rs + pidx * 16 + 4 * fq) * sc;
                    bf16_t* rowp = QK + (size_t)row * 1792 + u.pn * BM + wc * 32 + 4 * fq;
#pragma unroll
                    for (int bj = 0; bj < 2; ++bj) {
                        if (u.pn == 2 && bj == 1) break;
                        const f32x4 v0 = acc[ai][bj][m][0], v1 = acc[ai][bj][m][1];
                        *(u32x2*)(rowp + bj * HALF) = pk4(v0 * c4 - v1 * s4);
                        *(u32x2*)(rowp + bj * HALF + 16) = pk4(v1 * c4 + v0 * s4);
                    }
                    if (u.pn == 2) {
                        const int b = row >> 13, pp = (pos & ~15) | perm16(pos & 15);
#pragma unroll
                        for (int n = 0; n < 2; ++n)
#pragma unroll
                            for (int i = 0; i < 4; ++i) { const int cv = wc * 32 + n * 16 + 4 * fq + i; VT[((size_t)(b * 2 + (cv >> 6)) * 64 + (cv & 63)) * 8192 + pp] = bf1(acc[ai][1][m][n][i]); }
                    }
                }
            return;
        }
#pragma unroll
        for (int ai = 0; ai < 2; ++ai)
#pragma unroll
            for (int m = 0; m < 4; ++m) {
                bf16_t* rowp = QK + (size_t)(row0 + ai * HALF + m * 16) * 1792 + u.pn * BM + wc * 32 + 4 * fq;
#pragma unroll
                for (int bj = 0; bj < 2; ++bj)
#pragma unroll
                    for (int n = 0; n < 2; ++n) *(u32x2*)(rowp + bj * HALF + n * 16) = pk4(gelu4(acc[ai][bj][m][n]));
            }
    }
};
struct EpiRes {
    static constexpr bool PERM = false, AFTER_DRAIN = false, MODE = 0;
    const float* base; bf16_t* out; const float* gate; float* RSS;
    __device__ __forceinline__ void operator()(const f32x4 (&acc)[2][2][4][2], const Unit& u, int wr, int wc, int fr, int fq) const {
        const int row0 = u.pm * BM + wr * 64 + fr, col0 = u.pn * BM + wc * 32 + 4 * fq, b = u.pm >> 5;
        f32x4 gv[2][2];
#pragma unroll
        for (int bj = 0; bj < 2; ++bj)
#pragma unroll
            for (int n = 0; n < 2; ++n) gv[bj][n] = *(const f32x4*)(gate + (size_t)b * 6144 + col0 + bj * HALF + n * 16);
#pragma unroll
        for (int ai = 0; ai < 2; ++ai) {
            f32x4 bs[4][2][2];
#pragma unroll
            for (int m = 0; m < 4; ++m)
#pragma unroll
                for (int bj = 0; bj < 2; ++bj)
#pragma unroll
                    for (int n = 0; n < 2; ++n) bs[m][bj][n] = *(const f32x4*)(base + (size_t)(row0 + ai * HALF + m * 16) * 1024 + col0 + bj * HALF + n * 16);
#pragma unroll
            for (int m = 0; m < 4; ++m) { const int row = row0 + ai * HALF + m * 16; float ss = 0.f, am = 0.f;
#pragma unroll
                for (int bj = 0; bj < 2; ++bj)
#pragma unroll
                    for (int n = 0; n < 2; ++n) { const f32x4 o = bs[m][bj][n] + gv[bj][n] * acc[ai][bj][m][n]; const u32x2 w = pk4(o); *(u32x2*)(out + (size_t)row * 1024 + col0 + bj * HALF + n * 16) = w;
                        const float r0 = __builtin_bit_cast(float, w.x << 16), r1 = __builtin_bit_cast(float, w.x & 0xffff0000u), r2 = __builtin_bit_cast(float, w.y << 16), r3 = __builtin_bit_cast(float, w.y & 0xffff0000u);
                        ss += (r0 * r0 + r1 * r1) + (r2 * r2 + r3 * r3); am = fmaxf(fmaxf(am, fmaxf(fabsf(r0), fabsf(r1))), fmaxf(fabsf(r2), fabsf(r3))); }
                ss += __shfl_xor(ss, 16); ss += __shfl_xor(ss, 32); am = fmaxf(am, __shfl_xor(am, 16)); am = fmaxf(am, __shfl_xor(am, 32));
                if (fq == 0) { RSS[(size_t)row * 16 + u.pn * 4 + wc] = ss; RSS[(size_t)M_ROWS * 16 + (size_t)row * 16 + u.pn * 4 + wc] = am; } }
        }
    }
};
struct EpiSwiGLU {
    static constexpr bool PERM = true, AFTER_DRAIN = false, MODE = 0;
    bf16_t* HID;
    __device__ __forceinline__ void operator()(const f32x4 (&acc)[2][2][4][2], const Unit& u, int wr, int wc, int fr, int fq) const {
        const int row0 = u.pm * BM + wr * 64 + fr, col0 = (u.pn & 3) * HALF + wc * 32 + 8 * fq;
#pragma unroll
        for (int ai = 0; ai < 2; ++ai)
#pragma unroll
            for (int m = 0; m < 4; ++m) {
                const f32x4 g0 = acc[ai][0][m][0], g1 = acc[ai][0][m][1], u0 = acc[ai][1][m][0], u1 = acc[ai][1][m][1];
                u32x4 w;
                w.x = cvt_pk_bf16(silu1(g0[0]) * u0[0], silu1(g0[1]) * u0[1]); w.y = cvt_pk_bf16(silu1(g0[2]) * u0[2], silu1(g0[3]) * u0[3]);
                w.z = cvt_pk_bf16(silu1(g1[0]) * u1[0], silu1(g1[1]) * u1[1]); w.w = cvt_pk_bf16(silu1(g1[2]) * u1[2], silu1(g1[3]) * u1[3]);
                *(u32x4*)(HID + (size_t)(row0 + ai * HALF + m * 16) * 512 + col0) = w;
            }
    }
};
struct EpiSwiGLU8 {
    static constexpr bool PERM = true, AFTER_DRAIN = false, MODE = 1;
    unsigned char* HID; const PG8_LAS float* rtab; const float* CSC;
    __device__ __forceinline__ void operator()(const i32x4 (&acc)[2][2][4][2], const Unit& u, int wr, int wc, int fr, int fq) const {
        const int row0 = u.pm * BM + wr * 64 + fr, ct = u.pn & 3, col0 = ct * HALF + wc * 32 + 8 * fq;
        const float* cs = CSC + (size_t)(u.pn >> 2) * 1024 + ct * BM + wc * 32 + 8 * fq;
        const f32x4 cg0 = *(const f32x4*)(cs), cg1 = *(const f32x4*)(cs + 4), cu0 = *(const f32x4*)(cs + HALF), cu1 = *(const f32x4*)(cs + HALF + 4);
#pragma unroll
        for (int ai = 0; ai < 2; ++ai)
#pragma unroll
            for (int m = 0; m < 4; ++m) { const int row = row0 + ai * HALF + m * 16; const float rs = rtab[u.li * 256 + (row - u.pm * BM)];
                const f32x4 g0 = __builtin_convertvector(acc[ai][0][m][0], f32x4) * cg0 * rs, g1 = __builtin_convertvector(acc[ai][0][m][1], f32x4) * cg1 * rs;
                const f32x4 u0 = __builtin_convertvector(acc[ai][1][m][0], f32x4) * cu0 * rs, u1 = __builtin_convertvector(acc[ai][1][m][1], f32x4) * cu1 * rs;
                int w0 = __builtin_amdgcn_cvt_pk_fp8_f32(silu1(g0[0]) * u0[0], silu1(g0[1]) * u0[1], 0, false); w0 = __builtin_amdgcn_cvt_pk_fp8_f32(silu1(g0[2]) * u0[2], silu1(g0[3]) * u0[3], w0, true);
                int w1 = __builtin_amdgcn_cvt_pk_fp8_f32(silu1(g1[0]) * u1[0], silu1(g1[1]) * u1[1], 0, false); w1 = __builtin_amdgcn_cvt_pk_fp8_f32(silu1(g1[2]) * u1[2], silu1(g1[3]) * u1[3], w1, true);
                *(u32x2*)(HID + (size_t)row * 512 + col0) = (u32x2){(unsigned)w0, (unsigned)w1};
            }
    }
};
struct EpiDown {
    static constexpr bool PERM = true, AFTER_DRAIN = false; static constexpr int MODE = 2;
    unsigned char* Y; const float* CSD;
    __device__ __forceinline__ void operator()(const f32x4 (&acc)[2][2][4][2], const Unit& u, int wr, int wc, int fr, int fq) const {
        const int row0 = u.pm * BM + wr * 64 + fr, col0 = (u.pn & 3) * BM + wc * 32 + 8 * fq;
        f32x4 cs[2][2];
#pragma unroll
        for (int bj = 0; bj < 2; ++bj) { cs[bj][0] = *(const f32x4*)(CSD + (size_t)(u.pn >> 2) * 1024 + col0 + bj * HALF); cs[bj][1] = *(const f32x4*)(CSD + (size_t)(u.pn >> 2) * 1024 + col0 + bj * HALF + 4); }
#pragma unroll
        for (int ai = 0; ai < 2; ++ai)
#pragma unroll
            for (int m = 0; m < 4; ++m) { unsigned char* rowp = Y + (size_t)(row0 + ai * HALF + m * 16) * 1024 + col0;
#pragma unroll
                for (int bj = 0; bj < 2; ++bj) { const f32x4 v0 = acc[ai][bj][m][0] * cs[bj][0], v1 = acc[ai][bj][m][1] * cs[bj][1];
                    int w0 = __builtin_amdgcn_cvt_pk_fp8_f32(v0[0], v0[1], 0, false); w0 = __builtin_amdgcn_cvt_pk_fp8_f32(v0[2], v0[3], w0, true);
                    int w1 = __builtin_amdgcn_cvt_pk_fp8_f32(v1[0], v1[1], 0, false); w1 = __builtin_amdgcn_cvt_pk_fp8_f32(v1[2], v1[3], w1, true);
                    *(u32x2*)(rowp + bj * HALF) = (u32x2){(unsigned)w0, (unsigned)w1}; } }
    }
};
struct EpiInO {
    static constexpr bool PERM = true, AFTER_DRAIN = false, MODE = 0;
    bf16_t* BG; bf16_t* Y;
    __device__ __forceinline__ void operator()(const f32x4 (&acc)[2][2][4][2], const Unit& u, int wr, int wc, int fr, int fq) const {
        const int row0 = u.pm * BM + wr * 64 + fr;
        if (u.pn < 8) {
            const int col0 = u.pn * HALF + wc * 32 + 8 * fq;
#pragma unroll
            for (int ai = 0; ai < 2; ++ai)
#pragma unroll
                for (int m = 0; m < 4; ++m) { const f32x4 v0 = acc[ai][0][m][0] * acc[ai][1][m][0], v1 = acc[ai][0][m][1] * acc[ai][1][m][1];
                    u32x4 w; w.x = cvt_pk_bf16(v0[0], v0[1]); w.y = cvt_pk_bf16(v0[2], v0[3]); w.z = cvt_pk_bf16(v1[0], v1[1]); w.w = cvt_pk_bf16(v1[2], v1[3]);
                    *(u32x4*)(Y + (size_t)(row0 + ai * HALF + m * 16) * 1024 + col0) = w; }
        } else {
            const int col0 = (u.pn - 8) * BM + wc * 32 + 8 * fq;
#pragma unroll
            for (int ai = 0; ai < 2; ++ai)
#pragma unroll
                for (int m = 0; m < 4; ++m) { bf16_t* rowp = BG + (size_t)(row0 + ai * HALF + m * 16) * 1024 + col0;
#pragma unroll
                    for (int bj = 0; bj < 2; ++bj) { const f32x4 v0 = acc[ai][bj][m][0], v1 = acc[ai][bj][m][1];
                        u32x4 w; w.x = cvt_pk_bf16(v0[0], v0[1]); w.y = cvt_pk_bf16(v0[2], v0[3]); w.z = cvt_pk_bf16(v1[0], v1[1]); w.w = cvt_pk_bf16(v1[2], v1[3]);
                        *(u32x4*)(rowp + bj * HALF) = w; } }
        }
    }
};
struct EpiInO8 {
    static constexpr bool PERM = true, AFTER_DRAIN = false, MODE = 1;
    bf16_t* BG; bf16_t* Y; const float* RSC; const float* CSC;
    __device__ __forceinline__ void operator()(const i32x4 (&acc)[2][2][4][2], const Unit& u, int wr, int wc, int fr, int fq) const {
        asm volatile("" ::: "memory");
        const int row0 = u.pm * BM + wr * 64 + fr;
        const float* cs = CSC + u.pn * BM + wc * 32 + 8 * fq;
        const f32x4 c00 = *(const f32x4*)(cs), c01 = *(const f32x4*)(cs + 4), c10 = *(const f32x4*)(cs + HALF), c11 = *(const f32x4*)(cs + HALF + 4);
        if (u.pn < 8) {
            const int col0 = u.pn * HALF + wc * 32 + 8 * fq;
#pragma unroll
            for (int ai = 0; ai < 2; ++ai)
#pragma unroll
                for (int m = 0; m < 4; ++m) { const int row = row0 + ai * HALF + m * 16; const float rs = RSC[row], rs2 = rs * rs;
                    const f32x4 v0 = __builtin_convertvector(acc[ai][0][m][0], f32x4) * __builtin_convertvector(acc[ai][1][m][0], f32x4) * (c00 * c10) * rs2;
                    const f32x4 v1 = __builtin_convertvector(acc[ai][0][m][1], f32x4) * __builtin_convertvector(acc[ai][1][m][1], f32x4) * (c01 * c11) * rs2;
                    u32x4 w; w.x = cvt_pk_bf16(v0[0], v0[1]); w.y = cvt_pk_bf16(v0[2], v0[3]); w.z = cvt_pk_bf16(v1[0], v1[1]); w.w = cvt_pk_bf16(v1[2], v1[3]);
                    *(u32x4*)(Y + (size_t)row * 1024 + col0) = w; }
        } else {
            const int col0 = (u.pn - 8) * BM + wc * 32 + 8 * fq;
#pragma unroll
            for (int ai = 0; ai < 2; ++ai)
#pragma unroll
                for (int m = 0; m < 4; ++m) { const int row = row0 + ai * HALF + m * 16; const float rs = RSC[row]; bf16_t* rowp = BG + (size_t)row * 1024 + col0;
#pragma unroll
                    for (int bj = 0; bj < 2; ++bj) { const f32x4 v0 = __builtin_convertvector(acc[ai][bj][m][0], f32x4) * (bj ? c10 : c00) * rs, v1 = __builtin_convertvector(acc[ai][bj][m][1], f32x4) * (bj ? c11 : c01) * rs;
                        u32x4 w; w.x = cvt_pk_bf16(v0[0], v0[1]); w.y = cvt_pk_bf16(v0[2], v0[3]); w.z = cvt_pk_bf16(v1[0], v1[1]); w.w = cvt_pk_bf16(v1[2], v1[3]);
                        *(u32x4*)(rowp + bj * HALF) = w; } }
        }
    }
};
struct EpiRes8 {
    static constexpr bool PERM = false, AFTER_DRAIN = false, MODE = 1;
    bf16_t* lat; const float* gate; float* RSS; const float* RSC; const float* CSC;
    __device__ __forceinline__ void operator()(const i32x4 (&acc)[2][2][4][2], const Unit& u, int wr, int wc, int fr, int fq) const {
        const int row0 = u.pm * BM + wr * 64 + fr, col0 = u.pn * BM + wc * 32 + 4 * fq, b = u.pm >> 5;
        f32x4 gv[2][2];
#pragma unroll
        for (int bj = 0; bj < 2; ++bj)
#pragma unroll
            for (int n = 0; n < 2; ++n) gv[bj][n] = *(const f32x4*)(gate + (size_t)b * 6144 + col0 + bj * HALF + n * 16) * *(const f32x4*)(CSC + col0 + bj * HALF + n * 16);
#pragma unroll
        for (int ai = 0; ai < 2; ++ai) {
            u32x2 bs[4][2][2]; float rs[4];
#pragma unroll
            for (int m = 0; m < 4; ++m) { rs[m] = RSC[row0 + ai * HALF + m * 16];
#pragma unroll
                for (int bj = 0; bj < 2; ++bj)
#pragma unroll
                    for (int n = 0; n < 2; ++n) bs[m][bj][n] = *(const u32x2*)(lat + (size_t)(row0 + ai * HALF + m * 16) * 1024 + col0 + bj * HALF + n * 16); }
            asm volatile("" ::: "memory");
#pragma unroll
            for (int m = 0; m < 4; ++m) { const int row = row0 + ai * HALF + m * 16; float ss = 0.f, am = 0.f;
#pragma unroll
                for (int bj = 0; bj < 2; ++bj)
#pragma unroll
                    for (int n = 0; n < 2; ++n) { const u32x2 bw = bs[m][bj][n];
                        const f32x4 bf = (f32x4){__builtin_bit_cast(float, bw.x << 16), __builtin_bit_cast(float, bw.x & 0xffff0000u), __builtin_bit_cast(float, bw.y << 16), __builtin_bit_cast(float, bw.y & 0xffff0000u)};
                        const f32x4 o = bf + gv[bj][n] * (__builtin_convertvector(acc[ai][bj][m][n], f32x4) * rs[m]); const u32x2 w = pk4(o); *(u32x2*)(lat + (size_t)row * 1024 + col0 + bj * HALF + n * 16) = w;
                        const float r0 = __builtin_bit_cast(float, w.x << 16), r1 = __builtin_bit_cast(float, w.x & 0xffff0000u), r2 = __builtin_bit_cast(float, w.y << 16), r3 = __builtin_bit_cast(float, w.y & 0xffff0000u);
                        ss += (r0 * r0 + r1 * r1) + (r2 * r2 + r3 * r3); am = fmaxf(fmaxf(am, fmaxf(fabsf(r0), fabsf(r1))), fmaxf(fabsf(r2), fabsf(r3))); }
                ss += __shfl_xor(ss, 16); ss += __shfl_xor(ss, 32); am = fmaxf(am, __shfl_xor(am, 16)); am = fmaxf(am, __shfl_xor(am, 32));
                if (fq == 0) { RSS[(size_t)row * 16 + u.pn * 4 + wc] = ss; RSS[(size_t)M_ROWS * 16 + (size_t)row * 16 + u.pn * 4 + wc] = am; } }
            asm volatile("" ::: "memory");
        }
    }
};
struct InEOrder {
    static constexpr bool GATHER = false;
    StaticOrder so; int G, c;
    __device__ __forceinline__ unsigned goff(const Unit&, int) const { return 0u; }
    __device__ __forceinline__ bool next(int i, Unit& u) const {
        const long L = (long)i * G + c;
        if (L < 896) return so.next(i, u);
        if (L < 900) { u.pm = 128 + (int)(L - 896); u.pn = 2; return true; }
        return false;
    }
    __device__ __forceinline__ void a_ready(const Unit&) const {}
    __device__ __forceinline__ void done(const Unit&) const {}
};
template <bool GATH> struct MoeOrderT {
    static constexpr bool GATHER = GATH;
    const PG8_LAS int* tile_e; int nt, G, c; const PG8_LAS unsigned* gtab;
    __device__ __forceinline__ bool next(int i, Unit& u) const {
        const int nx = (G % NXCD == 0) ? NXCD : 1, x = c % nx, k = c / nx, per = G / nx, chunk = (nt + nx - 1) / nx;
        const int j = k + i * per, t = x * chunk + (j >> 2), tend = (x + 1) * chunk < nt ? (x + 1) * chunk : nt;
        if (t >= tend) return false;
        u.pm = t; u.pn = tile_e[t] * 4 + (j & 3); u.li = i; return true;
    }
    __device__ __forceinline__ unsigned goff(const Unit& u, int r) const { return gtab[u.li * 256 + r]; }
    __device__ __forceinline__ void a_ready(const Unit&) const {}
    __device__ __forceinline__ void done(const Unit&) const {}
};
typedef MoeOrderT<false> MoeOrder;
typedef MoeOrderT<true> MoeGatherOrder;
template <class Epi, class Sched, bool ALIGN_EPI = false, bool SP2 = false>
__device__ __forceinline__ void gemm_phase(PG8_LAS unsigned char* lds, const Gemm g, const Sched& S, const Epi& E, const int tid_in) {
    int tid_ = tid_in; asm volatile("" : "+v"(tid_));
    const int tid = tid_, wid = __builtin_amdgcn_readfirstlane(tid >> 6), lane = tid & 63, wr = wid >> 2, wc = wid & 3, fr = lane & 15, fq = lane >> 4;
    const int K = g.K, nt = K / BK;
    unsigned voffA[2], voffB[2];
#pragma unroll
    for (int i = 0; i < 2; ++i) { int R, C; stage_rc(tid * 16 + i * 8192, R, C); const int Rb = Epi::PERM ? ((R & ~31) + perm32(R & 31)) : R;
        voffA[i] = (unsigned)(R * K + C) * 2u; voffB[i] = (unsigned)(Rb * K + C) * 2u; }
    constexpr bool GATHER = Sched::GATHER;
    static_assert(!GATHER || SP2, "the gathered A path is written for the SP2 loop");
    unsigned gofC[2][2], gofN[2][2], go2[2][2]; int stR[2], stC2[2];
#pragma unroll
    for (int i = 0; i < 2; ++i) { int R, C; stage_rc(tid * 16 + i * 8192, R, C); stR[i] = R; stC2[i] = C * 2; gofC[0][i] = gofC[1][i] = gofN[0][i] = gofN[1][i] = go2[0][i] = go2[1][i] = 0u; }
#define PG8_GLOAD(dst, unit) do { if constexpr (GATHER) { _Pragma("unroll") for (int h_ = 0; h_ < 2; ++h_) _Pragma("unroll") for (int i_ = 0; i_ < 2; ++i_) dst[h_][i_] = S.goff(unit, h_ * HALF + stR[i_]) + (unsigned)stC2[i_]; } } while (0)
#define PG8_STA(bufoff, ptr, h, OFFS) do { if constexpr (GATHER) { PG8_STAGE(bufoff, ptr, OFFS[h]); } else { PG8_STAGE(bufoff, (ptr) + (h) * hstep, voffA); } } while (0)
    const size_t kstep = (size_t)(BK * 2);
    const size_t hstep = (size_t)HALF * K * 2;
    const size_t tstep = 2 * hstep;
    const unsigned ldsw = (unsigned)wid * 1024u;
    const int aoff = lds_byte(wr * 64 + fr, fq * 8), boff = lds_byte(wc * 32 + fr, fq * 8);
#define PG8_SA(b, h) (((b) * 2 + (h)) * HTB)
#define PG8_SB(b, h) ((4 + (b) * 2 + (h)) * HTB)
#define PG8_STAGE(bufoff, gbase, voff) do { _Pragma("unroll") for (int _i = 0; _i < 2; ++_i) \
        __builtin_amdgcn_global_load_lds((const unsigned*)((const char*)(gbase) + (voff)[_i]), (PG8_LAS unsigned*)(lds + (bufoff) + ldsw + _i * 8192), 16, 0, 0); } while (0)
#define PG8_LDA(dst, b, h) do { _Pragma("unroll") for (int m = 0; m < 4; ++m) _Pragma("unroll") for (int k = 0; k < 2; ++k) dst[m][k] = *(const PG8_LAS bf16x8*)(lds + PG8_SA(b, h) + aoff + m * 2048 + k * 1024); } while (0)
#define PG8_LDB(dst, b, h) do { _Pragma("unroll") for (int n = 0; n < 2; ++n) _Pragma("unroll") for (int k = 0; k < 2; ++k) dst[n][k] = *(const PG8_LAS bf16x8*)(lds + PG8_SB(b, h) + boff + n * 2048 + k * 1024); } while (0)
#define PG8_MMA(ai, bj, At, Bt) do { __builtin_amdgcn_s_setprio(1); _Pragma("unroll") for (int m = 0; m < 4; ++m) _Pragma("unroll") for (int n = 0; n < 2; ++n) _Pragma("unroll") for (int k = 0; k < 2; ++k) \
        acc[ai][bj][m][n] = mma16<Epi::MODE>(Bt[n][k], At[m][k], acc[ai][bj][m][n]); __builtin_amdgcn_s_setprio(0); } while (0)
#define PG8_WAIT_V(n) asm volatile("s_waitcnt vmcnt(" #n ")" ::: "memory")
#define PG8_WAIT_L(n) asm volatile("s_waitcnt lgkmcnt(" #n ")" ::: "memory")
#define PG8_BAR __builtin_amdgcn_s_barrier()
#define PG8_SCHED __builtin_amdgcn_sched_barrier(0)
    Unit cur, nxt; int ui = 0;
    if (!S.next(0, cur)) return;
    typedef typename AccSel<Epi::MODE == 1>::t acc_t;
    acc_t acc[2][2][4][2];
#pragma unroll
    for (int a = 0; a < 2; ++a)
#pragma unroll
        for (int b = 0; b < 2; ++b)
#pragma unroll
            for (int m = 0; m < 4; ++m)
#pragma unroll
                for (int n = 0; n < 2; ++n) acc[a][b][m][n] = acc_t{};
    bf16x8 At[4][2], B0[2][2], B1[2][2];
    const char* cA = (const char*)g.A + (GATHER ? (size_t)0 : (size_t)cur.pm * tstep); const char* cB = (const char*)g.Bt + (size_t)cur.pn * tstep;
    PG8_GLOAD(gofC, cur);
    S.a_ready(cur);
    if constexpr (SP2) {
        PG8_STAGE(PG8_SB(0, 0), cB, voffB); PG8_STAGE(PG8_SB(0, 1), cB + hstep, voffB); PG8_STA(PG8_SA(0, 0), cA, 0, gofC); PG8_STA(PG8_SA(0, 1), cA, 1, gofC);
        if (wr == 1) PG8_BAR;
        PG8_WAIT_V(2); PG8_BAR;
        PG8_STAGE(PG8_SB(1, 0), cB + kstep, voffB); PG8_STA(PG8_SA(1, 0), cA + kstep, 0, gofC); PG8_STAGE(PG8_SB(1, 1), cB + hstep + kstep, voffB);
        PG8_WAIT_V(6); PG8_BAR;
    } else {
        PG8_STAGE(PG8_SB(0, 0), cB, voffB); PG8_STAGE(PG8_SA(0, 0), cA, voffA); PG8_STAGE(PG8_SB(0, 1), cB + hstep, voffB); PG8_STAGE(PG8_SA(0, 1), cA + hstep, voffA);
        if (wr == 1) PG8_BAR;
        PG8_WAIT_V(4); PG8_BAR;
        PG8_STAGE(PG8_SB(1, 0), cB + kstep, voffB); PG8_STAGE(PG8_SA(1, 0), cA + kstep, voffA); PG8_STAGE(PG8_SB(1, 1), cB + hstep + kstep, voffB);
        PG8_WAIT_V(6); PG8_BAR;
    }
    for (;;) {
        const bool has_next = S.next(ui + 1, nxt);
        if (has_next) PG8_GLOAD(gofN, nxt);
        const char* nA = has_next ? (const char*)g.A + (GATHER ? (size_t)0 : (size_t)nxt.pm * tstep) : cA; const char* nB = has_next ? (const char*)g.Bt + (size_t)nxt.pn * tstep : cB;
        for (int t = 0; t < nt; t += 2) {
            const bool last = (t == nt - 2);
            const char* a1 = cA + (size_t)(t + 1) * kstep;
            const char* a2 = last ? nA : cA + (size_t)(t + 2) * kstep; const char* b2 = last ? nB : cB + (size_t)(t + 2) * kstep;
            const char* a3 = a2 + kstep; const char* b3 = b2 + kstep;
            if constexpr (GATHER) { const bool usen = last && has_next;
#pragma unroll
                for (int h_ = 0; h_ < 2; ++h_)
#pragma unroll
                    for (int i_ = 0; i_ < 2; ++i_) go2[h_][i_] = usen ? gofN[h_][i_] : gofC[h_][i_]; }
            if (last && has_next) S.a_ready(nxt);
            if constexpr (SP2) {
            PG8_LDB(B0, 0, 0); PG8_LDB(B1, 0, 1); PG8_SCHED; PG8_LDA(At, 0, 0); PG8_STA(PG8_SA(1, 1), a1, 1, gofC);
            PG8_WAIT_V(8); PG8_WAIT_L(0); PG8_BAR; PG8_MMA(0, 0, At, B0); PG8_MMA(0, 1, At, B1); PG8_BAR; PG8_SCHED;
            PG8_LDA(At, 0, 1); PG8_STAGE(PG8_SB(0, 0), b2, voffB); PG8_STAGE(PG8_SB(0, 1), b2 + hstep, voffB); PG8_STA(PG8_SA(0, 0), a2, 0, go2);
            PG8_WAIT_V(8); PG8_WAIT_L(0); PG8_BAR; PG8_MMA(1, 0, At, B0); PG8_MMA(1, 1, At, B1); PG8_BAR; PG8_SCHED;
            PG8_LDB(B0, 1, 0); PG8_LDB(B1, 1, 1); PG8_SCHED; PG8_LDA(At, 1, 0); PG8_STA(PG8_SA(0, 1), a2, 1, go2);
            PG8_WAIT_V(8); PG8_WAIT_L(0); PG8_BAR; PG8_MMA(0, 0, At, B0); PG8_MMA(0, 1, At, B1); PG8_BAR; PG8_SCHED;
            PG8_LDA(At, 1, 1); PG8_STAGE(PG8_SB(1, 0), b3, voffB); PG8_STAGE(PG8_SB(1, 1), b3 + hstep, voffB); PG8_STA(PG8_SA(1, 0), a3, 0, go2);
            PG8_WAIT_V(8); PG8_WAIT_L(0); PG8_BAR; PG8_MMA(1, 0, At, B0); PG8_MMA(1, 1, At, B1); PG8_BAR; PG8_SCHED;
            } else {
            PG8_LDB(B0, 0, 0); PG8_SCHED; PG8_LDA(At, 0, 0); PG8_STAGE(PG8_SA(1, 1), a1 + hstep, voffA);
            PG8_WAIT_L(8); PG8_BAR; PG8_WAIT_L(0); PG8_MMA(0, 0, At, B0); PG8_BAR; PG8_SCHED;
            PG8_LDB(B1, 0, 1); PG8_STAGE(PG8_SB(0, 0), b2, voffB);
            PG8_BAR; PG8_WAIT_L(0); PG8_MMA(0, 1, At, B1); PG8_BAR;
            PG8_LDA(At, 0, 1); PG8_STAGE(PG8_SA(0, 0), a2, voffA);
            PG8_BAR; PG8_WAIT_L(0); PG8_MMA(1, 0, At, B0); PG8_BAR; PG8_SCHED;
            PG8_STAGE(PG8_SB(0, 1), b2 + hstep, voffB);
            PG8_WAIT_V(6); PG8_BAR; PG8_MMA(1, 1, At, B1); PG8_BAR;
            PG8_LDB(B0, 1, 0); PG8_SCHED; PG8_LDA(At, 1, 0); PG8_STAGE(PG8_SA(0, 1), a2 + hstep, voffA);
            PG8_WAIT_L(8); PG8_BAR; PG8_WAIT_L(0); PG8_MMA(0, 0, At, B0); PG8_BAR; PG8_SCHED;
            PG8_LDB(B1, 1, 1); PG8_STAGE(PG8_SB(1, 0), b3, voffB);
            PG8_BAR; PG8_WAIT_L(0); PG8_MMA(0, 1, At, B1); PG8_BAR;
            PG8_LDA(At, 1, 1); PG8_STAGE(PG8_SA(1, 0), a3, voffA);
            PG8_BAR; PG8_WAIT_L(0); PG8_MMA(1, 0, At, B0); PG8_BAR; PG8_SCHED;
            PG8_STAGE(PG8_SB(1, 1), b3 + hstep, voffB);
            PG8_WAIT_V(6); PG8_BAR; PG8_MMA(1, 1, At, B1); PG8_BAR;
            }
        }
        if constexpr (ALIGN_EPI) { if (wr == 0) PG8_BAR; }
        if constexpr (!Epi::AFTER_DRAIN) { E(acc, cur, wr, wc, fr, fq); S.done(cur); }
        if (!has_next) break;
#pragma unroll
        for (int a = 0; a < 2; ++a)
#pragma unroll
            for (int b = 0; b < 2; ++b)
#pragma unroll
                for (int m = 0; m < 4; ++m)
#pragma unroll
                    for (int n = 0; n < 2; ++n) acc[a][b][m][n] = acc_t{};
        cur = nxt; cA = nA; cB = nB; ++ui;
        if constexpr (GATHER) {
#pragma unroll
            for (int h_ = 0; h_ < 2; ++h_)
#pragma unroll
                for (int i_ = 0; i_ < 2; ++i_) gofC[h_][i_] = gofN[h_][i_]; }
        if constexpr (ALIGN_EPI) { if (wr == 1) PG8_BAR; }
    }
    PG8_WAIT_V(0);
    if constexpr (!ALIGN_EPI) { if (wr == 0) PG8_BAR; }
    PG8_BAR;
    if constexpr (Epi::AFTER_DRAIN) { E.fused(acc, cur, wr, wc, fr, fq, lds, wid, lane); S.done(cur); }
#undef PG8_GLOAD
#undef PG8_STA
#undef PG8_SA
#undef PG8_SB
#undef PG8_STAGE
#undef PG8_LDA
#undef PG8_LDB
#undef PG8_MMA
#undef PG8_WAIT_V
#undef PG8_WAIT_L
#undef PG8_BAR
#undef PG8_SCHED
}
}
constexpr int NWAVES = 8;
constexpr int BATCH = 4, SEQ = 8192, D = 1024, M = BATCH * SEQ, CTXL = 256, MC = BATCH * CTXL;
constexpr int NINE = 1792, NEXP = 32, EH = 512;
constexpr float EPS = 1e-6f;
constexpr int N_PHASES = 18;
#ifndef MK_ONE_LAUNCH
#define MK_ONE_LAUNCH 1
#endif
constexpr size_t MiB = 1u << 20;
constexpr size_t WS_CTL = 0, CTL_ZERO_BYTES = 1 * MiB;
constexpr size_t WS_MOD = 1 * MiB;
constexpr size_t WS_MODC = WS_MOD + 2 * 4 * 6144 * 4;
constexpr size_t WS_MODP = 1 * MiB + 768 * 1024;
static_assert(WS_MODC + 6144 * 4 <= 1 * MiB + 256 * 1024, "MOD/MODC overlap the rope tables");
constexpr size_t WS_ROPE = 1 * MiB + 256 * 1024;
constexpr size_t WS_WSP = 1 * MiB + 512 * 1024;
constexpr size_t WS_TOKE = 2 * MiB;
constexpr size_t WS_TOKP = 2 * MiB + 256 * 1024;
constexpr size_t WS_TOKW = 2 * MiB + 512 * 1024;
constexpr size_t WS_TOKS = 2 * MiB + 768 * 1024;
constexpr size_t WS_KC = 3 * MiB;
constexpr size_t WS_VCT = 3 * MiB + 256 * 1024;
constexpr size_t WS_VT = 4 * MiB;
constexpr size_t WS_WINE = 12 * MiB, WS_WOUTE = 16 * MiB, WS_WINO = 18 * MiB, WS_WOUTO = 24 * MiB;
constexpr size_t WS_WGU = 26 * MiB;
constexpr size_t WS_WD = 154 * MiB;
constexpr size_t WS_H = 218 * MiB;
constexpr size_t WS_A = 284 * MiB;
constexpr size_t WS_B = 428 * MiB;
constexpr size_t WS_RSS = 574 * MiB;
constexpr size_t WS_CSC = 502 * MiB;
constexpr size_t WS_CSC2 = 502 * MiB + 256 * 1024;
constexpr size_t WS_RSC = 502 * MiB + 512 * 1024;
constexpr size_t WS_LAT = 503 * MiB;
constexpr size_t WS_LIST = 567 * MiB;
constexpr size_t WS_TOKSC = 571 * MiB;
constexpr size_t WS_CSD = 578 * MiB;
constexpr size_t WS_END = 579 * MiB;
constexpr int CW_TMO = 0, CW_CODE = 1, CW_Q0 = 512, CW_Q1 = 576, CW_BAR = 4096, CW_GCNT = 8192;

constexpr int RING_BYTES = 131072;
constexpr int LDS_BYTES = 155648;
constexpr int MISC_OFF = LDS_BYTES - 256;
constexpr int MOE_TAB_OFF = RING_BYTES;
constexpr int MOE_GTAB_OFF = RING_BYTES + 2048, MOE_RTAB_OFF = MOE_GTAB_OFF + 8 * 1024, MOE_MAXU = 8;
static_assert(MOE_RTAB_OFF + 8 * 1024 <= LDS_BYTES - 256, "LDS map");
constexpr int RW_STRIDE = 2064;
constexpr int RT_WH = 0, RT_WL = 36 * RW_STRIDE, RT_CNT = 72 * RW_STRIDE, RT_BASE = RT_CNT + 128, RT_INFO = RT_CNT + 256, RT_RED = RT_INFO + 128 * 8 * 4;
static_assert(RT_RED + 64 <= MISC_OFF, "LDS map");

#define GAS __attribute__((address_space(1)))
#define LAS __attribute__((address_space(3)))
typedef unsigned short bf16;
typedef unsigned v4u __attribute__((ext_vector_type(4)));
typedef unsigned v2u __attribute__((ext_vector_type(2)));
typedef float f32x4 __attribute__((ext_vector_type(4)));
typedef float f32x16 __attribute__((ext_vector_type(16)));
typedef short bf16x8 __attribute__((ext_vector_type(8)));
typedef GAS unsigned gu32;
#define RLX_AGENT __ATOMIC_RELAXED, __HIP_MEMORY_SCOPE_AGENT
#define LDS_WAIT() asm volatile("s_waitcnt lgkmcnt(0)" ::: "memory")
__device__ __forceinline__ unsigned f2bf(float f) { unsigned u = __builtin_bit_cast(unsigned, f); return (u + 0x7fffu + ((u >> 16) & 1u)) >> 16; }
__device__ __forceinline__ unsigned pk2(float lo, float hi) { return f2bf(lo) | (f2bf(hi) << 16); }
__device__ __forceinline__ float bflo(unsigned w) { return __builtin_bit_cast(float, w << 16); }
__device__ __forceinline__ float bfhi(unsigned w) { return __builtin_bit_cast(float, w & 0xffff0000u); }
__device__ __forceinline__ float wave_sum(float v) {
#pragma unroll
    for (int o = 1; o < 64; o <<= 1) v += __shfl_xor(v, o);
    return v;
}
__device__ __forceinline__ void lds_barrier() { asm volatile("s_waitcnt lgkmcnt(0)\n\ts_barrier" ::: "memory"); }
#define XB_TMO      128
#define XB_XCNT(j)  (256  + 64 * (j))
#define XB_XSUB(j)  (1280 + 64 * (j))
#define XB_XGEN(j)  (2304 + 64 * (j))
#define XB_TOP      3328
#define XB_TOPGEN   3392
#define XCD_BAR_WORDS 3456
#define XB_SPIN_CAP (1u << 18)

__device__ __forceinline__ unsigned xb_ld(unsigned* p)              { return __hip_atomic_load(p, __ATOMIC_RELAXED, __HIP_MEMORY_SCOPE_AGENT); }
__device__ __forceinline__ unsigned xb_add(unsigned* p, unsigned v) { return __hip_atomic_fetch_add(p, v, __ATOMIC_RELAXED, __HIP_MEMORY_SCOPE_AGENT); }
__device__ __forceinline__ unsigned xb_xcc_id() { return (unsigned)__builtin_amdgcn_s_getreg((3 << 11) | 20) & 0xFu; }
#define XB_SPIN(cond, bar) do { unsigned _sp = 0; while (cond) { __builtin_amdgcn_s_sleep(1); \
    if ((++_sp & 255u) == 0u) { if (xb_ld(&(bar)[XB_TMO])) break; if (_sp > XB_SPIN_CAP) { atomicAdd(&(bar)[XB_TMO], 1u); break; } } } } while (0)

struct XcdBarrier {
    unsigned* bar; unsigned x;
    volatile LAS unsigned* st;
};

__device__ __forceinline__ XcdBarrier xcd_barrier_post(unsigned* bar, volatile LAS unsigned* st) {
    XcdBarrier b; b.bar = bar; b.x = xb_xcc_id(); b.st = st;
    if (threadIdx.x == 0) (void)xb_add(&bar[XB_XCNT(b.x)], 1u);
    return b;
}
__device__ __forceinline__ void xcd_barrier_complete(unsigned* bar, unsigned x, unsigned& nloc, unsigned& nx) {
    const unsigned G = gridDim.x * gridDim.y * gridDim.z;
    unsigned sum, cnt, mine, sp = 0u;
    for (;;) {
        sum = 0u; cnt = 0u; mine = 0u;
#pragma unroll
        for (unsigned j = 0; j < 16; ++j) { const unsigned c = xb_ld(&bar[XB_XCNT(j)]); sum += c; cnt += (c > 0u) ? 1u : 0u; mine = (j == x) ? c : mine; }
        if (sum == G) break;
        __builtin_amdgcn_s_sleep(1);
        if ((++sp & 255u) == 0u) { if (xb_ld(&bar[XB_TMO])) break; if (sp > XB_SPIN_CAP) { atomicAdd(&bar[XB_TMO], 1u); break; } }
    }
    nloc = mine > 0u ? mine : 1u; nx = cnt > 0u ? cnt : 1u;
}

__device__ __forceinline__ void xcd_barrier(const XcdBarrier& b, const int xb_tid) {
    asm volatile("s_waitcnt vmcnt(0)" ::: "memory");
    __syncthreads();
    if (xb_tid == 0) {
        unsigned* bar = b.bar;
        __builtin_amdgcn_s_waitcnt(0);
        unsigned nloc = b.st[0], nx = b.st[1];
        if (nloc == 0u) { xcd_barrier_complete(bar, b.x, nloc, nx); b.st[0] = nloc; b.st[1] = nx; }
        const unsigned old = xb_add(&bar[XB_XSUB(b.x)], 1u);
        const unsigned gen = old / nloc;
        if (old + 1u == (gen + 1u) * nloc) {
            __builtin_amdgcn_fence(__ATOMIC_RELEASE, "agent");
            asm volatile("s_waitcnt vmcnt(0)" ::: "memory");
            const unsigned og = xb_add(&bar[XB_TOP], 1u);
            const unsigned tg = og / nx;
            if (og + 1u == (tg + 1u) * nx) xb_add(&bar[XB_TOPGEN], 1u);
            else XB_SPIN(xb_ld(&bar[XB_TOPGEN]) == tg, bar);
            __builtin_amdgcn_fence(__ATOMIC_ACQUIRE, "agent");
            xb_add(&bar[XB_XGEN(b.x)], 1u);
            asm volatile("s_waitcnt vmcnt(0)" ::: "memory");
        } else {
            XB_SPIN(xb_ld(&bar[XB_XGEN(b.x)]) == gen, bar);
            __builtin_amdgcn_fence(__ATOMIC_ACQUIRE, "agent");
            asm volatile("s_waitcnt vmcnt(0)" ::: "memory");
        }
    }
    __syncthreads();
}

struct Args { const float* in[25]; float* out; unsigned char* ws; int ph_lo, ph_hi; };
struct Ctx {
    LAS unsigned char* lds; unsigned ldsaddr;
    int tid, lane, wave, G, bid;
    float* out; unsigned char* ws; gu32* ctl;
};
__device__ __forceinline__ const float* kin(int k) {
    const __attribute__((address_space(4))) Args* ka = (const __attribute__((address_space(4))) Args*)__builtin_amdgcn_kernarg_segment_ptr();
    return (const float*)(const GAS float*)ka->in[k];
}
__device__ const float ROPE_INV[16] = {1.000000000e+00f, 5.623413324e-01f, 3.162277639e-01f, 1.778279394e-01f, 1.000000015e-01f, 5.623413250e-02f, 3.162277490e-02f, 1.778279431e-02f,
                                       9.999999776e-03f, 5.623413250e-03f, 3.162277630e-03f, 1.778279431e-03f, 1.000000047e-03f, 5.623413017e-04f, 3.162277571e-04f, 1.778279402e-04f};

__device__ __forceinline__ void transpose_item(const float* W, int K, int N, bf16* WT, int k0, int n0, int drow0, LAS float* scr, int lane) {
    float tv[32];
#pragma unroll
    for (int i = 0; i < 32; ++i) tv[i] = W[(size_t)(k0 + 2 * i + (lane >> 5)) * N + n0 + (lane & 31)];
#pragma unroll
    for (int i = 0; i < 32; ++i) scr[(2 * i + (lane >> 5)) * 33 + (lane & 31)] = tv[i];
    LDS_WAIT(); asm volatile("" ::: "memory");
    const int c = lane & 7;
#pragma unroll
    for (int j = 0; j < 4; ++j) { const int n = (lane >> 3) + 8 * j; const LAS float* s = scr + (8 * c) * 33 + n;
        v4u o; o.x = pk2(s[0 * 33], s[1 * 33]); o.y = pk2(s[2 * 33], s[3 * 33]); o.z = pk2(s[4 * 33], s[5 * 33]); o.w = pk2(s[6 * 33], s[7 * 33]);
        *(GAS v4u*)(WT + (size_t)(drow0 + n) * K + k0 + 8 * c) = o; }
    LDS_WAIT(); asm volatile("" ::: "memory");
}
__device__ __forceinline__ void sincos_acc(float a, float& s, float& c) {
    const double x = (double)a, kf = __builtin_rint(x * 0.63661977236758134308), r = x - kf * 1.57079632679489661923, r2 = r * r;
    const double sp = r * (1.0 + r2 * (-1.0 / 6 + r2 * (1.0 / 120 + r2 * (-1.0 / 5040 + r2 * (1.0 / 362880 + r2 * (-1.0 / 39916800 + r2 * (1.0 / 6227020800.0)))))));
    const double cp = 1.0 + r2 * (-0.5 + r2 * (1.0 / 24 + r2 * (-1.0 / 720 + r2 * (1.0 / 40320 + r2 * (-1.0 / 3628800 + r2 * (1.0 / 479001600 + r2 * (-1.0 / 87178291200.0)))))));
    const int k = (int)kf & 3;
    s = (float)((k == 0) ? sp : (k == 1) ? cp : (k == 2) ? -sp : -cp);
    c = (float)((k == 0) ? cp : (k == 1) ? -sp : (k == 2) ? -cp : sp);
}
__device__ __forceinline__ void adaln_unit(const Ctx& C, int u) {
    const int l = u / 96, col = (u % 96) * 64 + C.lane;
    LAS float* sil = (LAS float*)C.lds; LAS float* red = (LAS float*)(C.lds + 5 * 1024 * 4);
    for (int idx = C.tid; idx < 5120; idx += NWAVES * 64) { const float v = (idx < 4096) ? kin(1)[idx] : kin(3)[idx - 4096]; sil[idx] = v / (1.0f + __expf(-v)); }
    __syncthreads();
    float acc[5] = {0.f, 0.f, 0.f, 0.f, 0.f};
    const int k0 = C.wave * 128; const float* wp = kin(4) + (size_t)l * 1024 * 6144 + (size_t)k0 * 6144 + col;
#pragma unroll 1
    for (int kq = 0; kq < 128; kq += 32) { float wv[32];
#pragma unroll
        for (int kk = 0; kk < 32; ++kk) wv[kk] = wp[(size_t)(kq + kk) * 6144];
#pragma unroll
        for (int kk = 0; kk < 32; ++kk)
#pragma unroll
            for (int v = 0; v < 5; ++v) acc[v] += sil[v * 1024 + k0 + kq + kk] * wv[kk]; }
#pragma unroll
    for (int v = 0; v < 5; ++v) red[(C.wave * 5 + v) * 64 + C.lane] = acc[v];
    __syncthreads();
    if (C.wave == 0) {
        float* MOD = (float*)(C.ws + WS_MOD); float* MODC = (float*)(C.ws + WS_MODC); float* MODP = (float*)(C.ws + WS_MODP); const float bias = kin(5)[l * 6144 + col];
#pragma unroll
        for (int v = 0; v < 5; ++v) { float s = 0.f;
#pragma unroll
            for (int w = 0; w < NWAVES; ++w) s += red[(w * 5 + v) * 64 + C.lane];
            s += bias;
            if (v < 4) { MOD[(size_t)(l * 4 + v) * 6144 + col] = s;
                const int ch = col >> 10;
                if (ch == 1 || ch == 4) { const int w2 = (ch == 4) ? 1 : 0; MODP[(size_t)((l * 4 + v) * 2 + w2) * 1024 + (col & 1023)] = ((w2 ? kin(7) : kin(6))[l * 1024 + (col & 1023)]) * (1.0f + s); }
            } else if (l == 0) MODC[col] = s; }
    }
    __syncthreads();
}
struct StripDesc { const float* W; int N, n0, drow0; unsigned char* W8; float* CSC; };
constexpr int N_STRIPS = 2048 + 96 + 32 + 56;
__device__ __forceinline__ StripDesc strip_desc(const Ctx& C, int st) {
    StripDesc d;
    if (st < 2048) { const int me = st >> 5, which = (st >> 4) & 1, j0 = 32 * (st & 15);
        d.W = (which ? kin(23) : kin(22)) + (size_t)me * 1024 * 512; d.N = 512; d.n0 = j0; d.W8 = (unsigned char*)(C.ws + WS_WGU) + (size_t)me * 1024 * 1024; d.CSC = (float*)(C.ws + WS_CSC) + (size_t)me * 1024;
        d.drow0 = 256 * (j0 >> 7) + (j0 & 127) + 128 * which;
    } else if (st < 2048 + 96) { const int n0 = 32 * (st - 2048), j = n0 & 1023;
        d.W = kin(15); d.N = 3072; d.n0 = n0; d.W8 = (unsigned char*)(C.ws + WS_WINO); d.CSC = (float*)(C.ws + WS_CSC2); d.drow0 = (n0 < 1024) ? 2048 + n0 : 256 * (j >> 7) + (j & 127) + ((n0 >= 2048) ? 128 : 0);
    } else if (st < 2048 + 96 + 32) { const int n0 = 32 * (st - 2048 - 96);
        d.W = kin(17); d.N = 1024; d.n0 = n0; d.W8 = (unsigned char*)(C.ws + WS_WOUTO); d.CSC = (float*)(C.ws + WS_CSC2) + 3072; d.drow0 = n0;
    } else { const int n0 = 32 * (st - 2048 - 96 - 32);
        d.W = kin(9); d.N = 1792; d.n0 = n0; d.W8 = (unsigned char*)(C.ws + WS_WINE); d.CSC = (float*)(C.ws + WS_CSC2) + 4096; d.drow0 = n0; }
    return d;
}
#define QS_LOAD(v, d) do { const float* p_ = (d).W + (size_t)(16 * kr) * (d).N + (d).n0 + 4 * c4; _Pragma("unroll") for (int i = 0; i < 16; ++i) v[i] = *(const f32x4*)(p_ + (size_t)i * (d).N); } while (0)
__device__ __forceinline__ void quant_strip_regs(const Ctx& C, const f32x4 (&v)[16], const StripDesc& d, int par) {
    const int c4 = C.tid & 7, kr = C.tid >> 3;
    LAS float* part = (LAS float*)(C.lds + par * 2048); LAS float* cmax = part + 256;
    f32x4 mx = (f32x4){0.f, 0.f, 0.f, 0.f};
#pragma unroll
    for (int i = 0; i < 16; ++i) mx = __builtin_elementwise_max(mx, __builtin_elementwise_abs(v[i]));
#pragma unroll
    for (int j = 0; j < 4; ++j) { float m = mx[j]; m = fmaxf(m, __shfl_xor(m, 8)); m = fmaxf(m, __shfl_xor(m, 16)); m = fmaxf(m, __shfl_xor(m, 32)); mx[j] = m; }
    if ((C.lane >> 3) == 0) {
#pragma unroll
        for (int j = 0; j < 4; ++j) part[C.wave * 32 + 4 * c4 + j] = mx[j]; }
    lds_barrier();
    if (C.tid < 32) { float m = part[C.tid];
#pragma unroll
        for (int g = 1; g < 8; ++g) m = fmaxf(m, part[g * 32 + C.tid]);
        cmax[C.tid] = m; d.CSC[d.drow0 + C.tid] = m > 0.f ? m * (1.0f / 127.0f) : 1.0f; }
    lds_barrier();
#pragma unroll
    for (int j = 0; j < 4; ++j) { const float am = cmax[4 * c4 + j], inv = am > 0.f ? 127.0f / am : 0.f; unsigned w[4];
#pragma unroll
        for (int g = 0; g < 4; ++g) { unsigned acc = 0u;
#pragma unroll
            for (int e = 0; e < 4; ++e) acc |= ((unsigned)(int)__builtin_rintf(v[4 * g + e][j] * inv) & 0xffu) << (8 * e);
            w[g] = acc; }
        *(v4u*)(d.W8 + (size_t)(d.drow0 + 4 * c4 + j) * 1024 + 16 * kr) = (v4u){w[0], w[1], w[2], w[3]}; }
    (void)kr;
}
constexpr int N_PSTRIPS = 1024 + (N_STRIPS - 2176);
__device__ __forceinline__ int strip_of(const Ctx& C, int i) {
    int p;
    if (C.G != 256) { p = C.bid + i * C.G; }
    else if (C.bid < 192) { if (i >= 4) return -1; p = C.bid + 192 * i; }
    else p = 768 + (C.bid - 192) + 64 * i;
    if (p >= N_PSTRIPS) return -1;
    return p < 1024 ? p : p + 1152;
}
__device__ __forceinline__ void quant_strips(const Ctx& C) {
    const int c4 = C.tid & 7, kr = C.tid >> 3;
    f32x4 va[16], vb[16];
    int i = 0, sta = strip_of(C, 0);
    if (sta >= 0) {
        StripDesc da = strip_desc(C, sta), db = da; QS_LOAD(va, da);
#pragma unroll 1
        for (;;) {
            const int stb = strip_of(C, i + 1); if (stb >= 0) { db = strip_desc(C, stb); QS_LOAD(vb, db); }
            quant_strip_regs(C, va, da, 0);
            if (stb < 0) break;
            i += 2; sta = strip_of(C, i); if (sta >= 0) { da = strip_desc(C, sta); QS_LOAD(va, da); }
            quant_strip_regs(C, vb, db, 1);
            if (sta < 0) break;
        }
    }
    __syncthreads();
}
__device__ __forceinline__ void quant_strips_q(const Ctx& C, gu32* qhead, int nq1, int base1, int nq2, int base2) {
    const int nq = nq1 + nq2;
#define QS_MAP(q) ((q) < nq1 ? base1 + (q) : base2 + (q) - nq1)
    const int c4 = C.tid & 7, kr = C.tid >> 3;
    volatile LAS int* qi = (volatile LAS int*)(C.lds + 4096);
    __syncthreads();
    if (C.tid == 0) { qi[0] = (int)__hip_atomic_fetch_add(qhead, 1u, RLX_AGENT); qi[1] = (int)__hip_atomic_fetch_add(qhead, 1u, RLX_AGENT); }
    __syncthreads();
    int sta = qi[0], stb = qi[1];
    f32x4 va[16], vb[16];
    if (sta < nq) {
        StripDesc da = strip_desc(C, QS_MAP(sta)), db = da; QS_LOAD(va, da);
#pragma unroll 1
        for (;;) {
            const bool hb = stb < nq; if (hb) { db = strip_desc(C, QS_MAP(stb)); QS_LOAD(vb, db); }
            if (C.tid == 0) qi[0] = (int)__hip_atomic_fetch_add(qhead, 1u, RLX_AGENT);
            quant_strip_regs(C, va, da, 0);
            sta = qi[0];
            if (!hb) break;
            const bool ha = sta < nq; if (ha) { da = strip_desc(C, QS_MAP(sta)); QS_LOAD(va, da); }
            if (C.tid == 0) qi[1] = (int)__hip_atomic_fetch_add(qhead, 1u, RLX_AGENT);
            quant_strip_regs(C, vb, db, 1);
            stb = qi[1];
            if (!ha) break;
        }
    }
    __syncthreads();
}
#undef QS_MAP
#undef QS_LOAD
#define WD_LOAD(v, sd) do { const float* p_ = kin(24) + (size_t)((sd) >> 5) * 512 * 1024 + (size_t)(8 * kr) * 1024 + 32 * ((sd) & 31) + 4 * c4; _Pragma("unroll") for (int i = 0; i < 8; ++i) v[i] = *(const f32x4*)(p_ + (size_t)i * 1024); } while (0)
__device__ __forceinline__ void wd_strip_regs(const Ctx& C, const f32x4 (&v)[8], int sd, int par) {
    const int c4 = C.tid & 7, kr = C.tid >> 3, me = sd >> 5, n0 = 32 * (sd & 31);
    LAS float* part = (LAS float*)(C.lds + par * 2048); LAS float* cmax = part + 256;
    f32x4 mx = (f32x4){0.f, 0.f, 0.f, 0.f};
#pragma unroll
    for (int i = 0; i < 8; ++i) mx = __builtin_elementwise_max(mx, __builtin_elementwise_abs(v[i]));
#pragma unroll
    for (int j = 0; j < 4; ++j) { float m = mx[j]; m = fmaxf(m, __shfl_xor(m, 8)); m = fmaxf(m, __shfl_xor(m, 16)); m = fmaxf(m, __shfl_xor(m, 32)); mx[j] = m; }
    if ((C.lane >> 3) == 0) {
#pragma unroll
        for (int j = 0; j < 4; ++j) part[C.wave * 32 + 4 * c4 + j] = mx[j]; }
    lds_barrier();
    if (C.tid < 32) { float m = part[C.tid];
#pragma unroll
        for (int g = 1; g < 8; ++g) m = fmaxf(m, part[g * 32 + C.tid]);
        cmax[C.tid] = m; ((float*)(C.ws + WS_CSD))[(size_t)me * 1024 + n0 + C.tid] = m > 0.f ? m * (1.0f / 240.0f) : 1.0f; }
    lds_barrier();
    unsigned char* W8 = (unsigned char*)(C.ws + WS_WD) + (size_t)me * 1024 * 512;
#pragma unroll
    for (int j = 0; j < 4; ++j) { const float am = cmax[4 * c4 + j], inv = am > 0.f ? 240.0f / am : 0.f;
        int w0 = __builtin_amdgcn_cvt_pk_fp8_f32(v[0][j] * inv, v[1][j] * inv, 0, false); w0 = __builtin_amdgcn_cvt_pk_fp8_f32(v[2][j] * inv, v[3][j] * inv, w0, true);
        int w1 = __builtin_amdgcn_cvt_pk_fp8_f32(v[4][j] * inv, v[5][j] * inv, 0, false); w1 = __builtin_amdgcn_cvt_pk_fp8_f32(v[6][j] * inv, v[7][j] * inv, w1, true);
        *(v2u*)(W8 + (size_t)(n0 + 4 * c4 + j) * 512 + 8 * kr) = (v2u){(unsigned)w0, (unsigned)w1}; }
}
__device__ __forceinline__ void wd_strips(const Ctx& C, int first, int stride, int end) {
    const int c4 = C.tid & 7, kr = C.tid >> 3;
    f32x4 va[8], vb[8];
    int sa = first;
    if (sa < end) { WD_LOAD(va, sa);
#pragma unroll 1
        for (;;) {
            const int sb = sa + stride; if (sb < end) WD_LOAD(vb, sb);
            wd_strip_regs(C, va, sa, 0);
            if (sb >= end) break;
            sa = sb + stride; if (sa < end) WD_LOAD(va, sa);
            wd_strip_regs(C, vb, sb, 1);
            if (sa >= end) break;
        }
    }
    __syncthreads();
}
#undef WD_LOAD
#if defined(TPROBE_P0)
#define P0_STAMP(i) do { if (C.tid == 0) { const unsigned long long n_ = __builtin_amdgcn_s_memrealtime(); volatile LAS unsigned long long* st_ = (volatile LAS unsigned long long*)(C.lds + MISC_OFF + 128); st_[i] = n_; \
        if ((i) == 3 && false) { const unsigned el_ = (unsigned)(n_ - st_[0]); __hip_atomic_fetch_max((unsigned*)(C.ctl + 200), el_, RLX_AGENT); __hip_atomic_fetch_max((unsigned*)(C.ctl + 203 + (C.bid >> 6)), el_, RLX_AGENT); } } } while (0)
#else
#define P0_STAMP(i) do { } while (0)
#endif
__device__ __forceinline__ void p0_prologue(const Ctx& C) {
    P0_STAMP(0);
    for (int u = C.bid; u < 192; u += C.G) adaln_unit(C, u);
    P0_STAMP(1);
    quant_strips(C);
    wd_strips(C, C.bid, C.G, 1024);
    wd_strips(C, 1664 + C.bid, C.G, 2048);
    P0_STAMP(2);
    LAS float* scr = (LAS float*)(C.lds + C.wave * 16384);
    const int gw = C.bid * NWAVES + C.wave, NGW = C.G * NWAVES;
    for (int it = gw; it < 512; it += NGW)
        transpose_item(kin(14), 1024, 1024, (bf16*)(C.ws + WS_WOUTE), 64 * (it / 32), 32 * (it % 32), 32 * (it % 32), scr, C.lane);
    for (int it = gw; it < 256; it += NGW) {
        const f32x4* src = (const f32x4*)(kin(12) + (size_t)it * 512) + 2 * C.lane; const f32x4 a = src[0], b = src[1];
        v4u o; o.x = pk2(a.x, a.y); o.y = pk2(a.z, a.w); o.z = pk2(b.x, b.y); o.w = pk2(b.z, b.w);
        const int hh = it >> 5, i = 4 * (it & 31) + (C.lane >> 4), c = C.lane & 15;
        *(v4u*)((bf16*)(C.ws + WS_WSP) + ((size_t)(((hh * 8 + (c >> 1)) * 4 + (i >> 5)) * 64 + (i & 31) + 32 * (c & 1))) * 8) = o;
    }
    { const int gt = gw * 64 + C.lane;
        if (gt < 2048) { float s, c; sincos_acc((float)(gt >> 4) * ROPE_INV[gt & 15], s, c); ((float*)(C.ws + WS_ROPE))[gt] = c; ((float*)(C.ws + WS_ROPE))[2048 + gt] = s; } }
    P0_STAMP(3);
}
__device__ __forceinline__ void wd1_items(const Ctx& C, int hb, int nhb) { wd_strips(C, 1024 + hb, nhb, 1664); }

__device__ __forceinline__ void unpack8(const v4u w, float (&f)[8]) { f[0] = bflo(w.x); f[1] = bfhi(w.x); f[2] = bflo(w.y); f[3] = bfhi(w.y); f[4] = bflo(w.z); f[5] = bfhi(w.z); f[6] = bflo(w.w); f[7] = bfhi(w.w); }
__device__ __forceinline__ void load_mod(const float* gam, const float* shp, const float* scp, int lane, f32x4 (&sc)[4], f32x4 (&sh)[4]) {
#pragma unroll
    for (int j = 0; j < 4; ++j) { const int idx = lane + 64 * j; const f32x4 g = ((const f32x4*)gam)[idx], s = ((const f32x4*)scp)[idx]; sc[j] = g * (1.0f + s); sh[j] = ((const f32x4*)shp)[idx]; }
}
__device__ __forceinline__ float row_rinv(const f32x4 (&v)[4]) {
    float ss = 0.f;
#pragma unroll
    for (int j = 0; j < 4; ++j) ss += (v[j].x * v[j].x + v[j].y * v[j].y) + (v[j].z * v[j].z + v[j].w * v[j].w);
    return rsqrtf(wave_sum(ss) * (1.0f / 1024.0f) + EPS);
}
__device__ __forceinline__ void mod_store(const f32x4 (&v)[4], float rinv, const f32x4 (&sc)[4], const f32x4 (&sh)[4], bf16* orow, int lane) {
#pragma unroll
    for (int j = 0; j < 4; ++j) { const f32x4 o = v[j] * rinv * sc[j] + sh[j]; v2u w; w.x = pk2(o.x, o.y); w.y = pk2(o.z, o.w); ((v2u*)orow)[lane + 64 * j] = w; }
}
__device__ __forceinline__ void mod_store8(const f32x4 (&v)[4], float rinv, const f32x4 (&sc)[4], const f32x4 (&sh)[4], unsigned char* orow8, float* rsc, int lane) {
    f32x4 o[4]; float am = 0.f;
#pragma unroll
    for (int j = 0; j < 4; ++j) { o[j] = v[j] * rinv * sc[j] + sh[j]; am = fmaxf(am, fmaxf(fmaxf(fabsf(o[j].x), fabsf(o[j].y)), fmaxf(fabsf(o[j].z), fabsf(o[j].w)))); }
#pragma unroll
    for (int s = 1; s < 64; s <<= 1) am = fmaxf(am, __shfl_xor(am, s));
    const float inv = am > 0.f ? 127.0f / am : 0.f;
#pragma unroll
    for (int j = 0; j < 4; ++j) { const unsigned w = ((unsigned)(int)__builtin_rintf(o[j].x * inv) & 0xffu) | (((unsigned)(int)__builtin_rintf(o[j].y * inv) & 0xffu) << 8) | (((unsigned)(int)__builtin_rintf(o[j].z * inv) & 0xffu) << 16) | (((unsigned)(int)__builtin_rintf(o[j].w * inv) & 0xffu) << 24);
        ((unsigned*)orow8)[lane + 64 * j] = w; }
    if (lane == 0) *rsc = am > 0.f ? am * (1.0f / 127.0f) : 1.0f;
}
__device__ __forceinline__ void phase_norm1_l0(const Ctx& C) {
    const int gw = C.bid * NWAVES + C.wave, NGW = C.G * NWAVES;
    const float* MOD = (const float*)(C.ws + WS_MOD); const float* MODC = (const float*)(C.ws + WS_MODC); bf16* H = (bf16*)(C.ws + WS_H);
    const int nrow = (M + MC - gw + NGW - 1) / NGW;
    f32x4 sc[4], sh[4]; int curb = -1;
    f32x4 va[4][4], vb[4][4];
#define N1_SRC(row) (((row) < M) ? kin(0) + (size_t)(row) * D : kin(2) + (size_t)((row) - M) * D)
#define N1_LOAD(buf, i0) do { _Pragma("unroll") for (int r = 0; r < 4; ++r) { const int row_ = gw + ((i0) + r) * NGW; if ((i0) + r < nrow) { const float* s_ = N1_SRC(row_); \
            _Pragma("unroll") for (int j = 0; j < 4; ++j) buf[r][j] = ((const f32x4*)s_)[C.lane + 64 * j]; } } } while (0)
#define N1_PROC(buf, i0) do { _Pragma("unroll") for (int r = 0; r < 4; ++r) { const int row_ = gw + ((i0) + r) * NGW; if ((i0) + r < nrow) { const int b_ = (row_ < M) ? (row_ >> 13) : 4; \
            if (b_ != curb) { curb = b_; if (b_ < 4) { const float* mod = MOD + (size_t)b_ * 6144; load_mod(kin(6), mod, mod + 1024, C.lane, sc, sh); } else load_mod(kin(6), MODC, MODC + 1024, C.lane, sc, sh); } \
            mod_store8(buf[r], row_rinv(buf[r]), sc, sh, (unsigned char*)H + (size_t)row_ * D, (float*)(C.ws + WS_RSC) + row_, C.lane); } } } while (0)
    N1_LOAD(va, 0);
#pragma unroll 1
    for (int i0 = 0; i0 < nrow; i0 += 8) {
        N1_LOAD(vb, i0 + 4); N1_PROC(va, i0);
        N1_LOAD(va, i0 + 8); N1_PROC(vb, i0 + 4); }
#undef N1_LOAD
#undef N1_PROC
#undef N1_SRC
}
__device__ __forceinline__ void phase_router(const Ctx& C, int l) {
    LAS unsigned char* WH = C.lds + RT_WH; LAS unsigned char* WL = C.lds + RT_WL;
    LAS int* cnt = (LAS int*)(C.lds + RT_CNT); LAS int* base = (LAS int*)(C.lds + RT_BASE); LAS int* info = (LAS int*)(C.lds + RT_INFO);
    const float* wrg = kin(18) + l * 4096; const float* wre = kin(20) + l * 32768; const float* brg = kin(19) + l * 4; const float* bre = kin(21) + l * 32;
    for (int idx = C.tid; idx < 9216; idx += NWAVES * 64) { const int k = idx / 9, q9 = idx - 9 * k;
        const f32x4 v = (q9 == 0) ? *(const f32x4*)(wrg + 4 * k) : *(const f32x4*)(wre + 32 * k + 4 * (q9 - 1));
        const int row0 = (q9 == 0) ? 32 : 16 * ((q9 - 1) & 1) + 4 * ((q9 - 1) >> 1);
#pragma unroll
        for (int i = 0; i < 4; ++i) { const unsigned hi = f2bf(v[i]), lo = f2bf(v[i] - bflo(hi));
            *(LAS bf16*)(WH + (row0 + i) * RW_STRIDE + 2 * k) = (bf16)hi; *(LAS bf16*)(WL + (row0 + i) * RW_STRIDE + 2 * k) = (bf16)lo; } }
    if (C.tid < 32) cnt[C.tid] = 0;
    __syncthreads();
    const float* MOD = (const float*)(C.ws + WS_MOD); const float* MODP = (const float*)(C.ws + WS_MODP); const float* RSS = (const float*)(C.ws + WS_RSS); unsigned char* H8 = (unsigned char*)(C.ws + WS_H);
    int* LIST = (int*)(C.ws + WS_LIST); float* TOKSC = (float*)(C.ws + WS_TOKSC); LAS float* red = (LAS float*)(C.lds + RT_RED);
    gu32* gcnt = C.ctl + CW_GCNT + l * 32;
    int* TOKE = (int*)(C.ws + WS_TOKE); int* TOKP = (int*)(C.ws + WS_TOKP); float* TOKW = (float*)(C.ws + WS_TOKW);
    const int r = C.lane & 15, q = C.lane >> 4;
    for (int rb = C.bid; rb < M / 128; rb += C.G) {
        const int bq = rb >> 6; const size_t row = (size_t)rb * 128 + C.wave * 16 + r;
        { const float* sp_ = MODP + (size_t)((l * 4 + bq) * 2 + 1) * 1024; const float* hp_ = MOD + (size_t)(l * 4 + bq) * 6144 + 3 * 1024;
            float ms = fmaxf(fabsf(sp_[C.tid]), fabsf(sp_[C.tid + 512])), mh = fmaxf(fabsf(hp_[C.tid]), fabsf(hp_[C.tid + 512]));
#pragma unroll
            for (int o = 1; o < 64; o <<= 1) { ms = fmaxf(ms, __shfl_xor(ms, o)); mh = fmaxf(mh, __shfl_xor(mh, o)); }
            __syncthreads();
            if (C.lane == 0) { red[C.wave] = ms; red[8 + C.wave] = mh; }
            __syncthreads(); }
        float scmax = red[0], shmax = red[8];
#pragma unroll
        for (int w = 1; w < 8; ++w) { scmax = fmaxf(scmax, red[w]); shmax = fmaxf(shmax, red[8 + w]); }
        float rinv, qinv, qscale; { const f32x4* rp = (const f32x4*)(RSS + row * 16); const f32x4 a = rp[0], b = rp[1], c = rp[2], d = rp[3];
            const f32x4 t = (a + b) + (c + d); rinv = rsqrtf(((t.x + t.y) + (t.z + t.w)) * (1.0f / 1024.0f) + EPS);
            const f32x4* mp = (const f32x4*)(RSS + (size_t)M * 16 + row * 16); const f32x4 m4 = __builtin_elementwise_max(__builtin_elementwise_max(mp[0], mp[1]), __builtin_elementwise_max(mp[2], mp[3]));
            const float xmax = fmaxf(fmaxf(m4.x, m4.y), fmaxf(m4.z, m4.w)), bound = xmax * rinv * scmax + shmax;
            qinv = bound > 0.f ? 127.0f / bound : 0.f; qscale = bound > 0.f ? bound * (1.0f / 127.0f) : 1.0f; }
        const v4u* xr = (const v4u*)((const bf16*)(C.ws + WS_LAT) + row * D + 8 * q);
        const f32x4* sp = (const f32x4*)(MODP + (size_t)((l * 4 + bq) * 2 + 1) * 1024 + 8 * q); const f32x4* hp = (const f32x4*)(MOD + (size_t)(l * 4 + bq) * 6144 + 3 * 1024 + 8 * q);
        unsigned char* hrow = H8 + row * D + 8 * q;
        const LAS unsigned char* a0 = WH + (C.lane & 15) * RW_STRIDE + 16 * q; const LAS unsigned char* a2 = WH + (32 + (C.lane & 3)) * RW_STRIDE + 16 * q;
        pg8::f32x4 acc[3];
#pragma unroll
        for (int t = 0; t < 3; ++t) acc[t] = (pg8::f32x4){0.f, 0.f, 0.f, 0.f};
        v4u xc[8], xn[8];
#pragma unroll
        for (int s = 0; s < 8; ++s) xc[s] = xr[4 * s];
        for (int kb = 0; kb < 4; ++kb) {
            if (kb < 3) {
#pragma unroll
                for (int s = 0; s < 8; ++s) xn[s] = xr[4 * (8 * (kb + 1) + s)]; }
#pragma unroll
            for (int s = 0; s < 8; ++s) { const int kk = 8 * kb + s;
                const f32x4 sv0 = sp[8 * kk], sv1 = sp[8 * kk + 1], hv0 = hp[8 * kk], hv1 = hp[8 * kk + 1];
                const f32x4 x0 = (f32x4){bflo(xc[s].x), bfhi(xc[s].x), bflo(xc[s].y), bfhi(xc[s].y)}, x1 = (f32x4){bflo(xc[s].z), bfhi(xc[s].z), bflo(xc[s].w), bfhi(xc[s].w)};
                const f32x4 h0 = x0 * rinv * sv0 + hv0, h1 = x1 * rinv * sv1 + hv1;
                v4u hi; hi.x = pg8::cvt_pk_bf16(h0.x, h0.y); hi.y = pg8::cvt_pk_bf16(h0.z, h0.w); hi.z = pg8::cvt_pk_bf16(h1.x, h1.y); hi.w = pg8::cvt_pk_bf16(h1.z, h1.w);
                v4u lo; lo.x = pg8::cvt_pk_bf16(h0.x - bflo(hi.x), h0.y - bfhi(hi.x)); lo.y = pg8::cvt_pk_bf16(h0.z - bflo(hi.y), h0.w - bfhi(hi.y));
                lo.z = pg8::cvt_pk_bf16(h1.x - bflo(hi.z), h1.y - bfhi(hi.z)); lo.w = pg8::cvt_pk_bf16(h1.z - bflo(hi.w), h1.w - bfhi(hi.w));
                { unsigned w0 = 0u, w1 = 0u;
                    w0 = ((unsigned)(int)__builtin_rintf(h0.x * qinv) & 0xffu) | (((unsigned)(int)__builtin_rintf(h0.y * qinv) & 0xffu) << 8) | (((unsigned)(int)__builtin_rintf(h0.z * qinv) & 0xffu) << 16) | (((unsigned)(int)__builtin_rintf(h0.w * qinv) & 0xffu) << 24);
                    w1 = ((unsigned)(int)__builtin_rintf(h1.x * qinv) & 0xffu) | (((unsigned)(int)__builtin_rintf(h1.y * qinv) & 0xffu) << 8) | (((unsigned)(int)__builtin_rintf(h1.z * qinv) & 0xffu) << 16) | (((unsigned)(int)__builtin_rintf(h1.w * qinv) & 0xffu) << 24);
                    *(v2u*)(hrow + 32 * kk) = (v2u){w0, w1}; }
                const bf16x8 bh = __builtin_bit_cast(bf16x8, hi), bl = __builtin_bit_cast(bf16x8, lo);
#pragma unroll
                for (int t = 0; t < 3; ++t) { const LAS unsigned char* ap = ((t == 2) ? a2 : a0 + 16 * t * RW_STRIDE) + 64 * kk;
                    const bf16x8 ah = *(const LAS bf16x8*)ap, al = *(const LAS bf16x8*)(ap + RT_WL);
                    acc[t] = __builtin_amdgcn_mfma_f32_16x16x32_bf16(ah, bh, acc[t], 0, 0, 0);
                    acc[t] = __builtin_amdgcn_mfma_f32_16x16x32_bf16(al, bh, acc[t], 0, 0, 0);
                    acc[t] = __builtin_amdgcn_mfma_f32_16x16x32_bf16(ah, bl, acc[t], 0, 0, 0); } }
            if (kb < 3) {
#pragma unroll
                for (int s = 0; s < 8; ++s) xc[s] = xn[s]; }
        }
        float gl[4];
#pragma unroll
        for (int gi = 0; gi < 4; ++gi) gl[gi] = acc[2][gi] + brg[gi];
        int gidx = 0; float gmax = gl[0];
#pragma unroll
        for (int gi = 1; gi < 4; ++gi) if (gl[gi] > gmax) { gmax = gl[gi]; gidx = gi; }
        if (q == gidx) {
            float den = 0.f;
#pragma unroll
            for (int gi = 0; gi < 4; ++gi) den += __expf(gl[gi] - gmax);
            const float gwt = 1.0f / den;
            float ev[8];
#pragma unroll
            for (int j = 0; j < 8; ++j) ev[j] = acc[j >> 2][j & 3] + bre[8 * q + j];
            int i0 = 0; float v0 = ev[0];
#pragma unroll
            for (int j = 1; j < 8; ++j) if (ev[j] > v0) { v0 = ev[j]; i0 = j; }
            int i1 = (i0 == 0) ? 1 : 0; float v1 = (i0 == 0) ? ev[1] : ev[0];
#pragma unroll
            for (int j = 1; j < 8; ++j) if (j != i0 && ev[j] > v1) { v1 = ev[j]; i1 = j; }
            const float t = __expf(v1 - v0), p0 = 1.0f / (1.0f + t), p1 = t * p0;
            const int rr = C.wave * 16 + r, e0 = gidx * 8 + i0, e1 = gidx * 8 + i1;
            const int pl0 = __hip_atomic_fetch_add(cnt + e0, 1, __ATOMIC_RELAXED, __HIP_MEMORY_SCOPE_WORKGROUP), pl1 = __hip_atomic_fetch_add(cnt + e1, 1, __ATOMIC_RELAXED, __HIP_MEMORY_SCOPE_WORKGROUP);
            info[rr * 8 + 0] = e0; info[rr * 8 + 1] = e1; info[rr * 8 + 2] = pl0; info[rr * 8 + 3] = pl1;
            info[rr * 8 + 4] = __builtin_bit_cast(int, gwt * p0); info[rr * 8 + 5] = __builtin_bit_cast(int, gwt * p1); info[rr * 8 + 6] = __builtin_bit_cast(int, qscale);
        }
        __syncthreads();
        if (C.tid < 32) base[C.tid] = (int)__hip_atomic_fetch_add(gcnt + C.tid, (unsigned)cnt[C.tid], RLX_AGENT);
        __syncthreads();
        if (C.tid < 128) { const size_t orow = (size_t)rb * 128 + C.tid; const int e0 = info[C.tid * 8], e1 = info[C.tid * 8 + 1];
            const int p0 = base[e0] + info[C.tid * 8 + 2], p1 = base[e1] + info[C.tid * 8 + 3];
            TOKE[orow] = e0 | (e1 << 8); TOKP[orow * 2] = p0; TOKP[orow * 2 + 1] = p1; LIST[(size_t)e0 * 32768 + p0] = (int)orow; LIST[(size_t)e1 * 32768 + p1] = (int)orow;
            TOKW[orow * 2] = __builtin_bit_cast(float, info[C.tid * 8 + 4]); TOKW[orow * 2 + 1] = __builtin_bit_cast(float, info[C.tid * 8 + 5]); TOKSC[orow] = __builtin_bit_cast(float, info[C.tid * 8 + 6]); }
        __syncthreads();
        if (C.tid < 32) cnt[C.tid] = 0;
        __syncthreads();
    }
}
__device__ __forceinline__ int moe_tables(const Ctx& C, int l) {
    LAS int* tile_e = (LAS int*)(C.lds + MOE_TAB_OFF); LAS int* seg = (LAS int*)(C.lds + MOE_TAB_OFF + 1280); LAS int* lc = (LAS int*)(C.lds + MOE_TAB_OFF + 1280 + 160);
    if (C.tid < 32) lc[C.tid] = (int)__hip_atomic_load(C.ctl + CW_GCNT + l * 32 + C.tid, RLX_AGENT);
    __syncthreads();
    if (C.tid == 0) { int t = 0;
        for (int e = 0; e < 32; ++e) { seg[e] = t * 256; const int n = (lc[e] + 255) >> 8; for (int k = 0; k < n; ++k) tile_e[t + k] = e; t += n; }
        seg[32] = t * 256; }
    __syncthreads();
    return seg[32] >> 8;
}
template <class Sched> __device__ __forceinline__ void moe_gather_tables(const Ctx& C, const Sched& S) {
    const LAS int* tile_e = (const LAS int*)(C.lds + MOE_TAB_OFF); const LAS int* seg = (const LAS int*)(C.lds + MOE_TAB_OFF + 1280); const LAS int* lc = (const LAS int*)(C.lds + MOE_TAB_OFF + 1280 + 160);
    LAS unsigned* gtab = (LAS unsigned*)(C.lds + MOE_GTAB_OFF); LAS float* rtab = (LAS float*)(C.lds + MOE_RTAB_OFF);
    const int* LIST = (const int*)(C.ws + WS_LIST); const float* TOKSC = (const float*)(C.ws + WS_TOKSC);
    pg8::Unit u;
    for (int i = 0; i < MOE_MAXU && S.next(i, u); ++i) {
        if (C.tid < 256) { const int e = tile_e[u.pm], pos = u.pm * 256 - seg[e] + C.tid, tok = LIST[(size_t)e * 32768 + (pos < lc[e] ? pos : 0)];
            gtab[i * 256 + C.tid] = (unsigned)tok * 1024u; rtab[i * 256 + C.tid] = TOKSC[tok]; }
    }
    __syncthreads();
}
template <bool FINAL> __device__ __forceinline__ void phase_combine(const Ctx& C, int lp) {
    const int gw = C.bid * NWAVES + C.wave, NGW = C.G * NWAVES;
    const float* MOD = (const float*)(C.ws + WS_MOD); bf16* H = (bf16*)(C.ws + WS_H); const unsigned char* YB = (const unsigned char*)(C.ws + WS_A); bf16* LAT = (bf16*)(C.ws + WS_LAT);
    const int* TOKE = (const int*)(C.ws + WS_TOKE); const int* TOKP = (const int*)(C.ws + WS_TOKP); const float* TOKW = (const float*)(C.ws + WS_TOKW);
    (void)moe_tables(C, lp); const LAS int* seg = (const LAS int*)(C.lds + MOE_TAB_OFF + 1280);
    for (int grp = gw; grp < M / 16; grp += NGW) {
        const int b = grp >> 9; f32x4 g2[4], sc[4], sh[4];
#pragma unroll
        for (int j = 0; j < 4; ++j) g2[j] = ((const f32x4*)(MOD + (size_t)(lp * 4 + b) * 6144 + 5 * 1024))[C.lane + 64 * j];
        if (FINAL) {
#pragma unroll
            for (int j = 0; j < 4; ++j) { sc[j] = ((const f32x4*)kin(8))[C.lane + 64 * j]; sh[j] = (f32x4){0.f, 0.f, 0.f, 0.f}; }
        } else { const float* mod = MOD + (size_t)(4 + b) * 6144; load_mod(kin(6) + 1024, mod, mod + 1024, C.lane, sc, sh); }
        const int tev = TOKE[(size_t)grp * 16 + (C.lane & 15)], tsv = TOKP[(size_t)grp * 32 + (C.lane & 31)], twv = __builtin_bit_cast(int, TOKW[(size_t)grp * 32 + (C.lane & 31)]);
        v2u xv[4][4]; unsigned ya[4][4], yc[4][4]; float w0[4], w1[4];
#define CB_LOAD(buf, r0) do { const size_t row_ = (size_t)grp * 16 + (r0); \
            const int ee_ = __builtin_amdgcn_readlane(tev, (r0)); const int s0_ = seg[ee_ & 255] + __builtin_amdgcn_readlane(tsv, 2 * (r0)), s1_ = seg[ee_ >> 8] + __builtin_amdgcn_readlane(tsv, 2 * (r0) + 1); \
            w0[buf] = __builtin_bit_cast(float, __builtin_amdgcn_readlane(twv, 2 * (r0))); w1[buf] = __builtin_bit_cast(float, __builtin_amdgcn_readlane(twv, 2 * (r0) + 1)); \
            _Pragma("unroll") for (int j = 0; j < 4; ++j) { xv[buf][j] = ((const v2u*)(LAT + row_ * D))[C.lane + 64 * j]; \
                ya[buf][j] = ((const unsigned*)(YB + (size_t)s0_ * D))[C.lane + 64 * j]; yc[buf][j] = ((const unsigned*)(YB + (size_t)s1_ * D))[C.lane + 64 * j]; } } while (0)
#define CB_PROC(buf, r0) do { const size_t row = (size_t)grp * 16 + (r0); f32x4 v[4]; \
            _Pragma("unroll") for (int j = 0; j < 4; ++j) { const int a = (int)ya[buf][j], c = (int)yc[buf][j]; \
                const f32x4 y0 = (f32x4){__builtin_amdgcn_cvt_f32_fp8(a, 0), __builtin_amdgcn_cvt_f32_fp8(a, 1), __builtin_amdgcn_cvt_f32_fp8(a, 2), __builtin_amdgcn_cvt_f32_fp8(a, 3)}, \
                            y1 = (f32x4){__builtin_amdgcn_cvt_f32_fp8(c, 0), __builtin_amdgcn_cvt_f32_fp8(c, 1), __builtin_amdgcn_cvt_f32_fp8(c, 2), __builtin_amdgcn_cvt_f32_fp8(c, 3)}; \
                const v2u xw = xv[buf][j]; v[j] = (f32x4){bflo(xw.x), bfhi(xw.x), bflo(xw.y), bfhi(xw.y)} + g2[j] * (y0 * w0[buf] + y1 * w1[buf]); } \
            if (FINAL) { const float rinv = row_rinv(v); _Pragma("unroll") for (int j = 0; j < 4; ++j) ((f32x4*)(C.out + row * D))[C.lane + 64 * j] = v[j] * rinv * sc[j]; } \
            else { _Pragma("unroll") for (int j = 0; j < 4; ++j) { v2u w_; w_.x = pk2(v[j].x, v[j].y); w_.y = pk2(v[j].z, v[j].w); ((v2u*)(LAT + row * D))[C.lane + 64 * j] = w_; \
                    v[j] = (f32x4){bflo(w_.x), bfhi(w_.x), bflo(w_.y), bfhi(w_.y)}; } const float rinv = row_rinv(v); mod_store8(v, rinv, sc, sh, (unsigned char*)H + row * D, (float*)(C.ws + WS_RSC) + row, C.lane); } } while (0)
        CB_LOAD(0, 0); CB_LOAD(1, 1); CB_LOAD(2, 2);
#pragma unroll 1
        for (int it = 0; it < 4; ++it) { const int r0 = 4 * it;
            CB_LOAD(3, r0 + 3); CB_PROC(0, r0);
            if (it < 3) CB_LOAD(0, r0 + 4);
            CB_PROC(1, r0 + 1);
            if (it < 3) CB_LOAD(1, r0 + 5);
            CB_PROC(2, r0 + 2);
            if (it < 3) CB_LOAD(2, r0 + 6);
            CB_PROC(3, r0 + 3); }
#undef CB_PROC
#undef CB_LOAD
    }
}
__device__ __forceinline__ void phase_conv(const Ctx& C) {
    const int gw = C.bid * NWAVES + C.wave, NGW = C.G * NWAVES;
    const bf16* BG = (const bf16*)(C.ws + WS_A); const bf16* Y = BG + (size_t)M * D; unsigned char* MIX8 = (unsigned char*)(C.ws + WS_B); float* RSC = (float*)(C.ws + WS_RSC);
    float cw[3][2][8];
#pragma unroll
    for (int t = 0; t < 3; ++t)
#pragma unroll
        for (int j = 0; j < 2; ++j) { const f32x4 a = *(const f32x4*)(kin(16) + t * 1024 + j * 512 + 8 * C.lane), b = *(const f32x4*)(kin(16) + t * 1024 + j * 512 + 8 * C.lane + 4);
            cw[t][j][0] = a.x; cw[t][j][1] = a.y; cw[t][j][2] = a.z; cw[t][j][3] = a.w; cw[t][j][4] = b.x; cw[t][j][5] = b.y; cw[t][j][6] = b.z; cw[t][j][7] = b.w; }
    const v4u zero4 = (v4u){0u, 0u, 0u, 0u};
    for (int grp = gw; grp < M / 16; grp += NGW) {
        const size_t t0 = (size_t)grp * 16; v4u prev[2], cur[2];
        v4u yn[4][2], bgv[4][2];
#define CV_LOAD(buf, r0) do { const size_t row_ = t0 + (r0); const bool last_ = (row_ & 8191) == 8191; \
            _Pragma("unroll") for (int j = 0; j < 2; ++j) { yn[buf][j] = last_ ? zero4 : ((const v4u*)(Y + (row_ + 1) * D))[C.lane + 64 * j]; bgv[buf][j] = ((const v4u*)(BG + row_ * D))[C.lane + 64 * j]; } } while (0)
#pragma unroll
        for (int j = 0; j < 2; ++j) { prev[j] = ((t0 & 8191) == 0) ? zero4 : ((const v4u*)(Y + (t0 - 1) * D))[C.lane + 64 * j]; cur[j] = ((const v4u*)(Y + t0 * D))[C.lane + 64 * j]; }
#define CV_PROC(buf, r0) do { const size_t row = t0 + (r0); float ov[2][8]; float am = 0.f; \
            _Pragma("unroll") for (int j = 0; j < 2; ++j) { const v4u nx = yn[buf][j]; \
                float fp[8], fc[8], fn[8], fb[8]; unpack8(prev[j], fp); unpack8(cur[j], fc); unpack8(nx, fn); unpack8(bgv[buf][j], fb); \
                _Pragma("unroll") for (int e = 0; e < 8; ++e) { ov[j][e] = fb[e] * (fp[e] * cw[0][j][e] + fc[e] * cw[1][j][e] + fn[e] * cw[2][j][e]); am = fmaxf(am, fabsf(ov[j][e])); } \
                prev[j] = cur[j]; cur[j] = nx; } \
            _Pragma("unroll") for (int s_ = 1; s_ < 64; s_ <<= 1) am = fmaxf(am, __shfl_xor(am, s_)); \
            const float inv = am > 0.f ? 127.0f / am : 0.f; \
            _Pragma("unroll") for (int j = 0; j < 2; ++j) { unsigned w0 = 0u, w1 = 0u; \
                _Pragma("unroll") for (int e = 0; e < 4; ++e) { w0 |= ((unsigned)(int)__builtin_rintf(ov[j][e] * inv) & 0xffu) << (8 * e); w1 |= ((unsigned)(int)__builtin_rintf(ov[j][4 + e] * inv) & 0xffu) << (8 * e); } \
                ((v2u*)(MIX8 + row * D))[C.lane + 64 * j] = (v2u){w0, w1}; } \
            if (C.lane == 0) RSC[row] = am > 0.f ? am * (1.0f / 127.0f) : 1.0f; } while (0)
        CV_LOAD(0, 0); CV_LOAD(1, 1); CV_LOAD(2, 2);
#pragma unroll 1
        for (int it = 0; it < 4; ++it) { const int r0 = 4 * it;
            CV_LOAD(3, r0 + 3); CV_PROC(0, r0);
            if (it < 3) CV_LOAD(0, r0 + 4);
            CV_PROC(1, r0 + 1);
            if (it < 3) CV_LOAD(1, r0 + 5);
            CV_PROC(2, r0 + 2);
            if (it < 3) CV_LOAD(2, r0 + 6);
            CV_PROC(3, r0 + 3); }
#undef CV_PROC
#undef CV_LOAD
    }
}
constexpr float LOG2E = 1.4426950408889634f;
constexpr float QSCALE = 0.125f * LOG2E;
constexpr int AT_K = 0, AT_V = 24576, AT_WS = 49152, AT_ST = 51200;
__device__ __forceinline__ int crow(int r, int hi) { return (r & 3) + 8 * (r >> 2) + 4 * hi; }
__device__ __forceinline__ bf16x8 pack8(float a0, float a1, float a2, float a3, float a4, float a5, float a6, float a7) {
    v4u w; w.x = pg8::cvt_pk_bf16(a0, a1); w.y = pg8::cvt_pk_bf16(a2, a3); w.z = pg8::cvt_pk_bf16(a4, a5); w.w = pg8::cvt_pk_bf16(a6, a7); return __builtin_bit_cast(bf16x8, w);
}
__device__ __forceinline__ void attn_unit(const Ctx& C, int au) {
    const int qblk = au & 127, kvh = (au >> 7) & 1, b = au >> 8;
    const int ph = C.wave & 1, head = kvh * 4 + (C.wave >> 1), q32 = C.lane & 31, hi = C.lane >> 5;
    const bf16* QK = (const bf16*)(C.ws + WS_A); const bf16* VT = (const bf16*)(C.ws + WS_VT); const bf16* KC = (const bf16*)(C.ws + WS_KC); const bf16* VCT = (const bf16*)(C.ws + WS_VCT);
    bf16* MIX = (bf16*)(C.ws + WS_B);
    const size_t qrow = (size_t)b * SEQ + 64 * qblk + 32 * ph + q32;
    bf16x8 qf[4];
#pragma unroll
    for (int ds = 0; ds < 4; ++ds) qf[ds] = *(const bf16x8*)(QK + qrow * NINE + head * 64 + 16 * ds + 8 * hi);
    const float m0 = kin(10)[head] * LOG2E;
    float m = bflo(f2bf(m0)), l = (hi == 0) ? __builtin_amdgcn_exp2f(m0 - m) : 0.0f;
    v4u aone_w = {(hi == 0) ? 0x3F80u : 0u, 0u, 0u, 0u}, nmb_w = {(hi == 0) ? f2bf(-m) : 0u, 0u, 0u, 0u};
    const bf16x8 aone = __builtin_bit_cast(bf16x8, aone_w);
    f32x16 zero16;
#pragma unroll
    for (int r = 0; r < 16; ++r) zero16[r] = 0.f;
    f32x16 o0, o1;
#pragma unroll
    for (int r = 0; r < 16; ++r) { o0[r] = 0.f; o1[r] = 0.f; }
    const int jlo = (qblk < 2) ? 2 - qblk : 0, jhi = (qblk > 125) ? 129 - qblk : 4, NT = 4 + jhi - jlo + 1;
    const int prow = 8 * C.wave + (C.lane >> 3), pch = (C.lane & 7) ^ ((prow >> 1) & 7);
    LAS float* wsf = (LAS float*)(C.lds + AT_WS) + C.wave * 64;
    unsigned fa[4];
#pragma unroll
    for (int v = 0; v < 4; ++v) fa[v] = q32 * 128 + (((2 * v + hi) ^ ((q32 >> 1) & 7)) * 16);
#define AT_DMAK(t, bufi) do { const bf16* p_; if ((t) < 4) p_ = KC + ((size_t)(b * 256 + 64 * (t) + prow) * 128 + kvh * 64 + 8 * pch); \
        else { const int kblk_ = qblk - 2 + jlo + (t) - 4; p_ = QK + ((size_t)(b * SEQ + 64 * kblk_ + prow) * NINE + 512 + kvh * 64 + 8 * pch); } \
        __builtin_amdgcn_global_load_lds((const unsigned*)p_, (LAS unsigned*)(C.lds + AT_K + (bufi) * 8192 + C.wave * 1024), 16, 0, 0); } while (0)
#define AT_DMAV(t, bufi) do { const bf16* p_; if ((t) < 4) p_ = VCT + ((size_t)((b * 2 + kvh) * 64 + prow) * 256 + 64 * (t) + 8 * pch); \
        else { const int kblk_ = qblk - 2 + jlo + (t) - 4; p_ = VT + ((size_t)((b * 2 + kvh) * 64 + prow) * SEQ + 64 * kblk_ + 8 * pch); } \
        __builtin_amdgcn_global_load_lds((const unsigned*)p_, (LAS unsigned*)(C.lds + AT_V + (bufi) * 8192 + C.wave * 1024), 16, 0, 0); } while (0)
#define AT_CL(x) (((x) < NT) ? (x) : NT - 1)
#define AT_VMWAIT(n) asm volatile("s_waitcnt vmcnt(" #n ")" ::: "memory")
    AT_DMAK(0, 0); AT_DMAK(1, 1); AT_DMAV(0, 0); AT_DMAK(2, 2); AT_DMAV(1, 1);
    AT_VMWAIT(2);
    lds_barrier();
    auto qk = [&](const int kbuf, f32x16& p0, f32x16& p1) __attribute__((always_inline)) {
        const LAS unsigned char* kb = C.lds + AT_K + kbuf * 8192;
#pragma unroll
        for (int ds = 0; ds < 4; ++ds) {
            const bf16x8 a0 = *(const LAS bf16x8*)(kb + fa[ds]), a1 = *(const LAS bf16x8*)(kb + fa[ds] + 4096);
            if (ds == 0) { const bf16x8 nmb = __builtin_bit_cast(bf16x8, nmb_w);
                p0 = __builtin_amdgcn_mfma_f32_32x32x16_bf16(aone, nmb, zero16, 0, 0, 0); p1 = __builtin_amdgcn_mfma_f32_32x32x16_bf16(aone, nmb, zero16, 0, 0, 0); }
            p0 = __builtin_amdgcn_mfma_f32_32x32x16_bf16(a0, qf[ds], p0, 0, 0, 0); p1 = __builtin_amdgcn_mfma_f32_32x32x16_bf16(a1, qf[ds], p1, 0, 0, 0);
        }
    };
    auto sm_a = [&](const int t, f32x16& p0, f32x16& p1) __attribute__((always_inline)) {
        const int j = (t < 4) ? -1 : jlo + t - 4;
        if (j == 0 || j == 4) {
            int dq = 32 * ph + q32 - 4 * hi; asm volatile("" : "+v"(dq));
            if (j == 0) {
#pragma unroll
                for (int r = 0; r < 16; ++r) { const int kc = (r & 3) + 8 * (r >> 2); if (kc < dq) p0[r] = -__builtin_inff(); if (kc + 32 < dq) p1[r] = -__builtin_inff(); }
            } else {
#pragma unroll
                for (int r = 0; r < 16; ++r) { const int kc = (r & 3) + 8 * (r >> 2); if (kc > dq) p0[r] = -__builtin_inff(); if (kc + 32 > dq) p1[r] = -__builtin_inff(); }
            }
        }
#define MX3(a, b, c) __builtin_fmaxf(__builtin_fmaxf((a), (b)), (c))
        float rm = MX3(p0[0], p0[1], p1[0]), rm2 = MX3(p0[2], p0[3], p1[1]); rm = MX3(rm, p1[2], p1[3]);
#pragma unroll
        for (int r = 4; r < 16; r += 4) { rm = MX3(rm, p0[r], p0[r + 1]); rm2 = MX3(rm2, p0[r + 2], p0[r + 3]); rm = MX3(rm, p1[r], p1[r + 1]); rm2 = MX3(rm2, p1[r + 2], p1[r + 3]); }
#undef MX3
        rm = fmaxf(fmaxf(rm, rm2), __shfl_xor(fmaxf(rm, rm2), 32));
        if (__any(rm > 6.0f)) {
            const float mn = bflo(f2bf(m + fmaxf(rm, 0.f))), dl = mn - m, al = __builtin_amdgcn_exp2f(-dl); m = mn; l *= al; nmb_w.x = (hi == 0) ? f2bf(-m) : 0u;
            if (hi == 0) wsf[q32] = al;
#pragma unroll
            for (int r = 0; r < 16; ++r) { const float f = wsf[crow(r, hi)]; o0[r] *= f; o1[r] *= f; p0[r] -= dl; p1[r] -= dl; }
        }
    };
#define AT_SB __builtin_amdgcn_sched_barrier(0)
    auto step_b = [&](const int kbuf, const int vbuf, f32x16& p0, f32x16& p1, f32x16& n0, f32x16& n1) __attribute__((always_inline)) {
        const LAS unsigned char* kb = C.lds + AT_K + kbuf * 8192; const LAS unsigned char* vb = C.lds + AT_V + vbuf * 8192;
        float ls = 0.f;
        bf16x8 ka0 = *(const LAS bf16x8*)(kb + fa[0]), ka1 = *(const LAS bf16x8*)(kb + fa[0] + 4096);
        bf16x8 kc0 = *(const LAS bf16x8*)(kb + fa[1]), kc1 = *(const LAS bf16x8*)(kb + fa[1] + 4096);
        { const bf16x8 nmb = __builtin_bit_cast(bf16x8, nmb_w); n0 = __builtin_amdgcn_mfma_f32_32x32x16_bf16(aone, nmb, zero16, 0, 0, 0); }
        n1 = __builtin_amdgcn_mfma_f32_32x32x16_bf16(ka1, qf[0], n0, 0, 0, 0); n0 = __builtin_amdgcn_mfma_f32_32x32x16_bf16(ka0, qf[0], n0, 0, 0, 0);
#pragma unroll
        for (int r = 0; r < 4; ++r) { p0[r] = __builtin_amdgcn_exp2f(p0[r]); p1[r] = __builtin_amdgcn_exp2f(p1[r]); }
        AT_SB;
        ka0 = *(const LAS bf16x8*)(kb + fa[2]); ka1 = *(const LAS bf16x8*)(kb + fa[2] + 4096);
        n0 = __builtin_amdgcn_mfma_f32_32x32x16_bf16(kc0, qf[1], n0, 0, 0, 0); n1 = __builtin_amdgcn_mfma_f32_32x32x16_bf16(kc1, qf[1], n1, 0, 0, 0);
#pragma unroll
        for (int r = 4; r < 8; ++r) { p0[r] = __builtin_amdgcn_exp2f(p0[r]); p1[r] = __builtin_amdgcn_exp2f(p1[r]); }
        const bf16x8 pa_0 = pack8(p0[0], p0[1], p0[2], p0[3], p0[4], p0[5], p0[6], p0[7]);
        const bf16x8 pb_0 = pack8(p1[0], p1[1], p1[2], p1[3], p1[4], p1[5], p1[6], p1[7]);
        AT_SB;
        kc0 = *(const LAS bf16x8*)(kb + fa[3]); kc1 = *(const LAS bf16x8*)(kb + fa[3] + 4096);
        bf16x8 va0 = *(const LAS bf16x8*)(vb + fa[0]), va1 = *(const LAS bf16x8*)(vb + fa[0] + 4096);
        n0 = __builtin_amdgcn_mfma_f32_32x32x16_bf16(ka0, qf[2], n0, 0, 0, 0); n1 = __builtin_amdgcn_mfma_f32_32x32x16_bf16(ka1, qf[2], n1, 0, 0, 0);
#pragma unroll
        for (int r = 8; r < 12; ++r) { p0[r] = __builtin_amdgcn_exp2f(p0[r]); p1[r] = __builtin_amdgcn_exp2f(p1[r]); }
        o0 = __builtin_amdgcn_mfma_f32_32x32x16_bf16(pa_0, va0, o0, 0, 0, 0); o1 = __builtin_amdgcn_mfma_f32_32x32x16_bf16(pa_0, va1, o1, 0, 0, 0);
#pragma unroll
        for (int r = 0; r < 8; ++r) { ls += p0[r]; ls += p1[r]; }
        AT_SB;
        va0 = *(const LAS bf16x8*)(vb + fa[2]); va1 = *(const LAS bf16x8*)(vb + fa[2] + 4096);
        n0 = __builtin_amdgcn_mfma_f32_32x32x16_bf16(kc0, qf[3], n0, 0, 0, 0); n1 = __builtin_amdgcn_mfma_f32_32x32x16_bf16(kc1, qf[3], n1, 0, 0, 0);
#pragma unroll
        for (int r = 12; r < 16; ++r) { p0[r] = __builtin_amdgcn_exp2f(p0[r]); p1[r] = __builtin_amdgcn_exp2f(p1[r]); }
        o0 = __builtin_amdgcn_mfma_f32_32x32x16_bf16(pb_0, va0, o0, 0, 0, 0); o1 = __builtin_amdgcn_mfma_f32_32x32x16_bf16(pb_0, va1, o1, 0, 0, 0);
        const bf16x8 pa_1 = pack8(p0[8], p0[9], p0[10], p0[11], p0[12], p0[13], p0[14], p0[15]);
        const bf16x8 pb_1 = pack8(p1[8], p1[9], p1[10], p1[11], p1[12], p1[13], p1[14], p1[15]);
        AT_SB;
        va0 = *(const LAS bf16x8*)(vb + fa[1]); va1 = *(const LAS bf16x8*)(vb + fa[1] + 4096);
        const bf16x8 vb0 = *(const LAS bf16x8*)(vb + fa[3]), vb1 = *(const LAS bf16x8*)(vb + fa[3] + 4096);
        o0 = __builtin_amdgcn_mfma_f32_32x32x16_bf16(pa_1, va0, o0, 0, 0, 0); o1 = __builtin_amdgcn_mfma_f32_32x32x16_bf16(pa_1, va1, o1, 0, 0, 0);
#pragma unroll
        for (int r = 8; r < 16; ++r) { ls += p0[r]; ls += p1[r]; }
        o0 = __builtin_amdgcn_mfma_f32_32x32x16_bf16(pb_1, vb0, o0, 0, 0, 0); o1 = __builtin_amdgcn_mfma_f32_32x32x16_bf16(pb_1, vb1, o1, 0, 0, 0);
        l += ls;
        AT_SB;
    };
    f32x16 pa0, pa1, pb0, pb1;
    qk(0, pa0, pa1);
    lds_barrier();
    int b0 = 0, b1 = 1, b2 = 2;
    for (int t = 0; t < NT; t += 2) {
        { const int tk = AT_CL(t + 3), tv = AT_CL(t + 2); AT_DMAK(tk, b0); AT_DMAV(tv, b2); }
        sm_a(t, pa0, pa1);
        step_b(b1, b0, pa0, pa1, pb0, pb1);
        AT_VMWAIT(2); lds_barrier();
        if (t + 1 >= NT) break;
        { const int tk = AT_CL(t + 4), tv = AT_CL(t + 3); AT_DMAK(tk, b1); AT_DMAV(tv, b0); }
        sm_a(t + 1, pb0, pb1);
        step_b(b2, b1, pb0, pb1, pa0, pa1);
        AT_VMWAIT(2); lds_barrier();
        { const int n0 = b2, n1 = b0, n2 = b1; b0 = n0; b1 = n1; b2 = n2; }
    }
    AT_VMWAIT(0); lds_barrier();
#undef AT_SB
#undef AT_DMAK
#undef AT_DMAV
#undef AT_CL
#undef AT_VMWAIT
    l += __shfl_xor(l, 32);
    if (hi == 0) wsf[32 + q32] = l;
    LAS bf16* stg = (LAS bf16*)(C.lds + AT_ST) + C.wave * 2048;
#pragma unroll
    for (int r = 0; r < 16; ++r) { const int orow = crow(r, hi); const float rl = 1.0f / wsf[32 + orow];
        stg[orow * 64 + q32] = (bf16)f2bf(o0[r] * rl); stg[orow * 64 + 32 + q32] = (bf16)f2bf(o1[r] * rl); }
    bf16* Ow = MIX + ((size_t)b * SEQ + 64 * qblk + 32 * ph) * D + head * 64;
#pragma unroll
    for (int i = 0; i < 4; ++i) { const int pc = i * 64 + C.lane, row = pc >> 3, ch = pc & 7; const v4u v = *(const LAS v4u*)(stg + row * 64 + ch * 8); *(v4u*)(Ow + (size_t)row * D + ch * 8) = v; }
    lds_barrier();
}
constexpr int ZS = 1040;
__device__ __forceinline__ v2u tr_read(unsigned addr) { v2u r; asm volatile("ds_read_b64_tr_b16 %0, %1\n\ts_waitcnt lgkmcnt(0)" : "=&v"(r) : "v"(addr) : "memory"); return r; }
template <int OFF> __device__ __forceinline__ v2u tr_read_o(unsigned addr) { v2u r; asm volatile("ds_read_b64_tr_b16 %0, %1 offset:%2\n\ts_waitcnt lgkmcnt(0)" : "=&v"(r) : "v"(addr), "i"(OFF) : "memory"); return r; }
template <int CTRL> __device__ __forceinline__ float dppf(float x) { return __builtin_bit_cast(float, __builtin_amdgcn_mov_dpp(__builtin_bit_cast(int, x), CTRL, 0xf, 0xf, true)); }
__device__ __forceinline__ float wave_allsum(float x) {
    x += dppf<0xB1>(x); x += dppf<0x4E>(x); x += dppf<0x141>(x); x += dppf<0x128>(x);
    x += __shfl_xor(x, 16); x += __shfl_xor(x, 32);
    return x;
}
__device__ __forceinline__ void sgu_unit(const Ctx& C, int su) {
    const size_t R0 = (size_t)su * 128;
    const bf16* QK = (const bf16*)(C.ws + WS_A); bf16* MIX = (bf16*)(C.ws + WS_B); const bf16* WSP = (const bf16*)(C.ws + WS_WSP);
    { float gs[8]; const f32x4 a = *(const f32x4*)(kin(11) + 8 * C.lane), c = *(const f32x4*)(kin(11) + 8 * C.lane + 4);
        gs[0] = a.x; gs[1] = a.y; gs[2] = a.z; gs[3] = a.w; gs[4] = c.x; gs[5] = c.y; gs[6] = c.z; gs[7] = c.w;
        v4u zr[16];
#pragma unroll
        for (int rr = 0; rr < 16; ++rr) zr[rr] = *(const v4u*)(QK + (R0 + C.wave * 16 + rr) * NINE + 1280 + 8 * C.lane);
        float s1[16], s2[16];
#pragma unroll
        for (int rr = 0; rr < 16; ++rr) { float x[8]; unpack8(zr[rr], x); float a = 0.f, q = 0.f;
#pragma unroll
            for (int e = 0; e < 8; ++e) { a += x[e]; q += x[e] * x[e]; }
            s1[rr] = a; s2[rr] = q; }
#pragma unroll
        for (int rr = 0; rr < 16; ++rr) { s1[rr] = wave_allsum(s1[rr]); s2[rr] = wave_allsum(s2[rr]); }
#pragma unroll
        for (int rr = 0; rr < 16; ++rr) { const int j = C.wave * 16 + rr;
            float x[8]; unpack8(zr[rr], x);
            const float mean = s1[rr] * (1.0f / 512.0f), var = fmaxf(s2[rr] * (1.0f / 512.0f) - mean * mean, 0.f), rstd = rsqrtf(var + EPS);
#pragma unroll
            for (int e = 0; e < 8; ++e) x[e] -= mean;
            v4u w; w.x = pk2(x[0] * rstd * gs[0], x[1] * rstd * gs[1]); w.y = pk2(x[2] * rstd * gs[2], x[3] * rstd * gs[3]);
            w.z = pk2(x[4] * rstd * gs[4], x[5] * rstd * gs[5]); w.w = pk2(x[6] * rstd * gs[6], x[7] * rstd * gs[7]);
            *(LAS v4u*)(C.lds + j * ZS + 16 * C.lane) = w; }
    }
    __syncthreads();
    int ln = C.lane; asm volatile("" : "+v"(ln));
    const int h = C.wave, l31 = ln & 31, hi = ln >> 5, g16 = (ln >> 4) & 1, q4 = (ln & 15) >> 2, p4 = ln & 3;
    f32x16 acc[2][4];
#pragma unroll
    for (int cb = 0; cb < 2; ++cb)
#pragma unroll
        for (int ib = 0; ib < 4; ++ib)
#pragma unroll
            for (int r = 0; r < 16; ++r) acc[cb][ib][r] = 0.f;
    const bf16* wb[4]; const bf16* ub[4]; bf16* ob[4];
#pragma unroll
    for (int ib = 0; ib < 4; ++ib) { wb[ib] = WSP + (size_t)h * 16384 + ib * 512 + 8 * ln; ub[ib] = QK + (R0 + 32 * ib + l31) * NINE + 768 + 64 * h + 8 * hi; ob[ib] = MIX + (R0 + 32 * ib + l31) * D + 512 + 64 * h + 8 * hi;
        asm volatile("" : "+v"(wb[ib]), "+v"(ub[ib]), "+v"(ob[ib])); }
    bf16x8 bwa[2][4], bwb[2][4];
#define SG_WLOAD(dst, ks0) do { _Pragma("unroll") for (int kk = 0; kk < 2; ++kk) _Pragma("unroll") for (int ib = 0; ib < 4; ++ib) dst[kk][ib] = *(const GAS bf16x8*)(wb[ib] + 2048 * ((ks0) + kk)); } while (0)
    unsigned trb0 = C.ldsaddr + (unsigned)((8 * hi + q4) * ZS + (64 * h + 16 * g16 + 4 * p4) * 2), trb1 = trb0 + 64u * ZS;
    asm volatile("" : "+v"(trb0), "+v"(trb1));
#define SG_ONE(src, kk, ks) do { constexpr int ksl = ((ks) & 3); const unsigned tb = ((ks) < 4) ? trb0 : trb1; bf16x8 az[2]; \
        { const v2u lo = tr_read_o<16 * ksl * ZS>(tb), hi2 = tr_read_o<16 * ksl * ZS + 4 * ZS>(tb); az[0] = __builtin_bit_cast(bf16x8, (v4u){lo.x, lo.y, hi2.x, hi2.y}); } \
        { const v2u lo = tr_read_o<16 * ksl * ZS + 64>(tb), hi2 = tr_read_o<16 * ksl * ZS + 4 * ZS + 64>(tb); az[1] = __builtin_bit_cast(bf16x8, (v4u){lo.x, lo.y, hi2.x, hi2.y}); } \
        _Pragma("unroll") for (int cb = 0; cb < 2; ++cb) _Pragma("unroll") for (int ib = 0; ib < 4; ++ib) acc[cb][ib] = __builtin_amdgcn_mfma_f32_32x32x16_bf16(az[cb], src[kk][ib], acc[cb][ib], 0, 0, 0); } while (0)
#define SG_STEP(src, ks0) do { SG_ONE(src, 0, (ks0)); SG_ONE(src, 1, (ks0) + 1); } while (0)
    SG_WLOAD(bwa, 0);
    SG_WLOAD(bwb, 2); SG_STEP(bwa, 0);
    SG_WLOAD(bwa, 4); SG_STEP(bwb, 2);
    SG_WLOAD(bwb, 6); SG_STEP(bwa, 4);
    SG_STEP(bwb, 6);
#undef SG_WLOAD
#undef SG_STEP
#undef SG_ONE
    asm volatile("" ::: "memory");
    v4u uw[4][2][2]; float bias[4];
#pragma unroll
    for (int ib = 0; ib < 4; ++ib) { const int i = 32 * ib + l31; bias[ib] = kin(13)[h * 128 + i];
#pragma unroll
        for (int cb = 0; cb < 2; ++cb)
#pragma unroll
            for (int rp = 0; rp < 2; ++rp) uw[ib][cb][rp] = *(const GAS v4u*)(ub[ib] + 32 * cb + 16 * rp); }
#pragma unroll
    for (int ib = 0; ib < 4; ++ib) {
#pragma unroll
        for (int cb = 0; cb < 2; ++cb)
#pragma unroll
            for (int rp = 0; rp < 2; ++rp) { const v4u U = uw[ib][cb][rp];
                const auto ux = __builtin_amdgcn_permlane32_swap(U.x, U.z, false, false), uy = __builtin_amdgcn_permlane32_swap(U.y, U.w, false, false);
                unsigned wx[2], wy[2];
#pragma unroll
                for (int g = 0; g < 2; ++g) { const int rg = 2 * rp + g; const unsigned u0 = ux[g], u1 = uy[g];
                    const float o0 = bflo(u0) * (acc[cb][ib][4 * rg] + bias[ib]), o1 = bfhi(u0) * (acc[cb][ib][4 * rg + 1] + bias[ib]), o2 = bflo(u1) * (acc[cb][ib][4 * rg + 2] + bias[ib]), o3 = bfhi(u1) * (acc[cb][ib][4 * rg + 3] + bias[ib]);
                    wx[g] = pk2(o0, o1); wy[g] = pk2(o2, o3); }
                const auto sx = __builtin_amdgcn_permlane32_swap(wx[0], wx[1], false, false), sy = __builtin_amdgcn_permlane32_swap(wy[0], wy[1], false, false);
                v4u S; S.x = sx[0]; S.y = sy[0]; S.z = sx[1]; S.w = sy[1];
                *(GAS v4u*)(ob[ib] + 32 * cb + 16 * rp) = S; }
    }
    lds_barrier();
}
__device__ __forceinline__ void phase_attn_sgu(const Ctx& C) {
    P0_STAMP(4);
    const int natt = (BATCH * 2 * 128 - C.bid + C.G - 1) / C.G, slot = (C.bid & 3) < natt ? (C.bid & 3) : natt;
    int ai = 0;
#pragma unroll 1
#define AT_FRESH(Cx) do { int z_ = 0; asm volatile("" : "+s"(z_)); Cx.lane = (int)__builtin_amdgcn_mbcnt_hi(~0u, __builtin_amdgcn_mbcnt_lo(~0u, (unsigned)z_)); Cx.tid = Cx.wave * 64 + Cx.lane; } while (0)
    for (; ai < slot; ++ai) { Ctx Ca = C; AT_FRESH(Ca); attn_unit(Ca, C.bid + ai * C.G); }
    for (int su = C.bid; su < M / 128; su += C.G) { Ctx Ca = C; AT_FRESH(Ca); sgu_unit(Ca, su); }
#pragma unroll 1
    for (; ai < natt; ++ai) { Ctx Ca = C; AT_FRESH(Ca); attn_unit(Ca, C.bid + ai * C.G); }
#undef AT_FRESH
    P0_STAMP(5);
    P0_STAMP(6);
}
__global__ void __launch_bounds__(NWAVES * 64, 2) mk_fwd(Args args) {
    extern __shared__ __attribute__((aligned(16))) unsigned char lds_raw[];
    Ctx C;
    C.lds = (LAS unsigned char*)lds_raw; C.ldsaddr = (unsigned)(uintptr_t)C.lds;
    C.tid = threadIdx.x; C.lane = C.tid & 63; C.wave = __builtin_amdgcn_readfirstlane(C.tid >> 6);
    C.G = gridDim.x; C.bid = blockIdx.x;
    C.out = args.out; C.ws = args.ws; C.ctl = (gu32*)(args.ws + WS_CTL);
    volatile LAS unsigned* MISC = (volatile LAS unsigned*)(C.lds + MISC_OFF);
    if (C.tid < 64) MISC[C.tid] = 0u;
    __syncthreads();
#define FRESH_IDS(Cx) do { int z_ = 0; asm volatile("" : "+s"(z_)); Cx.lane = (int)__builtin_amdgcn_mbcnt_hi(~0u, __builtin_amdgcn_mbcnt_lo(~0u, (unsigned)z_)); Cx.tid = Cx.wave * 64 + Cx.lane; } while (0)
    const int lo = args.ph_lo, hi = args.ph_hi;
    const bool one = (hi - lo) > 1;
    XcdBarrier bar; bar.bar = (unsigned*)(C.ctl + CW_BAR); bar.x = 0; bar.st = nullptr;
    if (one) bar = xcd_barrier_post((unsigned*)(C.ctl + CW_BAR), MISC + 8);
#ifndef PHMASK
#define PHMASK 0x3ffff
#endif
#define IN(k) (((PHMASK >> (k)) & 1) && lo <= (k) && (k) < hi)
#define SEAM(k) do { if (IN(k) && IN((k) + 1)) { Ctx Cb = C; FRESH_IDS(Cb); xcd_barrier(bar, Cb.tid); } } while (0)
#ifndef DUPMASK
#define DUPMASK 0
#endif
#define DUP(k) DUP_##k
#if (DUPMASK >> 0) & 1
#define DUP_0 _Pragma("unroll") for (int rep_ = 0; rep_ < 2; ++rep_)
#else
#define DUP_0
#endif
#if (DUPMASK >> 1) & 1
#define DUP_1 _Pragma("unroll") for (int rep_ = 0; rep_ < 2; ++rep_)
#else
#define DUP_1
#endif
#if (DUPMASK >> 2) & 1
#define DUP_2 _Pragma("unroll") for (int rep_ = 0; rep_ < 2; ++rep_)
#else
#define DUP_2
#endif
#if (DUPMASK >> 3) & 1
#define DUP_3 _Pragma("unroll") for (int rep_ = 0; rep_ < 2; ++rep_)
#else
#define DUP_3
#endif
#if (DUPMASK >> 4) & 1
#define DUP_4 _Pragma("unroll") for (int rep_ = 0; rep_ < 2; ++rep_)
#else
#define DUP_4
#endif
#if (DUPMASK >> 5) & 1
#define DUP_5 _Pragma("unroll") for (int rep_ = 0; rep_ < 2; ++rep_)
#else
#define DUP_5
#endif
#if (DUPMASK >> 6) & 1
#define DUP_6 _Pragma("unroll") for (int rep_ = 0; rep_ < 2; ++rep_)
#else
#define DUP_6
#endif
#if (DUPMASK >> 7) & 1
#define DUP_7 _Pragma("unroll") for (int rep_ = 0; rep_ < 2; ++rep_)
#else
#define DUP_7
#endif
#if (DUPMASK >> 8) & 1
#define DUP_8 _Pragma("unroll") for (int rep_ = 0; rep_ < 2; ++rep_)
#else
#define DUP_8
#endif
#if (DUPMASK >> 9) & 1
#define DUP_9 _Pragma("unroll") for (int rep_ = 0; rep_ < 2; ++rep_)
#else
#define DUP_9
#endif
#if (DUPMASK >> 10) & 1
#define DUP_10 _Pragma("unroll") for (int rep_ = 0; rep_ < 2; ++rep_)
#else
#define DUP_10
#endif
#if (DUPMASK >> 11) & 1
#define DUP_11 _Pragma("unroll") for (int rep_ = 0; rep_ < 2; ++rep_)
#else
#define DUP_11
#endif
#if (DUPMASK >> 12) & 1
#define DUP_12 _Pragma("unroll") for (int rep_ = 0; rep_ < 2; ++rep_)
#else
#define DUP_12
#endif
#if (DUPMASK >> 13) & 1
#define DUP_13 _Pragma("unroll") for (int rep_ = 0; rep_ < 2; ++rep_)
#else
#define DUP_13
#endif
#if (DUPMASK >> 14) & 1
#define DUP_14 _Pragma("unroll") for (int rep_ = 0; rep_ < 2; ++rep_)
#else
#define DUP_14
#endif
#if (DUPMASK >> 15) & 1
#define DUP_15 _Pragma("unroll") for (int rep_ = 0; rep_ < 2; ++rep_)
#else
#define DUP_15
#endif
#if (DUPMASK >> 16) & 1
#define DUP_16 _Pragma("unroll") for (int rep_ = 0; rep_ < 2; ++rep_)
#else
#define DUP_16
#endif
#if (DUPMASK >> 17) & 1
#define DUP_17 _Pragma("unroll") for (int rep_ = 0; rep_ < 2; ++rep_)
#else
#define DUP_17
#endif
    bf16* const H = (bf16*)(C.ws + WS_H); bf16* const RA = (bf16*)(C.ws + WS_A); bf16* const RB = (bf16*)(C.ws + WS_B);
    const float* const MOD = (const float*)(C.ws + WS_MOD);

#if defined(TPROBE)
    unsigned long long tp_t = 0ull, tp_acc = 0ull; const bool tp_on = (C.bid == 0 && C.wave == 0);
    constexpr int TW[18] = {TPROBE};
#define TSTART() do { if (tp_on) tp_t = __builtin_amdgcn_s_memrealtime(); } while (0)
#define TEND(k) do { if (tp_on) { const unsigned long long n_ = __builtin_amdgcn_s_memrealtime(); tp_acc += (unsigned long long)TW[k] * (n_ - tp_t); tp_t = n_; } } while (0)
#else
#define TSTART() do { } while (0)
#define TEND(k) do { } while (0)
#endif
    TSTART();
    DUP(0) { if (IN(0)) { Ctx Cp = C; FRESH_IDS(Cp); p0_prologue(Cp); } SEAM(0); TEND(0); }
    DUP(1) { if (IN(1)) { Ctx Cp = C; FRESH_IDS(Cp); phase_norm1_l0(Cp); } SEAM(1); TEND(1); }
    DUP(2) { if (IN(2)) { Ctx Cp = C; FRESH_IDS(Cp);
        pg8::Gemm g{H, (const bf16*)(Cp.ws + WS_WINE), M, NINE, D / 2}; pg8::InEOrder S; S.so.init(M, NINE, Cp.G, Cp.bid); S.G = Cp.G; S.c = Cp.bid;
        pg8::EpiInE8 E{RA, (bf16*)(Cp.ws + WS_VT), (bf16*)(Cp.ws + WS_KC), (bf16*)(Cp.ws + WS_VCT), (const float*)(Cp.ws + WS_ROPE), (const float*)(Cp.ws + WS_ROPE) + 2048, QSCALE, (const float*)(Cp.ws + WS_RSC), (const float*)(Cp.ws + WS_CSC2) + 4096};
        pg8::gemm_phase<pg8::EpiInE8, pg8::InEOrder, true, true>(Cp.lds, g, S, E, Cp.tid);
        { const int nmax = (900 + Cp.G - 1) / Cp.G, nfull = 900 - (nmax - 1) * Cp.G;
            if (nmax > 1 && Cp.bid >= nfull) wd1_items(Cp, Cp.bid - nfull, Cp.G - nfull);
            else if (nmax == 1 || nfull >= Cp.G) wd1_items(Cp, Cp.bid, Cp.G); }
    } SEAM(2); TEND(2); }
    DUP(3) { if (IN(3)) { Ctx Cp = C; FRESH_IDS(Cp); phase_attn_sgu(Cp); } SEAM(3); TEND(3); }
    DUP(4) { if (IN(4)) { Ctx Cp = C; FRESH_IDS(Cp);
        pg8::Gemm g{RB, (const bf16*)(Cp.ws + WS_WOUTE), M, D, D}; pg8::StaticOrder S; S.init(M, D, Cp.G, Cp.bid);
        pg8::EpiRes E{kin(0), (bf16*)(Cp.ws + WS_LAT), MOD + 2 * 1024, (float*)(Cp.ws + WS_RSS)};
        pg8::gemm_phase<pg8::EpiRes, pg8::StaticOrder, true, true>(Cp.lds, g, S, E, Cp.tid);
    } SEAM(4); TEND(4); }
    DUP(5) { if (IN(5)) { Ctx Cp = C; FRESH_IDS(Cp); phase_router(Cp, 0); } SEAM(5); TEND(5); }
    TEND(6);
    DUP(7) { if (IN(7)) { Ctx Cp = C; FRESH_IDS(Cp);
        const int nt = moe_tables(Cp, 0);
        pg8::Gemm g{H, (const bf16*)(Cp.ws + WS_WGU), nt * 256, NEXP * 1024, D / 2}; pg8::MoeGatherOrder S{(const LAS int*)(Cp.lds + MOE_TAB_OFF), nt, Cp.G, Cp.bid, (const LAS unsigned*)(Cp.lds + MOE_GTAB_OFF)};
        moe_gather_tables(Cp, S);
        pg8::EpiSwiGLU8 E{(unsigned char*)RB, (const LAS float*)(Cp.lds + MOE_RTAB_OFF), (const float*)(Cp.ws + WS_CSC)};
        pg8::gemm_phase<pg8::EpiSwiGLU8, pg8::MoeGatherOrder, true, true>(Cp.lds, g, S, E, Cp.tid);
        quant_strips_q(Cp, Cp.ctl + CW_Q0, 704, 1024, 128, 2048);
    } SEAM(7); TEND(7); }
    DUP(8) { if (IN(8)) { Ctx Cp = C; FRESH_IDS(Cp);
        const int nt = moe_tables(Cp, 0);
        pg8::Gemm g{RB, (const bf16*)(Cp.ws + WS_WD), nt * 256, NEXP * 1024, EH / 2}; pg8::MoeOrder S{(const LAS int*)(Cp.lds + MOE_TAB_OFF), nt, Cp.G, Cp.bid, nullptr};
        pg8::EpiDown E{(unsigned char*)RA, (const float*)(Cp.ws + WS_CSD)};
        pg8::gemm_phase<pg8::EpiDown, pg8::MoeOrder, true, true>(Cp.lds, g, S, E, Cp.tid);
        quant_strips_q(Cp, Cp.ctl + CW_Q1, 320, 1728, 0, 0);
    } SEAM(8); TEND(8); }
    DUP(9) { if (IN(9)) { Ctx Cp = C; FRESH_IDS(Cp); phase_combine<false>(Cp, 0); } SEAM(9); TEND(9); }
    DUP(10) { if (IN(10)) { Ctx Cp = C; FRESH_IDS(Cp);
        pg8::Gemm g{H, (const bf16*)(Cp.ws + WS_WINO), M, 3072, D / 2}; pg8::StaticOrder S; S.init(M, 3072, Cp.G, Cp.bid);
        pg8::EpiInO8 E{RA, RA + (size_t)M * D, (const float*)(Cp.ws + WS_RSC), (const float*)(Cp.ws + WS_CSC2)};
        pg8::gemm_phase<pg8::EpiInO8, pg8::StaticOrder, true, true>(Cp.lds, g, S, E, Cp.tid);
    } SEAM(10); TEND(10); }
    DUP(11) { if (IN(11)) { Ctx Cp = C; FRESH_IDS(Cp); phase_conv(Cp); } SEAM(11); TEND(11); }
    DUP(12) { if (IN(12)) { Ctx Cp = C; FRESH_IDS(Cp);
        pg8::Gemm g{RB, (const bf16*)(Cp.ws + WS_WOUTO), M, D, D / 2}; pg8::StaticOrder S; S.init(M, D, Cp.G, Cp.bid);
        pg8::EpiRes8 E{(bf16*)(Cp.ws + WS_LAT), MOD + (size_t)4 * 6144 + 2 * 1024, (float*)(Cp.ws + WS_RSS), (const float*)(Cp.ws + WS_RSC), (const float*)(Cp.ws + WS_CSC2) + 3072};
        pg8::gemm_phase<pg8::EpiRes8, pg8::StaticOrder, true, true>(Cp.lds, g, S, E, Cp.tid);
    } SEAM(12); TEND(12); }
    DUP(13) { if (IN(13)) { Ctx Cp = C; FRESH_IDS(Cp); phase_router(Cp, 1); } SEAM(13); TEND(13); }
    TEND(14);
    DUP(15) { if (IN(15)) { Ctx Cp = C; FRESH_IDS(Cp);
        const int nt = moe_tables(Cp, 1);
        pg8::Gemm g{H, (const bf16*)(Cp.ws + WS_WGU + (size_t)NEXP * 1024 * 1024), nt * 256, NEXP * 1024, D / 2}; pg8::MoeGatherOrder S{(const LAS int*)(Cp.lds + MOE_TAB_OFF), nt, Cp.G, Cp.bid, (const LAS unsigned*)(Cp.lds + MOE_GTAB_OFF)};
        moe_gather_tables(Cp, S);
        pg8::EpiSwiGLU8 E{(unsigned char*)RB, (const LAS float*)(Cp.lds + MOE_RTAB_OFF), (const float*)(Cp.ws + WS_CSC) + (size_t)NEXP * 1024};
        pg8::gemm_phase<pg8::EpiSwiGLU8, pg8::MoeGatherOrder, true, true>(Cp.lds, g, S, E, Cp.tid);
    } SEAM(15); TEND(15); }
    DUP(16) { if (IN(16)) { Ctx Cp = C; FRESH_IDS(Cp);
        const int nt = moe_tables(Cp, 1);
        pg8::Gemm g{RB, (const bf16*)(Cp.ws + WS_WD + (size_t)NEXP * 1024 * 512), nt * 256, NEXP * 1024, EH / 2}; pg8::MoeOrder S{(const LAS int*)(Cp.lds + MOE_TAB_OFF), nt, Cp.G, Cp.bid, nullptr};
        pg8::EpiDown E{(unsigned char*)RA, (const float*)(Cp.ws + WS_CSD) + (size_t)NEXP * 1024};
        pg8::gemm_phase<pg8::EpiDown, pg8::MoeOrder, true, true>(Cp.lds, g, S, E, Cp.tid);
    } SEAM(16); TEND(16); }
    DUP(17) { if (IN(17)) { Ctx Cp = C; FRESH_IDS(Cp); phase_combine<true>(Cp, 1); } TEND(17); }
#if defined(TPROBE_P0)
    if (tp_on) { constexpr int PW[5] = {TPROBE_P0}; volatile LAS unsigned long long* st_ = (volatile LAS unsigned long long*)(C.lds + MISC_OFF + 128);
        for (int i = 0; i < 3; ++i) tp_acc += (unsigned long long)PW[i] * (st_[i + 1] - st_[i]);
        tp_acc += (unsigned long long)PW[3] * (st_[5] - st_[4]) + (unsigned long long)PW[4] * (st_[6] - st_[5]);
#if defined(TPROBE_P0MAX)
        tp_acc += 4ull * (unsigned long long)__hip_atomic_load(C.ctl + TPROBE_P0MAX, RLX_AGENT);
#endif
    }
#endif
#if defined(TPROBE)
    if (tp_on) { const unsigned long long t0_ = __builtin_amdgcn_s_memrealtime(); while (__builtin_amdgcn_s_memrealtime() - t0_ < tp_acc) __builtin_amdgcn_s_sleep(8); }
#endif
#undef IN
#undef SEAM
}

extern "C" void kernel_launch(void* const* d_in, const int* in_sizes, int n_in, void* d_out, int out_size, void* d_ws, size_t ws_size, hipStream_t stream) {
    static int grid = 0;
    if (grid == 0) {
        if (n_in != 25 || in_sizes[0] != M * D || out_size != M * D || ws_size < WS_END) { fprintf(stderr, "kernel_launch: unexpected shapes (n_in %d, in0 %d, out %d, ws %zu)\n", n_in, n_in > 0 ? in_sizes[0] : -1, out_size, ws_size); grid = -1; return; }
        int dev = 0, cus = 0, per_cu = 0;
        if (hipGetDevice(&dev) != hipSuccess || hipDeviceGetAttribute(&cus, hipDeviceAttributeMultiprocessorCount, dev) != hipSuccess) { grid = -1; return; }
        if (hipFuncSetAttribute((const void*)mk_fwd, hipFuncAttributeMaxDynamicSharedMemorySize, LDS_BYTES) != hipSuccess) { fprintf(stderr, "kernel_launch: hipFuncSetAttribute failed\n"); grid = -1; return; }
        if (hipOccupancyMaxActiveBlocksPerMultiprocessor(&per_cu, (const void*)mk_fwd, NWAVES * 64, LDS_BYTES) != hipSuccess || per_cu < 1) { fprintf(stderr, "kernel_launch: occupancy query says %d\n", per_cu); }
        (void)hipGetLastError();
        grid = cus;
    }
    if (grid < 0) return;
    if (hipMemsetAsync((char*)d_ws + WS_CTL, 0, CTL_ZERO_BYTES, stream) != hipSuccess) return;
    Args a{};
    for (int i = 0; i < 25; ++i) a.in[i] = (const float*)d_in[i];
    a.out = (float*)d_out; a.ws = (unsigned char*)d_ws;
#if defined(PROBE_K)
    a.ph_lo = 0; a.ph_hi = PROBE_K + 1; hipLaunchKernelGGL(mk_fwd, dim3(grid), dim3(NWAVES * 64), LDS_BYTES, stream, a);
    (void)hipMemsetAsync((char*)d_ws + WS_CTL, 0, (PROBE_K == 5 || PROBE_K == 13) ? CTL_ZERO_BYTES : (size_t)4 * CW_GCNT, stream);
    a.ph_lo = PROBE_K; a.ph_hi = PROBE_K + 1; hipLaunchKernelGGL(mk_fwd, dim3(grid), dim3(NWAVES * 64), LDS_BYTES, stream, a);
    (void)hipMemsetAsync((char*)d_ws + WS_CTL, 0, 4 * CW_GCNT, stream);
    if (PROBE_K + 1 < N_PHASES) { a.ph_lo = PROBE_K + 1; a.ph_hi = N_PHASES; hipLaunchKernelGGL(mk_fwd, dim3(grid), dim3(NWAVES * 64), LDS_BYTES, stream, a); }
#elif MK_ONE_LAUNCH
    a.ph_lo = 0; a.ph_hi = N_PHASES;
    hipLaunchKernelGGL(mk_fwd, dim3(grid), dim3(NWAVES * 64), LDS_BYTES, stream, a);
#else
    for (int p = 0; p < N_PHASES; ++p) { a.ph_lo = p; a.ph_hi = p + 1; hipLaunchKernelGGL(mk_fwd, dim3(grid), dim3(NWAVES * 64), LDS_BYTES, stream, a); }
#endif
}
```
